# Optimizing an MI355X kernel written in HIP

```python
import math
import jax, jax.numpy as jnp
from jax import lax
import numpy as np

D_MODEL = 1024
BATCH = 8
SEQ = 2048
DEPTH = 4

CTX_LEN = 256
GRID_W = 64
LAYER_KINDS = ('attn', 'lru', 'conv')
N_MIXERS = len(LAYER_KINDS)
EPS = 1e-6
NEG_INF = -1e30
N_HEADS = 16
N_KV_HEADS = 4
HEAD_DIM = D_MODEL // N_HEADS
Q_DIM = N_HEADS * HEAD_DIM
KV_DIM = N_KV_HEADS * HEAD_DIM
WINDOW = 128
ROPE_BASE = 10000.0
LRU_WIDTH = D_MODEL
LRU_BLOCKS = 16
LRU_BLOCK = LRU_WIDTH // LRU_BLOCKS
LRU_C = 8.0
LRU_CONV = 4
CONV_WIDTH = D_MODEL
CONV_K = 3

kernel_name = 'hybrid_interleaved_dit_backbone'


def rmsnorm(x, g):
    xf = x.astype(jnp.float32)
    y = xf * lax.rsqrt(jnp.mean(xf * xf, axis=-1, keepdims=True) + EPS)
    return (y * g.astype(jnp.float32)).astype(x.dtype)


def modulation(cvec, w, b):
    m = jax.nn.silu(cvec) @ w + b
    return jnp.split(m, 3, axis=-1)


def axial_rope_tables(n_tokens):
    rows = n_tokens // GRID_W
    row = jnp.repeat(jnp.arange(rows), GRID_W).astype(jnp.float32)
    col = jnp.tile(jnp.arange(GRID_W), rows).astype(jnp.float32)
    half = HEAD_DIM // 2
    inv = 1.0 / (ROPE_BASE ** (jnp.arange(0, half, 2, dtype=jnp.float32) / half))
    ang = jnp.stack([row[:, None] * inv, col[:, None] * inv], axis=1)
    return jnp.cos(ang), jnp.sin(ang)


def apply_rope(x, cos, sin):
    shp = x.shape
    xr = x.astype(jnp.float32).reshape(shp[0], shp[1], -1, 2, 2, HEAD_DIM // 4)
    x1, x2 = xr[..., 0, :], xr[..., 1, :]
    c = cos[None, :, None]
    s = sin[None, :, None]
    out = jnp.stack([x1 * c - x2 * s, x2 * c + x1 * s], axis=-2)
    return out.reshape(shp).astype(x.dtype)


def dwconv(u, w, pad):
    C = u.shape[-1]
    return lax.conv_general_dilated(u, w[:, None, :].astype(u.dtype), window_strides=(1,),
                                    padding=[pad], dimension_numbers=('NWC', 'WIO', 'NWC'),
                                    feature_group_count=C)


def linear_scan(a, b):
    def comb(l, r):
        return l[0] * r[0], r[0] * l[1] + r[1]
    return lax.associative_scan(comb, (a, b), axis=1)[1]


def attn_mixer(hl, hc, w_in, w_out, sink, cos, sin, need_ctx):
    B, L, _ = hl.shape
    n_ctx = hc.shape[1]
    nb = L // WINDOW
    G = N_HEADS // N_KV_HEADS
    scale = HEAD_DIM ** -0.5
    q, k, v, g = jnp.split(hl @ w_in, [Q_DIM, Q_DIM + KV_DIM, Q_DIM + 2 * KV_DIM], axis=-1)
    q = apply_rope(q.reshape(B, L, N_KV_HEADS, G, HEAD_DIM), cos, sin) * scale
    k = apply_rope(k.reshape(B, L, N_KV_HEADS, HEAD_DIM), cos, sin)
    v = v.reshape(B, L, N_KV_HEADS, HEAD_DIM)
    kc, vc = jnp.split(hc @ w_in[:, Q_DIM:Q_DIM + 2 * KV_DIM], 2, axis=-1)
    kc = kc.reshape(B, n_ctx, N_KV_HEADS, HEAD_DIM)
    vc = vc.reshape(B, n_ctx, N_KV_HEADS, HEAD_DIM)
    sink_f = sink.astype(jnp.float32).reshape(N_KV_HEADS, G, 1, 1)

    def band(t):
        tp = jnp.pad(t, ((0, 0), (WINDOW, WINDOW), (0, 0), (0, 0)))
        tp = tp.reshape(B, nb + 2, WINDOW, N_KV_HEADS, HEAD_DIM)
        return jnp.concatenate([tp[:, :-2], tp[:, 1:-1], tp[:, 2:]], axis=2)

    kb, vb = band(k), band(v)
    qb = q.reshape(B, nb, WINDOW, N_KV_HEADS, G, HEAD_DIM)
    s_band = jnp.einsum('bnqkgd,bnskd->bnkgqs', qb, kb).astype(jnp.float32)
    qrel = jnp.arange(WINDOW)[:, None] + WINDOW
    srel = jnp.arange(3 * WINDOW)[None, :]
    kabs = jnp.arange(nb)[:, None, None] * WINDOW - WINDOW + srel[None]
    mask = (jnp.abs(qrel - srel) <= WINDOW)[None] & (kabs >= 0) & (kabs < L)
    s_band = jnp.where(mask[None, :, None, None], s_band, NEG_INF)
    s_ctx = jnp.einsum('bnqkgd,bckd->bnkgqc', qb, kc).astype(jnp.float32)
    m = jnp.maximum(jnp.maximum(s_band.max(-1, keepdims=True), s_ctx.max(-1, keepdims=True)), sink_f)
    e_band = jnp.exp(s_band - m)
    e_ctx = jnp.exp(s_ctx - m)
    denom = e_band.sum(-1, keepdims=True) + e_ctx.sum(-1, keepdims=True) + jnp.exp(sink_f - m)
    o = (jnp.einsum('bnkgqs,bnskd->bnqkgd', (e_band / denom).astype(v.dtype), vb)
         + jnp.einsum('bnkgqc,bckd->bnqkgd', (e_ctx / denom).astype(v.dtype), vc))
    yl = (o.reshape(B, L, Q_DIM) * jax.nn.silu(g)) @ w_out
    if not need_ctx:
        return yl, None
    qc = (hc @ w_in[:, :Q_DIM]).reshape(B, n_ctx, N_KV_HEADS, G, HEAD_DIM) * scale
    gc = hc @ w_in[:, Q_DIM + 2 * KV_DIM:]
    s = jnp.einsum('bqkgd,bckd->bkgqc', qc, kc).astype(jnp.float32)
    mc = jnp.maximum(s.max(-1, keepdims=True), sink_f)
    e = jnp.exp(s - mc)
    p = e / (e.sum(-1, keepdims=True) + jnp.exp(sink_f - mc))
    oc = jnp.einsum('bkgqc,bckd->bqkgd', p.astype(vc.dtype), vc)
    yc = (oc.reshape(B, n_ctx, Q_DIM) * jax.nn.silu(gc)) @ w_out
    return yl, yc


def rglru_direction(uc, ul, conv_w, conv_b, wa, ba, wx, bx, lam):
    def gates(xs):
        B, n, _ = xs.shape
        xb = xs.reshape(B, n, LRU_BLOCKS, LRU_BLOCK)
        r = jax.nn.sigmoid(jnp.einsum('bnhi,hij->bnhj', xb, wa).reshape(B, n, LRU_WIDTH) + ba)
        i = jax.nn.sigmoid(jnp.einsum('bnhi,hij->bnhj', xb, wx).reshape(B, n, LRU_WIDTH) + bx)
        log_a = -LRU_C * r.astype(jnp.float32) * jax.nn.softplus(-lam.astype(jnp.float32))
        a = jnp.exp(log_a)
        b = jnp.sqrt(-jnp.expm1(2.0 * log_a)) * (i * xs).astype(jnp.float32)
        return a, b

    xc = dwconv(uc, conv_w, (LRU_CONV - 1, 0)) + conv_b
    xl = dwconv(ul, conv_w, (LRU_CONV - 1, 0)) + conv_b
    ac, bc = gates(xc)
    hc = linear_scan(ac, bc)
    al, bl = gates(xl)
    bl = bl.at[:, 0].add(al[:, 0] * hc[:, -1])
    hl = linear_scan(al, bl)
    return hc, hl


def lru_mixer(hl, hc, w_in, w_out, conv_w, conv_b, gate_a_w, gate_a_b, gate_x_w, gate_x_b, lam, need_ctx):
    ul, gl = jnp.split(hl @ w_in, 2, axis=-1)
    if need_ctx:
        uc, gc = jnp.split(hc @ w_in, 2, axis=-1)
    else:
        uc = hc @ w_in[:, :LRU_WIDTH]
    hc_f, hl_f = rglru_direction(uc, ul, conv_w[0], conv_b[0], gate_a_w[0], gate_a_b[0],
                                 gate_x_w[0], gate_x_b[0], lam[0])
    hc_b, hl_b = rglru_direction(jnp.flip(uc, 1), jnp.flip(ul, 1), conv_w[1], conv_b[1], gate_a_w[1],
                                 gate_a_b[1], gate_x_w[1], gate_x_b[1], lam[1])
    yl = ((hl_f + jnp.flip(hl_b, 1)).astype(hl.dtype) * jax.nn.silu(gl)) @ w_out
    if not need_ctx:
        return yl, None
    yc = ((hc_f + jnp.flip(hc_b, 1)).astype(hc.dtype) * jax.nn.silu(gc)) @ w_out
    return yl, yc


def short_conv_branch(h, w_in, w_out, conv_w, conv_b):
    u, bg, cg, g = jnp.split(h @ w_in, 4, axis=-1)
    y = bg * (dwconv(cg * u, conv_w, (CONV_K // 2, CONV_K // 2)) + conv_b)
    return (y * jax.nn.silu(g)) @ w_out


def conv_mixer(hl, hc, w_in, w_out, conv_w, conv_b, need_ctx):
    yl = short_conv_branch(hl, w_in, w_out, conv_w, conv_b)
    yc = short_conv_branch(hc, w_in, w_out, conv_w, conv_b) if need_ctx else None
    return yl, yc


def setup_inputs(seed: int = 0) -> dict:
    key = jax.random.key(seed)
    keys = iter(jax.random.split(key, 128))
    D = D_MODEL

    def normal(shape, std):
        return jax.random.normal(next(keys), shape, jnp.float32) * std

    p = {
        'x': normal((BATCH, SEQ, D), 1.0),
        'c': normal((BATCH, D), 1.0),
        'ctx': normal((BATCH, CTX_LEN, D), 1.0),
        'c_ctx': normal((D,), 1.0),
    }
    for i in range(DEPTH):
        kind = LAYER_KINDS[i % N_MIXERS]
        pre = 'l%d_' % i
        p[pre + 'norm_g'] = 1.0 + normal((D,), 0.02)
        p[pre + 'mod_w'] = normal((D, 3 * D), 0.5 * D ** -0.5)
        p[pre + 'mod_b'] = normal((3 * D,), 0.02)
        if kind == 'attn':
            p[pre + 'w_in'] = normal((D, 2 * Q_DIM + 2 * KV_DIM), D ** -0.5)
            p[pre + 'w_out'] = normal((Q_DIM, D), Q_DIM ** -0.5)
            p[pre + 'sink'] = normal((N_HEADS,), 0.5)
        elif kind == 'lru':
            p[pre + 'w_in'] = normal((D, 2 * LRU_WIDTH), D ** -0.5)
            p[pre + 'w_out'] = normal((LRU_WIDTH, D), LRU_WIDTH ** -0.5)
            p[pre + 'conv_w'] = normal((2, LRU_CONV, LRU_WIDTH), LRU_CONV ** -0.5)
            p[pre + 'conv_b'] = normal((2, LRU_WIDTH), 0.02)
            p[pre + 'gate_a_w'] = normal((2, LRU_BLOCKS, LRU_BLOCK, LRU_BLOCK), LRU_BLOCK ** -0.5)
            p[pre + 'gate_a_b'] = normal((2, LRU_WIDTH), 0.02)
            p[pre + 'gate_x_w'] = normal((2, LRU_BLOCKS, LRU_BLOCK, LRU_BLOCK), LRU_BLOCK ** -0.5)
            p[pre + 'gate_x_b'] = normal((2, LRU_WIDTH), 0.02)
            u = jax.random.uniform(next(keys), (2, LRU_WIDTH), jnp.float32, minval=0.9, maxval=0.999)
            s = u ** (1.0 / LRU_C)
            p[pre + 'lambda'] = jnp.log(s) - jnp.log1p(-s)
        else:
            p[pre + 'w_in'] = normal((D, 4 * CONV_WIDTH), D ** -0.5)
            p[pre + 'w_out'] = normal((CONV_WIDTH, D), CONV_WIDTH ** -0.5)
            p[pre + 'conv_w'] = normal((CONV_K, CONV_WIDTH), CONV_K ** -0.5)
            p[pre + 'conv_b'] = normal((CONV_WIDTH,), 0.02)
    p['final_norm_g'] = 1.0 + normal((D,), 0.02)
    return p


def reference(x, c, ctx, c_ctx,
              l0_norm_g, l0_mod_w, l0_mod_b, l0_w_in, l0_w_out, l0_sink,
              l1_norm_g, l1_mod_w, l1_mod_b, l1_w_in, l1_w_out, l1_conv_w, l1_conv_b,
              l1_gate_a_w, l1_gate_a_b, l1_gate_x_w, l1_gate_x_b, l1_lambda,
              l2_norm_g, l2_mod_w, l2_mod_b, l2_w_in, l2_w_out, l2_conv_w, l2_conv_b,
              l3_norm_g, l3_mod_w, l3_mod_b, l3_w_in, l3_w_out, l3_sink,
              final_norm_g):
    layers = [
        (l0_norm_g, l0_mod_w, l0_mod_b, (l0_w_in, l0_w_out, l0_sink)),
        (l1_norm_g, l1_mod_w, l1_mod_b, (l1_w_in, l1_w_out, l1_conv_w, l1_conv_b, l1_gate_a_w,
                                         l1_gate_a_b, l1_gate_x_w, l1_gate_x_b, l1_lambda)),
        (l2_norm_g, l2_mod_w, l2_mod_b, (l2_w_in, l2_w_out, l2_conv_w, l2_conv_b)),
        (l3_norm_g, l3_mod_w, l3_mod_b, (l3_w_in, l3_w_out, l3_sink)),
    ]
    cos, sin = axial_rope_tables(x.shape[1])
    xl, xc = x, ctx
    for i in range(DEPTH):
        norm_g, mod_w, mod_b, mp = layers[i]
        kind = LAYER_KINDS[i % N_MIXERS]
        need_ctx = i < DEPTH - 1
        shift, scale, gate = modulation(c, mod_w, mod_b)
        shift_c, scale_c, gate_c = modulation(c_ctx, mod_w, mod_b)
        hl = rmsnorm(xl, norm_g) * (1.0 + scale[:, None]) + shift[:, None]
        hc = rmsnorm(xc, norm_g) * (1.0 + scale_c) + shift_c
        if kind == 'attn':
            yl, yc = attn_mixer(hl, hc, *mp, cos, sin, need_ctx)
        elif kind == 'lru':
            yl, yc = lru_mixer(hl, hc, *mp, need_ctx)
        else:
            yl, yc = conv_mixer(hl, hc, *mp, need_ctx)
        xl = xl + gate[:, None] * yl
        if need_ctx:
            xc = xc + gate_c * yc
    return rmsnorm(xl, final_norm_g)
```

```cpp
#include <hip/hip_runtime.h>
#include <hip/hip_cooperative_groups.h>
#include <cstdio>
#include <cstdint>
namespace cg = cooperative_groups;

namespace pg8 {
#define PG8_LAS __attribute__((address_space(3)))
typedef unsigned short bf16_t;
typedef short bf16x8 __attribute__((ext_vector_type(8)));
typedef float f32x4 __attribute__((ext_vector_type(4)));
typedef unsigned u32x4 __attribute__((ext_vector_type(4)));
constexpr int BM = 256, BK = 64, HALF = 128, HTB = HALF * BK * 2  , STAGE_BYTES = 8 * HTB, NXCD = 8, WGM = 8;

__host__ __device__ __forceinline__ int lds_byte(int r, int c) { const int st = (r >> 4) * 2 + (c >> 5), rr = r & 15, cc = c & 31, ob = rr * 64 + cc * 2; return st * 1024 + (ob ^ (((ob >> 9) & 1) << 5)); }
__host__ __device__ __forceinline__ void stage_rc(int b, int& R, int& C) { const int st = b / 1024, sb = b % 1024, swz = sb ^ (((sb >> 9) & 1) << 5); R = (st >> 1) * 16 + swz / 64; C = (st & 1) * 32 + (swz % 64) / 2; }
__host__ __device__ __forceinline__ int perm32(int rho) { const int n = rho >> 4, i = rho & 15; return 8 * (i >> 2) + 4 * n + (i & 3); }

struct Unit { int pm, pn; };
struct Gemm { const bf16_t* A; const bf16_t* Bt; int M, N, K; };

struct StaticOrder {
    int nM, nN, nwg, G, c;
    __host__ __device__ void init(int M, int N, int G_, int c_) { nM = M / BM; nN = N / BM; nwg = nM * nN; G = G_; c = c_; }
    __host__ __device__ bool next(int i, Unit& u) const {
        const long L = (long)i * G + c; if (L >= nwg) return false;
        int wgid = (int)L; { const int q = nwg / NXCD, r = nwg % NXCD, xcd = wgid % NXCD, off = wgid / NXCD; wgid = (xcd < r ? xcd * (q + 1) : r * (q + 1) + (xcd - r) * q) + off; }
        const int nig = WGM * nN, gid = wgid / nig, fm = gid * WGM, gsz = (nM - fm) < WGM ? (nM - fm) : WGM;
        u.pm = fm + ((wgid % nig) % gsz); u.pn = (wgid % nig) / gsz; return true;
    }
    __device__ __forceinline__ void a_ready(const Unit&) const {}
    __device__ __forceinline__ void done(const Unit&) const {}
};

__device__ __forceinline__ unsigned cvt_pk_bf16(float lo, float hi) { unsigned r; asm volatile("v_cvt_pk_bf16_f32 %0, %1, %2" : "=v"(r) : "v"(lo), "v"(hi)); return r; }
typedef float f32x2 __attribute__((ext_vector_type(2)));
__device__ __forceinline__ float silu_f(float v) { return v * __builtin_amdgcn_rcpf(1.0f + __builtin_amdgcn_exp2f(-v * 1.4426950408889634f)); }
constexpr float QSCALE = 0.125f * 1.4426950408889634f;

struct OrderG {
    StaticOrder so; int extra;
    __device__ __forceinline__ bool next(int i, Unit& u) const {
        long L = (long)i * so.G + so.c; if (L < so.nwg) return so.next(i, u);
        L -= so.nwg; if (L >= extra) return false; u.pm = 64 + (int)(L >> 1); u.pn = 4 + (int)(L & 1); return true;
    }
    __device__ __forceinline__ void a_ready(const Unit&) const {}
    __device__ __forceinline__ void done(const Unit&) const {}
};

struct EpiIn {
    static constexpr bool PERM = true, AFTER_DRAIN = false;
    bf16_t* O; int ldc; int kind; const float* rope;
    __device__ __forceinline__ void operator()(const f32x4 (&acc)[2][2][4][2], const Unit& u, int wr, int wc, int fr, int fq) const {
        const int colt = u.pn * BM; const bool lat = u.pm < 64;
        int mode = 0; float sc = 1.f;
        if (kind == 0) { if (colt < 1024) { mode = lat ? 2 : 0; sc = QSCALE; } else if (colt < 1280) mode = lat ? 2 : 0; else if (colt < 1536) mode = 0; else mode = 1; }
        else if (kind == 1) mode = colt < 1024 ? 0 : 1;
        else mode = colt < 3072 ? 0 : 1;
        const int row0 = u.pm * BM + wr * 64 + fr; const int col0 = colt + wc * 32 + 8 * fq;
        const float sgn = (fq < 2) ? -1.f : 1.f;
#pragma unroll
        for (int ai = 0; ai < 2; ++ai)
#pragma unroll
            for (int m = 0; m < 4; ++m) {
                const int row = row0 + ai * HALF + m * 16;
                bf16_t* rowp = O + (size_t)row * ldc + col0;
                f32x4 cs[4];
                if (mode == 2) { const int l = row & 2047; const int p = (wc & 1) ? (l & 63) : (l >> 6); const f32x4* rp = (const f32x4*)(rope + (p * 16 + 8 * (fq & 1)) * 2);
                    cs[0] = rp[0]; cs[1] = rp[1]; cs[2] = rp[2]; cs[3] = rp[3]; }
#pragma unroll
                for (int bj = 0; bj < 2; ++bj) {
                    f32x4 v0 = acc[ai][bj][m][0], v1 = acc[ai][bj][m][1];
                    if (mode == 1) {
#pragma unroll
                        for (int e = 0; e < 4; ++e) { v0[e] = silu_f(v0[e]); v1[e] = silu_f(v1[e]); }
                    } else if (mode == 2) {
                        f32x4 p0, p1;
#pragma unroll
                        for (int e = 0; e < 4; ++e) { p0[e] = __shfl_xor(v0[e], 32); p1[e] = __shfl_xor(v1[e], 32); }
                        v0[0] = v0[0] * cs[0][0] + sgn * p0[0] * cs[0][1]; v0[1] = v0[1] * cs[0][2] + sgn * p0[1] * cs[0][3];
                        v0[2] = v0[2] * cs[1][0] + sgn * p0[2] * cs[1][1]; v0[3] = v0[3] * cs[1][2] + sgn * p0[3] * cs[1][3];
                        v1[0] = v1[0] * cs[2][0] + sgn * p1[0] * cs[2][1]; v1[1] = v1[1] * cs[2][2] + sgn * p1[1] * cs[2][3];
                        v1[2] = v1[2] * cs[3][0] + sgn * p1[2] * cs[3][1]; v1[3] = v1[3] * cs[3][2] + sgn * p1[3] * cs[3][3];
                    }
                    v0 = v0 * sc; v1 = v1 * sc;
                    u32x4 w; w.x = cvt_pk_bf16(v0[0], v0[1]); w.y = cvt_pk_bf16(v0[2], v0[3]); w.z = cvt_pk_bf16(v1[0], v1[1]); w.w = cvt_pk_bf16(v1[2], v1[3]);
                    *(u32x4*)(rowp + bj * HALF) = w;
                }
            }
    }
};

struct EpiRes {
    static constexpr bool PERM = true, AFTER_DRAIN = false;
    const float* inL; const float* inC; float* outL; float* outC; const float* gate;
    __device__ __forceinline__ void operator()(const f32x4 (&acc)[2][2][4][2], const Unit& u, int wr, int wc, int fr, int fq) const {
        const bool lat = u.pm < 64;
        const float* ib = lat ? inL + (size_t)u.pm * BM * 1024 : inC + (size_t)(u.pm - 64) * BM * 1024;
        float* ob = lat ? outL + (size_t)u.pm * BM * 1024 : outC + (size_t)(u.pm - 64) * BM * 1024;
        const float* g = gate + (lat ? (u.pm >> 3) : 8) * 1024;
        const int col0 = u.pn * BM + wc * 32 + 8 * fq;
        f32x4 gv[2][2];
#pragma unroll
        for (int bj = 0; bj < 2; ++bj)
#pragma unroll
            for (int n = 0; n < 2; ++n) gv[bj][n] = *(const f32x4*)(g + col0 + bj * HALF + n * 4);
#pragma unroll
        for (int ai = 0; ai < 2; ++ai)
#pragma unroll
            for (int m = 0; m < 4; ++m) { const size_t off = (size_t)(ai * HALF + wr * 64 + m * 16 + fr) * 1024 + col0;
#pragma unroll
                for (int bj = 0; bj < 2; ++bj)
#pragma unroll
                    for (int n = 0; n < 2; ++n) { const f32x4 x = __builtin_nontemporal_load((const f32x4*)(ib + off + bj * HALF + n * 4));
                        *(f32x4*)(ob + off + bj * HALF + n * 4) = x + gv[bj][n] * acc[ai][bj][m][n]; }
                if (m & 1) asm volatile("" ::: "memory"); }
    }
};

template <class Epi, class Sched, bool ALIGN_EPI = false, bool SP2 = false>
__device__ __forceinline__ void gemm_phase(PG8_LAS unsigned char* lds, const Gemm g, const Sched& S, const Epi& E, const int wv_) {
    int tid_ = wv_ * 64 + (int)__builtin_amdgcn_mbcnt_hi(~0u, __builtin_amdgcn_mbcnt_lo(~0u, 0u)); asm volatile("" : "+v"(tid_));
    const int tid = tid_, wid = __builtin_amdgcn_readfirstlane(tid >> 6), lane = tid & 63, wr = wid >> 2, wc = wid & 3, fr = lane & 15, fq = lane >> 4;
    const int K = g.K, nt = K / BK;
    unsigned voffA[2], voffB[2];
#pragma unroll
    for (int i = 0; i < 2; ++i) { int R, C; stage_rc(tid * 16 + i * 8192, R, C); const int Rb = Epi::PERM ? ((R & ~31) + perm32(R & 31)) : R;
        voffA[i] = (unsigned)(R * K + C) * 2u; voffB[i] = (unsigned)(Rb * K + C) * 2u; }
    const size_t kstep = (size_t)(BK * 2);
    const size_t hstep = (size_t)HALF * K * 2;
    const size_t tstep = 2 * hstep;
    const unsigned ldsw = (unsigned)wid * 1024u;
    const int aoff = lds_byte(wr * 64 + fr, fq * 8), boff = lds_byte(wc * 32 + fr, fq * 8);
#define PG8_SA(b, h) (((b) * 2 + (h)) * HTB)
#define PG8_SB(b, h) ((4 + (b) * 2 + (h)) * HTB)
#define PG8_STAGE(bufoff, gbase, voff) do { _Pragma("unroll") for (int _i = 0; _i < 2; ++_i) \
        __builtin_amdgcn_global_load_lds((const unsigned*)((const char*)(gbase) + (voff)[_i]), (PG8_LAS unsigned*)(lds + (bufoff) + ldsw + _i * 8192), 16, 0, 0); } while (0)
#define PG8_LDA(dst, b, h) do { _Pragma("unroll") for (int m = 0; m < 4; ++m) _Pragma("unroll") for (int k = 0; k < 2; ++k) dst[m][k] = *(const PG8_LAS bf16x8*)(lds + PG8_SA(b, h) + aoff + m * 2048 + k * 1024); } while (0)
#define PG8_LDB(dst, b, h) do { _Pragma("unroll") for (int n = 0; n < 2; ++n) _Pragma("unroll") for (int k = 0; k < 2; ++k) dst[n][k] = *(const PG8_LAS bf16x8*)(lds + PG8_SB(b, h) + boff + n * 2048 + k * 1024); } while (0)
#define PG8_MMA(ai, bj, At, Bt) do { __builtin_amdgcn_s_setprio(1); _Pragma("unroll") for (int m = 0; m < 4; ++m) _Pragma("unroll") for (int n = 0; n < 2; ++n) _Pragma("unroll") for (int k = 0; k < 2; ++k) \
        acc[ai][bj][m][n] = __builtin_amdgcn_mfma_f32_16x16x32_bf16(Bt[n][k], At[m][k], acc[ai][bj][m][n], 0, 0, 0); __builtin_amdgcn_s_setprio(0); } while (0)
#define PG8_WAIT_V(n) asm volatile("s_waitcnt vmcnt(" #n ")" ::: "memory")
#define PG8_WAIT_L(n) asm volatile("s_waitcnt lgkmcnt(" #n ")" ::: "memory")
#define PG8_BAR __builtin_amdgcn_s_barrier()
#define PG8_SCHED __builtin_amdgcn_sched_barrier(0)
    Unit cur, nxt; int ui = 0;
    if (!S.next(0, cur)) return;
    f32x4 acc[2][2][4][2];
#pragma unroll
    for (int a = 0; a < 2; ++a)
#pragma unroll
        for (int b = 0; b < 2; ++b)
#pragma unroll
            for (int m = 0; m < 4; ++m)
#pragma unroll
                for (int n = 0; n < 2; ++n) acc[a][b][m][n] = (f32x4){0.f, 0.f, 0.f, 0.f};
    bf16x8 At[4][2], B0[2][2], B1[2][2];
    const char* cA = (const char*)g.A + (size_t)cur.pm * tstep; const char* cB = (const char*)g.Bt + (size_t)cur.pn * tstep;
    S.a_ready(cur);
    if constexpr (SP2) {
        PG8_STAGE(PG8_SB(0, 0), cB, voffB); PG8_STAGE(PG8_SB(0, 1), cB + hstep, voffB); PG8_STAGE(PG8_SA(0, 0), cA, voffA); PG8_STAGE(PG8_SA(0, 1), cA + hstep, voffA);
        if (wr == 1) PG8_BAR;
        PG8_WAIT_V(2); PG8_BAR;
        PG8_STAGE(PG8_SB(1, 0), cB + kstep, voffB); PG8_STAGE(PG8_SA(1, 0), cA + kstep, voffA); PG8_STAGE(PG8_SB(1, 1), cB + hstep + kstep, voffB);
        PG8_WAIT_V(6); PG8_BAR;
    } else {
        PG8_STAGE(PG8_SB(0, 0), cB, voffB); PG8_STAGE(PG8_SA(0, 0), cA, voffA); PG8_STAGE(PG8_SB(0, 1), cB + hstep, voffB); PG8_STAGE(PG8_SA(0, 1), cA + hstep, voffA);
        if (wr == 1) PG8_BAR;
        PG8_WAIT_V(4); PG8_BAR;
        PG8_STAGE(PG8_SB(1, 0), cB + kstep, voffB); PG8_STAGE(PG8_SA(1, 0), cA + kstep, voffA); PG8_STAGE(PG8_SB(1, 1), cB + hstep + kstep, voffB);
        PG8_WAIT_V(6); PG8_BAR;
    }
    for (;;) {
        const bool has_next = S.next(ui + 1, nxt);
        const char* nA = has_next ? (const char*)g.A + (size_t)nxt.pm * tstep : cA; const char* nB = has_next ? (const char*)g.Bt + (size_t)nxt.pn * tstep : cB;
        for (int t = 0; t < nt; t += 2) {
            const bool last = (t == nt - 2);
            const char* a1 = cA + (size_t)(t + 1) * kstep;
            const char* a2 = last ? nA : cA + (size_t)(t + 2) * kstep; const char* b2 = last ? nB : cB + (size_t)(t + 2) * kstep;
            const char* a3 = a2 + kstep; const char* b3 = b2 + kstep;
            if (last && has_next) S.a_ready(nxt);
            if constexpr (SP2) {
            PG8_LDB(B0, 0, 0); PG8_LDB(B1, 0, 1); PG8_SCHED; PG8_LDA(At, 0, 0); PG8_STAGE(PG8_SA(1, 1), a1 + hstep, voffA);
            PG8_WAIT_V(8); PG8_WAIT_L(0); PG8_BAR; PG8_MMA(0, 0, At, B0); PG8_MMA(0, 1, At, B1); PG8_BAR; PG8_SCHED;
            PG8_LDA(At, 0, 1); PG8_STAGE(PG8_SB(0, 0), b2, voffB); PG8_STAGE(PG8_SB(0, 1), b2 + hstep, voffB); PG8_STAGE(PG8_SA(0, 0), a2, voffA);
            PG8_WAIT_V(8); PG8_WAIT_L(0); PG8_BAR; PG8_MMA(1, 0, At, B0); PG8_MMA(1, 1, At, B1); PG8_BAR; PG8_SCHED;
            PG8_LDB(B0, 1, 0); PG8_LDB(B1, 1, 1); PG8_SCHED; PG8_LDA(At, 1, 0); PG8_STAGE(PG8_SA(0, 1), a2 + hstep, voffA);
            PG8_WAIT_V(8); PG8_WAIT_L(0); PG8_BAR; PG8_MMA(0, 0, At, B0); PG8_MMA(0, 1, At, B1); PG8_BAR; PG8_SCHED;
            PG8_LDA(At, 1, 1); PG8_STAGE(PG8_SB(1, 0), b3, voffB); PG8_STAGE(PG8_SB(1, 1), b3 + hstep, voffB); PG8_STAGE(PG8_SA(1, 0), a3, voffA);
            PG8_WAIT_V(8); PG8_WAIT_L(0); PG8_BAR; PG8_MMA(1, 0, At, B0); PG8_MMA(1, 1, At, B1); PG8_BAR; PG8_SCHED;
            } else {
            PG8_LDB(B0, 0, 0); PG8_SCHED; PG8_LDA(At, 0, 0); PG8_STAGE(PG8_SA(1, 1), a1 + hstep, voffA);
            PG8_WAIT_L(8); PG8_BAR; PG8_WAIT_L(0); PG8_MMA(0, 0, At, B0); PG8_BAR; PG8_SCHED;
            PG8_LDB(B1, 0, 1); PG8_STAGE(PG8_SB(0, 0), b2, voffB);
            PG8_BAR; PG8_WAIT_L(0); PG8_MMA(0, 1, At, B1); PG8_BAR;
            PG8_LDA(At, 0, 1); PG8_STAGE(PG8_SA(0, 0), a2, voffA);
            PG8_BAR; PG8_WAIT_L(0); PG8_MMA(1, 0, At, B0); PG8_BAR; PG8_SCHED;
            PG8_STAGE(PG8_SB(0, 1), b2 + hstep, voffB);
            PG8_WAIT_V(6); PG8_BAR; PG8_MMA(1, 1, At, B1); PG8_BAR;
            PG8_LDB(B0, 1, 0); PG8_SCHED; PG8_LDA(At, 1, 0); PG8_STAGE(PG8_SA(0, 1), a2 + hstep, voffA);
            PG8_WAIT_L(8); PG8_BAR; PG8_WAIT_L(0); PG8_MMA(0, 0, At, B0); PG8_BAR; PG8_SCHED;
            PG8_LDB(B1, 1, 1); PG8_STAGE(PG8_SB(1, 0), b3, voffB);
            PG8_BAR; PG8_WAIT_L(0); PG8_MMA(0, 1, At, B1); PG8_BAR;
            PG8_LDA(At, 1, 1); PG8_STAGE(PG8_SA(1, 0), a3, voffA);
            PG8_BAR; PG8_WAIT_L(0); PG8_MMA(1, 0, At, B0); PG8_BAR; PG8_SCHED;
            PG8_STAGE(PG8_SB(1, 1), b3 + hstep, voffB);
            PG8_WAIT_V(6); PG8_BAR; PG8_MMA(1, 1, At, B1); PG8_BAR;
            }
        }
        if constexpr (ALIGN_EPI) { if (wr == 0) PG8_BAR; }
        if constexpr (!Epi::AFTER_DRAIN) { E(acc, cur, wr, wc, fr, fq); S.done(cur); }
        if (!has_next) break;
#pragma unroll
        for (int a = 0; a < 2; ++a)
#pragma unroll
            for (int b = 0; b < 2; ++b)
#pragma unroll
                for (int m = 0; m < 4; ++m)
#pragma unroll
                    for (int n = 0; n < 2; ++n) acc[a][b][m][n] = (f32x4){0.f, 0.f, 0.f, 0.f};
        cur = nxt; cA = nA; cB = nB; ++ui;
        if constexpr (ALIGN_EPI) { if (wr == 1) PG8_BAR; }
    }
    PG8_WAIT_V(0);
    if constexpr (!ALIGN_EPI) { if (wr == 0) PG8_BAR; }
    PG8_BAR;
    if constexpr (Epi::AFTER_DRAIN) { E.fused(acc, cur, wr, wc, fr, fq, lds, wid, lane); S.done(cur); }
#undef PG8_SA
#undef PG8_SB
#undef PG8_STAGE
#undef PG8_LDA
#undef PG8_LDB
#undef PG8_MMA
#undef PG8_WAIT_V
#undef PG8_WAIT_L
#undef PG8_BAR
#undef PG8_SCHED
}
}

#define LAS __attribute__((address_space(3)))
typedef unsigned short bf16_t;
typedef short bf16x8 __attribute__((ext_vector_type(8)));
typedef short s16x4 __attribute__((ext_vector_type(4)));
typedef float f32x4 __attribute__((ext_vector_type(4)));
typedef float f32x2 __attribute__((ext_vector_type(2)));
typedef float f32x16 __attribute__((ext_vector_type(16)));
typedef unsigned u32x4 __attribute__((ext_vector_type(4)));
typedef unsigned u32x2 __attribute__((ext_vector_type(2)));

#ifndef DUP_ATTN
#define DUP_ATTN 1
#endif
#ifndef DUP_LRU
#define DUP_LRU 1
#endif
#ifndef DUP_CONV
#define DUP_CONV 1
#endif
#ifndef DUP_GIN
#define DUP_GIN 1
#endif
#ifndef DUP_NORM
#define DUP_NORM 1
#endif
#ifndef DUP_PRO
#define DUP_PRO 1
#endif
#ifndef DUP_GOUT0
#define DUP_GOUT0 1
#endif
#ifndef DUP_LRUBC
#define DUP_LRUBC 1
#endif
#ifndef DUP_ATTEPI
#define DUP_ATTEPI 1
#endif
#ifndef DUP_SYNC
#define DUP_SYNC 1
#endif
#ifndef CTX_SMALL
#define CTX_SMALL 1
#endif
constexpr int NTHREADS = 512, NWAVES = 8;
constexpr int DM = 1024, NB = 8, SEQ = 2048, CTX = 256;
constexpr int ML = NB * SEQ, MC = NB * CTX, MT = ML + MC;
constexpr float EPS = 1e-6f, LOG2E = 1.4426950408889634f;
constexpr int LDS_BYTES = 147456;

constexpr size_t MiB = 1u << 20;
constexpr size_t WS_MODP = 1 * MiB;
constexpr size_t WS_GATE = 5 * MiB;
constexpr size_t WS_ROPE = 5 * MiB + 512 * 1024;
constexpr size_t WS_GW = 6 * MiB;
constexpr size_t WS_WIN[4] = {8 * MiB, 15 * MiB, 21 * MiB, 31 * MiB};
constexpr size_t WS_WOUT[4] = {13 * MiB, 19 * MiB, 29 * MiB, 36 * MiB};
constexpr size_t WS_XC = 38 * MiB;
constexpr size_t WS_XN = 46 * MiB;
constexpr size_t WS_ACT = 82 * MiB;
constexpr size_t WS_HF = 154 * MiB;
constexpr size_t WS_END = 226 * MiB;

struct Args { const float* in[36]; float* out; unsigned char* ws; };

#define LBAR() do { asm volatile("s_waitcnt lgkmcnt(0)" ::: "memory"); __builtin_amdgcn_s_barrier(); asm volatile("" ::: "memory"); } while (0)

__device__ __forceinline__ unsigned f2bf(float f) { unsigned u = __builtin_bit_cast(unsigned, f); return (u + 0x7fffu + ((u >> 16) & 1u)) >> 16; }
__device__ __forceinline__ unsigned pk2(float lo, float hi) { return pg8::cvt_pk_bf16(lo, hi); }
__device__ __forceinline__ float bflo(unsigned w) { return __builtin_bit_cast(float, w << 16); }
__device__ __forceinline__ float bfhi(unsigned w) { return __builtin_bit_cast(float, w & 0xffff0000u); }
__device__ __forceinline__ unsigned char* ows(unsigned char* p) { const unsigned long long v = (unsigned long long)p; unsigned lo = __builtin_amdgcn_readfirstlane((unsigned)v), hi = __builtin_amdgcn_readfirstlane((unsigned)(v >> 32)); asm volatile("" : "+s"(lo), "+s"(hi)); return (unsigned char*)(__attribute__((address_space(1))) unsigned char*)(((unsigned long long)hi << 32) | lo); }
__device__ __forceinline__ int otid(int wv) { int t = wv * 64 + (int)__builtin_amdgcn_mbcnt_hi(~0u, __builtin_amdgcn_mbcnt_lo(~0u, 0u)); asm volatile("" : "+v"(t)); return t; }
__device__ __forceinline__ float wave_sum(float v) {
#pragma unroll
    for (int o = 1; o < 64; o <<= 1) v += __shfl_xor(v, o);
    return v;
}
using pg8::silu_f;

__device__ __forceinline__ void transpose_item(const float* W, int K, int N, bf16_t* WT, LAS float* scr, int item, int lane) {
    const int nblk = N / 32, kb = item / nblk, nb = item % nblk, k0 = 64 * kb, n0 = 32 * nb;
    float tv[32];
#pragma unroll
    for (int i = 0; i < 32; ++i) tv[i] = __builtin_nontemporal_load(W + (size_t)(k0 + 2 * i + (lane >> 5)) * N + n0 + (lane & 31));
#pragma unroll
    for (int i = 0; i < 32; ++i) scr[(2 * i + (lane >> 5)) * 33 + (lane & 31)] = tv[i];
    asm volatile("s_waitcnt lgkmcnt(0)" ::: "memory");
    const int c = lane & 7;
#pragma unroll
    for (int j = 0; j < 4; ++j) { const int n = (lane >> 3) + 8 * j; const LAS float* s = scr + (8 * c) * 33 + n;
        u32x4 o; o.x = pk2(s[0 * 33], s[1 * 33]); o.y = pk2(s[2 * 33], s[3 * 33]); o.z = pk2(s[4 * 33], s[5 * 33]); o.w = pk2(s[6 * 33], s[7 * 33]);
        *(u32x4*)(WT + (size_t)(n0 + n) * K + k0 + 8 * c) = o; }
    asm volatile("s_waitcnt lgkmcnt(0)" ::: "memory");
}

__device__ __forceinline__ void phase_prep(const Args& A, LAS unsigned char* L, int layer, int vbid, int vG, const int wv) {
    const int tid = otid(wv), lane = tid & 63, wave = tid >> 6;
    unsigned char* ws = ows(A.ws);
    const float* Wm = (layer == 0 ? A.in[5] : layer == 1 ? A.in[11] : layer == 2 ? A.in[23] : A.in[30]);
    for (int task = vbid; task < 48; task += vG) {
        const int cc = task >> 3, kc = task & 7;
        LAS float* s = (LAS float*)L;
        for (int idx = tid; idx < 9 * 128; idx += NTHREADS) { const int r = idx >> 7, kk = idx & 127;
            const float v = (r < 8) ? A.in[1][r * DM + kc * 128 + kk] : A.in[3][kc * 128 + kk];
            s[idx] = v / (1.0f + __expf(-v)); }
        LBAR();
        const int col = cc * 512 + tid;
        float acc[9];
#pragma unroll
        for (int r = 0; r < 9; ++r) acc[r] = 0.f;
        const float* wp = Wm + (size_t)(kc * 128) * 3072 + col;
#pragma unroll 32
        for (int kk = 0; kk < 128; ++kk) { const float w = __builtin_nontemporal_load(wp + (size_t)kk * 3072);
#pragma unroll
            for (int r = 0; r < 9; ++r) acc[r] += s[r * 128 + kk] * w; }
        float* mp = (float*)(ws + WS_MODP) + (size_t)((layer * 8 + kc) * 9) * 3072 + col;
#pragma unroll
        for (int r = 0; r < 9; ++r) mp[(size_t)r * 3072] = acc[r];
        LBAR();
    }
    if (layer == 0 && vbid == vG - 1) {
        float* rt = (float*)(ws + WS_ROPE);
        for (int idx = tid; idx < 1024; idx += NTHREADS) { const int p = idx >> 4, j = idx & 15;
            const float inv = 1.0f / __builtin_powf(10000.0f, (float)j * (1.0f / 16.0f));
            const float ang = (float)p * inv; float t = ang * 0.15915494309189535f; t -= __builtin_rintf(t);
            rt[idx * 2] = __builtin_amdgcn_cosf(t); rt[idx * 2 + 1] = __builtin_amdgcn_sinf(t); }
    }
    LAS float* scr = (LAS float*)(L + wave * 16384);
    const int rb = (vbid + vG - (48 % vG)) % vG;
    const int gw = rb * NWAVES + wave, NGW = vG * NWAVES;
    const int Nin = (layer == 0 || layer == 3) ? 2560 : (layer == 1 ? 2048 : 4096);
    const float* win = (layer == 0 ? A.in[7] : layer == 1 ? A.in[13] : layer == 2 ? A.in[25] : A.in[32]);
    const float* wout = (layer == 0 ? A.in[8] : layer == 1 ? A.in[14] : layer == 2 ? A.in[26] : A.in[33]);
    bf16_t* wint = (bf16_t*)(ws + (layer == 0 ? WS_WIN[0] : layer == 1 ? WS_WIN[1] : layer == 2 ? WS_WIN[2] : WS_WIN[3]));
    bf16_t* woutt = (bf16_t*)(ws + (layer == 0 ? WS_WOUT[0] : layer == 1 ? WS_WOUT[1] : layer == 2 ? WS_WOUT[2] : WS_WOUT[3]));
    const int IIN = 16 * (Nin / 32), IO = 16 * 32, IGW = layer == 0 ? 64 * 2 : 0;
    const int nitems = IIN + IO + IGW;
    for (int it = gw; it < nitems; it += NGW) {
        int r = it;
        if (r < IIN) { transpose_item(win, 1024, Nin, wint, scr, r, lane); continue; } r -= IIN;
        if (r < IO) { transpose_item(wout, 1024, 1024, woutt, scr, r, lane); continue; } r -= IO;
        { const int blk = r >> 1, sub = r & 1;
          const int dir = blk >> 5, gate = (blk >> 4) & 1, h = blk & 15;
          const float* src = (gate == 0 ? A.in[17] : A.in[19]) + (size_t)(dir * 16 + h) * 4096;
          transpose_item(src, 64, 64, (bf16_t*)(ws + WS_GW) + (size_t)blk * 4096, scr, sub, lane); }
    }
}

template <int NR> __device__ __forceinline__ void norm_rows(const float* const (&xrow)[NR], bf16_t* const (&orow)[NR], const LAS float* const (&gs)[NR], const LAS float* const (&sh)[NR], int lane) {
    f32x4 v[NR][4]; float s[NR];
#pragma unroll
    for (int i = 0; i < NR; ++i) { const f32x4* xr = (const f32x4*)xrow[i] + lane;
#pragma unroll
        for (int j = 0; j < 4; ++j) v[i][j] = __builtin_nontemporal_load(xr + 64 * j); }
#pragma unroll
    for (int i = 0; i < NR; ++i) { float a = 0.f;
#pragma unroll
        for (int j = 0; j < 4; ++j) a += (v[i][j].x * v[i][j].x + v[i][j].y * v[i][j].y) + (v[i][j].z * v[i][j].z + v[i][j].w * v[i][j].w);
        s[i] = a; }
#pragma unroll
    for (int o = 1; o < 64; o <<= 1) {
#pragma unroll
        for (int i = 0; i < NR; ++i) s[i] += __shfl_xor(s[i], o); }
#pragma unroll
    for (int i = 0; i < NR; ++i) { const float rstd = 1.0f / sqrtf(s[i] * (1.0f / DM) + EPS); u32x2* o8 = (u32x2*)orow[i] + lane;
#pragma unroll
        for (int j = 0; j < 4; ++j) { const f32x4 g = *(const LAS f32x4*)(gs[i] + 256 * j + 4 * lane), b = *(const LAS f32x4*)(sh[i] + 256 * j + 4 * lane);
            const f32x4 y = v[i][j] * rstd * g + b; u32x2 w; w.x = pk2(y.x, y.y); w.y = pk2(y.z, y.w); o8[64 * j] = w; } }
}
__device__ __forceinline__ void phase_norm(const Args& A, int layer, const float* xL, const float* xC, LAS unsigned char* L, const int wv) {
    const int tid = otid(wv), lane = tid & 63, wave = tid >> 6, bid = blockIdx.x, G = gridDim.x;
    const float* norm_g = (layer == 0 ? A.in[4] : layer == 1 ? A.in[10] : layer == 2 ? A.in[22] : A.in[29]);
    const float* mod_b = (layer == 0 ? A.in[6] : layer == 1 ? A.in[12] : layer == 2 ? A.in[24] : A.in[31]);
    unsigned char* ws = ows(A.ws);
    const float* modp = (const float*)(ws + WS_MODP) + (size_t)(layer * 8) * 9 * 3072;
    bf16_t* XN = (bf16_t*)(ws + WS_XN);
    LAS float* tab = (LAS float*)L;
    for (int vb = bid; vb < 256; vb += G) {
        const int batch = vb >> 5;
        for (int idx = tid; idx < 4096; idx += NTHREADS) { const int which = idx >> 10, col = idx & 1023; const int r = (which < 2) ? batch : 8; const int mcol = (which & 1) ? col : 1024 + col;
            float v = mod_b[mcol];
#pragma unroll
            for (int kc = 0; kc < 8; ++kc) v += modp[(size_t)(kc * 9 + r) * 3072 + mcol];
            if (!(which & 1)) v = norm_g[col] * (1.0f + v);
            tab[idx] = v; }
        if (vb < 9) { float* gf = (float*)(ws + WS_GATE) + (size_t)(layer * 9 + vb) * 1024;
            for (int col = tid; col < 1024; col += NTHREADS) { float v = mod_b[2048 + col];
#pragma unroll
                for (int kc = 0; kc < 8; ++kc) v += modp[(size_t)(kc * 9 + vb) * 3072 + 2048 + col];
                gf[col] = v; } }
        LBAR();
#pragma unroll 1
        for (int bt = 0; bt < 3; ++bt) {
            const float* xr[3]; bf16_t* orow[3]; const LAS float* gs[3]; const LAS float* sh[3];
#pragma unroll
            for (int i = 0; i < 3; ++i) { const int ri = bt * 3 + i;
                if (ri < 8) { const int row = vb * 64 + wave * 8 + ri; xr[i] = xL + (size_t)row * DM; orow[i] = XN + (size_t)row * DM; gs[i] = tab; sh[i] = tab + 1024; }
                else { const int row = vb * 8 + wave; xr[i] = xC + (size_t)row * DM; orow[i] = XN + (size_t)(ML + row) * DM; gs[i] = tab + 2048; sh[i] = tab + 3072; } }
            norm_rows<3>(xr, orow, gs, sh, lane);
        }
        LBAR();
    }
}

#define MFMA32(a, b, c) __builtin_amdgcn_mfma_f32_32x32x16_bf16((a), (b), (c), 0, 0, 0)
#define MFMA16(a, b, c) __builtin_amdgcn_mfma_f32_16x16x32_bf16((a), (b), (c), 0, 0, 0)
__device__ __forceinline__ int crow(int r, int hi) { return (r & 3) + 8 * (r >> 2) + 4 * hi; }
typedef short v4i16_t __attribute__((ext_vector_type(4)));
__device__ __forceinline__ float max3f(float a, float b, float c) { float r; asm("v_max3_f32 %0, %1, %2, %3" : "=v"(r) : "v"(a), "v"(b), "v"(c)); return r; }
__device__ __forceinline__ s16x4 vtr(LAS const unsigned char* p) { return __builtin_bit_cast(s16x4, __builtin_amdgcn_ds_read_tr16_b64_v4i16((LAS v4i16_t*)p)); }

__device__ __forceinline__ void phase_attn(const bf16_t* ACT, bf16_t* Y, const float* sink, bool need_ctx, LAS unsigned char* L, const int wv) {
    constexpr int LD = 2560, KSTR = 144, TILEB = 64 * KSTR, BUFB = 2 * TILEB;
    const int tid = otid(wv), lane = tid & 63, r32 = lane & 31, hi = lane >> 5, wave = __builtin_amdgcn_readfirstlane(tid >> 6);
    const int g = wave >> 1, half = wave & 1, G = gridDim.x;
    const int skey = tid >> 3, sch = tid & 7;
    const int stoff = skey * KSTR + sch * 16;
    const int koff = r32 * KSTR + hi * 16;
    const int voff = TILEB + (4 * hi + ((lane & 15) >> 2)) * KSTR + (16 * ((lane >> 4) & 1) + 4 * (lane & 3)) * 2;
    const int nunits = need_ctx ? 1152 : 1024;
    for (int u = blockIdx.x; u < nunits; u += G) {
        int b, kvh, qb; bool lat;
        if (u < 1024) { b = u >> 7; kvh = (u >> 5) & 3; qb = u & 31; lat = true; } else { const int e = u - 1024; b = e >> 4; kvh = (e >> 2) & 3; qb = e & 3; lat = false; }
        const int h = kvh * 4 + g;
        const int qpos = qb * 64 + half * 32 + r32;
        const int qrow = lat ? b * SEQ + qpos : ML + b * CTX + qpos;
        int tlo = 4, thi = 4;
        if (lat) { tlo = qb == 0 ? 6 : (qb == 1 ? 5 : 4); thi = qb == 31 ? 7 : (qb == 30 ? 8 : 9); }
        const int n = 4 + (thi - tlo);
        const int kp_base = qb * 64 - 128;
        bf16x8 qf[4];
        { const bf16_t* qp = ACT + (size_t)qrow * LD + h * 64 + hi * 8;
#pragma unroll
          for (int d0 = 0; d0 < 4; ++d0) qf[d0] = __builtin_nontemporal_load((const bf16x8*)(qp + d0 * 16)); }
        float m_run = sink[h] * LOG2E, l_run = hi ? 0.f : 1.f;
        f32x16 o0, o1;
#pragma unroll
        for (int r = 0; r < 16; ++r) { o0[r] = 0.f; o1[r] = 0.f; }
        const size_t kcol = 1024 + kvh * 64 + sch * 8, vcol = 1280 + kvh * 64 + sch * 8;
#define ATT_TROW(s_) (((s_) < 4 ? ML + b * CTX + (s_) * 64 : b * SEQ + kp_base + (tlo + (s_) - 8) * 64) + skey)
        u32x4 kq0, vq0, kq1, vq1, kq2, vq2;
        { const size_t krow = (size_t)ATT_TROW(0); kq0 = *(const u32x4*)(ACT + krow * LD + kcol); vq0 = *(const u32x4*)(ACT + krow * LD + vcol); }
        { const size_t krow = (size_t)ATT_TROW(1); kq1 = *(const u32x4*)(ACT + krow * LD + kcol); vq1 = *(const u32x4*)(ACT + krow * LD + vcol); }
        { const size_t krow = (size_t)ATT_TROW(2); kq2 = *(const u32x4*)(ACT + krow * LD + kcol); vq2 = *(const u32x4*)(ACT + krow * LD + vcol); }
        LBAR();
        *(LAS u32x4*)(L + stoff) = kq0; *(LAS u32x4*)(L + TILEB + stoff) = vq0;
        { const size_t krow = (size_t)ATT_TROW(3); kq0 = *(const u32x4*)(ACT + krow * LD + kcol); vq0 = *(const u32x4*)(ACT + krow * LD + vcol); }
        LBAR();
#define ATT_STEP(s_, KQ, VQ) do { const int s = (s_); \
            const int t = s < 4 ? s : tlo + (s - 4); \
            LAS const unsigned char* B = L + (s & 1) * BUFB; \
 \
              \
            bf16x8 kf[8]; s16x4 vl[8], vh[8]; \
_Pragma("unroll") \
            for (int d0 = 0; d0 < 4; ++d0) { kf[2 * d0] = *(const LAS bf16x8*)(B + koff + d0 * 32); kf[2 * d0 + 1] = *(const LAS bf16x8*)(B + koff + 32 * KSTR + d0 * 32); } \
_Pragma("unroll") \
            for (int i = 0; i < 4; ++i) { LAS const unsigned char* vp = B + voff + i * 16 * KSTR; vl[2 * i] = vtr(vp); vh[2 * i] = vtr(vp + 8 * KSTR); vl[2 * i + 1] = vtr(vp + 64); vh[2 * i + 1] = vtr(vp + 8 * KSTR + 64); } \
            __builtin_amdgcn_sched_barrier(0); \
            f32x16 p0, p1; \
_Pragma("unroll") \
            for (int r = 0; r < 16; ++r) { p0[r] = 0.f; p1[r] = 0.f; } \
_Pragma("unroll") \
            for (int d0 = 0; d0 < 4; ++d0) { p0 = MFMA32(kf[2 * d0], qf[d0], p0); p1 = MFMA32(kf[2 * d0 + 1], qf[d0], p1); } \
            if (t == 4 || t == 8) { const int kp0 = kp_base + (t - 4) * 64 - qpos; \
_Pragma("unroll") \
                for (int r = 0; r < 16; ++r) { const int d0 = kp0 + crow(r, hi), d1 = d0 + 32; \
                    if (d0 > 128 || d0 < -128) p0[r] = -1e30f; if (d1 > 128 || d1 < -128) p1[r] = -1e30f; } } \
            float mt = max3f(p0[0], p0[1], p1[0]), mt2 = max3f(p0[2], p0[3], p1[1]); mt = max3f(mt, p1[2], p1[3]); \
_Pragma("unroll") \
            for (int r = 4; r < 16; r += 4) { mt = max3f(mt, p0[r], p0[r + 1]); mt2 = max3f(mt2, p0[r + 2], p0[r + 3]); mt = max3f(mt, p1[r], p1[r + 1]); mt2 = max3f(mt2, p1[r + 2], p1[r + 3]); } \
            mt = fmaxf(mt, mt2); \
            mt = fmaxf(mt, __shfl_xor(mt, 32)) - m_run; \
 \
            float dl = 0.f; \
            if (s == 0) dl = fmaxf(mt, 0.f); else if (mt > 8.0f) dl = mt; \
            if (__any(dl != 0.f)) { const float alpha = __builtin_amdgcn_exp2f(-dl); m_run += dl; l_run *= alpha; \
_Pragma("unroll") \
                for (int r = 0; r < 16; ++r) { o0[r] *= alpha; o1[r] *= alpha; } } \
            float ls = 0.f, ls2 = 0.f; \
_Pragma("unroll") \
            for (int r = 0; r < 16; ++r) { p0[r] = __builtin_amdgcn_exp2f(p0[r] - m_run); p1[r] = __builtin_amdgcn_exp2f(p1[r] - m_run); ls += p0[r]; ls2 += p1[r]; } \
            ls += ls2; \
            l_run += ls; \
            bf16x8 pb[2][2]; \
_Pragma("unroll") \
            for (int j = 0; j < 2; ++j) { \
                u32x4 w0, w1; \
                w0.x = pk2(p0[8 * j + 0], p0[8 * j + 1]); w0.y = pk2(p0[8 * j + 2], p0[8 * j + 3]); w0.z = pk2(p0[8 * j + 4], p0[8 * j + 5]); w0.w = pk2(p0[8 * j + 6], p0[8 * j + 7]); \
                w1.x = pk2(p1[8 * j + 0], p1[8 * j + 1]); w1.y = pk2(p1[8 * j + 2], p1[8 * j + 3]); w1.z = pk2(p1[8 * j + 4], p1[8 * j + 5]); w1.w = pk2(p1[8 * j + 6], p1[8 * j + 7]); \
                pb[0][j] = __builtin_bit_cast(bf16x8, w0); pb[1][j] = __builtin_bit_cast(bf16x8, w1); \
            } \
 \
_Pragma("unroll") \
            for (int kb = 0; kb < 2; ++kb) \
_Pragma("unroll") \
                for (int j = 0; j < 2; ++j) { const int i = kb * 2 + j; \
                    const bf16x8 a0 = __builtin_shufflevector(vl[2 * i], vh[2 * i], 0, 1, 2, 3, 4, 5, 6, 7), a1 = __builtin_shufflevector(vl[2 * i + 1], vh[2 * i + 1], 0, 1, 2, 3, 4, 5, 6, 7); \
                    o0 = MFMA32(a0, pb[kb][j], o0); o1 = MFMA32(a1, pb[kb][j], o1); \
                } \
            if (s + 1 < n) { LAS unsigned char* Bn = L + ((s + 1) & 1) * BUFB; *(LAS u32x4*)(Bn + stoff) = KQ; *(LAS u32x4*)(Bn + TILEB + stoff) = VQ; } \
            LBAR(); \
            if (s + 4 < n) { const size_t krow = (size_t)ATT_TROW(s + 4); KQ = *(const u32x4*)(ACT + krow * LD + kcol); VQ = *(const u32x4*)(ACT + krow * LD + vcol); } \
        } while (0)
#pragma unroll 1
        for (int s0 = 0; s0 < n; s0 += 3) {
            ATT_STEP(s0, kq1, vq1);
            if (s0 + 1 < n) ATT_STEP(s0 + 1, kq2, vq2);
            if (s0 + 2 < n) ATT_STEP(s0 + 2, kq0, vq0);
        }
#undef ATT_STEP
#undef ATT_TROW
        u32x4 sgq[4];
        { const int qrow0 = qrow - r32;
#pragma unroll
          for (int it = 0; it < 4; ++it) sgq[it] = __builtin_nontemporal_load((const u32x4*)(ACT + (size_t)(qrow0 + it * 8 + (lane >> 3)) * LD + 1536 + h * 64 + (lane & 7) * 8)); }
        const float lt = l_run + __shfl_xor(l_run, 32); const float inv = 1.0f / lt;
        LAS float* stg = (LAS float*)(L + 40960 + wave * 8704);
#pragma unroll
        for (int db = 0; db < 2; ++db)
#pragma unroll
            for (int q4 = 0; q4 < 4; ++q4) { const int d = 32 * db + 8 * q4 + 4 * hi; f32x4 v;
                if (db == 0) v = (f32x4){o0[4 * q4], o0[4 * q4 + 1], o0[4 * q4 + 2], o0[4 * q4 + 3]}; else v = (f32x4){o1[4 * q4], o1[4 * q4 + 1], o1[4 * q4 + 2], o1[4 * q4 + 3]};
                *(LAS f32x4*)(stg + r32 * 68 + d) = v * inv; }
        asm volatile("s_waitcnt lgkmcnt(0)" ::: "memory");
        { const int qrow0 = qrow - r32; const int er = lane >> 3, ec = (lane & 7) * 8;
#pragma unroll
          for (int it = 0; it < 4; ++it) { const int row = it * 8 + er; const size_t grow = (size_t)(qrow0 + row);
              const f32x4 a0 = *(const LAS f32x4*)(stg + row * 68 + ec), a1 = *(const LAS f32x4*)(stg + row * 68 + ec + 4);
              const u32x4 gw = sgq[it];
              u32x4 w; w.x = pk2(a0.x * bflo(gw.x), a0.y * bfhi(gw.x)); w.y = pk2(a0.z * bflo(gw.y), a0.w * bfhi(gw.y)); w.z = pk2(a1.x * bflo(gw.z), a1.y * bfhi(gw.z)); w.w = pk2(a1.z * bflo(gw.w), a1.w * bfhi(gw.w));
              *(u32x4*)(Y + grow * DM + h * 64 + ec) = w; } }
    }
    LBAR();
}

__device__ __forceinline__ void phase_lru(const Args& A, const bf16_t* ACT, bf16_t* Y, float* HF, LAS unsigned char* L, const int wv) {
    constexpr int LD = 2048, TT = 128, USTR = 144;
    const int tid = otid(wv), lane = tid & 63, wave = __builtin_amdgcn_readfirstlane(tid >> 6), G = gridDim.x;
    LAS unsigned char* UL = L;
    LAS unsigned char* XA = L + 19200;
    LAS float* XF = (LAS float*)(L + 19200 + 18432);
    LAS f32x2* AB = (LAS f32x2*)(L + 19200 + 18432 + 16384);
    LAS f32x2* CAR = (LAS f32x2*)(L + 19200 + 18432 + 16384 + 32768);
    LAS float* ST = (LAS float*)(L + 19200 + 18432 + 16384 + 32768 + 4096);
    LAS float* CW = (LAS float*)(L + 19200 + 18432 + 16384 + 32768 + 4096 + 256);
    const bf16_t* gwT = (const bf16_t*)(ows(A.ws) + WS_GW);
    const float* conv_w = A.in[15]; const float* conv_b = A.in[16]; const float* ba = A.in[18]; const float* bx = A.in[20]; const float* lam = A.in[21];
    const int fr = lane & 15, fq = lane >> 4;
    const int stok = tid >> 3, sch = tid & 7;
    const int ch = tid & 31, sc = tid >> 5;
    const int otok = tid >> 2, oq = tid & 3;
    for (int u = blockIdx.x; u < 256; u += G) {
        const int b = u >> 5, hb = u & 31, hblk = hb >> 1, half = hb & 1, cin0 = hblk * 64, c0 = cin0 + half * 32;
#pragma unroll 1
        for (int dir = 0; dir < 2; ++dir) {
            LBAR();
            if (tid < 320) { const int k = tid >> 6, c = tid & 63; CW[tid] = (k < 4) ? conv_w[(size_t)(dir * 4 + k) * DM + cin0 + c] : conv_b[(size_t)dir * DM + cin0 + c]; }
            const int cbk = wave & 1;
            bf16x8 wr_[2], wi_[2];
            { const bf16_t* pr = gwT + ((size_t)((dir * 2 + 0) * 16 + hblk) * 64 + half * 32 + cbk * 16 + fr) * 64 + fq * 8;
              const bf16_t* pi = gwT + ((size_t)((dir * 2 + 1) * 16 + hblk) * 64 + half * 32 + cbk * 16 + fr) * 64 + fq * 8;
              wr_[0] = *(const bf16x8*)pr; wr_[1] = *(const bf16x8*)(pr + 32); wi_[0] = *(const bf16x8*)pi; wi_[1] = *(const bf16x8*)(pi + 32); }
            float eba[4], ebx[4], esp[4];
#pragma unroll
            for (int e = 0; e < 4; ++e) { const int c = dir * DM + c0 + cbk * 16 + 4 * fq + e; eba[e] = ba[c]; ebx[e] = bx[c];
                const float nl = -lam[c]; esp[e] = (fmaxf(nl, 0.f) + log1pf(__expf(-fabsf(nl)))) * (-8.0f * LOG2E); }
            if (tid < 32) ST[tid] = 0.f;
            u32x4 ur[2], uh = (u32x4){0u, 0u, 0u, 0u};
            { const int rowbase = ML + b * CTX;
#pragma unroll
              for (int i2 = 0; i2 < 2; ++i2) { const int S = stok + 64 * i2; const int row = rowbase + (dir ? CTX - 1 - S : S); ur[i2] = *(const u32x4*)(ACT + (size_t)row * LD + cin0 + sch * 8); } }
            f32x4 hf0 = (f32x4){0.f, 0.f, 0.f, 0.f}, hf1 = hf0; u32x4 gv = (u32x4){0u, 0u, 0u, 0u}; size_t orow = 0; int oseq = 0;
#define LRU_OUT() do { const f32x4 h0 = *(const LAS f32x4*)(XF + otok * 32 + oq * 8), h1 = *(const LAS f32x4*)(XF + otok * 32 + oq * 8 + 4); \
                if (dir == 0) { f32x4* hp = (f32x4*)(HF + ((size_t)u * 2304 + oseq) * 32 + oq * 8); hp[0] = h0; hp[1] = h1; } \
                else { const f32x4 s0 = h0 + hf0, s1 = h1 + hf1; u32x4 w; \
                    w.x = pk2(s0.x * bflo(gv.x), s0.y * bfhi(gv.x)); w.y = pk2(s0.z * bflo(gv.y), s0.w * bfhi(gv.y)); w.z = pk2(s1.x * bflo(gv.z), s1.y * bfhi(gv.z)); w.w = pk2(s1.z * bflo(gv.w), s1.w * bfhi(gv.w)); \
                    *(u32x4*)(Y + orow * DM + c0 + oq * 8) = w; } } while (0)
#pragma unroll 1
            for (int tl = 0; tl < 18; ++tl) {
                const int seg = tl < 2 ? 0 : 1, S0 = seg ? (tl - 2) * TT : tl * TT, seglen = seg ? SEQ : CTX, rowbase = seg ? b * SEQ : ML + b * CTX;
                LBAR();
                *(LAS u32x4*)(UL + (3 + stok) * USTR + sch * 16) = ur[0]; *(LAS u32x4*)(UL + (3 + 64 + stok) * USTR + sch * 16) = ur[1];
                if (tid < 24) *(LAS u32x4*)(UL + stok * USTR + sch * 16) = uh;
                if (tl > 0) LRU_OUT();
                LBAR();
                { const int S = S0 + otok; const int pos = dir ? seglen - 1 - S : S; orow = (size_t)(rowbase + pos); oseq = seg ? CTX + pos : pos;
                  if (dir == 1) { const f32x4* hp = (const f32x4*)(HF + ((size_t)u * 2304 + oseq) * 32 + oq * 8); hf0 = __builtin_nontemporal_load(hp); hf1 = __builtin_nontemporal_load(hp + 1); gv = __builtin_nontemporal_load((const u32x4*)(ACT + orow * LD + 1024 + c0 + oq * 8)); } }
                if (tl + 1 < 18) { const int tn = tl + 1; const int seg2 = tn < 2 ? 0 : 1, S02 = seg2 ? (tn - 2) * TT : tn * TT, seglen2 = seg2 ? SEQ : CTX, rowbase2 = seg2 ? b * SEQ : ML + b * CTX;
#pragma unroll
                    for (int i2 = 0; i2 < 2; ++i2) { const int S = S02 + stok + 64 * i2; const int row = rowbase2 + (dir ? seglen2 - 1 - S : S); ur[i2] = *(const u32x4*)(ACT + (size_t)row * LD + cin0 + sch * 8); }
                    uh = (u32x4){0u, 0u, 0u, 0u};
                    if (tid < 24 && S02 > 0) { const int S = S02 - 3 + stok; const int row = rowbase2 + (dir ? seglen2 - 1 - S : S); uh = *(const u32x4*)(ACT + (size_t)row * LD + cin0 + sch * 8); } }
                for (int rep_ = 0; rep_ < DUP_LRUBC; ++rep_) {
                { float x0[8], x1[8];
                  { const f32x4 ca = *(const LAS f32x4*)(CW + 256 + sch * 8), cc = *(const LAS f32x4*)(CW + 256 + sch * 8 + 4);
                    x0[0] = ca.x; x0[1] = ca.y; x0[2] = ca.z; x0[3] = ca.w; x0[4] = cc.x; x0[5] = cc.y; x0[6] = cc.z; x0[7] = cc.w;
#pragma unroll
                    for (int e = 0; e < 8; ++e) x1[e] = x0[e]; }
#pragma unroll
                  for (int k = 0; k < 4; ++k) { const f32x4 wa = *(const LAS f32x4*)(CW + k * 64 + sch * 8), wb = *(const LAS f32x4*)(CW + k * 64 + sch * 8 + 4);
                      const u32x4 u0 = *(const LAS u32x4*)(UL + (stok + k) * USTR + sch * 16), u1 = *(const LAS u32x4*)(UL + (stok + 64 + k) * USTR + sch * 16);
                      x0[0] += wa.x * bflo(u0.x); x0[1] += wa.y * bfhi(u0.x); x0[2] += wa.z * bflo(u0.y); x0[3] += wa.w * bfhi(u0.y);
                      x0[4] += wb.x * bflo(u0.z); x0[5] += wb.y * bfhi(u0.z); x0[6] += wb.z * bflo(u0.w); x0[7] += wb.w * bfhi(u0.w);
                      x1[0] += wa.x * bflo(u1.x); x1[1] += wa.y * bfhi(u1.x); x1[2] += wa.z * bflo(u1.y); x1[3] += wa.w * bfhi(u1.y);
                      x1[4] += wb.x * bflo(u1.z); x1[5] += wb.y * bfhi(u1.z); x1[6] += wb.z * bflo(u1.w); x1[7] += wb.w * bfhi(u1.w); }
                  u32x4 w; w.x = pk2(x0[0], x0[1]); w.y = pk2(x0[2], x0[3]); w.z = pk2(x0[4], x0[5]); w.w = pk2(x0[6], x0[7]);
                  *(LAS u32x4*)(XA + stok * USTR + sch * 16) = w;
                  w.x = pk2(x1[0], x1[1]); w.y = pk2(x1[2], x1[3]); w.z = pk2(x1[4], x1[5]); w.w = pk2(x1[6], x1[7]);
                  *(LAS u32x4*)(XA + (stok + 64) * USTR + sch * 16) = w;
                  if ((sch >> 2) == half) { LAS f32x4* xf = (LAS f32x4*)(XF + stok * 32 + (sch & 3) * 8); xf[0] = (f32x4){x0[0], x0[1], x0[2], x0[3]}; xf[1] = (f32x4){x0[4], x0[5], x0[6], x0[7]};
                      xf = (LAS f32x4*)(XF + (stok + 64) * 32 + (sch & 3) * 8); xf[0] = (f32x4){x1[0], x1[1], x1[2], x1[3]}; xf[1] = (f32x4){x1[4], x1[5], x1[6], x1[7]}; } }
                LBAR();
#pragma unroll
                for (int i2 = 0; i2 < 2; ++i2) { const int tb = (wave >> 1) + 4 * i2; const int tok = tb * 16 + fr;
                    const bf16x8 x0 = *(const LAS bf16x8*)(XA + tok * USTR + fq * 16), x1 = *(const LAS bf16x8*)(XA + tok * USTR + 64 + fq * 16);
                    f32x4 ar = (f32x4){0.f, 0.f, 0.f, 0.f}, ai = (f32x4){0.f, 0.f, 0.f, 0.f};
                    ar = MFMA16(wr_[0], x0, ar); ar = MFMA16(wr_[1], x1, ar); ai = MFMA16(wi_[0], x0, ai); ai = MFMA16(wi_[1], x1, ai);
                    const f32x4 xv = *(const LAS f32x4*)(XF + tok * 32 + cbk * 16 + 4 * fq);
                    float av[4], bv[4];
#pragma unroll
                    for (int e = 0; e < 4; ++e) { const float r = __builtin_amdgcn_rcpf(1.0f + __builtin_amdgcn_exp2f(-(ar[e] + eba[e]) * LOG2E)); const float ig = __builtin_amdgcn_rcpf(1.0f + __builtin_amdgcn_exp2f(-(ai[e] + ebx[e]) * LOG2E));
                        const float a_ = __builtin_amdgcn_exp2f(r * esp[e]); av[e] = a_; bv[e] = __builtin_amdgcn_sqrtf(fmaxf(1.0f - a_ * a_, 0.f)) * (ig * xv[e]); }
                    LAS f32x4* ab = (LAS f32x4*)(AB + tok * 32 + cbk * 16 + 4 * fq); ab[0] = (f32x4){av[0], bv[0], av[1], bv[1]}; ab[1] = (f32x4){av[2], bv[2], av[3], bv[3]}; }
                LBAR();
                }
                float a8[8], b8[8];
                { float Ap = 1.f, H = 0.f;
#pragma unroll
                  for (int k = 0; k < 8; ++k) { const f32x2 v = AB[(sc * 8 + k) * 32 + ch]; a8[k] = v.x; b8[k] = v.y; H = v.x * H + v.y; Ap *= v.x; }
                  CAR[sc * 32 + ch] = (f32x2){Ap, H}; }
                LBAR();
                float hrun = ST[(tl & 1) * 32 + ch];
                { f32x2 cr[15];
#pragma unroll
                  for (int s = 0; s < 15; ++s) cr[s] = CAR[s * 32 + ch];
#pragma unroll
                  for (int s = 0; s < 15; ++s) hrun = (s < sc) ? cr[s].x * hrun + cr[s].y : hrun; }
#pragma unroll
                for (int k = 0; k < 8; ++k) { hrun = a8[k] * hrun + b8[k]; XF[(sc * 8 + k) * 32 + ch] = hrun; }
                if (sc == 15) ST[((tl + 1) & 1) * 32 + ch] = hrun;
            }
            LBAR();
            LRU_OUT();
            asm volatile("s_waitcnt vmcnt(0)" ::: "memory");
        }
        LBAR();
    }
#undef LRU_OUT
}

__device__ __forceinline__ void cu8(const bf16_t* ACT, size_t row, int col, float* o) {
    const u32x4 a = __builtin_nontemporal_load((const u32x4*)(ACT + row * 4096 + col)), c = __builtin_nontemporal_load((const u32x4*)(ACT + row * 4096 + 2048 + col));
    o[0] = bflo(a.x) * bflo(c.x); o[1] = bfhi(a.x) * bfhi(c.x); o[2] = bflo(a.y) * bflo(c.y); o[3] = bfhi(a.y) * bfhi(c.y);
    o[4] = bflo(a.z) * bflo(c.z); o[5] = bfhi(a.z) * bfhi(c.z); o[6] = bflo(a.w) * bflo(c.w); o[7] = bfhi(a.w) * bfhi(c.w);
}
__device__ __forceinline__ void phase_conv(const Args& A, const bf16_t* ACT, bf16_t* Y, const int wv) {
    const float* conv_w = A.in[27]; const float* conv_b = A.in[28];
    const int nitems = (MT / 8) * 128;
    const int tid = otid(wv);
    for (int item = blockIdx.x * NTHREADS + tid; item < nitems; item += gridDim.x * NTHREADS) {
        const int rg = item >> 7, chunk = item & 127, col = chunk * 8, row0 = rg * 8;
        const int seglen = row0 < ML ? SEQ : CTX;
        const bool first = (row0 % seglen) == 0, last = ((row0 + 8) % seglen) == 0;
        float w0[8], w1[8], w2[8], cb[8];
        { const f32x4* p = (const f32x4*)(conv_w + col); f32x4 a = p[0], c = p[1]; w0[0] = a.x; w0[1] = a.y; w0[2] = a.z; w0[3] = a.w; w0[4] = c.x; w0[5] = c.y; w0[6] = c.z; w0[7] = c.w;
          p = (const f32x4*)(conv_w + DM + col); a = p[0]; c = p[1]; w1[0] = a.x; w1[1] = a.y; w1[2] = a.z; w1[3] = a.w; w1[4] = c.x; w1[5] = c.y; w1[6] = c.z; w1[7] = c.w;
          p = (const f32x4*)(conv_w + 2 * DM + col); a = p[0]; c = p[1]; w2[0] = a.x; w2[1] = a.y; w2[2] = a.z; w2[3] = a.w; w2[4] = c.x; w2[5] = c.y; w2[6] = c.z; w2[7] = c.w;
          p = (const f32x4*)(conv_b + col); a = p[0]; c = p[1]; cb[0] = a.x; cb[1] = a.y; cb[2] = a.z; cb[3] = a.w; cb[4] = c.x; cb[5] = c.y; cb[6] = c.z; cb[7] = c.w; }
        float prev[8], cur[8], nxt[8];
        if (first) {
#pragma unroll
            for (int e = 0; e < 8; ++e) prev[e] = 0.f;
        } else cu8(ACT, (size_t)row0 - 1, col, prev);
        cu8(ACT, (size_t)row0, col, cur);
#pragma unroll
        for (int k = 0; k < 8; ++k) {
            const size_t row = (size_t)row0 + k;
            if (k == 7 && last) {
#pragma unroll
                for (int e = 0; e < 8; ++e) nxt[e] = 0.f;
            } else cu8(ACT, row + 1, col, nxt);
            const u32x4 bgw = __builtin_nontemporal_load((const u32x4*)(ACT + row * 4096 + 1024 + col)), sgw = __builtin_nontemporal_load((const u32x4*)(ACT + row * 4096 + 3072 + col));
            float y[8];
#pragma unroll
            for (int e = 0; e < 8; ++e) y[e] = w0[e] * prev[e] + w1[e] * cur[e] + w2[e] * nxt[e] + cb[e];
            y[0] *= bflo(bgw.x) * bflo(sgw.x); y[1] *= bfhi(bgw.x) * bfhi(sgw.x); y[2] *= bflo(bgw.y) * bflo(sgw.y); y[3] *= bfhi(bgw.y) * bfhi(sgw.y);
            y[4] *= bflo(bgw.z) * bflo(sgw.z); y[5] *= bfhi(bgw.z) * bfhi(sgw.z); y[6] *= bflo(bgw.w) * bflo(sgw.w); y[7] *= bfhi(bgw.w) * bfhi(sgw.w);
            u32x4 w; w.x = pk2(y[0], y[1]); w.y = pk2(y[2], y[3]); w.z = pk2(y[4], y[5]); w.w = pk2(y[6], y[7]);
            *(u32x4*)(Y + row * DM + col) = w;
#pragma unroll
            for (int e = 0; e < 8; ++e) { prev[e] = cur[e]; cur[e] = nxt[e]; }
        }
    }
}

__device__ __forceinline__ void phase_ctx_wout(const bf16_t* Yc, const bf16_t* Wt, const float* xin, float* xout, const float* gate, LAS unsigned char* L, const int wv) {
    constexpr int PITCH = 144, ABYTES = 128 * PITCH, BUFB = 192 * PITCH;
    const int tid = otid(wv), lane = tid & 63, r32 = lane & 31, hi = lane >> 5, wave = wv, G = gridDim.x;
    const int srow = tid >> 3, sch = tid & 7;
    const int aoff = ((wave >> 1) * 32 + r32) * PITCH + hi * 64, boff = ABYTES + ((wave & 1) * 32 + r32) * PITCH + hi * 64;
    for (int t = blockIdx.x; t < 256; t += G) {
        const int tm = t >> 4, tn = t & 15;
        const bf16_t* ga0 = Yc + (size_t)(tm * 128 + srow) * DM + sch * 8; const bf16_t* ga1 = ga0 + (size_t)64 * DM; const bf16_t* gb = Wt + (size_t)(tn * 64 + srow) * DM + sch * 8;
        f32x16 acc;
#pragma unroll
        for (int r = 0; r < 16; ++r) acc[r] = 0.f;
        u32x4 qa0[3], qa1[3], qb[3];
#define CTX_LOAD(q, s_) do { qa0[q] = *(const u32x4*)(ga0 + (s_) * 64); qa1[q] = *(const u32x4*)(ga1 + (s_) * 64); qb[q] = *(const u32x4*)(gb + (s_) * 64); } while (0)
#define CTX_WRITE(q, buf) do { LAS unsigned char* Bn = L + (buf) * BUFB; *(LAS u32x4*)(Bn + srow * PITCH + sch * 16) = qa0[q]; *(LAS u32x4*)(Bn + (64 + srow) * PITCH + sch * 16) = qa1[q]; *(LAS u32x4*)(Bn + ABYTES + srow * PITCH + sch * 16) = qb[q]; } while (0)
#define CTX_STEP(s_, q) do { const int s = (s_); LAS const unsigned char* B = L + (s & 1) * BUFB; bf16x8 a[4], b[4]; \
            _Pragma("unroll") for (int j = 0; j < 4; ++j) { a[j] = *(const LAS bf16x8*)(B + aoff + j * 16); b[j] = *(const LAS bf16x8*)(B + boff + j * 16); } \
            _Pragma("unroll") for (int j = 0; j < 4; ++j) acc = MFMA32(a[j], b[j], acc); \
            if (s + 1 < 16) CTX_WRITE(q, (s + 1) & 1); \
            LBAR(); \
            if (s + 4 < 16) CTX_LOAD(q, s + 4); } while (0)
        CTX_LOAD(0, 0); CTX_LOAD(1, 1); CTX_LOAD(2, 2);
        LBAR();
        CTX_WRITE(0, 0);
        CTX_LOAD(0, 3);
        LBAR();
#pragma unroll 1
        for (int s0 = 0; s0 < 16; s0 += 3) {
            CTX_STEP(s0, 1);
            if (s0 + 1 < 16) CTX_STEP(s0 + 1, 2);
            if (s0 + 2 < 16) CTX_STEP(s0 + 2, 0);
        }
#undef CTX_LOAD
#undef CTX_WRITE
#undef CTX_STEP
        const int m0 = tm * 128 + (wave >> 1) * 32, col = tn * 64 + (wave & 1) * 32 + r32; const float gv = gate[col];
#pragma unroll
        for (int r = 0; r < 16; ++r) { const size_t o = (size_t)(m0 + crow(r, hi)) * DM + col; xout[o] = __builtin_nontemporal_load(xin + o) + gv * acc[r]; }
    }
    LBAR();
}

__device__ __forceinline__ void phase_final(float* out, const float* g, const int wv) {
    const int tid = otid(wv); const int lane = tid & 63, gw = blockIdx.x * NWAVES + (tid >> 6), NGW = gridDim.x * NWAVES;
    f32x4 gv[4];
#pragma unroll
    for (int j = 0; j < 4; ++j) gv[j] = *((const f32x4*)g + 64 * j + lane);
    for (int row0 = gw * 4; row0 < ML; row0 += NGW * 4) {
        f32x4 v[4][4]; float s[4];
#pragma unroll
        for (int i = 0; i < 4; ++i) { const f32x4* xr = (const f32x4*)(out + (size_t)(row0 + i) * DM) + lane;
#pragma unroll
            for (int j = 0; j < 4; ++j) v[i][j] = __builtin_nontemporal_load(xr + 64 * j); }
#pragma unroll
        for (int i = 0; i < 4; ++i) { float a = 0.f;
#pragma unroll
            for (int j = 0; j < 4; ++j) a += (v[i][j].x * v[i][j].x + v[i][j].y * v[i][j].y) + (v[i][j].z * v[i][j].z + v[i][j].w * v[i][j].w);
            s[i] = a; }
#pragma unroll
        for (int o = 1; o < 64; o <<= 1) {
#pragma unroll
            for (int i = 0; i < 4; ++i) s[i] += __shfl_xor(s[i], o); }
#pragma unroll
        for (int i = 0; i < 4; ++i) { const float rstd = 1.0f / sqrtf(s[i] * (1.0f / DM) + EPS); f32x4* xr = (f32x4*)(out + (size_t)(row0 + i) * DM) + lane;
#pragma unroll
            for (int j = 0; j < 4; ++j) __builtin_nontemporal_store(v[i][j] * rstd * gv[j], xr + 64 * j); }
    }
}

#define RLX_AGENT __ATOMIC_RELAXED, __HIP_MEMORY_SCOPE_AGENT
#define XB_TMO      128
#define XB_XCNT(j)  (256  + 64 * (j))
#define XB_XSUB(j)  (1280 + 64 * (j))
#define XB_XGEN(j)  (2304 + 64 * (j))
#define XB_TOP      3328
#define XB_TOPGEN   3392
#define XCD_BAR_WORDS 3456
#define XB_SPIN_CAP (1u << 18)

__device__ __forceinline__ unsigned xb_ld(unsigned* p)              { return __hip_atomic_load(p, __ATOMIC_RELAXED, __HIP_MEMORY_SCOPE_AGENT); }
__device__ __forceinline__ unsigned xb_add(unsigned* p, unsigned v) { return __hip_atomic_fetch_add(p, v, __ATOMIC_RELAXED, __HIP_MEMORY_SCOPE_AGENT); }
__device__ __forceinline__ unsigned xb_xcc_id() { return (unsigned)__builtin_amdgcn_s_getreg((3 << 11) | 20) & 0xFu; }
#define XB_SPIN(cond, bar) do { unsigned _sp = 0; while (cond) { __builtin_amdgcn_s_sleep(1); \
    if ((++_sp & 255u) == 0u) { if (xb_ld(&(bar)[XB_TMO])) break; if (_sp > XB_SPIN_CAP) { atomicAdd(&(bar)[XB_TMO], 1u); break; } } } } while (0)

struct XcdBarrier {
    unsigned* bar; unsigned x;
    volatile LAS unsigned* st;
};

__device__ __forceinline__ XcdBarrier xcd_barrier_post(unsigned* bar, volatile LAS unsigned* st) {
    XcdBarrier b; b.bar = bar; b.x = xb_xcc_id(); b.st = st;
    if (threadIdx.x == 0) (void)xb_add(&bar[XB_XCNT(b.x)], 1u);
    return b;
}
__device__ __forceinline__ void xcd_barrier_complete(unsigned* bar, unsigned x, unsigned& nloc, unsigned& nx) {
    const unsigned G = gridDim.x * gridDim.y * gridDim.z;
    unsigned sum, cnt, mine, sp = 0u;
    for (;;) {
        sum = 0u; cnt = 0u; mine = 0u;
#pragma unroll
        for (unsigned j = 0; j < 16; ++j) { const unsigned c = xb_ld(&bar[XB_XCNT(j)]); sum += c; cnt += (c > 0u) ? 1u : 0u; mine = (j == x) ? c : mine; }
        if (sum == G) break;
        __builtin_amdgcn_s_sleep(1);
        if ((++sp & 255u) == 0u) { if (xb_ld(&bar[XB_TMO])) break; if (sp > XB_SPIN_CAP) { atomicAdd(&bar[XB_TMO], 1u); break; } }
    }
    nloc = mine > 0u ? mine : 1u; nx = cnt > 0u ? cnt : 1u;
}

__device__ __forceinline__ void xcd_barrier(const XcdBarrier& b) {
    asm volatile("s_waitcnt vmcnt(0)" ::: "memory");
    __syncthreads();
    if (threadIdx.x == 0) {
        unsigned* bar = b.bar;
        __builtin_amdgcn_s_waitcnt(0);
        unsigned nloc = b.st[0], nx = b.st[1];
        if (nloc == 0u) { xcd_barrier_complete(bar, b.x, nloc, nx); b.st[0] = nloc; b.st[1] = nx; }
        const unsigned old = xb_add(&bar[XB_XSUB(b.x)], 1u);
        const unsigned gen = old / nloc;
        if (old + 1u == (gen + 1u) * nloc) {
            __builtin_amdgcn_fence(__ATOMIC_RELEASE, "agent");
            asm volatile("s_waitcnt vmcnt(0)" ::: "memory");
            const unsigned og = xb_add(&bar[XB_TOP], 1u);
            const unsigned tg = og / nx;
            if (og + 1u == (tg + 1u) * nx) xb_add(&bar[XB_TOPGEN], 1u);
            else XB_SPIN(xb_ld(&bar[XB_TOPGEN]) == tg, bar);
            __builtin_amdgcn_fence(__ATOMIC_ACQUIRE, "agent");
            xb_add(&bar[XB_XGEN(b.x)], 1u);
            asm volatile("s_waitcnt vmcnt(0)" ::: "memory");
        } else {
            XB_SPIN(xb_ld(&bar[XB_XGEN(b.x)]) == gen, bar);
            __builtin_amdgcn_fence(__ATOMIC_ACQUIRE, "agent");
            asm volatile("s_waitcnt vmcnt(0)" ::: "memory");
        }
    }
    __syncthreads();
}

__global__ void __launch_bounds__(NTHREADS, 2) hybrid_fwd(Args A) {
    extern __shared__ __attribute__((aligned(16))) unsigned char lds[];
    cg::grid_group grid = cg::this_grid();
    LAS unsigned char* L = (LAS unsigned char*)lds;
    unsigned char* ws = A.ws;
    const int G = gridDim.x;
    float* XL = A.out; float* XC = (float*)(ws + WS_XC);
    bf16_t* XN = (bf16_t*)(ws + WS_XN); bf16_t* ACT = (bf16_t*)(ws + WS_ACT);
    const float* gatef = (const float*)(ws + WS_GATE);

    const int wv = __builtin_amdgcn_readfirstlane((int)threadIdx.x >> 6);
    volatile LAS unsigned* MISC = (volatile LAS unsigned*)(L + 131072 + 320);
    if (threadIdx.x < 32) MISC[threadIdx.x] = 0u;
    __syncthreads();
    XcdBarrier xbar = xcd_barrier_post((unsigned*)ws + 4096, MISC + 8);
#define GSYNC() xcd_barrier(xbar)
#pragma unroll 1
    for (int l = 0; l < 4; ++l) { phase_prep(A, L, l, (int)((blockIdx.x + 64 * l) % G), G, wv); LBAR(); }
    if (A.out == nullptr) grid.sync();
    for (int rep = 0; rep < DUP_SYNC; ++rep) GSYNC();
#pragma unroll 1
    for (int layer = 0; layer < 4; ++layer) {
        ws = ows(ws);
        const int kind = layer == 3 ? 0 : layer;
        const int Nin = kind == 0 ? 2560 : (kind == 1 ? 2048 : 4096);
        const float* xinL = layer == 0 ? A.in[0] : XL; const float* xinC = layer == 0 ? A.in[2] : XC;
        for (int rep = 0; rep < DUP_NORM; ++rep) phase_norm(A, layer, xinL, xinC, L, wv);
        GSYNC();
        {
            const bf16_t* Wt = (const bf16_t*)(ws + (layer == 0 ? WS_WIN[0] : layer == 1 ? WS_WIN[1] : layer == 2 ? WS_WIN[2] : WS_WIN[3]));
            pg8::Gemm g{XN, Wt, layer == 3 ? ML : MT, Nin, DM};
            pg8::OrderG S; S.so.init(layer == 3 ? ML : MT, Nin, G, (int)blockIdx.x); S.extra = layer == 3 ? 16 : 0;
            pg8::EpiIn E{ACT, Nin, kind, (const float*)(ws + WS_ROPE)};
            for (int rep = 0; rep < DUP_GIN; ++rep) pg8::gemm_phase<pg8::EpiIn, pg8::OrderG, true, true>(L, g, S, E, wv);
        }
        GSYNC();
        if (kind == 0) { for (int rep = 0; rep < DUP_ATTN; ++rep) phase_attn(ACT, XN, (layer == 0 ? A.in[9] : A.in[34]), layer == 0, L, wv); }
        else if (kind == 1) { for (int rep = 0; rep < DUP_LRU; ++rep) phase_lru(A, ACT, XN, (float*)(ws + WS_HF), L, wv); }
        else { for (int rep = 0; rep < DUP_CONV; ++rep) phase_conv(A, ACT, XN, wv); }
        GSYNC();
        {
            const bf16_t* Wt = (const bf16_t*)(ws + (layer == 0 ? WS_WOUT[0] : layer == 1 ? WS_WOUT[1] : layer == 2 ? WS_WOUT[2] : WS_WOUT[3]));
            const int Mo = (CTX_SMALL || layer == 3) ? ML : MT;
            pg8::Gemm g{XN, Wt, Mo, DM, DM};
            pg8::OrderG S; S.so.init(Mo, DM, G, (int)blockIdx.x); S.extra = 0;
            pg8::EpiRes E{xinL, xinC, XL, XC, gatef + (size_t)layer * 9 * 1024};
            for (int rep = 0; rep < (layer == 0 ? DUP_GOUT0 : 1); ++rep) pg8::gemm_phase<pg8::EpiRes, pg8::OrderG, true, true>(L, g, S, E, wv);
            if (CTX_SMALL && layer < 3) phase_ctx_wout(XN + (size_t)ML * DM, Wt, xinC, XC, gatef + (size_t)(layer * 9 + 8) * 1024, L, wv);
        }
        GSYNC();
    }
    phase_final(XL, A.in[35], wv);
}

extern "C" void kernel_launch(void* const* d_in, const int* in_sizes, int n_in, void* d_out, int out_size, void* d_ws, size_t ws_size, hipStream_t stream) {
    static int grid = 0;
    if (grid == 0) {
        if (n_in != 36 || out_size != ML * DM || ws_size < WS_END) { fprintf(stderr, "kernel_launch: unexpected shapes (n_in %d, out %d, ws %zu)\n", n_in, out_size, ws_size); grid = -1; return; }
        int dev = 0, cus = 0, per_cu = 0;
        hipGetDevice(&dev); hipDeviceGetAttribute(&cus, hipDeviceAttributeMultiprocessorCount, dev);
        if (hipFuncSetAttribute((const void*)hybrid_fwd, hipFuncAttributeMaxDynamicSharedMemorySize, LDS_BYTES) != hipSuccess) { fprintf(stderr, "kernel_launch: hipFuncSetAttribute failed\n"); grid = -1; return; }
        if (hipOccupancyMaxActiveBlocksPerMultiprocessor(&per_cu, (const void*)hybrid_fwd, NTHREADS, LDS_BYTES) != hipSuccess || per_cu < 1) { fprintf(stderr, "kernel_launch: occupancy query says %d\n", per_cu); per_cu = 1; }
        (void)hipGetLastError();
        grid = cus * (per_cu > 1 ? 1 : per_cu);
        if (grid > 256) grid = 256;
    }
    if (grid < 0) return;
    if (hipMemsetAsync(d_ws, 0, 65536, stream) != hipSuccess) { fprintf(stderr, "kernel_launch: memset failed\n"); return; }
    Args a{};
    for (int i = 0; i < 36; ++i) a.in[i] = (const float*)d_in[i];
    a.out = (float*)d_out; a.ws = (unsigned char*)d_ws;
    void* args[] = {&a};
    hipError_t e = hipLaunchCooperativeKernel((const void*)hybrid_fwd, dim3(grid), dim3(NTHREADS), args, LDS_BYTES, stream);
    if (e != hipSuccess) fprintf(stderr, "kernel_launch: cooperative launch failed: %s (grid %d)\n", hipGetErrorString(e), grid);
}
```

```cpp
#include <hip/hip_runtime.h>
#include <hip/hip_cooperative_groups.h>
#include <cstdio>
#include <cstdint>
namespace cg = cooperative_groups;

namespace pg8 {
#define PG8_LAS __attribute__((address_space(3)))
typedef unsigned short bf16_t;
typedef short bf16x8 __attribute__((ext_vector_type(8)));
typedef float f32x4 __attribute__((ext_vector_type(4)));
typedef unsigned u32x4 __attribute__((ext_vector_type(4)));
constexpr int BM = 256, BK = 64, HALF = 128, HTB = HALF * BK * 2  , STAGE_BYTES = 8 * HTB, NXCD = 8, WGM = 8;

__host__ __device__ __forceinline__ int lds_byte(int r, int c) { const int st = (r >> 4) * 2 + (c >> 5), rr = r & 15, cc = c & 31, ob = rr * 64 + cc * 2; return st * 1024 + (ob ^ (((ob >> 9) & 1) << 5)); }
__host__ __device__ __forceinline__ void stage_rc(int b, int& R, int& C) { const int st = b / 1024, sb = b % 1024, swz = sb ^ (((sb >> 9) & 1) << 5); R = (st >> 1) * 16 + swz / 64; C = (st & 1) * 32 + (swz % 64) / 2; }
__host__ __device__ __forceinline__ int perm32(int rho) { const int n = rho >> 4, i = rho & 15; return 8 * (i >> 2) + 4 * n + (i & 3); }

struct Unit { int pm, pn; };
struct Gemm { const bf16_t* A; const bf16_t* Bt; int M, N, K; };

struct StaticOrder {
    int nM, nN, nwg, G, c;
    __host__ __device__ void init(int M, int N, int G_, int c_) { nM = M / BM; nN = N / BM; nwg = nM * nN; G = G_; c = c_; }
    __host__ __device__ bool next(int i, Unit& u) const {
        const long L = (long)i * G + c; if (L >= nwg) return false;
        int wgid = (int)L; { const int q = nwg / NXCD, r = nwg % NXCD, xcd = wgid % NXCD, off = wgid / NXCD; wgid = (xcd < r ? xcd * (q + 1) : r * (q + 1) + (xcd - r) * q) + off; }
        const int nig = WGM * nN, gid = wgid / nig, fm = gid * WGM, gsz = (nM - fm) < WGM ? (nM - fm) : WGM;
        u.pm = fm + ((wgid % nig) % gsz); u.pn = (wgid % nig) / gsz; return true;
    }
    __device__ __forceinline__ void a_ready(const Unit&) const {}
    __device__ __forceinline__ void done(const Unit&) const {}
};

__device__ __forceinline__ unsigned cvt_pk_bf16(float lo, float hi) { unsigned r; asm volatile("v_cvt_pk_bf16_f32 %0, %1, %2" : "=v"(r) : "v"(lo), "v"(hi)); return r; }
typedef float f32x2 __attribute__((ext_vector_type(2)));
__device__ __forceinline__ float silu_f(float v) { return v * __builtin_amdgcn_rcpf(1.0f + __builtin_amdgcn_exp2f(-v * 1.4426950408889634f)); }
constexpr float QSCALE = 0.125f * 1.4426950408889634f;

struct OrderG {
    StaticOrder so; int extra;
    __device__ __forceinline__ bool next(int i, Unit& u) const {
        long L = (long)i * so.G + so.c; if (L < so.nwg) return so.next(i, u);
        L -= so.nwg; if (L >= extra) return false; u.pm = 64 + (int)(L >> 1); u.pn = 4 + (int)(L & 1); return true;
    }
    __device__ __forceinline__ void a_ready(const Unit&) const {}
    __device__ __forceinline__ void done(const Unit&) const {}
};

struct EpiIn {
    static constexpr bool PERM = true, AFTER_DRAIN = false;
    bf16_t* O; int ldc; int kind; const float* rope;
    __device__ __forceinline__ void operator()(const f32x4 (&acc)[2][2][4][2], const Unit& u, int wr, int wc, int fr, int fq) const {
        const int colt = u.pn * BM; const bool lat = u.pm < 64;
        int mode = 0; float sc = 1.f;
        if (kind == 0) { if (colt < 1024) { mode = lat ? 2 : 0; sc = QSCALE; } else if (colt < 1280) mode = lat ? 2 : 0; else if (colt < 1536) mode = 0; else mode = 1; }
        else if (kind == 1) mode = colt < 1024 ? 0 : 1;
        else mode = colt < 3072 ? 0 : 1;
        const int row0 = u.pm * BM + wr * 64 + fr; const int col0 = colt + wc * 32 + 8 * fq;
        const float sgn = (fq < 2) ? -1.f : 1.f;
#pragma unroll
        for (int ai = 0; ai < 2; ++ai)
#pragma unroll
            for (int m = 0; m < 4; ++m) {
                const int row = row0 + ai * HALF + m * 16;
                bf16_t* rowp = O + (size_t)row * ldc + col0;
                f32x4 cs[4];
                if (mode == 2) { const int l = row & 2047; const int p = (wc & 1) ? (l & 63) : (l >> 6); const f32x4* rp = (const f32x4*)(rope + (p * 16 + 8 * (fq & 1)) * 2);
                    cs[0] = rp[0]; cs[1] = rp[1]; cs[2] = rp[2]; cs[3] = rp[3]; }
#pragma unroll
                for (int bj = 0; bj < 2; ++bj) {
                    f32x4 v0 = acc[ai][bj][m][0], v1 = acc[ai][bj][m][1];
                    if (mode == 1) {
#pragma unroll
                        for (int e = 0; e < 4; ++e) { v0[e] = silu_f(v0[e]); v1[e] = silu_f(v1[e]); }
                    } else if (mode == 2) {
                        f32x4 p0, p1;
#pragma unroll
                        for (int e = 0; e < 4; ++e) { p0[e] = __shfl_xor(v0[e], 32); p1[e] = __shfl_xor(v1[e], 32); }
                        v0[0] = v0[0] * cs[0][0] + sgn * p0[0] * cs[0][1]; v0[1] = v0[1] * cs[0][2] + sgn * p0[1] * cs[0][3];
                        v0[2] = v0[2] * cs[1][0] + sgn * p0[2] * cs[1][1]; v0[3] = v0[3] * cs[1][2] + sgn * p0[3] * cs[1][3];
                        v1[0] = v1[0] * cs[2][0] + sgn * p1[0] * cs[2][1]; v1[1] = v1[1] * cs[2][2] + sgn * p1[1] * cs[2][3];
                        v1[2] = v1[2] * cs[3][0] + sgn * p1[2] * cs[3][1]; v1[3] = v1[3] * cs[3][2] + sgn * p1[3] * cs[3][3];
                    }
                    v0 = v0 * sc; v1 = v1 * sc;
                    u32x4 w; w.x = cvt_pk_bf16(v0[0], v0[1]); w.y = cvt_pk_bf16(v0[2], v0[3]); w.z = cvt_pk_bf16(v1[0], v1[1]); w.w = cvt_pk_bf16(v1[2], v1[3]);
                    *(u32x4*)(rowp + bj * HALF) = w;
                }
            }
    }
};

struct EpiRes {
    static constexpr bool PERM = true, AFTER_DRAIN = false;
    const float* inL; const float* inC; float* outL; float* outC; const float* gate;
    __device__ __forceinline__ void operator()(const f32x4 (&acc)[2][2][4][2], const Unit& u, int wr, int wc, int fr, int fq) const {
        const bool lat = u.pm < 64;
        const float* ib = lat ? inL + (size_t)u.pm * BM * 1024 : inC + (size_t)(u.pm - 64) * BM * 1024;
        float* ob = lat ? outL + (size_t)u.pm * BM * 1024 : outC + (size_t)(u.pm - 64) * BM * 1024;
        const float* g = gate + (lat ? (u.pm >> 3) : 8) * 1024;
        const int col0 = u.pn * BM + wc * 32 + 8 * fq;
        f32x4 gv[2][2];
#pragma unroll
        for (int bj = 0; bj < 2; ++bj)
#pragma unroll
            for (int n = 0; n < 2; ++n) gv[bj][n] = *(const f32x4*)(g + col0 + bj * HALF + n * 4);
#pragma unroll
        for (int ai = 0; ai < 2; ++ai)
#pragma unroll
            for (int m = 0; m < 4; ++m) { const size_t off = (size_t)(ai * HALF + wr * 64 + m * 16 + fr) * 1024 + col0;
#pragma unroll
                for (int bj = 0; bj < 2; ++bj)
#pragma unroll
                    for (int n = 0; n < 2; ++n) { const f32x4 x = __builtin_nontemporal_load((const f32x4*)(ib + off + bj * HALF + n * 4));
                        *(f32x4*)(ob + off + bj * HALF + n * 4) = x + gv[bj][n] * acc[ai][bj][m][n]; }
                if (m & 1) asm volatile("" ::: "memory"); }
    }
};

template <class Epi, class Sched, bool ALIGN_EPI = false, bool SP2 = false>
__device__ __forceinline__ void gemm_phase(PG8_LAS unsigned char* lds, const Gemm g, const Sched& S, const Epi& E, const int wv_) {
    int tid_ = wv_ * 64 + (int)__builtin_amdgcn_mbcnt_hi(~0u, __builtin_amdgcn_mbcnt_lo(~0u, 0u)); asm volatile("" : "+v"(tid_));
    const int tid = tid_, wid = __builtin_amdgcn_readfirstlane(tid >> 6), lane = tid & 63, wr = wid >> 2, wc = wid & 3, fr = lane & 15, fq = lane >> 4;
    const int K = g.K, nt = K / BK;
    unsigned voffA[2], voffB[2];
#pragma unroll
    for (int i = 0; i < 2; ++i) { int R, C; stage_rc(tid * 16 + i * 8192, R, C); const int Rb = Epi::PERM ? ((R & ~31) + perm32(R & 31)) : R;
        voffA[i] = (unsigned)(R * K + C) * 2u; voffB[i] = (unsigned)(Rb * K + C) * 2u; }
    const size_t kstep = (size_t)(BK * 2);
    const size_t hstep = (size_t)HALF * K * 2;
    const size_t tstep = 2 * hstep;
    const unsigned ldsw = (unsigned)wid * 1024u;
    const int aoff = lds_byte(wr * 64 + fr, fq * 8), boff = lds_byte(wc * 32 + fr, fq * 8);
#define PG8_SA(b, h) (((b) * 2 + (h)) * HTB)
#define PG8_SB(b, h) ((4 + (b) * 2 + (h)) * HTB)
#define PG8_STAGE(bufoff, gbase, voff) do { _Pragma("unroll") for (int _i = 0; _i < 2; ++_i) \
        __builtin_amdgcn_global_load_lds((const unsigned*)((const char*)(gbase) + (voff)[_i]), (PG8_LAS unsigned*)(lds + (bufoff) + ldsw + _i * 8192), 16, 0, 0); } while (0)
#define PG8_LDA(dst, b, h) do { _Pragma("unroll") for (int m = 0; m < 4; ++m) _Pragma("unroll") for (int k = 0; k < 2; ++k) dst[m][k] = *(const PG8_LAS bf16x8*)(lds + PG8_SA(b, h) + aoff + m * 2048 + k * 1024); } while (0)
#define PG8_LDB(dst, b, h) do { _Pragma("unroll") for (int n = 0; n < 2; ++n) _Pragma("unroll") for (int k = 0; k < 2; ++k) dst[n][k] = *(const PG8_LAS bf16x8*)(lds + PG8_SB(b, h) + boff + n * 2048 + k * 1024); } while (0)
#define PG8_MMA(ai, bj, At, Bt) do { __builtin_amdgcn_s_setprio(1); _Pragma("unroll") for (int m = 0; m < 4; ++m) _Pragma("unroll") for (int n = 0; n < 2; ++n) _Pragma("unroll") for (int k = 0; k < 2; ++k) \
        acc[ai][bj][m][n] = __builtin_amdgcn_mfma_f32_16x16x32_bf16(Bt[n][k], At[m][k], acc[ai][bj][m][n], 0, 0, 0); __builtin_amdgcn_s_setprio(0); } while (0)
#define PG8_WAIT_V(n) asm volatile("s_waitcnt vmcnt(" #n ")" ::: "memory")
#define PG8_WAIT_L(n) asm volatile("s_waitcnt lgkmcnt(" #n ")" ::: "memory")
#define PG8_BAR __builtin_amdgcn_s_barrier()
#define PG8_SCHED __builtin_amdgcn_sched_barrier(0)
    Unit cur, nxt; int ui = 0;
    if (!S.next(0, cur)) return;
    f32x4 acc[2][2][4][2];
#pragma unroll
    for (int a = 0; a < 2; ++a)
#pragma unroll
        for (int b = 0; b < 2; ++b)
#pragma unroll
            for (int m = 0; m < 4; ++m)
#pragma unroll
                for (int n = 0; n < 2; ++n) acc[a][b][m][n] = (f32x4){0.f, 0.f, 0.f, 0.f};
    bf16x8 At[4][2], B0[2][2], B1[2][2];
    const char* cA = (const char*)g.A + (size_t)cur.pm * tstep; const char* cB = (const char*)g.Bt + (size_t)cur.pn * tstep;
    S.a_ready(cur);
    if constexpr (SP2) {
        PG8_STAGE(PG8_SB(0, 0), cB, voffB); PG8_STAGE(PG8_SB(0, 1), cB + hstep, voffB); PG8_STAGE(PG8_SA(0, 0), cA, voffA); PG8_STAGE(PG8_SA(0, 1), cA + hstep, voffA);
        if (wr == 1) PG8_BAR;
        PG8_WAIT_V(2); PG8_BAR;
        PG8_STAGE(PG8_SB(1, 0), cB + kstep, voffB); PG8_STAGE(PG8_SA(1, 0), cA + kstep, voffA); PG8_STAGE(PG8_SB(1, 1), cB + hstep + kstep, voffB);
        PG8_WAIT_V(6); PG8_BAR;
    } else {
        PG8_STAGE(PG8_SB(0, 0), cB, voffB); PG8_STAGE(PG8_SA(0, 0), cA, voffA); PG8_STAGE(PG8_SB(0, 1), cB + hstep, voffB); PG8_STAGE(PG8_SA(0, 1), cA + hstep, voffA);
        if (wr == 1) PG8_BAR;
        PG8_WAIT_V(4); PG8_BAR;
        PG8_STAGE(PG8_SB(1, 0), cB + kstep, voffB); PG8_STAGE(PG8_SA(1, 0), cA + kstep, voffA); PG8_STAGE(PG8_SB(1, 1), cB + hstep + kstep, voffB);
        PG8_WAIT_V(6); PG8_BAR;
    }
    for (;;) {
        const bool has_next = S.next(ui + 1, nxt);
        const char* nA = has_next ? (const char*)g.A + (size_t)nxt.pm * tstep : cA; const char* nB = has_next ? (const char*)g.Bt + (size_t)nxt.pn * tstep : cB;
        for (int t = 0; t < nt; t += 2) {
            const bool last = (t == nt - 2);
            const char* a1 = cA + (size_t)(t + 1) * kstep;
            const char* a2 = last ? nA : cA + (size_t)(t + 2) * kstep; const char* b2 = last ? nB : cB + (size_t)(t + 2) * kstep;
            const char* a3 = a2 + kstep; const char* b3 = b2 + kstep;
            if (last && has_next) S.a_ready(nxt);
            if constexpr (SP2) {
            PG8_LDB(B0, 0, 0); PG8_LDB(B1, 0, 1); PG8_SCHED; PG8_LDA(At, 0, 0); PG8_STAGE(PG8_SA(1, 1), a1 + hstep, voffA);
            PG8_WAIT_V(8); PG8_WAIT_L(0); PG8_BAR; PG8_MMA(0, 0, At, B0); PG8_MMA(0, 1, At, B1); PG8_BAR; PG8_SCHED;
            PG8_LDA(At, 0, 1); PG8_STAGE(PG8_SB(0, 0), b2, voffB); PG8_STAGE(PG8_SB(0, 1), b2 + hstep, voffB); PG8_STAGE(PG8_SA(0, 0), a2, voffA);
            PG8_WAIT_V(8); PG8_WAIT_L(0); PG8_BAR; PG8_MMA(1, 0, At, B0); PG8_MMA(1, 1, At, B1); PG8_BAR; PG8_SCHED;
            PG8_LDB(B0, 1, 0); PG8_LDB(B1, 1, 1); PG8_SCHED; PG8_LDA(At, 1, 0); PG8_STAGE(PG8_SA(0, 1), a2 + hstep, voffA);
            PG8_WAIT_V(8); PG8_WAIT_L(0); PG8_BAR; PG8_MMA(0, 0, At, B0); PG8_MMA(0, 1, At, B1); PG8_BAR; PG8_SCHED;
            PG8_LDA(At, 1, 1); PG8_STAGE(PG8_SB(1, 0), b3, voffB); PG8_STAGE(PG8_SB(1, 1), b3 + hstep, voffB); PG8_STAGE(PG8_SA(1, 0), a3, voffA);
            PG8_WAIT_V(8); PG8_WAIT_L(0); PG8_BAR; PG8_MMA(1, 0, At, B0); PG8_MMA(1, 1, At, B1); PG8_BAR; PG8_SCHED;
            } else {
            PG8_LDB(B0, 0, 0); PG8_SCHED; PG8_LDA(At, 0, 0); PG8_STAGE(PG8_SA(1, 1), a1 + hstep, voffA);
            PG8_WAIT_L(8); PG8_BAR; PG8_WAIT_L(0); PG8_MMA(0, 0, At, B0); PG8_BAR; PG8_SCHED;
            PG8_LDB(B1, 0, 1); PG8_STAGE(PG8_SB(0, 0), b2, voffB);
            PG8_BAR; PG8_WAIT_L(0); PG8_MMA(0, 1, At, B1); PG8_BAR;
            PG8_LDA(At, 0, 1); PG8_STAGE(PG8_SA(0, 0), a2, voffA);
            PG8_BAR; PG8_WAIT_L(0); PG8_MMA(1, 0, At, B0); PG8_BAR; PG8_SCHED;
            PG8_STAGE(PG8_SB(0, 1), b2 + hstep, voffB);
            PG8_WAIT_V(6); PG8_BAR; PG8_MMA(1, 1, At, B1); PG8_BAR;
            PG8_LDB(B0, 1, 0); PG8_SCHED; PG8_LDA(At, 1, 0); PG8_STAGE(PG8_SA(0, 1), a2 + hstep, voffA);
            PG8_WAIT_L(8); PG8_BAR; PG8_WAIT_L(0); PG8_MMA(0, 0, At, B0); PG8_BAR; PG8_SCHED;
            PG8_LDB(B1, 1, 1); PG8_STAGE(PG8_SB(1, 0), b3, voffB);
            PG8_BAR; PG8_WAIT_L(0); PG8_MMA(0, 1, At, B1); PG8_BAR;
            PG8_LDA(At, 1, 1); PG8_STAGE(PG8_SA(1, 0), a3, voffA);
            PG8_BAR; PG8_WAIT_L(0); PG8_MMA(1, 0, At, B0); PG8_BAR; PG8_SCHED;
            PG8_STAGE(PG8_SB(1, 1), b3 + hstep, voffB);
            PG8_WAIT_V(6); PG8_BAR; PG8_MMA(1, 1, At, B1); PG8_BAR;
            }
        }
        if constexpr (ALIGN_EPI) { if (wr == 0) PG8_BAR; }
        if constexpr (!Epi::AFTER_DRAIN) { E(acc, cur, wr, wc, fr, fq); S.done(cur); }
        if (!has_next) break;
#pragma unroll
        for (int a = 0; a < 2; ++a)
#pragma unroll
            for (int b = 0; b < 2; ++b)
#pragma unroll
                for (int m = 0; m < 4; ++m)
#pragma unroll
                    for (int n = 0; n < 2; ++n) acc[a][b][m][n] = (f32x4){0.f, 0.f, 0.f, 0.f};
        cur = nxt; cA = nA; cB = nB; ++ui;
        if constexpr (ALIGN_EPI) { if (wr == 1) PG8_BAR; }
    }
    PG8_WAIT_V(0);
    if constexpr (!ALIGN_EPI) { if (wr == 0) PG8_BAR; }
    PG8_BAR;
    if constexpr (Epi::AFTER_DRAIN) { E.fused(acc, cur, wr, wc, fr, fq, lds, wid, lane); S.done(cur); }
#undef PG8_SA
#undef PG8_SB
#undef PG8_STAGE
#undef PG8_LDA
#undef PG8_LDB
#undef PG8_MMA
#undef PG8_WAIT_V
#undef PG8_WAIT_L
#undef PG8_BAR
#undef PG8_SCHED
}
}

#define LAS __attribute__((address_space(3)))
typedef unsigned short bf16_t;
typedef short bf16x8 __attribute__((ext_vector_type(8)));
typedef short s16x4 __attribute__((ext_vector_type(4)));
typedef float f32x4 __attribute__((ext_vector_type(4)));
typedef float f32x2 __attribute__((ext_vector_type(2)));
typedef float f32x16 __attribute__((ext_vector_type(16)));
typedef unsigned u32x4 __attribute__((ext_vector_type(4)));
typedef unsigned u32x2 __attribute__((ext_vector_type(2)));

#ifndef DUP_ATTN
#define DUP_ATTN 1
#endif
#ifndef DUP_LRU
#define DUP_LRU 1
#endif
#ifndef DUP_CONV
#define DUP_CONV 1
#endif
#ifndef DUP_GIN
#define DUP_GIN 1
#endif
#ifndef DUP_NORM
#define DUP_NORM 1
#endif
#ifndef DUP_PRO
#define DUP_PRO 1
#endif
#ifndef DUP_GOUT0
#define DUP_GOUT0 1
#endif
#ifndef DUP_LRUBC
#define DUP_LRUBC 1
#endif
#ifndef DUP_ATTEPI
#define DUP_ATTEPI 1
#endif
#ifndef DUP_SYNC
#define DUP_SYNC 1
#endif
#ifndef CTX_SMALL
#define CTX_SMALL 1
#endif
constexpr int NTHREADS = 512, NWAVES = 8;
constexpr int DM = 1024, NB = 8, SEQ = 2048, CTX = 256;
constexpr int ML = NB * SEQ, MC = NB * CTX, MT = ML + MC;
constexpr float EPS = 1e-6f, LOG2E = 1.4426950408889634f;
constexpr int LDS_BYTES = 147456;

constexpr size_t MiB = 1u << 20;
constexpr size_t WS_MODP = 1 * MiB;
constexpr size_t WS_GATE = 5 * MiB;
constexpr size_t WS_ROPE = 5 * MiB + 512 * 1024;
constexpr size_t WS_GW = 6 * MiB;
constexpr size_t WS_WIN[4] = {8 * MiB, 15 * MiB, 21 * MiB, 31 * MiB};
constexpr size_t WS_WOUT[4] = {13 * MiB, 19 * MiB, 29 * MiB, 36 * MiB};
constexpr size_t WS_XC = 38 * MiB;
constexpr size_t WS_XN = 46 * MiB;
constexpr size_t WS_ACT = 82 * MiB;
constexpr size_t WS_HF = 154 * MiB;
constexpr size_t WS_END = 226 * MiB;

struct Args { const float* in[36]; float* out; unsigned char* ws; };

#define LBAR() do { asm volatile("s_waitcnt lgkmcnt(0)" ::: "memory"); __builtin_amdgcn_s_barrier(); asm volatile("" ::: "memory"); } while (0)

__device__ __forceinline__ unsigned f2bf(float f) { unsigned u = __builtin_bit_cast(unsigned, f); return (u + 0x7fffu + ((u >> 16) & 1u)) >> 16; }
__device__ __forceinline__ unsigned pk2(float lo, float hi) { return pg8::cvt_pk_bf16(lo, hi); }
__device__ __forceinline__ float bflo(unsigned w) { return __builtin_bit_cast(float, w << 16); }
__device__ __forceinline__ float bfhi(unsigned w) { return __builtin_bit_cast(float, w & 0xffff0000u); }
__device__ __forceinline__ unsigned char* ows(unsigned char* p) { const unsigned long long v = (unsigned long long)p; unsigned lo = __builtin_amdgcn_readfirstlane((unsigned)v), hi = __builtin_amdgcn_readfirstlane((unsigned)(v >> 32)); asm volatile("" : "+s"(lo), "+s"(hi)); return (unsigned char*)(__attribute__((address_space(1))) unsigned char*)(((unsigned long long)hi << 32) | lo); }
__device__ __forceinline__ int otid(int wv) { int t = wv * 64 + (int)__builtin_amdgcn_mbcnt_hi(~0u, __builtin_amdgcn_mbcnt_lo(~0u, 0u)); asm volatile("" : "+v"(t)); return t; }
__device__ __forceinline__ float wave_sum(float v) {
#pragma unroll
    for (int o = 1; o < 64; o <<= 1) v += __shfl_xor(v, o);
    return v;
}
using pg8::silu_f;

__device__ __forceinline__ void transpose_item(const float* W, int K, int N, bf16_t* WT, LAS float* scr, int item, int lane) {
    const int nblk = N / 32, kb = item / nblk, nb = item % nblk, k0 = 64 * kb, n0 = 32 * nb;
    float tv[32];
#pragma unroll
    for (int i = 0; i < 32; ++i) tv[i] = __builtin_nontemporal_load(W + (size_t)(k0 + 2 * i + (lane >> 5)) * N + n0 + (lane & 31));
#pragma unroll
    for (int i = 0; i < 32; ++i) scr[(2 * i + (lane >> 5)) * 33 + (lane & 31)] = tv[i];
    asm volatile("s_waitcnt lgkmcnt(0)" ::: "memory");
    const int c = lane & 7;
#pragma unroll
    for (int j = 0; j < 4; ++j) { const int n = (lane >> 3) + 8 * j; const LAS float* s = scr + (8 * c) * 33 + n;
        u32x4 o; o.x = pk2(s[0 * 33], s[1 * 33]); o.y = pk2(s[2 * 33], s[3 * 33]); o.z = pk2(s[4 * 33], s[5 * 33]); o.w = pk2(s[6 * 33], s[7 * 33]);
        *(u32x4*)(WT + (size_t)(n0 + n) * K + k0 + 8 * c) = o; }
    asm volatile("s_waitcnt lgkmcnt(0)" ::: "memory");
}

__device__ __forceinline__ void phase_prep(const Args& A, LAS unsigned char* L, int layer, int vbid, int vG, const int wv) {
    const int tid = otid(wv), lane = tid & 63, wave = tid >> 6;
    unsigned char* ws = ows(A.ws);
    const float* Wm = (layer == 0 ? A.in[5] : layer == 1 ? A.in[11] : layer == 2 ? A.in[23] : A.in[30]);
    for (int task = vbid; task < 48; task += vG) {
        const int cc = task >> 3, kc = task & 7;
        LAS float* s = (LAS float*)L;
        for (int idx = tid; idx < 9 * 128; idx += NTHREADS) { const int r = idx >> 7, kk = idx & 127;
            const float v = (r < 8) ? A.in[1][r * DM + kc * 128 + kk] : A.in[3][kc * 128 + kk];
            s[idx] = v / (1.0f + __expf(-v)); }
        LBAR();
        const int col = cc * 512 + tid;
        float acc[9];
#pragma unroll
        for (int r = 0; r < 9; ++r) acc[r] = 0.f;
        const float* wp = Wm + (size_t)(kc * 128) * 3072 + col;
#pragma unroll 32
        for (int kk = 0; kk < 128; ++kk) { const float w = __builtin_nontemporal_load(wp + (size_t)kk * 3072);
#pragma unroll
            for (int r = 0; r < 9; ++r) acc[r] += s[r * 128 + kk] * w; }
        float* mp = (float*)(ws + WS_MODP) + (size_t)((layer * 8 + kc) * 9) * 3072 + col;
#pragma unroll
        for (int r = 0; r < 9; ++r) mp[(size_t)r * 3072] = acc[r];
        LBAR();
    }
    if (layer == 0 && vbid == vG - 1) {
        float* rt = (float*)(ws + WS_ROPE);
        for (int idx = tid; idx < 1024; idx += NTHREADS) { const int p = idx >> 4, j = idx & 15;
            const float inv = 1.0f / __builtin_powf(10000.0f, (float)j * (1.0f / 16.0f));
            const float ang = (float)p * inv; float t = ang * 0.15915494309189535f; t -= __builtin_rintf(t);
            rt[idx * 2] = __builtin_amdgcn_cosf(t); rt[idx * 2 + 1] = __builtin_amdgcn_sinf(t); }
    }
    LAS float* scr = (LAS float*)(L + wave * 16384);
    const int rb = (vbid + vG - (48 % vG)) % vG;
    const int gw = rb * NWAVES + wave, NGW = vG * NWAVES;
    const int Nin = (layer == 0 || layer == 3) ? 2560 : (layer == 1 ? 2048 : 4096);
    const float* win = (layer == 0 ? A.in[7] : layer == 1 ? A.in[13] : layer == 2 ? A.in[25] : A.in[32]);
    const float* wout = (layer == 0 ? A.in[8] : layer == 1 ? A.in[14] : layer == 2 ? A.in[26] : A.in[33]);
    bf16_t* wint = (bf16_t*)(ws + (layer == 0 ? WS_WIN[0] : layer == 1 ? WS_WIN[1] : layer == 2 ? WS_WIN[2] : WS_WIN[3]));
    bf16_t* woutt = (bf16_t*)(ws + (layer == 0 ? WS_WOUT[0] : layer == 1 ? WS_WOUT[1] : layer == 2 ? WS_WOUT[2] : WS_WOUT[3]));
    const int IIN = 16 * (Nin / 32), IO = 16 * 32, IGW = layer == 0 ? 64 * 2 : 0;
    const int nitems = IIN + IO + IGW;
    for (int it = gw; it < nitems; it += NGW) {
        int r = it;
        if (r < IIN) { transpose_item(win, 1024, Nin, wint, scr, r, lane); continue; } r -= IIN;
        if (r < IO) { transpose_item(wout, 1024, 1024, woutt, scr, r, lane); continue; } r -= IO;
        { const int blk = r >> 1, sub = r & 1;
          const int dir = blk >> 5, gate = (blk >> 4) & 1, h = blk & 15;
          const float* src = (gate == 0 ? A.in[17] : A.in[19]) + (size_t)(dir * 16 + h) * 4096;
          transpose_item(src, 64, 64, (bf16_t*)(ws + WS_GW) + (size_t)blk * 4096, scr, sub, lane); }
    }
}

template <int NR> __device__ __forceinline__ void norm_rows(const float* const (&xrow)[NR], bf16_t* const (&orow)[NR], const LAS float* const (&gs)[NR], const LAS float* const (&sh)[NR], int lane) {
    f32x4 v[NR][4]; float s[NR];
#pragma unroll
    for (int i = 0; i < NR; ++i) { const f32x4* xr = (const f32x4*)xrow[i] + lane;
#pragma unroll
        for (int j = 0; j < 4; ++j) v[i][j] = __builtin_nontemporal_load(xr + 64 * j); }
#pragma unroll
    for (int i = 0; i < NR; ++i) { float a = 0.f;
#pragma unroll
        for (int j = 0; j < 4; ++j) a += (v[i][j].x * v[i][j].x + v[i][j].y * v[i][j].y) + (v[i][j].z * v[i][j].z + v[i][j].w * v[i][j].w);
        s[i] = a; }
#pragma unroll
    for (int o = 1; o < 64; o <<= 1) {
#pragma unroll
        for (int i = 0; i < NR; ++i) s[i] += __shfl_xor(s[i], o); }
#pragma unroll
    for (int i = 0; i < NR; ++i) { const float rstd = 1.0f / sqrtf(s[i] * (1.0f / DM) + EPS); u32x2* o8 = (u32x2*)orow[i] + lane;
#pragma unroll
        for (int j = 0; j < 4; ++j) { const f32x4 g = *(const LAS f32x4*)(gs[i] + 256 * j + 4 * lane), b = *(const LAS f32x4*)(sh[i] + 256 * j + 4 * lane);
            const f32x4 y = v[i][j] * rstd * g + b; u32x2 w; w.x = pk2(y.x, y.y); w.y = pk2(y.z, y.w); o8[64 * j] = w; } }
}
__device__ __forceinline__ void phase_norm(const Args& A, int layer, const float* xL, const float* xC, LAS unsigned char* L, const int wv) {
    const int tid = otid(wv), lane = tid & 63, wave = tid >> 6, bid = blockIdx.x, G = gridDim.x;
    const float* norm_g = (layer == 0 ? A.in[4] : layer == 1 ? A.in[10] : layer == 2 ? A.in[22] : A.in[29]);
    const float* mod_b = (layer == 0 ? A.in[6] : layer == 1 ? A.in[12] : layer == 2 ? A.in[24] : A.in[31]);
    unsigned char* ws = ows(A.ws);
    const float* modp = (const float*)(ws + WS_MODP) + (size_t)(layer * 8) * 9 * 3072;
    bf16_t* XN = (bf16_t*)(ws + WS_XN);
    LAS float* tab = (LAS float*)L;
    for (int vb = bid; vb < 256; vb += G) {
        const int batch = vb >> 5;
#pragma unroll
        for (int i8 = 0; i8 < 8; ++i8) { const int idx = tid + i8 * NTHREADS; const int which = idx >> 10, col = idx & 1023; const int r = (which < 2) ? batch : 8; const int mcol = (which & 1) ? col : 1024 + col;
            float v = mod_b[mcol];
#pragma unroll
            for (int kc = 0; kc < 8; ++kc) v += modp[(size_t)(kc * 9 + r) * 3072 + mcol];
            if (!(which & 1)) v = norm_g[col] * (1.0f + v);
            tab[idx] = v; }
        if (vb < 9) { float* gf = (float*)(ws + WS_GATE) + (size_t)(layer * 9 + vb) * 1024;
            for (int col = tid; col < 1024; col += NTHREADS) { float v = mod_b[2048 + col];
#pragma unroll
                for (int kc = 0; kc < 8; ++kc) v += modp[(size_t)(kc * 9 + vb) * 3072 + 2048 + col];
                gf[col] = v; } }
        LBAR();
#pragma unroll 1
        for (int bt = 0; bt < 3; ++bt) {
            const float* xr[3]; bf16_t* orow[3]; const LAS float* gs[3]; const LAS float* sh[3];
#pragma unroll
            for (int i = 0; i < 3; ++i) { const int ri = bt * 3 + i;
                if (ri < 8) { const int row = vb * 64 + wave * 8 + ri; xr[i] = xL + (size_t)row * DM; orow[i] = XN + (size_t)row * DM; gs[i] = tab; sh[i] = tab + 1024; }
                else { const int row = vb * 8 + wave; xr[i] = xC + (size_t)row * DM; orow[i] = XN + (size_t)(ML + row) * DM; gs[i] = tab + 2048; sh[i] = tab + 3072; } }
            norm_rows<3>(xr, orow, gs, sh, lane);
        }
        LBAR();
    }
}

#define MFMA32(a, b, c) __builtin_amdgcn_mfma_f32_32x32x16_bf16((a), (b), (c), 0, 0, 0)
#define MFMA16(a, b, c) __builtin_amdgcn_mfma_f32_16x16x32_bf16((a), (b), (c), 0, 0, 0)
__device__ __forceinline__ int crow(int r, int hi) { return (r & 3) + 8 * (r >> 2) + 4 * hi; }
typedef short v4i16_t __attribute__((ext_vector_type(4)));
__device__ __forceinline__ float max3f(float a, float b, float c) { float r; asm("v_max3_f32 %0, %1, %2, %3" : "=v"(r) : "v"(a), "v"(b), "v"(c)); return r; }
__device__ __forceinline__ s16x4 vtr(LAS const unsigned char* p) { return __builtin_bit_cast(s16x4, __builtin_amdgcn_ds_read_tr16_b64_v4i16((LAS v4i16_t*)p)); }

__device__ __forceinline__ void phase_attn(const bf16_t* ACT, bf16_t* Y, const float* sink, bool need_ctx, LAS unsigned char* L, const int wv) {
    constexpr int LD = 2560, KSTR = 144, TILEB = 64 * KSTR, BUFB = 2 * TILEB;
    const int tid = otid(wv), lane = tid & 63, r32 = lane & 31, hi = lane >> 5, wave = __builtin_amdgcn_readfirstlane(tid >> 6);
    const int g = wave >> 1, half = wave & 1, G = gridDim.x;
    const int skey = tid >> 3, sch = tid & 7;
    const int stoff = skey * KSTR + sch * 16;
    const int koff = r32 * KSTR + hi * 16;
    const int voff = TILEB + (4 * hi + ((lane & 15) >> 2)) * KSTR + (16 * ((lane >> 4) & 1) + 4 * (lane & 3)) * 2;
    const int nunits = need_ctx ? 1152 : 1024;
    for (int u = blockIdx.x; u < nunits; u += G) {
        int b, kvh, qb; bool lat;
        if (u < 1024) { b = u >> 7; kvh = (u >> 5) & 3; qb = u & 31; lat = true; } else { const int e = u - 1024; b = e >> 4; kvh = (e >> 2) & 3; qb = e & 3; lat = false; }
        const int h = kvh * 4 + g;
        const int qpos = qb * 64 + half * 32 + r32;
        const int qrow = lat ? b * SEQ + qpos : ML + b * CTX + qpos;
        int tlo = 4, thi = 4;
        if (lat) { tlo = qb == 0 ? 6 : (qb == 1 ? 5 : 4); thi = qb == 31 ? 7 : (qb == 30 ? 8 : 9); }
        const int n = 4 + (thi - tlo);
        const int kp_base = qb * 64 - 128;
        bf16x8 qf[4];
        { const bf16_t* qp = ACT + (size_t)qrow * LD + h * 64 + hi * 8;
#pragma unroll
          for (int d0 = 0; d0 < 4; ++d0) qf[d0] = *(const bf16x8*)(qp + d0 * 16); }
        float m_run = sink[h] * LOG2E, l_run = hi ? 0.f : 1.f;
        f32x16 o0, o1;
#pragma unroll
        for (int r = 0; r < 16; ++r) { o0[r] = 0.f; o1[r] = 0.f; }
        const size_t kcol = 1024 + kvh * 64 + sch * 8, vcol = 1280 + kvh * 64 + sch * 8;
#define ATT_TROW(s_) (((s_) < 4 ? ML + b * CTX + (s_) * 64 : b * SEQ + kp_base + (tlo + (s_) - 8) * 64) + skey)
        u32x4 kq0, vq0, kq1, vq1, kq2, vq2;
        { const size_t krow = (size_t)ATT_TROW(0); kq0 = *(const u32x4*)(ACT + krow * LD + kcol); vq0 = *(const u32x4*)(ACT + krow * LD + vcol); }
        { const size_t krow = (size_t)ATT_TROW(1); kq1 = *(const u32x4*)(ACT + krow * LD + kcol); vq1 = *(const u32x4*)(ACT + krow * LD + vcol); }
        { const size_t krow = (size_t)ATT_TROW(2); kq2 = *(const u32x4*)(ACT + krow * LD + kcol); vq2 = *(const u32x4*)(ACT + krow * LD + vcol); }
        LBAR();
        *(LAS u32x4*)(L + stoff) = kq0; *(LAS u32x4*)(L + TILEB + stoff) = vq0;
        { const size_t krow = (size_t)ATT_TROW(3); kq0 = *(const u32x4*)(ACT + krow * LD + kcol); vq0 = *(const u32x4*)(ACT + krow * LD + vcol); }
        LBAR();
#define ATT_STEP(s_, KQ, VQ) do { const int s = (s_); \
            const int t = s < 4 ? s : tlo + (s - 4); \
            LAS const unsigned char* B = L + (s & 1) * BUFB; \
 \
              \
            bf16x8 kf[8]; s16x4 vl[8], vh[8]; \
_Pragma("unroll") \
            for (int d0 = 0; d0 < 4; ++d0) { kf[2 * d0] = *(const LAS bf16x8*)(B + koff + d0 * 32); kf[2 * d0 + 1] = *(const LAS bf16x8*)(B + koff + 32 * KSTR + d0 * 32); } \
_Pragma("unroll") \
            for (int i = 0; i < 4; ++i) { LAS const unsigned char* vp = B + voff + i * 16 * KSTR; vl[2 * i] = vtr(vp); vh[2 * i] = vtr(vp + 8 * KSTR); vl[2 * i + 1] = vtr(vp + 64); vh[2 * i + 1] = vtr(vp + 8 * KSTR + 64); } \
            __builtin_amdgcn_sched_barrier(0); \
            f32x16 p0, p1; \
_Pragma("unroll") \
            for (int r = 0; r < 16; ++r) { p0[r] = 0.f; p1[r] = 0.f; } \
_Pragma("unroll") \
            for (int d0 = 0; d0 < 4; ++d0) { p0 = MFMA32(kf[2 * d0], qf[d0], p0); p1 = MFMA32(kf[2 * d0 + 1], qf[d0], p1); } \
            if (t == 4 || t == 8) { const int kp0 = kp_base + (t - 4) * 64 - qpos; \
_Pragma("unroll") \
                for (int r = 0; r < 16; ++r) { const int d0 = kp0 + crow(r, hi), d1 = d0 + 32; \
                    if (d0 > 128 || d0 < -128) p0[r] = -1e30f; if (d1 > 128 || d1 < -128) p1[r] = -1e30f; } } \
            float mt = max3f(p0[0], p0[1], p1[0]), mt2 = max3f(p0[2], p0[3], p1[1]); mt = max3f(mt, p1[2], p1[3]); \
_Pragma("unroll") \
            for (int r = 4; r < 16; r += 4) { mt = max3f(mt, p0[r], p0[r + 1]); mt2 = max3f(mt2, p0[r + 2], p0[r + 3]); mt = max3f(mt, p1[r], p1[r + 1]); mt2 = max3f(mt2, p1[r + 2], p1[r + 3]); } \
            mt = fmaxf(mt, mt2); \
            mt = fmaxf(mt, __shfl_xor(mt, 32)) - m_run; \
 \
            float dl = 0.f; \
            if (s == 0) dl = fmaxf(mt, 0.f); else if (mt > 8.0f) dl = mt; \
            if (__any(dl != 0.f)) { const float alpha = __builtin_amdgcn_exp2f(-dl); m_run += dl; l_run *= alpha; \
_Pragma("unroll") \
                for (int r = 0; r < 16; ++r) { o0[r] *= alpha; o1[r] *= alpha; } } \
            float ls = 0.f, ls2 = 0.f; \
_Pragma("unroll") \
            for (int r = 0; r < 16; ++r) { p0[r] = __builtin_amdgcn_exp2f(p0[r] - m_run); p1[r] = __builtin_amdgcn_exp2f(p1[r] - m_run); ls += p0[r]; ls2 += p1[r]; } \
            ls += ls2; \
            l_run += ls; \
            bf16x8 pb[2][2]; \
_Pragma("unroll") \
            for (int j = 0; j < 2; ++j) { \
                u32x4 w0, w1; \
                w0.x = pk2(p0[8 * j + 0], p0[8 * j + 1]); w0.y = pk2(p0[8 * j + 2], p0[8 * j + 3]); w0.z = pk2(p0[8 * j + 4], p0[8 * j + 5]); w0.w = pk2(p0[8 * j + 6], p0[8 * j + 7]); \
                w1.x = pk2(p1[8 * j + 0], p1[8 * j + 1]); w1.y = pk2(p1[8 * j + 2], p1[8 * j + 3]); w1.z = pk2(p1[8 * j + 4], p1[8 * j + 5]); w1.w = pk2(p1[8 * j + 6], p1[8 * j + 7]); \
                pb[0][j] = __builtin_bit_cast(bf16x8, w0); pb[1][j] = __builtin_bit_cast(bf16x8, w1); \
            } \
 \
_Pragma("unroll") \
            for (int kb = 0; kb < 2; ++kb) \
_Pragma("unroll") \
                for (int j = 0; j < 2; ++j) { const int i = kb * 2 + j; \
                    const bf16x8 a0 = __builtin_shufflevector(vl[2 * i], vh[2 * i], 0, 1, 2, 3, 4, 5, 6, 7), a1 = __builtin_shufflevector(vl[2 * i + 1], vh[2 * i + 1], 0, 1, 2, 3, 4, 5, 6, 7); \
                    o0 = MFMA32(a0, pb[kb][j], o0); o1 = MFMA32(a1, pb[kb][j], o1); \
                } \
            if (s + 1 < n) { LAS unsigned char* Bn = L + ((s + 1) & 1) * BUFB; *(LAS u32x4*)(Bn + stoff) = KQ; *(LAS u32x4*)(Bn + TILEB + stoff) = VQ; } \
            LBAR(); \
            if (s + 4 < n) { const size_t krow = (size_t)ATT_TROW(s + 4); KQ = *(const u32x4*)(ACT + krow * LD + kcol); VQ = *(const u32x4*)(ACT + krow * LD + vcol); } \
        } while (0)
#pragma unroll 1
        for (int s0 = 0; s0 < n; s0 += 3) {
            ATT_STEP(s0, kq1, vq1);
            if (s0 + 1 < n) ATT_STEP(s0 + 1, kq2, vq2);
            if (s0 + 2 < n) ATT_STEP(s0 + 2, kq0, vq0);
        }
#undef ATT_STEP
#undef ATT_TROW
        u32x4 sgq[4];
        { const int qrow0 = qrow - r32;
#pragma unroll
          for (int it = 0; it < 4; ++it) sgq[it] = *(const u32x4*)(ACT + (size_t)(qrow0 + it * 8 + (lane >> 3)) * LD + 1536 + h * 64 + (lane & 7) * 8); }
        const float lt = l_run + __shfl_xor(l_run, 32); const float inv = 1.0f / lt;
        LAS float* stg = (LAS float*)(L + 40960 + wave * 8704);
#pragma unroll
        for (int db = 0; db < 2; ++db)
#pragma unroll
            for (int q4 = 0; q4 < 4; ++q4) { const int d = 32 * db + 8 * q4 + 4 * hi; f32x4 v;
                if (db == 0) v = (f32x4){o0[4 * q4], o0[4 * q4 + 1], o0[4 * q4 + 2], o0[4 * q4 + 3]}; else v = (f32x4){o1[4 * q4], o1[4 * q4 + 1], o1[4 * q4 + 2], o1[4 * q4 + 3]};
                *(LAS f32x4*)(stg + r32 * 68 + d) = v * inv; }
        asm volatile("s_waitcnt lgkmcnt(0)" ::: "memory");
        { const int qrow0 = qrow - r32; const int er = lane >> 3, ec = (lane & 7) * 8;
#pragma unroll
          for (int it = 0; it < 4; ++it) { const int row = it * 8 + er; const size_t grow = (size_t)(qrow0 + row);
              const f32x4 a0 = *(const LAS f32x4*)(stg + row * 68 + ec), a1 = *(const LAS f32x4*)(stg + row * 68 + ec + 4);
              const u32x4 gw = sgq[it];
              u32x4 w; w.x = pk2(a0.x * bflo(gw.x), a0.y * bfhi(gw.x)); w.y = pk2(a0.z * bflo(gw.y), a0.w * bfhi(gw.y)); w.z = pk2(a1.x * bflo(gw.z), a1.y * bfhi(gw.z)); w.w = pk2(a1.z * bflo(gw.w), a1.w * bfhi(gw.w));
              *(u32x4*)(Y + grow * DM + h * 64 + ec) = w; } }
    }
    LBAR();
}

__device__ __forceinline__ void phase_lru(const Args& A, const bf16_t* ACT, bf16_t* Y, float* HF, LAS unsigned char* L, const int wv) {
    constexpr int LD = 2048, TT = 128, USTR = 144;
    const int tid = otid(wv), lane = tid & 63, wave = __builtin_amdgcn_readfirstlane(tid >> 6), G = gridDim.x;
    LAS unsigned char* UL = L;
    LAS unsigned char* XA = L + 19200;
    LAS float* XF = (LAS float*)(L + 19200 + 18432);
    LAS f32x2* AB = (LAS f32x2*)(L + 19200 + 18432 + 16384);
    LAS f32x2* CAR = (LAS f32x2*)(L + 19200 + 18432 + 16384 + 32768);
    LAS float* ST = (LAS float*)(L + 19200 + 18432 + 16384 + 32768 + 4096);
    LAS float* CW = (LAS float*)(L + 19200 + 18432 + 16384 + 32768 + 4096 + 256);
    const bf16_t* gwT = (const bf16_t*)(ows(A.ws) + WS_GW);
    const float* conv_w = A.in[15]; const float* conv_b = A.in[16]; const float* ba = A.in[18]; const float* bx = A.in[20]; const float* lam = A.in[21];
    const int fr = lane & 15, fq = lane >> 4;
    const int stok = tid >> 3, sch = tid & 7;
    const int ch = tid & 31, sc = tid >> 5;
    const int otok = tid >> 2, oq = tid & 3;
    for (int u = blockIdx.x; u < 256; u += G) {
        const int b = u >> 5, hb = u & 31, hblk = hb >> 1, half = hb & 1, cin0 = hblk * 64, c0 = cin0 + half * 32;
#pragma unroll 1
        for (int dir = 0; dir < 2; ++dir) {
            LBAR();
            if (tid < 320) { const int k = tid >> 6, c = tid & 63; CW[tid] = (k < 4) ? conv_w[(size_t)(dir * 4 + k) * DM + cin0 + c] : conv_b[(size_t)dir * DM + cin0 + c]; }
            const int cbk = wave & 1;
            bf16x8 wr_[2], wi_[2];
            { const bf16_t* pr = gwT + ((size_t)((dir * 2 + 0) * 16 + hblk) * 64 + half * 32 + cbk * 16 + fr) * 64 + fq * 8;
              const bf16_t* pi = gwT + ((size_t)((dir * 2 + 1) * 16 + hblk) * 64 + half * 32 + cbk * 16 + fr) * 64 + fq * 8;
              wr_[0] = *(const bf16x8*)pr; wr_[1] = *(const bf16x8*)(pr + 32); wi_[0] = *(const bf16x8*)pi; wi_[1] = *(const bf16x8*)(pi + 32); }
            float eba[4], ebx[4], esp[4];
#pragma unroll
            for (int e = 0; e < 4; ++e) { const int c = dir * DM + c0 + cbk * 16 + 4 * fq + e; eba[e] = ba[c]; ebx[e] = bx[c];
                const float nl = -lam[c]; esp[e] = (fmaxf(nl, 0.f) + log1pf(__expf(-fabsf(nl)))) * (-8.0f * LOG2E); }
            if (tid < 32) ST[tid] = 0.f;
            u32x4 ur[2], uh = (u32x4){0u, 0u, 0u, 0u};
            { const int rowbase = ML + b * CTX;
#pragma unroll
              for (int i2 = 0; i2 < 2; ++i2) { const int S = stok + 64 * i2; const int row = rowbase + (dir ? CTX - 1 - S : S); ur[i2] = *(const u32x4*)(ACT + (size_t)row * LD + cin0 + sch * 8); } }
            f32x4 hf0 = (f32x4){0.f, 0.f, 0.f, 0.f}, hf1 = hf0; u32x4 gv = (u32x4){0u, 0u, 0u, 0u}; size_t orow = 0; int oseq = 0;
#define LRU_OUT() do { const f32x4 h0 = *(const LAS f32x4*)(XF + otok * 32 + oq * 8), h1 = *(const LAS f32x4*)(XF + otok * 32 + oq * 8 + 4); \
                if (dir == 0) { f32x4* hp = (f32x4*)(HF + ((size_t)u * 2304 + oseq) * 32 + oq * 8); hp[0] = h0; hp[1] = h1; } \
                else { const f32x4 s0 = h0 + hf0, s1 = h1 + hf1; u32x4 w; \
                    w.x = pk2(s0.x * bflo(gv.x), s0.y * bfhi(gv.x)); w.y = pk2(s0.z * bflo(gv.y), s0.w * bfhi(gv.y)); w.z = pk2(s1.x * bflo(gv.z), s1.y * bfhi(gv.z)); w.w = pk2(s1.z * bflo(gv.w), s1.w * bfhi(gv.w)); \
                    *(u32x4*)(Y + orow * DM + c0 + oq * 8) = w; } } while (0)
#pragma unroll 1
            for (int tl = 0; tl < 18; ++tl) {
                const int seg = tl < 2 ? 0 : 1, S0 = seg ? (tl - 2) * TT : tl * TT, seglen = seg ? SEQ : CTX, rowbase = seg ? b * SEQ : ML + b * CTX;
                LBAR();
                *(LAS u32x4*)(UL + (3 + stok) * USTR + sch * 16) = ur[0]; *(LAS u32x4*)(UL + (3 + 64 + stok) * USTR + sch * 16) = ur[1];
                if (tid < 24) *(LAS u32x4*)(UL + stok * USTR + sch * 16) = uh;
                if (tl > 0) LRU_OUT();
                LBAR();
                { const int S = S0 + otok; const int pos = dir ? seglen - 1 - S : S; orow = (size_t)(rowbase + pos); oseq = seg ? CTX + pos : pos;
                  if (dir == 1) { const f32x4* hp = (const f32x4*)(HF + ((size_t)u * 2304 + oseq) * 32 + oq * 8); hf0 = hp[0]; hf1 = hp[1]; gv = *(const u32x4*)(ACT + orow * LD + 1024 + c0 + oq * 8); } }
                if (tl + 1 < 18) { const int tn = tl + 1; const int seg2 = tn < 2 ? 0 : 1, S02 = seg2 ? (tn - 2) * TT : tn * TT, seglen2 = seg2 ? SEQ : CTX, rowbase2 = seg2 ? b * SEQ : ML + b * CTX;
#pragma unroll
                    for (int i2 = 0; i2 < 2; ++i2) { const int S = S02 + stok + 64 * i2; const int row = rowbase2 + (dir ? seglen2 - 1 - S : S); ur[i2] = *(const u32x4*)(ACT + (size_t)row * LD + cin0 + sch * 8); }
                    uh = (u32x4){0u, 0u, 0u, 0u};
                    if (tid < 24 && S02 > 0) { const int S = S02 - 3 + stok; const int row = rowbase2 + (dir ? seglen2 - 1 - S : S); uh = *(const u32x4*)(ACT + (size_t)row * LD + cin0 + sch * 8); } }
                for (int rep_ = 0; rep_ < DUP_LRUBC; ++rep_) {
                { float x0[8], x1[8];
                  { const f32x4 ca = *(const LAS f32x4*)(CW + 256 + sch * 8), cc = *(const LAS f32x4*)(CW + 256 + sch * 8 + 4);
                    x0[0] = ca.x; x0[1] = ca.y; x0[2] = ca.z; x0[3] = ca.w; x0[4] = cc.x; x0[5] = cc.y; x0[6] = cc.z; x0[7] = cc.w;
#pragma unroll
                    for (int e = 0; e < 8; ++e) x1[e] = x0[e]; }
#pragma unroll
                  for (int k = 0; k < 4; ++k) { const f32x4 wa = *(const LAS f32x4*)(CW + k * 64 + sch * 8), wb = *(const LAS f32x4*)(CW + k * 64 + sch * 8 + 4);
                      const u32x4 u0 = *(const LAS u32x4*)(UL + (stok + k) * USTR + sch * 16), u1 = *(const LAS u32x4*)(UL + (stok + 64 + k) * USTR + sch * 16);
                      x0[0] += wa.x * bflo(u0.x); x0[1] += wa.y * bfhi(u0.x); x0[2] += wa.z * bflo(u0.y); x0[3] += wa.w * bfhi(u0.y);
                      x0[4] += wb.x * bflo(u0.z); x0[5] += wb.y * bfhi(u0.z); x0[6] += wb.z * bflo(u0.w); x0[7] += wb.w * bfhi(u0.w);
                      x1[0] += wa.x * bflo(u1.x); x1[1] += wa.y * bfhi(u1.x); x1[2] += wa.z * bflo(u1.y); x1[3] += wa.w * bfhi(u1.y);
                      x1[4] += wb.x * bflo(u1.z); x1[5] += wb.y * bfhi(u1.z); x1[6] += wb.z * bflo(u1.w); x1[7] += wb.w * bfhi(u1.w); }
                  u32x4 w; w.x = pk2(x0[0], x0[1]); w.y = pk2(x0[2], x0[3]); w.z = pk2(x0[4], x0[5]); w.w = pk2(x0[6], x0[7]);
                  *(LAS u32x4*)(XA + stok * USTR + sch * 16) = w;
                  w.x = pk2(x1[0], x1[1]); w.y = pk2(x1[2], x1[3]); w.z = pk2(x1[4], x1[5]); w.w = pk2(x1[6], x1[7]);
                  *(LAS u32x4*)(XA + (stok + 64) * USTR + sch * 16) = w;
                  if ((sch >> 2) == half) { LAS f32x4* xf = (LAS f32x4*)(XF + stok * 32 + (sch & 3) * 8); xf[0] = (f32x4){x0[0], x0[1], x0[2], x0[3]}; xf[1] = (f32x4){x0[4], x0[5], x0[6], x0[7]};
                      xf = (LAS f32x4*)(XF + (stok + 64) * 32 + (sch & 3) * 8); xf[0] = (f32x4){x1[0], x1[1], x1[2], x1[3]}; xf[1] = (f32x4){x1[4], x1[5], x1[6], x1[7]}; } }
                LBAR();
#pragma unroll
                for (int i2 = 0; i2 < 2; ++i2) { const int tb = (wave >> 1) + 4 * i2; const int tok = tb * 16 + fr;
                    const bf16x8 x0 = *(const LAS bf16x8*)(XA + tok * USTR + fq * 16), x1 = *(const LAS bf16x8*)(XA + tok * USTR + 64 + fq * 16);
                    f32x4 ar = (f32x4){0.f, 0.f, 0.f, 0.f}, ai = (f32x4){0.f, 0.f, 0.f, 0.f};
                    ar = MFMA16(wr_[0], x0, ar); ar = MFMA16(wr_[1], x1, ar); ai = MFMA16(wi_[0], x0, ai); ai = MFMA16(wi_[1], x1, ai);
                    const f32x4 xv = *(const LAS f32x4*)(XF + tok * 32 + cbk * 16 + 4 * fq);
                    float av[4], bv[4];
#pragma unroll
                    for (int e = 0; e < 4; ++e) { const float r = __builtin_amdgcn_rcpf(1.0f + __builtin_amdgcn_exp2f(-(ar[e] + eba[e]) * LOG2E)); const float ig = __builtin_amdgcn_rcpf(1.0f + __builtin_amdgcn_exp2f(-(ai[e] + ebx[e]) * LOG2E));
                        const float a_ = __builtin_amdgcn_exp2f(r * esp[e]); av[e] = a_; bv[e] = __builtin_amdgcn_sqrtf(fmaxf(1.0f - a_ * a_, 0.f)) * (ig * xv[e]); }
                    LAS f32x4* ab = (LAS f32x4*)(AB + tok * 32 + cbk * 16 + 4 * fq); ab[0] = (f32x4){av[0], bv[0], av[1], bv[1]}; ab[1] = (f32x4){av[2], bv[2], av[3], bv[3]}; }
                LBAR();
                }
                float a8[8], b8[8];
                { float Ap = 1.f, H = 0.f;
#pragma unroll
                  for (int k = 0; k < 8; ++k) { const f32x2 v = AB[(sc * 8 + k) * 32 + ch]; a8[k] = v.x; b8[k] = v.y; H = v.x * H + v.y; Ap *= v.x; }
                  CAR[sc * 32 + ch] = (f32x2){Ap, H}; }
                LBAR();
                float hrun = ST[(tl & 1) * 32 + ch];
                { f32x2 cr[15];
#pragma unroll
                  for (int s = 0; s < 15; ++s) cr[s] = CAR[s * 32 + ch];
#pragma unroll
                  for (int s = 0; s < 15; ++s) hrun = (s < sc) ? cr[s].x * hrun + cr[s].y : hrun; }
#pragma unroll
                for (int k = 0; k < 8; ++k) { hrun = a8[k] * hrun + b8[k]; XF[(sc * 8 + k) * 32 + ch] = hrun; }
                if (sc == 15) ST[((tl + 1) & 1) * 32 + ch] = hrun;
            }
            LBAR();
            LRU_OUT();
            asm volatile("s_waitcnt vmcnt(0)" ::: "memory");
        }
        LBAR();
    }
#undef LRU_OUT
}

__device__ __forceinline__ void cu8(const bf16_t* ACT, size_t row, int col, float* o) {
    const u32x4 a = __builtin_nontemporal_load((const u32x4*)(ACT + row * 4096 + col)), c = __builtin_nontemporal_load((const u32x4*)(ACT + row * 4096 + 2048 + col));
    o[0] = bflo(a.x) * bflo(c.x); o[1] = bfhi(a.x) * bfhi(c.x); o[2] = bflo(a.y) * bflo(c.y); o[3] = bfhi(a.y) * bfhi(c.y);
    o[4] = bflo(a.z) * bflo(c.z); o[5] = bfhi(a.z) * bfhi(c.z); o[6] = bflo(a.w) * bflo(c.w); o[7] = bfhi(a.w) * bfhi(c.w);
}
__device__ __forceinline__ void phase_conv(const Args& A, const bf16_t* ACT, bf16_t* Y, const int wv) {
    const float* conv_w = A.in[27]; const float* conv_b = A.in[28];
    const int nitems = (MT / 8) * 128;
    const int tid = otid(wv);
    for (int item = blockIdx.x * NTHREADS + tid; item < nitems; item += gridDim.x * NTHREADS) {
        const int rg = item >> 7, chunk = item & 127, col = chunk * 8, row0 = rg * 8;
        const int seglen = row0 < ML ? SEQ : CTX;
        const bool first = (row0 % seglen) == 0, last = ((row0 + 8) % seglen) == 0;
        float w0[8], w1[8], w2[8], cb[8];
        { const f32x4* p = (const f32x4*)(conv_w + col); f32x4 a = p[0], c = p[1]; w0[0] = a.x; w0[1] = a.y; w0[2] = a.z; w0[3] = a.w; w0[4] = c.x; w0[5] = c.y; w0[6] = c.z; w0[7] = c.w;
          p = (const f32x4*)(conv_w + DM + col); a = p[0]; c = p[1]; w1[0] = a.x; w1[1] = a.y; w1[2] = a.z; w1[3] = a.w; w1[4] = c.x; w1[5] = c.y; w1[6] = c.z; w1[7] = c.w;
          p = (const f32x4*)(conv_w + 2 * DM + col); a = p[0]; c = p[1]; w2[0] = a.x; w2[1] = a.y; w2[2] = a.z; w2[3] = a.w; w2[4] = c.x; w2[5] = c.y; w2[6] = c.z; w2[7] = c.w;
          p = (const f32x4*)(conv_b + col); a = p[0]; c = p[1]; cb[0] = a.x; cb[1] = a.y; cb[2] = a.z; cb[3] = a.w; cb[4] = c.x; cb[5] = c.y; cb[6] = c.z; cb[7] = c.w; }
        float prev[8], cur[8], nxt[8];
        if (first) {
#pragma unroll
            for (int e = 0; e < 8; ++e) prev[e] = 0.f;
        } else cu8(ACT, (size_t)row0 - 1, col, prev);
        cu8(ACT, (size_t)row0, col, cur);
#pragma unroll
        for (int k = 0; k < 8; ++k) {
            const size_t row = (size_t)row0 + k;
            if (k == 7 && last) {
#pragma unroll
                for (int e = 0; e < 8; ++e) nxt[e] = 0.f;
            } else cu8(ACT, row + 1, col, nxt);
            const u32x4 bgw = __builtin_nontemporal_load((const u32x4*)(ACT + row * 4096 + 1024 + col)), sgw = __builtin_nontemporal_load((const u32x4*)(ACT + row * 4096 + 3072 + col));
            float y[8];
#pragma unroll
            for (int e = 0; e < 8; ++e) y[e] = w0[e] * prev[e] + w1[e] * cur[e] + w2[e] * nxt[e] + cb[e];
            y[0] *= bflo(bgw.x) * bflo(sgw.x); y[1] *= bfhi(bgw.x) * bfhi(sgw.x); y[2] *= bflo(bgw.y) * bflo(sgw.y); y[3] *= bfhi(bgw.y) * bfhi(sgw.y);
            y[4] *= bflo(bgw.z) * bflo(sgw.z); y[5] *= bfhi(bgw.z) * bfhi(sgw.z); y[6] *= bflo(bgw.w) * bflo(sgw.w); y[7] *= bfhi(bgw.w) * bfhi(sgw.w);
            u32x4 w; w.x = pk2(y[0], y[1]); w.y = pk2(y[2], y[3]); w.z = pk2(y[4], y[5]); w.w = pk2(y[6], y[7]);
            *(u32x4*)(Y + row * DM + col) = w;
#pragma unroll
            for (int e = 0; e < 8; ++e) { prev[e] = cur[e]; cur[e] = nxt[e]; }
        }
    }
}

__device__ __forceinline__ void phase_ctx_wout(const bf16_t* Yc, const bf16_t* Wt, const float* xin, float* xout, const float* gate, LAS unsigned char* L, const int wv) {
    constexpr int PITCH = 144, ABYTES = 128 * PITCH, BUFB = 192 * PITCH;
    const int tid = otid(wv), lane = tid & 63, r32 = lane & 31, hi = lane >> 5, wave = wv, G = gridDim.x;
    const int srow = tid >> 3, sch = tid & 7;
    const int aoff = ((wave >> 1) * 32 + r32) * PITCH + hi * 64, boff = ABYTES + ((wave & 1) * 32 + r32) * PITCH + hi * 64;
    for (int t = blockIdx.x; t < 256; t += G) {
        const int tm = t >> 4, tn = t & 15;
        const bf16_t* ga0 = Yc + (size_t)(tm * 128 + srow) * DM + sch * 8; const bf16_t* ga1 = ga0 + (size_t)64 * DM; const bf16_t* gb = Wt + (size_t)(tn * 64 + srow) * DM + sch * 8;
        f32x16 acc;
#pragma unroll
        for (int r = 0; r < 16; ++r) acc[r] = 0.f;
        u32x4 qa0[3], qa1[3], qb[3];
#define CTX_LOAD(q, s_) do { qa0[q] = *(const u32x4*)(ga0 + (s_) * 64); qa1[q] = *(const u32x4*)(ga1 + (s_) * 64); qb[q] = *(const u32x4*)(gb + (s_) * 64); } while (0)
#define CTX_WRITE(q, buf) do { LAS unsigned char* Bn = L + (buf) * BUFB; *(LAS u32x4*)(Bn + srow * PITCH + sch * 16) = qa0[q]; *(LAS u32x4*)(Bn + (64 + srow) * PITCH + sch * 16) = qa1[q]; *(LAS u32x4*)(Bn + ABYTES + srow * PITCH + sch * 16) = qb[q]; } while (0)
#define CTX_STEP(s_, q) do { const int s = (s_); LAS const unsigned char* B = L + (s & 1) * BUFB; bf16x8 a[4], b[4]; \
            _Pragma("unroll") for (int j = 0; j < 4; ++j) { a[j] = *(const LAS bf16x8*)(B + aoff + j * 16); b[j] = *(const LAS bf16x8*)(B + boff + j * 16); } \
            _Pragma("unroll") for (int j = 0; j < 4; ++j) acc = MFMA32(a[j], b[j], acc); \
            if (s + 1 < 16) CTX_WRITE(q, (s + 1) & 1); \
            LBAR(); \
            if (s + 4 < 16) CTX_LOAD(q, s + 4); } while (0)
        CTX_LOAD(0, 0); CTX_LOAD(1, 1); CTX_LOAD(2, 2);
        LBAR();
        CTX_WRITE(0, 0);
        CTX_LOAD(0, 3);
        LBAR();
#pragma unroll 1
        for (int s0 = 0; s0 < 16; s0 += 3) {
            CTX_STEP(s0, 1);
            if (s0 + 1 < 16) CTX_STEP(s0 + 1, 2);
            if (s0 + 2 < 16) CTX_STEP(s0 + 2, 0);
        }
#undef CTX_LOAD
#undef CTX_WRITE
#undef CTX_STEP
        const int m0 = tm * 128 + (wave >> 1) * 32, col = tn * 64 + (wave & 1) * 32 + r32; const float gv = gate[col];
#pragma unroll
        for (int r = 0; r < 16; ++r) { const size_t o = (size_t)(m0 + crow(r, hi)) * DM + col; xout[o] = xin[o] + gv * acc[r]; }
    }
    LBAR();
}

__device__ __forceinline__ void phase_final(float* out, const float* g, const int wv) {
    const int tid = otid(wv); const int lane = tid & 63, gw = blockIdx.x * NWAVES + (tid >> 6), NGW = gridDim.x * NWAVES;
    f32x4 gv[4];
#pragma unroll
    for (int j = 0; j < 4; ++j) gv[j] = *((const f32x4*)g + 64 * j + lane);
    for (int row0 = gw * 4; row0 < ML; row0 += NGW * 4) {
        f32x4 v[4][4]; float s[4];
#pragma unroll
        for (int i = 0; i < 4; ++i) { const f32x4* xr = (const f32x4*)(out + (size_t)(row0 + i) * DM) + lane;
#pragma unroll
            for (int j = 0; j < 4; ++j) v[i][j] = __builtin_nontemporal_load(xr + 64 * j); }
#pragma unroll
        for (int i = 0; i < 4; ++i) { float a = 0.f;
#pragma unroll
            for (int j = 0; j < 4; ++j) a += (v[i][j].x * v[i][j].x + v[i][j].y * v[i][j].y) + (v[i][j].z * v[i][j].z + v[i][j].w * v[i][j].w);
            s[i] = a; }
#pragma unroll
        for (int o = 1; o < 64; o <<= 1) {
#pragma unroll
            for (int i = 0; i < 4; ++i) s[i] += __shfl_xor(s[i], o); }
#pragma unroll
        for (int i = 0; i < 4; ++i) { const float rstd = 1.0f / sqrtf(s[i] * (1.0f / DM) + EPS); f32x4* xr = (f32x4*)(out + (size_t)(row0 + i) * DM) + lane;
#pragma unroll
            for (int j = 0; j < 4; ++j) xr[64 * j] = v[i][j] * rstd * gv[j]; }
    }
}

#define RLX_AGENT __ATOMIC_RELAXED, __HIP_MEMORY_SCOPE_AGENT
#define XB_TMO      128
#define XB_XCNT(j)  (256  + 64 * (j))
#define XB_XSUB(j)  (1280 + 64 * (j))
#define XB_XGEN(j)  (2304 + 64 * (j))
#define XB_TOP      3328
#define XB_TOPGEN   3392
#define XCD_BAR_WORDS 3456
#define XB_SPIN_CAP (1u << 18)

__device__ __forceinline__ unsigned xb_ld(unsigned* p)              { return __hip_atomic_load(p, __ATOMIC_RELAXED, __HIP_MEMORY_SCOPE_AGENT); }
__device__ __forceinline__ unsigned xb_add(unsigned* p, unsigned v) { return __hip_atomic_fetch_add(p, v, __ATOMIC_RELAXED, __HIP_MEMORY_SCOPE_AGENT); }
__device__ __forceinline__ unsigned xb_xcc_id() { return (unsigned)__builtin_amdgcn_s_getreg((3 << 11) | 20) & 0xFu; }
#define XB_SPIN(cond, bar) do { unsigned _sp = 0; while (cond) { __builtin_amdgcn_s_sleep(1); \
    if ((++_sp & 255u) == 0u) { if (xb_ld(&(bar)[XB_TMO])) break; if (_sp > XB_SPIN_CAP) { atomicAdd(&(bar)[XB_TMO], 1u); break; } } } } while (0)

struct XcdBarrier {
    unsigned* bar; unsigned x;
    volatile LAS unsigned* st;
};

__device__ __forceinline__ XcdBarrier xcd_barrier_post(unsigned* bar, volatile LAS unsigned* st) {
    XcdBarrier b; b.bar = bar; b.x = xb_xcc_id(); b.st = st;
    if (threadIdx.x == 0) (void)xb_add(&bar[XB_XCNT(b.x)], 1u);
    return b;
}
__device__ __forceinline__ void xcd_barrier_complete(unsigned* bar, unsigned x, unsigned& nloc, unsigned& nx) {
    const unsigned G = gridDim.x * gridDim.y * gridDim.z;
    unsigned sum, cnt, mine, sp = 0u;
    for (;;) {
        sum = 0u; cnt = 0u; mine = 0u;
#pragma unroll
        for (unsigned j = 0; j < 16; ++j) { const unsigned c = xb_ld(&bar[XB_XCNT(j)]); sum += c; cnt += (c > 0u) ? 1u : 0u; mine = (j == x) ? c : mine; }
        if (sum == G) break;
        __builtin_amdgcn_s_sleep(1);
        if ((++sp & 255u) == 0u) { if (xb_ld(&bar[XB_TMO])) break; if (sp > XB_SPIN_CAP) { atomicAdd(&bar[XB_TMO], 1u); break; } }
    }
    nloc = mine > 0u ? mine : 1u; nx = cnt > 0u ? cnt : 1u;
}

__device__ __forceinline__ void xcd_barrier(const XcdBarrier& b) {
    asm volatile("s_waitcnt vmcnt(0)" ::: "memory");
    __syncthreads();
    if (threadIdx.x == 0) {
        unsigned* bar = b.bar;
        __builtin_amdgcn_s_waitcnt(0);
        unsigned nloc = b.st[0], nx = b.st[1];
        if (nloc == 0u) { xcd_barrier_complete(bar, b.x, nloc, nx); b.st[0] = nloc; b.st[1] = nx; }
        const unsigned old = xb_add(&bar[XB_XSUB(b.x)], 1u);
        const unsigned gen = old / nloc;
        if (old + 1u == (gen + 1u) * nloc) {
            __builtin_amdgcn_fence(__ATOMIC_RELEASE, "agent");
            asm volatile("s_waitcnt vmcnt(0)" ::: "memory");
            const unsigned og = xb_add(&bar[XB_TOP], 1u);
            const unsigned tg = og / nx;
            if (og + 1u == (tg + 1u) * nx) xb_add(&bar[XB_TOPGEN], 1u);
            else XB_SPIN(xb_ld(&bar[XB_TOPGEN]) == tg, bar);
            __builtin_amdgcn_fence(__ATOMIC_ACQUIRE, "agent");
            xb_add(&bar[XB_XGEN(b.x)], 1u);
            asm volatile("s_waitcnt vmcnt(0)" ::: "memory");
        } else {
            XB_SPIN(xb_ld(&bar[XB_XGEN(b.x)]) == gen, bar);
            __builtin_amdgcn_fence(__ATOMIC_ACQUIRE, "agent");
            asm volatile("s_waitcnt vmcnt(0)" ::: "memory");
        }
    }
    __syncthreads();
}

__global__ void __launch_bounds__(NTHREADS, 2) hybrid_fwd(Args A) {
    extern __shared__ __attribute__((aligned(16))) unsigned char lds[];
    cg::grid_group grid = cg::this_grid();
    LAS unsigned char* L = (LAS unsigned char*)lds;
    unsigned char* ws = A.ws;
    const int G = gridDim.x;
    float* XL = A.out; float* XC = (float*)(ws + WS_XC);
    bf16_t* XN = (bf16_t*)(ws + WS_XN); bf16_t* ACT = (bf16_t*)(ws + WS_ACT);
    const float* gatef = (const float*)(ws + WS_GATE);

    const int wv = __builtin_amdgcn_readfirstlane((int)threadIdx.x >> 6);
    volatile LAS unsigned* MISC = (volatile LAS unsigned*)(L + 131072 + 320);
    if (threadIdx.x < 32) MISC[threadIdx.x] = 0u;
    __syncthreads();
    XcdBarrier xbar = xcd_barrier_post((unsigned*)ws + 4096, MISC + 8);
#define GSYNC() xcd_barrier(xbar)
#pragma unroll 1
    for (int l = 0; l < 4; ++l) { phase_prep(A, L, l, (int)((blockIdx.x + 64 * l) % G), G, wv); LBAR(); }
    if (A.out == nullptr) grid.sync();
    for (int rep = 0; rep < DUP_SYNC; ++rep) GSYNC();
#pragma unroll 1
    for (int layer = 0; layer < 4; ++layer) {
        ws = ows(ws);
        const int kind = layer == 3 ? 0 : layer;
        const int Nin = kind == 0 ? 2560 : (kind == 1 ? 2048 : 4096);
        const float* xinL = layer == 0 ? A.in[0] : XL; const float* xinC = layer == 0 ? A.in[2] : XC;
        for (int rep = 0; rep < DUP_NORM; ++rep) phase_norm(A, layer, xinL, xinC, L, wv);
        GSYNC();
        {
            const bf16_t* Wt = (const bf16_t*)(ws + (layer == 0 ? WS_WIN[0] : layer == 1 ? WS_WIN[1] : layer == 2 ? WS_WIN[2] : WS_WIN[3]));
            pg8::Gemm g{XN, Wt, layer == 3 ? ML : MT, Nin, DM};
            pg8::OrderG S; S.so.init(layer == 3 ? ML : MT, Nin, G, (int)blockIdx.x); S.extra = layer == 3 ? 16 : 0;
            pg8::EpiIn E{ACT, Nin, kind, (const float*)(ws + WS_ROPE)};
            for (int rep = 0; rep < DUP_GIN; ++rep) pg8::gemm_phase<pg8::EpiIn, pg8::OrderG, true, true>(L, g, S, E, wv);
        }
        GSYNC();
        if (kind == 0) { for (int rep = 0; rep < DUP_ATTN; ++rep) phase_attn(ACT, XN, (layer == 0 ? A.in[9] : A.in[34]), layer == 0, L, wv); }
        else if (kind == 1) { for (int rep = 0; rep < DUP_LRU; ++rep) phase_lru(A, ACT, XN, (float*)(ws + WS_HF), L, wv); }
        else { for (int rep = 0; rep < DUP_CONV; ++rep) phase_conv(A, ACT, XN, wv); }
        GSYNC();
        {
            const bf16_t* Wt = (const bf16_t*)(ws + (layer == 0 ? WS_WOUT[0] : layer == 1 ? WS_WOUT[1] : layer == 2 ? WS_WOUT[2] : WS_WOUT[3]));
            const int Mo = (CTX_SMALL || layer == 3) ? ML : MT;
            pg8::Gemm g{XN, Wt, Mo, DM, DM};
            pg8::OrderG S; S.so.init(Mo, DM, G, (int)blockIdx.x); S.extra = 0;
            pg8::EpiRes E{xinL, xinC, XL, XC, gatef + (size_t)layer * 9 * 1024};
            for (int rep = 0; rep < (layer == 0 ? DUP_GOUT0 : 1); ++rep) pg8::gemm_phase<pg8::EpiRes, pg8::OrderG, true, true>(L, g, S, E, wv);
            if (CTX_SMALL && layer < 3) phase_ctx_wout(XN + (size_t)ML * DM, Wt, xinC, XC, gatef + (size_t)(layer * 9 + 8) * 1024, L, wv);
        }
        GSYNC();
    }
    phase_final(XL, A.in[35], wv);
}

extern "C" void kernel_launch(void* const* d_in, const int* in_sizes, int n_in, void* d_out, int out_size, void* d_ws, size_t ws_size, hipStream_t stream) {
    static int grid = 0;
    if (grid == 0) {
        if (n_in != 36 || out_size != ML * DM || ws_size < WS_END) { fprintf(stderr, "kernel_launch: unexpected shapes (n_in %d, out %d, ws %zu)\n", n_in, out_size, ws_size); grid = -1; return; }
        int dev = 0, cus = 0, per_cu = 0;
        hipGetDevice(&dev); hipDeviceGetAttribute(&cus, hipDeviceAttributeMultiprocessorCount, dev);
        if (hipFuncSetAttribute((const void*)hybrid_fwd, hipFuncAttributeMaxDynamicSharedMemorySize, LDS_BYTES) != hipSuccess) { fprintf(stderr, "kernel_launch: hipFuncSetAttribute failed\n"); grid = -1; return; }
        if (hipOccupancyMaxActiveBlocksPerMultiprocessor(&per_cu, (const void*)hybrid_fwd, NTHREADS, LDS_BYTES) != hipSuccess || per_cu < 1) { fprintf(stderr, "kernel_launch: occupancy query says %d\n", per_cu); per_cu = 1; }
        (void)hipGetLastError();
        grid = cus * (per_cu > 1 ? 1 : per_cu);
        if (grid > 256) grid = 256;
    }
    if (grid < 0) return;
    if (hipMemsetAsync(d_ws, 0, 65536, stream) != hipSuccess) { fprintf(stderr, "kernel_launch: memset failed\n"); return; }
    Args a{};
    for (int i = 0; i < 36; ++i) a.in[i] = (const float*)d_in[i];
    a.out = (float*)d_out; a.ws = (unsigned char*)d_ws;
    void* args[] = {&a};
    hipError_t e = hipLaunchCooperativeKernel((const void*)hybrid_fwd, dim3(grid), dim3(NTHREADS), args, LDS_BYTES, stream);
    if (e != hipSuccess) fprintf(stderr, "kernel_launch: cooperative launch failed: %s (grid %d)\n", hipGetErrorString(e), grid);
}
```

```cpp
#include <hip/hip_runtime.h>
#include <hip/hip_cooperative_groups.h>
#include <cstdio>
#include <cstdint>
namespace cg = cooperative_groups;

namespace pg8 {
#define PG8_LAS __attribute__((address_space(3)))
typedef unsigned short bf16_t;
typedef short bf16x8 __attribute__((ext_vector_type(8)));
typedef float f32x4 __attribute__((ext_vector_type(4)));
typedef unsigned u32x4 __attribute__((ext_vector_type(4)));
constexpr int BM = 256, BK = 64, HALF = 128, HTB = HALF * BK * 2  , STAGE_BYTES = 8 * HTB, NXCD = 8, WGM = 8;

__host__ __device__ __forceinline__ int lds_byte(int r, int c) { const int st = (r >> 4) * 2 + (c >> 5), rr = r & 15, cc = c & 31, ob = rr * 64 + cc * 2; return st * 1024 + (ob ^ (((ob >> 9) & 1) << 5)); }
__host__ __device__ __forceinline__ void stage_rc(int b, int& R, int& C) { const int st = b / 1024, sb = b % 1024, swz = sb ^ (((sb >> 9) & 1) << 5); R = (st >> 1) * 16 + swz / 64; C = (st & 1) * 32 + (swz % 64) / 2; }
__host__ __device__ __forceinline__ int perm32(int rho) { const int n = rho >> 4, i = rho & 15; return 8 * (i >> 2) + 4 * n + (i & 3); }

struct Unit { int pm, pn; };
struct Gemm { const bf16_t* A; const bf16_t* Bt; int M, N, K; };

struct StaticOrder {
    int nM, nN, nwg, G, c;
    __host__ __device__ void init(int M, int N, int G_, int c_) { nM = M / BM; nN = N / BM; nwg = nM * nN; G = G_; c = c_; }
    __host__ __device__ bool next(int i, Unit& u) const {
        const long L = (long)i * G + c; if (L >= nwg) return false;
        int wgid = (int)L; { const int q = nwg / NXCD, r = nwg % NXCD, xcd = wgid % NXCD, off = wgid / NXCD; wgid = (xcd < r ? xcd * (q + 1) : r * (q + 1) + (xcd - r) * q) + off; }
        const int nig = WGM * nN, gid = wgid / nig, fm = gid * WGM, gsz = (nM - fm) < WGM ? (nM - fm) : WGM;
        u.pm = fm + ((wgid % nig) % gsz); u.pn = (wgid % nig) / gsz; return true;
    }
    __device__ __forceinline__ void a_ready(const Unit&) const {}
    __device__ __forceinline__ void done(const Unit&) const {}
};

__device__ __forceinline__ unsigned cvt_pk_bf16(float lo, float hi) { unsigned r; asm volatile("v_cvt_pk_bf16_f32 %0, %1, %2" : "=v"(r) : "v"(lo), "v"(hi)); return r; }
typedef float f32x2 __attribute__((ext_vector_type(2)));
__device__ __forceinline__ float silu_f(float v) { return v * __builtin_amdgcn_rcpf(1.0f + __builtin_amdgcn_exp2f(-v * 1.4426950408889634f)); }
constexpr float QSCALE = 0.125f * 1.4426950408889634f;

struct OrderG {
    StaticOrder so; int extra;
    __device__ __forceinline__ bool next(int i, Unit& u) const {
        long L = (long)i * so.G + so.c; if (L < so.nwg) return so.next(i, u);
        L -= so.nwg; if (L >= extra) return false; u.pm = 64 + (int)(L >> 1); u.pn = 4 + (int)(L & 1); return true;
    }
    __device__ __forceinline__ void a_ready(const Unit&) const {}
    __device__ __forceinline__ void done(const Unit&) const {}
};

struct EpiIn {
    static constexpr bool PERM = true, AFTER_DRAIN = false;
    bf16_t* O; int ldc; int kind; const float* rope;
    __device__ __forceinline__ void operator()(const f32x4 (&acc)[2][2][4][2], const Unit& u, int wr, int wc, int fr, int fq) const {
        const int colt = u.pn * BM; const bool lat = u.pm < 64;
        int mode = 0; float sc = 1.f;
        if (kind == 0) { if (colt < 1024) { mode = lat ? 2 : 0; sc = QSCALE; } else if (colt < 1280) mode = lat ? 2 : 0; else if (colt < 1536) mode = 0; else mode = 1; }
        else if (kind == 1) mode = colt < 1024 ? 0 : 1;
        else mode = colt < 3072 ? 0 : 1;
        const int row0 = u.pm * BM + wr * 64 + fr; const int col0 = colt + wc * 32 + 8 * fq;
        const float sgn = (fq < 2) ? -1.f : 1.f;
#pragma unroll
        for (int ai = 0; ai < 2; ++ai)
#pragma unroll
            for (int m = 0; m < 4; ++m) {
                const int row = row0 + ai * HALF + m * 16;
                bf16_t* rowp = O + (size_t)row * ldc + col0;
                f32x4 cs[4];
                if (mode == 2) { const int l = row & 2047; const int p = (wc & 1) ? (l & 63) : (l >> 6); const f32x4* rp = (const f32x4*)(rope + (p * 16 + 8 * (fq & 1)) * 2);
                    cs[0] = rp[0]; cs[1] = rp[1]; cs[2] = rp[2]; cs[3] = rp[3]; }
#pragma unroll
                for (int bj = 0; bj < 2; ++bj) {
                    f32x4 v0 = acc[ai][bj][m][0], v1 = acc[ai][bj][m][1];
                    if (mode == 1) {
#pragma unroll
                        for (int e = 0; e < 4; ++e) { v0[e] = silu_f(v0[e]); v1[e] = silu_f(v1[e]); }
                    } else if (mode == 2) {
                        f32x4 p0, p1;
#pragma unroll
                        for (int e = 0; e < 4; ++e) { p0[e] = __shfl_xor(v0[e], 32); p1[e] = __shfl_xor(v1[e], 32); }
                        v0[0] = v0[0] * cs[0][0] + sgn * p0[0] * cs[0][1]; v0[1] = v0[1] * cs[0][2] + sgn * p0[1] * cs[0][3];
                        v0[2] = v0[2] * cs[1][0] + sgn * p0[2] * cs[1][1]; v0[3] = v0[3] * cs[1][2] + sgn * p0[3] * cs[1][3];
                        v1[0] = v1[0] * cs[2][0] + sgn * p1[0] * cs[2][1]; v1[1] = v1[1] * cs[2][2] + sgn * p1[1] * cs[2][3];
                        v1[2] = v1[2] * cs[3][0] + sgn * p1[2] * cs[3][1]; v1[3] = v1[3] * cs[3][2] + sgn * p1[3] * cs[3][3];
                    }
                    v0 = v0 * sc; v1 = v1 * sc;
                    u32x4 w; w.x = cvt_pk_bf16(v0[0], v0[1]); w.y = cvt_pk_bf16(v0[2], v0[3]); w.z = cvt_pk_bf16(v1[0], v1[1]); w.w = cvt_pk_bf16(v1[2], v1[3]);
                    *(u32x4*)(rowp + bj * HALF) = w;
                }
            }
    }
};

struct EpiRes {
    static constexpr bool PERM = true, AFTER_DRAIN = false;
    const float* inL; const float* inC; float* outL; float* outC; const float* gate;
    __device__ __forceinline__ void operator()(const f32x4 (&acc)[2][2][4][2], const Unit& u, int wr, int wc, int fr, int fq) const {
        const bool lat = u.pm < 64;
        const float* ib = lat ? inL + (size_t)u.pm * BM * 1024 : inC + (size_t)(u.pm - 64) * BM * 1024;
        float* ob = lat ? outL + (size_t)u.pm * BM * 1024 : outC + (size_t)(u.pm - 64) * BM * 1024;
        const float* g = gate + (lat ? (u.pm >> 3) : 8) * 1024;
        const int col0 = u.pn * BM + wc * 32 + 8 * fq;
        f32x4 gv[2][2];
#pragma unroll
        for (int bj = 0; bj < 2; ++bj)
#pragma unroll
            for (int n = 0; n < 2; ++n) gv[bj][n] = *(const f32x4*)(g + col0 + bj * HALF + n * 4);
#pragma unroll
        for (int ai = 0; ai < 2; ++ai)
#pragma unroll
            for (int m = 0; m < 4; ++m) { const size_t off = (size_t)(ai * HALF + wr * 64 + m * 16 + fr) * 1024 + col0;
#pragma unroll
                for (int bj = 0; bj < 2; ++bj)
#pragma unroll
                    for (int n = 0; n < 2; ++n) { const f32x4 x = __builtin_nontemporal_load((const f32x4*)(ib + off + bj * HALF + n * 4));
                        *(f32x4*)(ob + off + bj * HALF + n * 4) = x + gv[bj][n] * acc[ai][bj][m][n]; }
                if (m & 1) asm volatile("" ::: "memory"); }
    }
};

template <class Epi, class Sched, bool ALIGN_EPI = false, bool SP2 = false>
__device__ __forceinline__ void gemm_phase(PG8_LAS unsigned char* lds, const Gemm g, const Sched& S, const Epi& E, const int wv_) {
    int tid_ = wv_ * 64 + (int)__builtin_amdgcn_mbcnt_hi(~0u, __builtin_amdgcn_mbcnt_lo(~0u, 0u)); asm volatile("" : "+v"(tid_));
    const int tid = tid_, wid = __builtin_amdgcn_readfirstlane(tid >> 6), lane = tid & 63, wr = wid >> 2, wc = wid & 3, fr = lane & 15, fq = lane >> 4;
    const int K = g.K, nt = K / BK;
    unsigned voffA[2], voffB[2];
#pragma unroll
    for (int i = 0; i < 2; ++i) { int R, C; stage_rc(tid * 16 + i * 8192, R, C); const int Rb = Epi::PERM ? ((R & ~31) + perm32(R & 31)) : R;
        voffA[i] = (unsigned)(R * K + C) * 2u; voffB[i] = (unsigned)(Rb * K + C) * 2u; }
    const size_t kstep = (size_t)(BK * 2);
    const size_t hstep = (size_t)HALF * K * 2;
    const size_t tstep = 2 * hstep;
    const unsigned ldsw = (unsigned)wid * 1024u;
    const int aoff = lds_byte(wr * 64 + fr, fq * 8), boff = lds_byte(wc * 32 + fr, fq * 8);
#define PG8_SA(b, h) (((b) * 2 + (h)) * HTB)
#define PG8_SB(b, h) ((4 + (b) * 2 + (h)) * HTB)
#define PG8_STAGE(bufoff, gbase, voff) do { _Pragma("unroll") for (int _i = 0; _i < 2; ++_i) \
        __builtin_amdgcn_global_load_lds((const unsigned*)((const char*)(gbase) + (voff)[_i]), (PG8_LAS unsigned*)(lds + (bufoff) + ldsw + _i * 8192), 16, 0, 0); } while (0)
#define PG8_LDA(dst, b, h) do { _Pragma("unroll") for (int m = 0; m < 4; ++m) _Pragma("unroll") for (int k = 0; k < 2; ++k) dst[m][k] = *(const PG8_LAS bf16x8*)(lds + PG8_SA(b, h) + aoff + m * 2048 + k * 1024); } while (0)
#define PG8_LDB(dst, b, h) do { _Pragma("unroll") for (int n = 0; n < 2; ++n) _Pragma("unroll") for (int k = 0; k < 2; ++k) dst[n][k] = *(const PG8_LAS bf16x8*)(lds + PG8_SB(b, h) + boff + n * 2048 + k * 1024); } while (0)
#define PG8_MMA(ai, bj, At, Bt) do { __builtin_amdgcn_s_setprio(1); _Pragma("unroll") for (int m = 0; m < 4; ++m) _Pragma("unroll") for (int n = 0; n < 2; ++n) _Pragma("unroll") for (int k = 0; k < 2; ++k) \
        acc[ai][bj][m][n] = __builtin_amdgcn_mfma_f32_16x16x32_bf16(Bt[n][k], At[m][k], acc[ai][bj][m][n], 0, 0, 0); __builtin_amdgcn_s_setprio(0); } while (0)
#define PG8_WAIT_V(n) asm volatile("s_waitcnt vmcnt(" #n ")" ::: "memory")
#define PG8_WAIT_L(n) asm volatile("s_waitcnt lgkmcnt(" #n ")" ::: "memory")
#define PG8_BAR __builtin_amdgcn_s_barrier()
#define PG8_SCHED __builtin_amdgcn_sched_barrier(0)
    Unit cur, nxt; int ui = 0;
    if (!S.next(0, cur)) return;
    f32x4 acc[2][2][4][2];
#pragma unroll
    for (int a = 0; a < 2; ++a)
#pragma unroll
        for (int b = 0; b < 2; ++b)
#pragma unroll
            for (int m = 0; m < 4; ++m)
#pragma unroll
                for (int n = 0; n < 2; ++n) acc[a][b][m][n] = (f32x4){0.f, 0.f, 0.f, 0.f};
    bf16x8 At[4][2], B0[2][2], B1[2][2];
    const char* cA = (const char*)g.A + (size_t)cur.pm * tstep; const char* cB = (const char*)g.Bt + (size_t)cur.pn * tstep;
    S.a_ready(cur);
    if constexpr (SP2) {
        PG8_STAGE(PG8_SB(0, 0), cB, voffB); PG8_STAGE(PG8_SB(0, 1), cB + hstep, voffB); PG8_STAGE(PG8_SA(0, 0), cA, voffA); PG8_STAGE(PG8_SA(0, 1), cA + hstep, voffA);
        if (wr == 1) PG8_BAR;
        PG8_WAIT_V(2); PG8_BAR;
        PG8_STAGE(PG8_SB(1, 0), cB + kstep, voffB); PG8_STAGE(PG8_SA(1, 0), cA + kstep, voffA); PG8_STAGE(PG8_SB(1, 1), cB + hstep + kstep, voffB);
        PG8_WAIT_V(6); PG8_BAR;
    } else {
        PG8_STAGE(PG8_SB(0, 0), cB, voffB); PG8_STAGE(PG8_SA(0, 0), cA, voffA); PG8_STAGE(PG8_SB(0, 1), cB + hstep, voffB); PG8_STAGE(PG8_SA(0, 1), cA + hstep, voffA);
        if (wr == 1) PG8_BAR;
        PG8_WAIT_V(4); PG8_BAR;
        PG8_STAGE(PG8_SB(1, 0), cB + kstep, voffB); PG8_STAGE(PG8_SA(1, 0), cA + kstep, voffA); PG8_STAGE(PG8_SB(1, 1), cB + hstep + kstep, voffB);
        PG8_WAIT_V(6); PG8_BAR;
    }
    for (;;) {
        const bool has_next = S.next(ui + 1, nxt);
        const char* nA = has_next ? (const char*)g.A + (size_t)nxt.pm * tstep : cA; const char* nB = has_next ? (const char*)g.Bt + (size_t)nxt.pn * tstep : cB;
        for (int t = 0; t < nt; t += 2) {
            const bool last = (t == nt - 2);
            const char* a1 = cA + (size_t)(t + 1) * kstep;
            const char* a2 = last ? nA : cA + (size_t)(t + 2) * kstep; const char* b2 = last ? nB : cB + (size_t)(t + 2) * kstep;
            const char* a3 = a2 + kstep; const char* b3 = b2 + kstep;
            if (last && has_next) S.a_ready(nxt);
            if constexpr (SP2) {
            PG8_LDB(B0, 0, 0); PG8_LDB(B1, 0, 1); PG8_SCHED; PG8_LDA(At, 0, 0); PG8_STAGE(PG8_SA(1, 1), a1 + hstep, voffA);
            PG8_WAIT_V(8); PG8_WAIT_L(0); PG8_BAR; PG8_MMA(0, 0, At, B0); PG8_MMA(0, 1, At, B1); PG8_BAR; PG8_SCHED;
            PG8_LDA(At, 0, 1); PG8_STAGE(PG8_SB(0, 0), b2, voffB); PG8_STAGE(PG8_SB(0, 1), b2 + hstep, voffB); PG8_STAGE(PG8_SA(0, 0), a2, voffA);
            PG8_WAIT_V(8); PG8_WAIT_L(0); PG8_BAR; PG8_MMA(1, 0, At, B0); PG8_MMA(1, 1, At, B1); PG8_BAR; PG8_SCHED;
            PG8_LDB(B0, 1, 0); PG8_LDB(B1, 1, 1); PG8_SCHED; PG8_LDA(At, 1, 0); PG8_STAGE(PG8_SA(0, 1), a2 + hstep, voffA);
            PG8_WAIT_V(8); PG8_WAIT_L(0); PG8_BAR; PG8_MMA(0, 0, At, B0); PG8_MMA(0, 1, At, B1); PG8_BAR; PG8_SCHED;
            PG8_LDA(At, 1, 1); PG8_STAGE(PG8_SB(1, 0), b3, voffB); PG8_STAGE(PG8_SB(1, 1), b3 + hstep, voffB); PG8_STAGE(PG8_SA(1, 0), a3, voffA);
            PG8_WAIT_V(8); PG8_WAIT_L(0); PG8_BAR; PG8_MMA(1, 0, At, B0); PG8_MMA(1, 1, At, B1); PG8_BAR; PG8_SCHED;
            } else {
            PG8_LDB(B0, 0, 0); PG8_SCHED; PG8_LDA(At, 0, 0); PG8_STAGE(PG8_SA(1, 1), a1 + hstep, voffA);
            PG8_WAIT_L(8); PG8_BAR; PG8_WAIT_L(0); PG8_MMA(0, 0, At, B0); PG8_BAR; PG8_SCHED;
            PG8_LDB(B1, 0, 1); PG8_STAGE(PG8_SB(0, 0), b2, voffB);
            PG8_BAR; PG8_WAIT_L(0); PG8_MMA(0, 1, At, B1); PG8_BAR;
            PG8_LDA(At, 0, 1); PG8_STAGE(PG8_SA(0, 0), a2, voffA);
            PG8_BAR; PG8_WAIT_L(0); PG8_MMA(1, 0, At, B0); PG8_BAR; PG8_SCHED;
            PG8_STAGE(PG8_SB(0, 1), b2 + hstep, voffB);
            PG8_WAIT_V(6); PG8_BAR; PG8_MMA(1, 1, At, B1); PG8_BAR;
            PG8_LDB(B0, 1, 0); PG8_SCHED; PG8_LDA(At, 1, 0); PG8_STAGE(PG8_SA(0, 1), a2 + hstep, voffA);
            PG8_WAIT_L(8); PG8_BAR; PG8_WAIT_L(0); PG8_MMA(0, 0, At, B0); PG8_BAR; PG8_SCHED;
            PG8_LDB(B1, 1, 1); PG8_STAGE(PG8_SB(1, 0), b3, voffB);
            PG8_BAR; PG8_WAIT_L(0); PG8_MMA(0, 1, At, B1); PG8_BAR;
            PG8_LDA(At, 1, 1); PG8_STAGE(PG8_SA(1, 0), a3, voffA);
            PG8_BAR; PG8_WAIT_L(0); PG8_MMA(1, 0, At, B0); PG8_BAR; PG8_SCHED;
            PG8_STAGE(PG8_SB(1, 1), b3 + hstep, voffB);
            PG8_WAIT_V(6); PG8_BAR; PG8_MMA(1, 1, At, B1); PG8_BAR;
            }
        }
        if constexpr (ALIGN_EPI) { if (wr == 0) PG8_BAR; }
        if constexpr (!Epi::AFTER_DRAIN) { E(acc, cur, wr, wc, fr, fq); S.done(cur); }
        if (!has_next) break;
#pragma unroll
        for (int a = 0; a < 2; ++a)
#pragma unroll
            for (int b = 0; b < 2; ++b)
#pragma unroll
                for (int m = 0; m < 4; ++m)
#pragma unroll
                    for (int n = 0; n < 2; ++n) acc[a][b][m][n] = (f32x4){0.f, 0.f, 0.f, 0.f};
        cur = nxt; cA = nA; cB = nB; ++ui;
        if constexpr (ALIGN_EPI) { if (wr == 1) PG8_BAR; }
    }
    PG8_WAIT_V(0);
    if constexpr (!ALIGN_EPI) { if (wr == 0) PG8_BAR; }
    PG8_BAR;
    if constexpr (Epi::AFTER_DRAIN) { E.fused(acc, cur, wr, wc, fr, fq, lds, wid, lane); S.done(cur); }
#undef PG8_SA
#undef PG8_SB
#undef PG8_STAGE
#undef PG8_LDA
#undef PG8_LDB
#undef PG8_MMA
#undef PG8_WAIT_V
#undef PG8_WAIT_L
#undef PG8_BAR
#undef PG8_SCHED
}
}

#define LAS __attribute__((address_space(3)))
typedef unsigned short bf16_t;
typedef short bf16x8 __attribute__((ext_vector_type(8)));
typedef short s16x4 __attribute__((ext_vector_type(4)));
typedef float f32x4 __attribute__((ext_vector_type(4)));
typedef float f32x2 __attribute__((ext_vector_type(2)));
typedef float f32x16 __attribute__((ext_vector_type(16)));
typedef unsigned u32x4 __attribute__((ext_vector_type(4)));
typedef unsigned u32x2 __attribute__((ext_vector_type(2)));

#ifndef DUP_ATTN
#define DUP_ATTN 1
#endif
#ifndef DUP_LRU
#define DUP_LRU 1
#endif
#ifndef DUP_CONV
#define DUP_CONV 1
#endif
#ifndef DUP_GIN
#define DUP_GIN 1
#endif
#ifndef DUP_NORM
#define DUP_NORM 1
#endif
#ifndef DUP_PRO
#define DUP_PRO 1
#endif
#ifndef DUP_GOUT0
#define DUP_GOUT0 1
#endif
#ifndef DUP_LRUBC
#define DUP_LRUBC 1
#endif
#ifndef DUP_ATTEPI
#define DUP_ATTEPI 1
#endif
#ifndef DUP_SYNC
#define DUP_SYNC 1
#endif
#ifndef CTX_SMALL
#define CTX_SMALL 1
#endif
constexpr int NTHREADS = 512, NWAVES = 8;
constexpr int DM = 1024, NB = 8, SEQ = 2048, CTX = 256;
constexpr int ML = NB * SEQ, MC = NB * CTX, MT = ML + MC;
constexpr float EPS = 1e-6f, LOG2E = 1.4426950408889634f;
constexpr int LDS_BYTES = 147456;

constexpr size_t MiB = 1u << 20;
constexpr size_t WS_MODP = 1 * MiB;
constexpr size_t WS_GATE = 5 * MiB;
constexpr size_t WS_ROPE = 5 * MiB + 512 * 1024;
constexpr size_t WS_GW = 6 * MiB;
constexpr size_t WS_WIN[4] = {8 * MiB, 15 * MiB, 21 * MiB, 31 * MiB};
constexpr size_t WS_WOUT[4] = {13 * MiB, 19 * MiB, 29 * MiB, 36 * MiB};
constexpr size_t WS_XC = 38 * MiB;
constexpr size_t WS_XN = 46 * MiB;
constexpr size_t WS_ACT = 82 * MiB;
constexpr size_t WS_HF = 154 * MiB;
constexpr size_t WS_END = 226 * MiB;

struct Args { const float* in[36]; float* out; unsigned char* ws; };

#define LBAR() do { asm volatile("s_waitcnt lgkmcnt(0)" ::: "memory"); __builtin_amdgcn_s_barrier(); asm volatile("" ::: "memory"); } while (0)

__device__ __forceinline__ unsigned f2bf(float f) { unsigned u = __builtin_bit_cast(unsigned, f); return (u + 0x7fffu + ((u >> 16) & 1u)) >> 16; }
__device__ __forceinline__ unsigned pk2(float lo, float hi) { return pg8::cvt_pk_bf16(lo, hi); }
__device__ __forceinline__ float bflo(unsigned w) { return __builtin_bit_cast(float, w << 16); }
__device__ __forceinline__ float bfhi(unsigned w) { return __builtin_bit_cast(float, w & 0xffff0000u); }
__device__ __forceinline__ unsigned char* ows(unsigned char* p) { const unsigned long long v = (unsigned long long)p; unsigned lo = __builtin_amdgcn_readfirstlane((unsigned)v), hi = __builtin_amdgcn_readfirstlane((unsigned)(v >> 32)); asm volatile("" : "+s"(lo), "+s"(hi)); return (unsigned char*)(__attribute__((address_space(1))) unsigned char*)(((unsigned long long)hi << 32) | lo); }
__device__ __forceinline__ int otid(int wv) { int t = wv * 64 + (int)__builtin_amdgcn_mbcnt_hi(~0u, __builtin_amdgcn_mbcnt_lo(~0u, 0u)); asm volatile("" : "+v"(t)); return t; }
__device__ __forceinline__ float wave_sum(float v) {
#pragma unroll
    for (int o = 1; o < 64; o <<= 1) v += __shfl_xor(v, o);
    return v;
}
using pg8::silu_f;

__device__ __forceinline__ void transpose_item(const float* W, int K, int N, bf16_t* WT, LAS float* scr, int item, int lane) {
    const int nblk = N / 32, kb = item / nblk, nb = item % nblk, k0 = 64 * kb, n0 = 32 * nb;
    float tv[32];
#pragma unroll
    for (int i = 0; i < 32; ++i) tv[i] = __builtin_nontemporal_load(W + (size_t)(k0 + 2 * i + (lane >> 5)) * N + n0 + (lane & 31));
#pragma unroll
    for (int i = 0; i < 32; ++i) scr[(2 * i + (lane >> 5)) * 33 + (lane & 31)] = tv[i];
    asm volatile("s_waitcnt lgkmcnt(0)" ::: "memory");
    const int c = lane & 7;
#pragma unroll
    for (int j = 0; j < 4; ++j) { const int n = (lane >> 3) + 8 * j; const LAS float* s = scr + (8 * c) * 33 + n;
        u32x4 o; o.x = pk2(s[0 * 33], s[1 * 33]); o.y = pk2(s[2 * 33], s[3 * 33]); o.z = pk2(s[4 * 33], s[5 * 33]); o.w = pk2(s[6 * 33], s[7 * 33]);
        *(u32x4*)(WT + (size_t)(n0 + n) * K + k0 + 8 * c) = o; }
    asm volatile("s_waitcnt lgkmcnt(0)" ::: "memory");
}

__device__ __forceinline__ void phase_prep(const Args& A, LAS unsigned char* L, int layer, int vbid, int vG, const int wv) {
    const int tid = otid(wv), lane = tid & 63, wave = tid >> 6;
    unsigned char* ws = ows(A.ws);
    const float* Wm = (layer == 0 ? A.in[5] : layer == 1 ? A.in[11] : layer == 2 ? A.in[23] : A.in[30]);
    for (int task = vbid; task < 48; task += vG) {
        const int cc = task >> 3, kc = task & 7;
        LAS float* s = (LAS float*)L;
        for (int idx = tid; idx < 9 * 128; idx += NTHREADS) { const int r = idx >> 7, kk = idx & 127;
            const float v = (r < 8) ? A.in[1][r * DM + kc * 128 + kk] : A.in[3][kc * 128 + kk];
            s[idx] = v / (1.0f + __expf(-v)); }
        LBAR();
        const int col = cc * 512 + tid;
        float acc[9];
#pragma unroll
        for (int r = 0; r < 9; ++r) acc[r] = 0.f;
        const float* wp = Wm + (size_t)(kc * 128) * 3072 + col;
#pragma unroll 32
        for (int kk = 0; kk < 128; ++kk) { const float w = __builtin_nontemporal_load(wp + (size_t)kk * 3072);
#pragma unroll
            for (int r = 0; r < 9; ++r) acc[r] += s[r * 128 + kk] * w; }
        float* mp = (float*)(ws + WS_MODP) + (size_t)((layer * 8 + kc) * 9) * 3072 + col;
#pragma unroll
        for (int r = 0; r < 9; ++r) mp[(size_t)r * 3072] = acc[r];
        LBAR();
    }
    if (layer == 0 && vbid == vG - 1) {
        float* rt = (float*)(ws + WS_ROPE);
        for (int idx = tid; idx < 1024; idx += NTHREADS) { const int p = idx >> 4, j = idx & 15;
            const float inv = 1.0f / __builtin_powf(10000.0f, (float)j * (1.0f / 16.0f));
            const float ang = (float)p * inv; float t = ang * 0.15915494309189535f; t -= __builtin_rintf(t);
            rt[idx * 2] = __builtin_amdgcn_cosf(t); rt[idx * 2 + 1] = __builtin_amdgcn_sinf(t); }
    }
    LAS float* scr = (LAS float*)(L + wave * 16384);
    const int rb = (vbid + vG - (48 % vG)) % vG;
    const int gw = rb * NWAVES + wave, NGW = vG * NWAVES;
    const int Nin = (layer == 0 || layer == 3) ? 2560 : (layer == 1 ? 2048 : 4096);
    const float* win = (layer == 0 ? A.in[7] : layer == 1 ? A.in[13] : layer == 2 ? A.in[25] : A.in[32]);
    const float* wout = (layer == 0 ? A.in[8] : layer == 1 ? A.in[14] : layer == 2 ? A.in[26] : A.in[33]);
    bf16_t* wint = (bf16_t*)(ws + (layer == 0 ? WS_WIN[0] : layer == 1 ? WS_WIN[1] : layer == 2 ? WS_WIN[2] : WS_WIN[3]));
    bf16_t* woutt = (bf16_t*)(ws + (layer == 0 ? WS_WOUT[0] : layer == 1 ? WS_WOUT[1] : layer == 2 ? WS_WOUT[2] : WS_WOUT[3]));
    const int IIN = 16 * (Nin / 32), IO = 16 * 32, IGW = layer == 0 ? 64 * 2 : 0;
    const int nitems = IIN + IO + IGW;
    for (int it = gw; it < nitems; it += NGW) {
        int r = it;
        if (r < IIN) { transpose_item(win, 1024, Nin, wint, scr, r, lane); continue; } r -= IIN;
        if (r < IO) { transpose_item(wout, 1024, 1024, woutt, scr, r, lane); continue; } r -= IO;
        { const int blk = r >> 1, sub = r & 1;
          const int dir = blk >> 5, gate = (blk >> 4) & 1, h = blk & 15;
          const float* src = (gate == 0 ? A.in[17] : A.in[19]) + (size_t)(dir * 16 + h) * 4096;
          transpose_item(src, 64, 64, (bf16_t*)(ws + WS_GW) + (size_t)blk * 4096, scr, sub, lane); }
    }
}

template <int NR> __device__ __forceinline__ void norm_rows(const float* const (&xrow)[NR], bf16_t* const (&orow)[NR], const LAS float* const (&gs)[NR], const LAS float* const (&sh)[NR], int lane) {
    f32x4 v[NR][4]; float s[NR];
#pragma unroll
    for (int i = 0; i < NR; ++i) { const f32x4* xr = (const f32x4*)xrow[i] + lane;
#pragma unroll
        for (int j = 0; j < 4; ++j) v[i][j] = __builtin_nontemporal_load(xr + 64 * j); }
#pragma unroll
    for (int i = 0; i < NR; ++i) { float a = 0.f;
#pragma unroll
        for (int j = 0; j < 4; ++j) a += (v[i][j].x * v[i][j].x + v[i][j].y * v[i][j].y) + (v[i][j].z * v[i][j].z + v[i][j].w * v[i][j].w);
        s[i] = a; }
#pragma unroll
    for (int o = 1; o < 64; o <<= 1) {
#pragma unroll
        for (int i = 0; i < NR; ++i) s[i] += __shfl_xor(s[i], o); }
#pragma unroll
    for (int i = 0; i < NR; ++i) { const float rstd = 1.0f / sqrtf(s[i] * (1.0f / DM) + EPS); u32x2* o8 = (u32x2*)orow[i] + lane;
#pragma unroll
        for (int j = 0; j < 4; ++j) { const f32x4 g = *(const LAS f32x4*)(gs[i] + 256 * j + 4 * lane), b = *(const LAS f32x4*)(sh[i] + 256 * j + 4 * lane);
            const f32x4 y = v[i][j] * rstd * g + b; u32x2 w; w.x = pk2(y.x, y.y); w.y = pk2(y.z, y.w); o8[64 * j] = w; } }
}
__device__ __forceinline__ void phase_norm(const Args& A, int layer, const float* xL, const float* xC, LAS unsigned char* L, const int wv) {
    const int tid = otid(wv), lane = tid & 63, wave = tid >> 6, bid = blockIdx.x, G = gridDim.x;
    const float* norm_g = (layer == 0 ? A.in[4] : layer == 1 ? A.in[10] : layer == 2 ? A.in[22] : A.in[29]);
    const float* mod_b = (layer == 0 ? A.in[6] : layer == 1 ? A.in[12] : layer == 2 ? A.in[24] : A.in[31]);
    unsigned char* ws = ows(A.ws);
    const float* modp = (const float*)(ws + WS_MODP) + (size_t)(layer * 8) * 9 * 3072;
    bf16_t* XN = (bf16_t*)(ws + WS_XN);
    LAS float* tab = (LAS float*)L;
    for (int vb = bid; vb < 256; vb += G) {
        const int batch = vb >> 5;
#pragma unroll
        for (int i8 = 0; i8 < 8; ++i8) { const int idx = tid + i8 * NTHREADS; const int which = idx >> 10, col = idx & 1023; const int r = (which < 2) ? batch : 8; const int mcol = (which & 1) ? col : 1024 + col;
            float v = mod_b[mcol];
#pragma unroll
            for (int kc = 0; kc < 8; ++kc) v += modp[(size_t)(kc * 9 + r) * 3072 + mcol];
            if (!(which & 1)) v = norm_g[col] * (1.0f + v);
            tab[idx] = v; }
        if (vb < 9) { float* gf = (float*)(ws + WS_GATE) + (size_t)(layer * 9 + vb) * 1024;
            for (int col = tid; col < 1024; col += NTHREADS) { float v = mod_b[2048 + col];
#pragma unroll
                for (int kc = 0; kc < 8; ++kc) v += modp[(size_t)(kc * 9 + vb) * 3072 + 2048 + col];
                gf[col] = v; } }
        LBAR();
#pragma unroll 1
        for (int bt = 0; bt < 3; ++bt) {
            const float* xr[3]; bf16_t* orow[3]; const LAS float* gs[3]; const LAS float* sh[3];
#pragma unroll
            for (int i = 0; i < 3; ++i) { const int ri = bt * 3 + i;
                if (ri < 8) { const int row = vb * 64 + wave * 8 + ri; xr[i] = xL + (size_t)row * DM; orow[i] = XN + (size_t)row * DM; gs[i] = tab; sh[i] = tab + 1024; }
                else { const int row = vb * 8 + wave; xr[i] = xC + (size_t)row * DM; orow[i] = XN + (size_t)(ML + row) * DM; gs[i] = tab + 2048; sh[i] = tab + 3072; } }
            norm_rows<3>(xr, orow, gs, sh, lane);
        }
        LBAR();
    }
}

#define MFMA32(a, b, c) __builtin_amdgcn_mfma_f32_32x32x16_bf16((a), (b), (c), 0, 0, 0)
#define MFMA16(a, b, c) __builtin_amdgcn_mfma_f32_16x16x32_bf16((a), (b), (c), 0, 0, 0)
__device__ __forceinline__ int crow(int r, int hi) { return (r & 3) + 8 * (r >> 2) + 4 * hi; }
typedef short v4i16_t __attribute__((ext_vector_type(4)));
__device__ __forceinline__ float max3f(float a, float b, float c) { float r; asm("v_max3_f32 %0, %1, %2, %3" : "=v"(r) : "v"(a), "v"(b), "v"(c)); return r; }
__device__ __forceinline__ s16x4 vtr(LAS const unsigned char* p) { return __builtin_bit_cast(s16x4, __builtin_amdgcn_ds_read_tr16_b64_v4i16((LAS v4i16_t*)p)); }

__device__ __forceinline__ void phase_attn(const bf16_t* ACT, bf16_t* Y, const float* sink, bool need_ctx, LAS unsigned char* L, const int wv) {
    constexpr int LD = 2560, KSTR = 144, TILEB = 64 * KSTR, BUFB = 2 * TILEB;
    const int tid = otid(wv), lane = tid & 63, r32 = lane & 31, hi = lane >> 5, wave = __builtin_amdgcn_readfirstlane(tid >> 6);
    const int g = wave >> 1, half = wave & 1, G = gridDim.x;
    const int skey = tid >> 3, sch = tid & 7;
    const int stoff = skey * KSTR + sch * 16;
    const int koff = r32 * KSTR + hi * 16;
    const int voff = TILEB + (4 * hi + ((lane & 15) >> 2)) * KSTR + (16 * ((lane >> 4) & 1) + 4 * (lane & 3)) * 2;
    const int nunits = need_ctx ? 1152 : 1024;
    for (int u = blockIdx.x; u < nunits; u += G) {
        int b, kvh, qb; bool lat;
        if (u < 1024) { b = u >> 7; kvh = (u >> 5) & 3; qb = u & 31; lat = true; } else { const int e = u - 1024; b = e >> 4; kvh = (e >> 2) & 3; qb = e & 3; lat = false; }
        const int h = kvh * 4 + g;
        const int qpos = qb * 64 + half * 32 + r32;
        const int qrow = lat ? b * SEQ + qpos : ML + b * CTX + qpos;
        int tlo = 4, thi = 4;
        if (lat) { tlo = qb == 0 ? 6 : (qb == 1 ? 5 : 4); thi = qb == 31 ? 7 : (qb == 30 ? 8 : 9); }
        const int n = 4 + (thi - tlo);
        const int kp_base = qb * 64 - 128;
        bf16x8 qf[4];
        { const bf16_t* qp = ACT + (size_t)qrow * LD + h * 64 + hi * 8;
#pragma unroll
          for (int d0 = 0; d0 < 4; ++d0) qf[d0] = *(const bf16x8*)(qp + d0 * 16); }
        float m_run = sink[h] * LOG2E, l_run = hi ? 0.f : 1.f;
        f32x16 o0, o1;
#pragma unroll
        for (int r = 0; r < 16; ++r) { o0[r] = 0.f; o1[r] = 0.f; }
        const size_t kcol = 1024 + kvh * 64 + sch * 8, vcol = 1280 + kvh * 64 + sch * 8;
#define ATT_TROW(s_) (((s_) < 4 ? ML + b * CTX + (s_) * 64 : b * SEQ + kp_base + (tlo + (s_) - 8) * 64) + skey)
        u32x4 kq0, vq0, kq1, vq1, kq2, vq2;
        { const size_t krow = (size_t)ATT_TROW(0); kq0 = *(const u32x4*)(ACT + krow * LD + kcol); vq0 = *(const u32x4*)(ACT + krow * LD + vcol); }
        { const size_t krow = (size_t)ATT_TROW(1); kq1 = *(const u32x4*)(ACT + krow * LD + kcol); vq1 = *(const u32x4*)(ACT + krow * LD + vcol); }
        { const size_t krow = (size_t)ATT_TROW(2); kq2 = *(const u32x4*)(ACT + krow * LD + kcol); vq2 = *(const u32x4*)(ACT + krow * LD + vcol); }
        LBAR();
        *(LAS u32x4*)(L + stoff) = kq0; *(LAS u32x4*)(L + TILEB + stoff) = vq0;
        { const size_t krow = (size_t)ATT_TROW(3); kq0 = *(const u32x4*)(ACT + krow * LD + kcol); vq0 = *(const u32x4*)(ACT + krow * LD + vcol); }
        LBAR();
#define ATT_STEP(s_, KQ, VQ) do { const int s = (s_); \
            const int t = s < 4 ? s : tlo + (s - 4); \
            LAS const unsigned char* B = L + (s & 1) * BUFB; \
 \
              \
            bf16x8 kf[8]; s16x4 vl[8], vh[8]; \
_Pragma("unroll") \
            for (int d0 = 0; d0 < 4; ++d0) { kf[2 * d0] = *(const LAS bf16x8*)(B + koff + d0 * 32); kf[2 * d0 + 1] = *(const LAS bf16x8*)(B + koff + 32 * KSTR + d0 * 32); } \
_Pragma("unroll") \
            for (int i = 0; i < 4; ++i) { LAS const unsigned char* vp = B + voff + i * 16 * KSTR; vl[2 * i] = vtr(vp); vh[2 * i] = vtr(vp + 8 * KSTR); vl[2 * i + 1] = vtr(vp + 64); vh[2 * i + 1] = vtr(vp + 8 * KSTR + 64); } \
            __builtin_amdgcn_sched_barrier(0); \
            f32x16 p0, p1; \
_Pragma("unroll") \
            for (int r = 0; r < 16; ++r) { p0[r] = 0.f; p1[r] = 0.f; } \
_Pragma("unroll") \
            for (int d0 = 0; d0 < 4; ++d0) { p0 = MFMA32(kf[2 * d0], qf[d0], p0); p1 = MFMA32(kf[2 * d0 + 1], qf[d0], p1); } \
            if (t == 4 || t == 8) { const int kp0 = kp_base + (t - 4) * 64 - qpos; \
_Pragma("unroll") \
                for (int r = 0; r < 16; ++r) { const int d0 = kp0 + crow(r, hi), d1 = d0 + 32; \
                    if (d0 > 128 || d0 < -128) p0[r] = -1e30f; if (d1 > 128 || d1 < -128) p1[r] = -1e30f; } } \
            float mt = max3f(p0[0], p0[1], p1[0]), mt2 = max3f(p0[2], p0[3], p1[1]); mt = max3f(mt, p1[2], p1[3]); \
_Pragma("unroll") \
            for (int r = 4; r < 16; r += 4) { mt = max3f(mt, p0[r], p0[r + 1]); mt2 = max3f(mt2, p0[r + 2], p0[r + 3]); mt = max3f(mt, p1[r], p1[r + 1]); mt2 = max3f(mt2, p1[r + 2], p1[r + 3]); } \
            mt = fmaxf(mt, mt2); \
            mt = fmaxf(mt, __shfl_xor(mt, 32)) - m_run; \
 \
            float dl = 0.f; \
            if (s == 0) dl = fmaxf(mt, 0.f); else if (mt > 8.0f) dl = mt; \
            if (__any(dl != 0.f)) { const float alpha = __builtin_amdgcn_exp2f(-dl); m_run += dl; l_run *= alpha; \
_Pragma("unroll") \
                for (int r = 0; r < 16; ++r) { o0[r] *= alpha; o1[r] *= alpha; } } \
            float ls = 0.f, ls2 = 0.f; \
_Pragma("unroll") \
            for (int r = 0; r < 16; ++r) { p0[r] = __builtin_amdgcn_exp2f(p0[r] - m_run); p1[r] = __builtin_amdgcn_exp2f(p1[r] - m_run); ls += p0[r]; ls2 += p1[r]; } \
            ls += ls2; \
            l_run += ls; \
            bf16x8 pb[2][2]; \
_Pragma("unroll") \
            for (int j = 0; j < 2; ++j) { \
                u32x4 w0, w1; \
                w0.x = pk2(p0[8 * j + 0], p0[8 * j + 1]); w0.y = pk2(p0[8 * j + 2], p0[8 * j + 3]); w0.z = pk2(p0[8 * j + 4], p0[8 * j + 5]); w0.w = pk2(p0[8 * j + 6], p0[8 * j + 7]); \
                w1.x = pk2(p1[8 * j + 0], p1[8 * j + 1]); w1.y = pk2(p1[8 * j + 2], p1[8 * j + 3]); w1.z = pk2(p1[8 * j + 4], p1[8 * j + 5]); w1.w = pk2(p1[8 * j + 6], p1[8 * j + 7]); \
                pb[0][j] = __builtin_bit_cast(bf16x8, w0); pb[1][j] = __builtin_bit_cast(bf16x8, w1); \
            } \
 \
_Pragma("unroll") \
            for (int kb = 0; kb < 2; ++kb) \
_Pragma("unroll") \
                for (int j = 0; j < 2; ++j) { const int i = kb * 2 + j; \
                    const bf16x8 a0 = __builtin_shufflevector(vl[2 * i], vh[2 * i], 0, 1, 2, 3, 4, 5, 6, 7), a1 = __builtin_shufflevector(vl[2 * i + 1], vh[2 * i + 1], 0, 1, 2, 3, 4, 5, 6, 7); \
                    o0 = MFMA32(a0, pb[kb][j], o0); o1 = MFMA32(a1, pb[kb][j], o1); \
                } \
            if (s + 1 < n) { LAS unsigned char* Bn = L + ((s + 1) & 1) * BUFB; *(LAS u32x4*)(Bn + stoff) = KQ; *(LAS u32x4*)(Bn + TILEB + stoff) = VQ; } \
            LBAR(); \
            if (s + 4 < n) { const size_t krow = (size_t)ATT_TROW(s + 4); KQ = *(const u32x4*)(ACT + krow * LD + kcol); VQ = *(const u32x4*)(ACT + krow * LD + vcol); } \
        } while (0)
#pragma unroll 1
        for (int s0 = 0; s0 < n; s0 += 3) {
            ATT_STEP(s0, kq1, vq1);
            if (s0 + 1 < n) ATT_STEP(s0 + 1, kq2, vq2);
            if (s0 + 2 < n) ATT_STEP(s0 + 2, kq0, vq0);
        }
#undef ATT_STEP
#undef ATT_TROW
        u32x4 sgq[4];
        { const int qrow0 = qrow - r32;
#pragma unroll
          for (int it = 0; it < 4; ++it) sgq[it] = *(const u32x4*)(ACT + (size_t)(qrow0 + it * 8 + (lane >> 3)) * LD + 1536 + h * 64 + (lane & 7) * 8); }
        const float lt = l_run + __shfl_xor(l_run, 32); const float inv = 1.0f / lt;
        LAS float* stg = (LAS float*)(L + 40960 + wave * 8704);
#pragma unroll
        for (int db = 0; db < 2; ++db)
#pragma unroll
            for (int q4 = 0; q4 < 4; ++q4) { const int d = 32 * db + 8 * q4 + 4 * hi; f32x4 v;
                if (db == 0) v = (f32x4){o0[4 * q4], o0[4 * q4 + 1], o0[4 * q4 + 2], o0[4 * q4 + 3]}; else v = (f32x4){o1[4 * q4], o1[4 * q4 + 1], o1[4 * q4 + 2], o1[4 * q4 + 3]};
                *(LAS f32x4*)(stg + r32 * 68 + d) = v * inv; }
        asm volatile("s_waitcnt lgkmcnt(0)" ::: "memory");
        { const int qrow0 = qrow - r32; const int er = lane >> 3, ec = (lane & 7) * 8;
#pragma unroll
          for (int it = 0; it < 4; ++it) { const int row = it * 8 + er; const size_t grow = (size_t)(qrow0 + row);
              const f32x4 a0 = *(const LAS f32x4*)(stg + row * 68 + ec), a1 = *(const LAS f32x4*)(stg + row * 68 + ec + 4);
              const u32x4 gw = sgq[it];
              u32x4 w; w.x = pk2(a0.x * bflo(gw.x), a0.y * bfhi(gw.x)); w.y = pk2(a0.z * bflo(gw.y), a0.w * bfhi(gw.y)); w.z = pk2(a1.x * bflo(gw.z), a1.y * bfhi(gw.z)); w.w = pk2(a1.z * bflo(gw.w), a1.w * bfhi(gw.w));
              *(u32x4*)(Y + grow * DM + h * 64 + ec) = w; } }
    }
    LBAR();
}

__device__ __forceinline__ void phase_lru(const Args& A, const bf16_t* ACT, bf16_t* Y, float* HF, LAS unsigned char* L, const int wv) {
    constexpr int LD = 2048, TT = 128, USTR = 144;
    const int tid = otid(wv), lane = tid & 63, wave = __builtin_amdgcn_readfirstlane(tid >> 6), G = gridDim.x;
    LAS unsigned char* UL = L;
    LAS unsigned char* XA = L + 19200;
    LAS float* XF = (LAS float*)(L + 19200 + 18432);
    LAS f32x2* AB = (LAS f32x2*)(L + 19200 + 18432 + 16384);
    LAS f32x2* CAR = (LAS f32x2*)(L + 19200 + 18432 + 16384 + 32768);
    LAS float* ST = (LAS float*)(L + 19200 + 18432 + 16384 + 32768 + 4096);
    LAS float* CW = (LAS float*)(L + 19200 + 18432 + 16384 + 32768 + 4096 + 256);
    const bf16_t* gwT = (const bf16_t*)(ows(A.ws) + WS_GW);
    const float* conv_w = A.in[15]; const float* conv_b = A.in[16]; const float* ba = A.in[18]; const float* bx = A.in[20]; const float* lam = A.in[21];
    const int fr = lane & 15, fq = lane >> 4;
    const int stok = tid >> 3, sch = tid & 7;
    const int ch = tid & 31, sc = tid >> 5;
    const int otok = tid >> 2, oq = tid & 3;
    for (int u = blockIdx.x; u < 256; u += G) {
        const int b = u >> 5, hb = u & 31, hblk = hb >> 1, half = hb & 1, cin0 = hblk * 64, c0 = cin0 + half * 32;
#pragma unroll 1
        for (int dir = 0; dir < 2; ++dir) {
            LBAR();
            if (tid < 320) { const int k = tid >> 6, c = tid & 63; CW[tid] = (k < 4) ? conv_w[(size_t)(dir * 4 + k) * DM + cin0 + c] : conv_b[(size_t)dir * DM + cin0 + c]; }
            const int cbk = wave & 1;
            bf16x8 wr_[2], wi_[2];
            { const bf16_t* pr = gwT + ((size_t)((dir * 2 + 0) * 16 + hblk) * 64 + half * 32 + cbk * 16 + fr) * 64 + fq * 8;
              const bf16_t* pi = gwT + ((size_t)((dir * 2 + 1) * 16 + hblk) * 64 + half * 32 + cbk * 16 + fr) * 64 + fq * 8;
              wr_[0] = *(const bf16x8*)pr; wr_[1] = *(const bf16x8*)(pr + 32); wi_[0] = *(const bf16x8*)pi; wi_[1] = *(const bf16x8*)(pi + 32); }
            float eba[4], ebx[4], esp[4];
#pragma unroll
            for (int e = 0; e < 4; ++e) { const int c = dir * DM + c0 + cbk * 16 + 4 * fq + e; eba[e] = ba[c]; ebx[e] = bx[c];
                const float nl = -lam[c]; esp[e] = (fmaxf(nl, 0.f) + log1pf(__expf(-fabsf(nl)))) * (-8.0f * LOG2E); }
            if (tid < 32) ST[tid] = 0.f;
            u32x4 ur[2], uh = (u32x4){0u, 0u, 0u, 0u};
            { const int rowbase = ML + b * CTX;
#pragma unroll
              for (int i2 = 0; i2 < 2; ++i2) { const int S = stok + 64 * i2; const int row = rowbase + (dir ? CTX - 1 - S : S); ur[i2] = *(const u32x4*)(ACT + (size_t)row * LD + cin0 + sch * 8); } }
            f32x4 hf0 = (f32x4){0.f, 0.f, 0.f, 0.f}, hf1 = hf0; u32x4 gv = (u32x4){0u, 0u, 0u, 0u}; size_t orow = 0; int oseq = 0;
#define LRU_OUT() do { const f32x4 h0 = *(const LAS f32x4*)(XF + otok * 32 + oq * 8), h1 = *(const LAS f32x4*)(XF + otok * 32 + oq * 8 + 4); \
                if (dir == 0) { f32x4* hp = (f32x4*)(HF + ((size_t)u * 2304 + oseq) * 32 + oq * 8); hp[0] = h0; hp[1] = h1; } \
                else { const f32x4 s0 = h0 + hf0, s1 = h1 + hf1; u32x4 w; \
                    w.x = pk2(s0.x * bflo(gv.x), s0.y * bfhi(gv.x)); w.y = pk2(s0.z * bflo(gv.y), s0.w * bfhi(gv.y)); w.z = pk2(s1.x * bflo(gv.z), s1.y * bfhi(gv.z)); w.w = pk2(s1.z * bflo(gv.w), s1.w * bfhi(gv.w)); \
                    *(u32x4*)(Y + orow * DM + c0 + oq * 8) = w; } } while (0)
#pragma unroll 1
            for (int tl = 0; tl < 18; ++tl) {
                const int seg = tl < 2 ? 0 : 1, S0 = seg ? (tl - 2) * TT : tl * TT, seglen = seg ? SEQ : CTX, rowbase = seg ? b * SEQ : ML + b * CTX;
                LBAR();
                *(LAS u32x4*)(UL + (3 + stok) * USTR + sch * 16) = ur[0]; *(LAS u32x4*)(UL + (3 + 64 + stok) * USTR + sch * 16) = ur[1];
                if (tid < 24) *(LAS u32x4*)(UL + stok * USTR + sch * 16) = uh;
                if (tl > 0) LRU_OUT();
                LBAR();
                { const int S = S0 + otok; const int pos = dir ? seglen - 1 - S : S; orow = (size_t)(rowbase + pos); oseq = seg ? CTX + pos : pos;
                  if (dir == 1) { const f32x4* hp = (const f32x4*)(HF + ((size_t)u * 2304 + oseq) * 32 + oq * 8); hf0 = hp[0]; hf1 = hp[1]; gv = *(const u32x4*)(ACT + orow * LD + 1024 + c0 + oq * 8); } }
                if (tl + 1 < 18) { const int tn = tl + 1; const int seg2 = tn < 2 ? 0 : 1, S02 = seg2 ? (tn - 2) * TT : tn * TT, seglen2 = seg2 ? SEQ : CTX, rowbase2 = seg2 ? b * SEQ : ML + b * CTX;
#pragma unroll
                    for (int i2 = 0; i2 < 2; ++i2) { const int S = S02 + stok + 64 * i2; const int row = rowbase2 + (dir ? seglen2 - 1 - S : S); ur[i2] = *(const u32x4*)(ACT + (size_t)row * LD + cin0 + sch * 8); }
                    uh = (u32x4){0u, 0u, 0u, 0u};
                    if (tid < 24 && S02 > 0) { const int S = S02 - 3 + stok; const int row = rowbase2 + (dir ? seglen2 - 1 - S : S); uh = *(const u32x4*)(ACT + (size_t)row * LD + cin0 + sch * 8); } }
                for (int rep_ = 0; rep_ < DUP_LRUBC; ++rep_) {
                { float x0[8], x1[8];
                  { const f32x4 ca = *(const LAS f32x4*)(CW + 256 + sch * 8), cc = *(const LAS f32x4*)(CW + 256 + sch * 8 + 4);
                    x0[0] = ca.x; x0[1] = ca.y; x0[2] = ca.z; x0[3] = ca.w; x0[4] = cc.x; x0[5] = cc.y; x0[6] = cc.z; x0[7] = cc.w;
#pragma unroll
                    for (int e = 0; e < 8; ++e) x1[e] = x0[e]; }
#pragma unroll
                  for (int k = 0; k < 4; ++k) { const f32x4 wa = *(const LAS f32x4*)(CW + k * 64 + sch * 8), wb = *(const LAS f32x4*)(CW + k * 64 + sch * 8 + 4);
                      const u32x4 u0 = *(const LAS u32x4*)(UL + (stok + k) * USTR + sch * 16), u1 = *(const LAS u32x4*)(UL + (stok + 64 + k) * USTR + sch * 16);
                      x0[0] += wa.x * bflo(u0.x); x0[1] += wa.y * bfhi(u0.x); x0[2] += wa.z * bflo(u0.y); x0[3] += wa.w * bfhi(u0.y);
                      x0[4] += wb.x * bflo(u0.z); x0[5] += wb.y * bfhi(u0.z); x0[6] += wb.z * bflo(u0.w); x0[7] += wb.w * bfhi(u0.w);
                      x1[0] += wa.x * bflo(u1.x); x1[1] += wa.y * bfhi(u1.x); x1[2] += wa.z * bflo(u1.y); x1[3] += wa.w * bfhi(u1.y);
                      x1[4] += wb.x * bflo(u1.z); x1[5] += wb.y * bfhi(u1.z); x1[6] += wb.z * bflo(u1.w); x1[7] += wb.w * bfhi(u1.w); }
                  u32x4 w; w.x = pk2(x0[0], x0[1]); w.y = pk2(x0[2], x0[3]); w.z = pk2(x0[4], x0[5]); w.w = pk2(x0[6], x0[7]);
                  *(LAS u32x4*)(XA + stok * USTR + sch * 16) = w;
                  w.x = pk2(x1[0], x1[1]); w.y = pk2(x1[2], x1[3]); w.z = pk2(x1[4], x1[5]); w.w = pk2(x1[6], x1[7]);
                  *(LAS u32x4*)(XA + (stok + 64) * USTR + sch * 16) = w;
                  if ((sch >> 2) == half) { LAS f32x4* xf = (LAS f32x4*)(XF + stok * 32 + (sch & 3) * 8); xf[0] = (f32x4){x0[0], x0[1], x0[2], x0[3]}; xf[1] = (f32x4){x0[4], x0[5], x0[6], x0[7]};
                      xf = (LAS f32x4*)(XF + (stok + 64) * 32 + (sch & 3) * 8); xf[0] = (f32x4){x1[0], x1[1], x1[2], x1[3]}; xf[1] = (f32x4){x1[4], x1[5], x1[6], x1[7]}; } }
                LBAR();
#pragma unroll
                for (int i2 = 0; i2 < 2; ++i2) { const int tb = (wave >> 1) + 4 * i2; const int tok = tb * 16 + fr;
                    const bf16x8 x0 = *(const LAS bf16x8*)(XA + tok * USTR + fq * 16), x1 = *(const LAS bf16x8*)(XA + tok * USTR + 64 + fq * 16);
                    f32x4 ar = (f32x4){0.f, 0.f, 0.f, 0.f}, ai = (f32x4){0.f, 0.f, 0.f, 0.f};
                    ar = MFMA16(wr_[0], x0, ar); ar = MFMA16(wr_[1], x1, ar); ai = MFMA16(wi_[0], x0, ai); ai = MFMA16(wi_[1], x1, ai);
                    const f32x4 xv = *(const LAS f32x4*)(XF + tok * 32 + cbk * 16 + 4 * fq);
                    float av[4], bv[4];
#pragma unroll
                    for (int e = 0; e < 4; ++e) { const float r = __builtin_amdgcn_rcpf(1.0f + __builtin_amdgcn_exp2f(-(ar[e] + eba[e]) * LOG2E)); const float ig = __builtin_amdgcn_rcpf(1.0f + __builtin_amdgcn_exp2f(-(ai[e] + ebx[e]) * LOG2E));
                        const float a_ = __builtin_amdgcn_exp2f(r * esp[e]); av[e] = a_; bv[e] = __builtin_amdgcn_sqrtf(fmaxf(1.0f - a_ * a_, 0.f)) * (ig * xv[e]); }
                    LAS f32x4* ab = (LAS f32x4*)(AB + tok * 32 + cbk * 16 + 4 * fq); ab[0] = (f32x4){av[0], bv[0], av[1], bv[1]}; ab[1] = (f32x4){av[2], bv[2], av[3], bv[3]}; }
                LBAR();
                }
                float a8[8], b8[8];
                { float Ap = 1.f, H = 0.f;
#pragma unroll
                  for (int k = 0; k < 8; ++k) { const f32x2 v = AB[(sc * 8 + k) * 32 + ch]; a8[k] = v.x; b8[k] = v.y; H = v.x * H + v.y; Ap *= v.x; }
                  CAR[sc * 32 + ch] = (f32x2){Ap, H}; }
                LBAR();
                float hrun = ST[(tl & 1) * 32 + ch];
                { f32x2 cr[15];
#pragma unroll
                  for (int s = 0; s < 15; ++s) cr[s] = CAR[s * 32 + ch];
#pragma unroll
                  for (int s = 0; s < 15; ++s) hrun = (s < sc) ? cr[s].x * hrun + cr[s].y : hrun; }
#pragma unroll
                for (int k = 0; k < 8; ++k) { hrun = a8[k] * hrun + b8[k]; XF[(sc * 8 + k) * 32 + ch] = hrun; }
                if (sc == 15) ST[((tl + 1) & 1) * 32 + ch] = hrun;
            }
            LBAR();
            LRU_OUT();
            asm volatile("s_waitcnt vmcnt(0)" ::: "memory");
        }
        LBAR();
    }
#undef LRU_OUT
}

__device__ __forceinline__ void cu8(const bf16_t* ACT, size_t row, int col, float* o) {
    const u32x4 a = __builtin_nontemporal_load((const u32x4*)(ACT + row * 4096 + col)), c = __builtin_nontemporal_load((const u32x4*)(ACT + row * 4096 + 2048 + col));
    o[0] = bflo(a.x) * bflo(c.x); o[1] = bfhi(a.x) * bfhi(c.x); o[2] = bflo(a.y) * bflo(c.y); o[3] = bfhi(a.y) * bfhi(c.y);
    o[4] = bflo(a.z) * bflo(c.z); o[5] = bfhi(a.z) * bfhi(c.z); o[6] = bflo(a.w) * bflo(c.w); o[7] = bfhi(a.w) * bfhi(c.w);
}
__device__ __forceinline__ void phase_conv(const Args& A, const bf16_t* ACT, bf16_t* Y, const int wv) {
    const float* conv_w = A.in[27]; const float* conv_b = A.in[28];
    const int nitems = (MT / 8) * 128;
    const int tid = otid(wv);
    for (int item = blockIdx.x * NTHREADS + tid; item < nitems; item += gridDim.x * NTHREADS) {
        const int rg = item >> 7, chunk = item & 127, col = chunk * 8, row0 = rg * 8;
        const int seglen = row0 < ML ? SEQ : CTX;
        const bool first = (row0 % seglen) == 0, last = ((row0 + 8) % seglen) == 0;
        float w0[8], w1[8], w2[8], cb[8];
        { const f32x4* p = (const f32x4*)(conv_w + col); f32x4 a = p[0], c = p[1]; w0[0] = a.x; w0[1] = a.y; w0[2] = a.z; w0[3] = a.w; w0[4] = c.x; w0[5] = c.y; w0[6] = c.z; w0[7] = c.w;
          p = (const f32x4*)(conv_w + DM + col); a = p[0]; c = p[1]; w1[0] = a.x; w1[1] = a.y; w1[2] = a.z; w1[3] = a.w; w1[4] = c.x; w1[5] = c.y; w1[6] = c.z; w1[7] = c.w;
          p = (const f32x4*)(conv_w + 2 * DM + col); a = p[0]; c = p[1]; w2[0] = a.x; w2[1] = a.y; w2[2] = a.z; w2[3] = a.w; w2[4] = c.x; w2[5] = c.y; w2[6] = c.z; w2[7] = c.w;
          p = (const f32x4*)(conv_b + col); a = p[0]; c = p[1]; cb[0] = a.x; cb[1] = a.y; cb[2] = a.z; cb[3] = a.w; cb[4] = c.x; cb[5] = c.y; cb[6] = c.z; cb[7] = c.w; }
        float prev[8], cur[8], nxt[8];
        if (first) {
#pragma unroll
            for (int e = 0; e < 8; ++e) prev[e] = 0.f;
        } else cu8(ACT, (size_t)row0 - 1, col, prev);
        cu8(ACT, (size_t)row0, col, cur);
#pragma unroll
        for (int k = 0; k < 8; ++k) {
            const size_t row = (size_t)row0 + k;
            if (k == 7 && last) {
#pragma unroll
                for (int e = 0; e < 8; ++e) nxt[e] = 0.f;
            } else cu8(ACT, row + 1, col, nxt);
            const u32x4 bgw = __builtin_nontemporal_load((const u32x4*)(ACT + row * 4096 + 1024 + col)), sgw = __builtin_nontemporal_load((const u32x4*)(ACT + row * 4096 + 3072 + col));
            float y[8];
#pragma unroll
            for (int e = 0; e < 8; ++e) y[e] = w0[e] * prev[e] + w1[e] * cur[e] + w2[e] * nxt[e] + cb[e];
            y[0] *= bflo(bgw.x) * bflo(sgw.x); y[1] *= bfhi(bgw.x) * bfhi(sgw.x); y[2] *= bflo(bgw.y) * bflo(sgw.y); y[3] *= bfhi(bgw.y) * bfhi(sgw.y);
            y[4] *= bflo(bgw.z) * bflo(sgw.z); y[5] *= bfhi(bgw.z) * bfhi(sgw.z); y[6] *= bflo(bgw.w) * bflo(sgw.w); y[7] *= bfhi(bgw.w) * bfhi(sgw.w);
            u32x4 w; w.x = pk2(y[0], y[1]); w.y = pk2(y[2], y[3]); w.z = pk2(y[4], y[5]); w.w = pk2(y[6], y[7]);
            *(u32x4*)(Y + row * DM + col) = w;
#pragma unroll
            for (int e = 0; e < 8; ++e) { prev[e] = cur[e]; cur[e] = nxt[e]; }
        }
    }
}

__device__ __forceinline__ void phase_ctx_wout(const bf16_t* Yc, const bf16_t* Wt, const float* xin, float* xout, const float* gate, LAS unsigned char* L, const int wv) {
    constexpr int PITCH = 144, ABYTES = 128 * PITCH, BUFB = 192 * PITCH;
    const int tid = otid(wv), lane = tid & 63, r32 = lane & 31, hi = lane >> 5, wave = wv, G = gridDim.x;
    const int srow = tid >> 3, sch = tid & 7;
    const int aoff = ((wave >> 1) * 32 + r32) * PITCH + hi * 64, boff = ABYTES + ((wave & 1) * 32 + r32) * PITCH + hi * 64;
    for (int t = blockIdx.x; t < 256; t += G) {
        const int tm = t >> 4, tn = t & 15;
        const bf16_t* ga0 = Yc + (size_t)(tm * 128 + srow) * DM + sch * 8; const bf16_t* ga1 = ga0 + (size_t)64 * DM; const bf16_t* gb = Wt + (size_t)(tn * 64 + srow) * DM + sch * 8;
        f32x16 acc;
#pragma unroll
        for (int r = 0; r < 16; ++r) acc[r] = 0.f;
        u32x4 qa0[3], qa1[3], qb[3];
#define CTX_LOAD(q, s_) do { qa0[q] = *(const u32x4*)(ga0 + (s_) * 64); qa1[q] = *(const u32x4*)(ga1 + (s_) * 64); qb[q] = *(const u32x4*)(gb + (s_) * 64); } while (0)
#define CTX_WRITE(q, buf) do { LAS unsigned char* Bn = L + (buf) * BUFB; *(LAS u32x4*)(Bn + srow * PITCH + sch * 16) = qa0[q]; *(LAS u32x4*)(Bn + (64 + srow) * PITCH + sch * 16) = qa1[q]; *(LAS u32x4*)(Bn + ABYTES + srow * PITCH + sch * 16) = qb[q]; } while (0)
#define CTX_STEP(s_, q) do { const int s = (s_); LAS const unsigned char* B = L + (s & 1) * BUFB; bf16x8 a[4], b[4]; \
            _Pragma("unroll") for (int j = 0; j < 4; ++j) { a[j] = *(const LAS bf16x8*)(B + aoff + j * 16); b[j] = *(const LAS bf16x8*)(B + boff + j * 16); } \
            _Pragma("unroll") for (int j = 0; j < 4; ++j) acc = MFMA32(a[j], b[j], acc); \
            if (s + 1 < 16) CTX_WRITE(q, (s + 1) & 1); \
            LBAR(); \
            if (s + 4 < 16) CTX_LOAD(q, s + 4); } while (0)
        CTX_LOAD(0, 0); CTX_LOAD(1, 1); CTX_LOAD(2, 2);
        LBAR();
        CTX_WRITE(0, 0);
        CTX_LOAD(0, 3);
        LBAR();
#pragma unroll 1
        for (int s0 = 0; s0 < 16; s0 += 3) {
            CTX_STEP(s0, 1);
            if (s0 + 1 < 16) CTX_STEP(s0 + 1, 2);
            if (s0 + 2 < 16) CTX_STEP(s0 + 2, 0);
        }
#undef CTX_LOAD
#undef CTX_WRITE
#undef CTX_STEP
        const int m0 = tm * 128 + (wave >> 1) * 32, col = tn * 64 + (wave & 1) * 32 + r32; const float gv = gate[col];
#pragma unroll
        for (int r = 0; r < 16; ++r) { const size_t o = (size_t)(m0 + crow(r, hi)) * DM + col; xout[o] = xin[o] + gv * acc[r]; }
    }
    LBAR();
}

__device__ __forceinline__ void phase_final(float* out, const float* g, const int wv) {
    const int tid = otid(wv); const int lane = tid & 63, gw = blockIdx.x * NWAVES + (tid >> 6), NGW = gridDim.x * NWAVES;
    f32x4 gv[4];
#pragma unroll
    for (int j = 0; j < 4; ++j) gv[j] = *((const f32x4*)g + 64 * j + lane);
    for (int row0 = gw * 4; row0 < ML; row0 += NGW * 4) {
        f32x4 v[4][4]; float s[4];
#pragma unroll
        for (int i = 0; i < 4; ++i) { const f32x4* xr = (const f32x4*)(out + (size_t)(row0 + i) * DM) + lane;
#pragma unroll
            for (int j = 0; j < 4; ++j) v[i][j] = __builtin_nontemporal_load(xr + 64 * j); }
#pragma unroll
        for (int i = 0; i < 4; ++i) { float a = 0.f;
#pragma unroll
            for (int j = 0; j < 4; ++j) a += (v[i][j].x * v[i][j].x + v[i][j].y * v[i][j].y) + (v[i][j].z * v[i][j].z + v[i][j].w * v[i][j].w);
            s[i] = a; }
#pragma unroll
        for (int o = 1; o < 64; o <<= 1) {
#pragma unroll
            for (int i = 0; i < 4; ++i) s[i] += __shfl_xor(s[i], o); }
#pragma unroll
        for (int i = 0; i < 4; ++i) { const float rstd = 1.0f / sqrtf(s[i] * (1.0f / DM) + EPS); f32x4* xr = (f32x4*)(out + (size_t)(row0 + i) * DM) + lane;
#pragma unroll
            for (int j = 0; j < 4; ++j) xr[64 * j] = v[i][j] * rstd * gv[j]; }
    }
}

#define RLX_AGENT __ATOMIC_RELAXED, __HIP_MEMORY_SCOPE_AGENT
#define XB_TMO      128
#define XB_XCNT(j)  (256  + 64 * (j))
#define XB_XSUB(j)  (1280 + 64 * (j))
#define XB_XGEN(j)  (2304 + 64 * (j))
#define XB_TOP      3328
#define XB_TOPGEN   3392
#define XCD_BAR_WORDS 3456
#define XB_SPIN_CAP (1u << 18)

__device__ __forceinline__ unsigned xb_ld(unsigned* p)              { return __hip_atomic_load(p, __ATOMIC_RELAXED, __HIP_MEMORY_SCOPE_AGENT); }
__device__ __forceinline__ unsigned xb_add(unsigned* p, unsigned v) { return __hip_atomic_fetch_add(p, v, __ATOMIC_RELAXED, __HIP_MEMORY_SCOPE_AGENT); }
__device__ __forceinline__ unsigned xb_xcc_id() { return (unsigned)__builtin_amdgcn_s_getreg((3 << 11) | 20) & 0xFu; }
#define XB_SPIN(cond, bar) do { unsigned _sp = 0; while (cond) { __builtin_amdgcn_s_sleep(1); \
    if ((++_sp & 255u) == 0u) { if (xb_ld(&(bar)[XB_TMO])) break; if (_sp > XB_SPIN_CAP) { atomicAdd(&(bar)[XB_TMO], 1u); break; } } } } while (0)

struct XcdBarrier {
    unsigned* bar; unsigned x;
    volatile LAS unsigned* st;
};

__device__ __forceinline__ XcdBarrier xcd_barrier_post(unsigned* bar, volatile LAS unsigned* st) {
    XcdBarrier b; b.bar = bar; b.x = xb_xcc_id(); b.st = st;
    if (threadIdx.x == 0) (void)xb_add(&bar[XB_XCNT(b.x)], 1u);
    return b;
}
__device__ __forceinline__ void xcd_barrier_complete(unsigned* bar, unsigned x, unsigned& nloc, unsigned& nx) {
    const unsigned G = gridDim.x * gridDim.y * gridDim.z;
    unsigned sum, cnt, mine, sp = 0u;
    for (;;) {
        sum = 0u; cnt = 0u; mine = 0u;
#pragma unroll
        for (unsigned j = 0; j < 16; ++j) { const unsigned c = xb_ld(&bar[XB_XCNT(j)]); sum += c; cnt += (c > 0u) ? 1u : 0u; mine = (j == x) ? c : mine; }
        if (sum == G) break;
        __builtin_amdgcn_s_sleep(1);
        if ((++sp & 255u) == 0u) { if (xb_ld(&bar[XB_TMO])) break; if (sp > XB_SPIN_CAP) { atomicAdd(&bar[XB_TMO], 1u); break; } }
    }
    nloc = mine > 0u ? mine : 1u; nx = cnt > 0u ? cnt : 1u;
}

__device__ __forceinline__ void xcd_barrier(const XcdBarrier& b) {
    asm volatile("s_waitcnt vmcnt(0)" ::: "memory");
    __syncthreads();
    if (threadIdx.x == 0) {
        unsigned* bar = b.bar;
        __builtin_amdgcn_s_waitcnt(0);
        unsigned nloc = b.st[0], nx = b.st[1];
        if (nloc == 0u) { xcd_barrier_complete(bar, b.x, nloc, nx); b.st[0] = nloc; b.st[1] = nx; }
        const unsigned old = xb_add(&bar[XB_XSUB(b.x)], 1u);
        const unsigned gen = old / nloc;
        if (old + 1u == (gen + 1u) * nloc) {
            __builtin_amdgcn_fence(__ATOMIC_RELEASE, "agent");
            asm volatile("s_waitcnt vmcnt(0)" ::: "memory");
            const unsigned og = xb_add(&bar[XB_TOP], 1u);
            const unsigned tg = og / nx;
            if (og + 1u == (tg + 1u) * nx) xb_add(&bar[XB_TOPGEN], 1u);
            else XB_SPIN(xb_ld(&bar[XB_TOPGEN]) == tg, bar);
            __builtin_amdgcn_fence(__ATOMIC_ACQUIRE, "agent");
            xb_add(&bar[XB_XGEN(b.x)], 1u);
            asm volatile("s_waitcnt vmcnt(0)" ::: "memory");
        } else {
            XB_SPIN(xb_ld(&bar[XB_XGEN(b.x)]) == gen, bar);
            __builtin_amdgcn_fence(__ATOMIC_ACQUIRE, "agent");
            asm volatile("s_waitcnt vmcnt(0)" ::: "memory");
        }
    }
    __syncthreads();
}

__global__ void __launch_bounds__(NTHREADS, 2) hybrid_fwd(Args A) {
    extern __shared__ __attribute__((aligned(16))) unsigned char lds[];
    cg::grid_group grid = cg::this_grid();
    LAS unsigned char* L = (LAS unsigned char*)lds;
    unsigned char* ws = A.ws;
    const int G = gridDim.x;
    float* XL = A.out; float* XC = (float*)(ws + WS_XC);
    bf16_t* XN = (bf16_t*)(ws + WS_XN); bf16_t* ACT = (bf16_t*)(ws + WS_ACT);
    const float* gatef = (const float*)(ws + WS_GATE);

    const int wv = __builtin_amdgcn_readfirstlane((int)threadIdx.x >> 6);
    volatile LAS unsigned* MISC = (volatile LAS unsigned*)(L + 131072 + 320);
    if (threadIdx.x < 32) MISC[threadIdx.x] = 0u;
    __syncthreads();
    XcdBarrier xbar = xcd_barrier_post((unsigned*)ws + 4096, MISC + 8);
#define GSYNC() xcd_barrier(xbar)
#pragma unroll 1
    for (int l = 0; l < 4; ++l) { phase_prep(A, L, l, (int)((blockIdx.x + 64 * l) % G), G, wv); LBAR(); }
    if (A.out == nullptr) grid.sync();
    for (int rep = 0; rep < DUP_SYNC; ++rep) GSYNC();
#pragma unroll 1
    for (int layer = 0; layer < 4; ++layer) {
        ws = ows(ws);
        const int kind = layer == 3 ? 0 : layer;
        const int Nin = kind == 0 ? 2560 : (kind == 1 ? 2048 : 4096);
        const float* xinL = layer == 0 ? A.in[0] : XL; const float* xinC = layer == 0 ? A.in[2] : XC;
        for (int rep = 0; rep < DUP_NORM; ++rep) phase_norm(A, layer, xinL, xinC, L, wv);
        GSYNC();
        {
            const bf16_t* Wt = (const bf16_t*)(ws + (layer == 0 ? WS_WIN[0] : layer == 1 ? WS_WIN[1] : layer == 2 ? WS_WIN[2] : WS_WIN[3]));
            pg8::Gemm g{XN, Wt, layer == 3 ? ML : MT, Nin, DM};
            pg8::OrderG S; S.so.init(layer == 3 ? ML : MT, Nin, G, (int)blockIdx.x); S.extra = layer == 3 ? 16 : 0;
            pg8::EpiIn E{ACT, Nin, kind, (const float*)(ws + WS_ROPE)};
            for (int rep = 0; rep < DUP_GIN; ++rep) pg8::gemm_phase<pg8::EpiIn, pg8::OrderG, true, true>(L, g, S, E, wv);
        }
        GSYNC();
        if (kind == 0) { for (int rep = 0; rep < DUP_ATTN; ++rep) phase_attn(ACT, XN, (layer == 0 ? A.in[9] : A.in[34]), layer == 0, L, wv); }
        else if (kind == 1) { for (int rep = 0; rep < DUP_LRU; ++rep) phase_lru(A, ACT, XN, (float*)(ws + WS_HF), L, wv); }
        else { for (int rep = 0; rep < DUP_CONV; ++rep) phase_conv(A, ACT, XN, wv); }
        GSYNC();
        {
            const bf16_t* Wt = (const bf16_t*)(ws + (layer == 0 ? WS_WOUT[0] : layer == 1 ? WS_WOUT[1] : layer == 2 ? WS_WOUT[2] : WS_WOUT[3]));
            const int Mo = (CTX_SMALL || layer == 3) ? ML : MT;
            pg8::Gemm g{XN, Wt, Mo, DM, DM};
            pg8::OrderG S; S.so.init(Mo, DM, G, (int)blockIdx.x); S.extra = 0;
            pg8::EpiRes E{xinL, xinC, XL, XC, gatef + (size_t)layer * 9 * 1024};
            const bool ctx_first = (blockIdx.x & 1) != 0;
#pragma unroll 1
            for (int step = 0; step < 2; ++step) {
                if ((step == 0) == ctx_first) { if (CTX_SMALL && layer < 3) phase_ctx_wout(XN + (size_t)ML * DM, Wt, xinC, XC, gatef + (size_t)(layer * 9 + 8) * 1024, L, wv); }
                else pg8::gemm_phase<pg8::EpiRes, pg8::OrderG, true, true>(L, g, S, E, wv);
            }
        }
        GSYNC();
    }
    phase_final(XL, A.in[35], wv);
}

extern "C" void kernel_launch(void* const* d_in, const int* in_sizes, int n_in, void* d_out, int out_size, void* d_ws, size_t ws_size, hipStream_t stream) {
    static int grid = 0;
    if (grid == 0) {
        if (n_in != 36 || out_size != ML * DM || ws_size < WS_END) { fprintf(stderr, "kernel_launch: unexpected shapes (n_in %d, out %d, ws %zu)\n", n_in, out_size, ws_size); grid = -1; return; }
        int dev = 0, cus = 0, per_cu = 0;
        hipGetDevice(&dev); hipDeviceGetAttribute(&cus, hipDeviceAttributeMultiprocessorCount, dev);
        if (hipFuncSetAttribute((const void*)hybrid_fwd, hipFuncAttributeMaxDynamicSharedMemorySize, LDS_BYTES) != hipSuccess) { fprintf(stderr, "kernel_launch: hipFuncSetAttribute failed\n"); grid = -1; return; }
        if (hipOccupancyMaxActiveBlocksPerMultiprocessor(&per_cu, (const void*)hybrid_fwd, NTHREADS, LDS_BYTES) != hipSuccess || per_cu < 1) { fprintf(stderr, "kernel_launch: occupancy query says %d\n", per_cu); per_cu = 1; }
        (void)hipGetLastError();
        grid = cus * (per_cu > 1 ? 1 : per_cu);
        if (grid > 256) grid = 256;
    }
    if (grid < 0) return;
    if (hipMemsetAsync(d_ws, 0, 65536, stream) != hipSuccess) { fprintf(stderr, "kernel_launch: memset failed\n"); return; }
    Args a{};
    for (int i = 0; i < 36; ++i) a.in[i] = (const float*)d_in[i];
    a.out = (float*)d_out; a.ws = (unsigned char*)d_ws;
    void* args[] = {&a};
    hipError_t e = hipLaunchCooperativeKernel((const void*)hybrid_fwd, dim3(grid), dim3(NTHREADS), args, LDS_BYTES, stream);
    if (e != hipSuccess) fprintf(stderr, "kernel_launch: cooperative launch failed: %s (grid %d)\n", hipGetErrorString(e), grid);
}
```

```cpp
#include <hip/hip_runtime.h>
#include <hip/hip_cooperative_groups.h>
#include <cstdio>
#include <cstdint>
namespace cg = cooperative_groups;

namespace pg8 {
#define PG8_LAS __attribute__((address_space(3)))
typedef unsigned short bf16_t;
typedef short bf16x8 __attribute__((ext_vector_type(8)));
typedef float f32x4 __attribute__((ext_vector_type(4)));
typedef unsigned u32x4 __attribute__((ext_vector_type(4)));
constexpr int BM = 256, BK = 64, HALF = 128, HTB = HALF * BK * 2  , STAGE_BYTES = 8 * HTB, NXCD = 8, WGM = 8;

__host__ __device__ __forceinline__ int lds_byte(int r, int c) { const int st = (r >> 4) * 2 + (c >> 5), rr = r & 15, cc = c & 31, ob = rr * 64 + cc * 2; return st * 1024 + (ob ^ (((ob >> 9) & 1) << 5)); }
__host__ __device__ __forceinline__ void stage_rc(int b, int& R, int& C) { const int st = b / 1024, sb = b % 1024, swz = sb ^ (((sb >> 9) & 1) << 5); R = (st >> 1) * 16 + swz / 64; C = (st & 1) * 32 + (swz % 64) / 2; }
__host__ __device__ __forceinline__ int perm32(int rho) { const int n = rho >> 4, i = rho & 15; return 8 * (i >> 2) + 4 * n + (i & 3); }

struct Unit { int pm, pn; };
struct Gemm { const bf16_t* A; const bf16_t* Bt; int M, N, K; };

struct StaticOrder {
    int nM, nN, nwg, G, c;
    __host__ __device__ void init(int M, int N, int G_, int c_) { nM = M / BM; nN = N / BM; nwg = nM * nN; G = G_; c = c_; }
    __host__ __device__ bool next(int i, Unit& u) const {
        const long L = (long)i * G + c; if (L >= nwg) return false;
        int wgid = (int)L; { const int q = nwg / NXCD, r = nwg % NXCD, xcd = wgid % NXCD, off = wgid / NXCD; wgid = (xcd < r ? xcd * (q + 1) : r * (q + 1) + (xcd - r) * q) + off; }
        const int nig = WGM * nN, gid = wgid / nig, fm = gid * WGM, gsz = (nM - fm) < WGM ? (nM - fm) : WGM;
        u.pm = fm + ((wgid % nig) % gsz); u.pn = (wgid % nig) / gsz; return true;
    }
    __device__ __forceinline__ void a_ready(const Unit&) const {}
    __device__ __forceinline__ void done(const Unit&) const {}
};

__device__ __forceinline__ unsigned cvt_pk_bf16(float lo, float hi) { unsigned r; asm volatile("v_cvt_pk_bf16_f32 %0, %1, %2" : "=v"(r) : "v"(lo), "v"(hi)); return r; }
typedef float f32x2 __attribute__((ext_vector_type(2)));
__device__ __forceinline__ float silu_f(float v) { return v * __builtin_amdgcn_rcpf(1.0f + __builtin_amdgcn_exp2f(-v * 1.4426950408889634f)); }
constexpr float QSCALE = 0.125f * 1.4426950408889634f;

struct OrderG {
    StaticOrder so; int extra;
    __device__ __forceinline__ bool next(int i, Unit& u) const {
        long L = (long)i * so.G + so.c; if (L < so.nwg) return so.next(i, u);
        L -= so.nwg; if (L >= extra) return false; u.pm = 64 + (int)(L >> 1); u.pn = 4 + (int)(L & 1); return true;
    }
    __device__ __forceinline__ void a_ready(const Unit&) const {}
    __device__ __forceinline__ void done(const Unit&) const {}
};

struct EpiIn {
    static constexpr bool PERM = true, AFTER_DRAIN = false;
    bf16_t* O; int ldc; int kind; const float* rope;
    __device__ __forceinline__ void operator()(const f32x4 (&acc)[2][2][4][2], const Unit& u, int wr, int wc, int fr, int fq) const {
        const int colt = u.pn * BM; const bool lat = u.pm < 64;
        int mode = 0; float sc = 1.f;
        if (kind == 0) { if (colt < 1024) { mode = lat ? 2 : 0; sc = QSCALE; } else if (colt < 1280) mode = lat ? 2 : 0; else if (colt < 1536) mode = 0; else mode = 1; }
        else if (kind == 1) mode = colt < 1024 ? 0 : 1;
        else mode = colt < 3072 ? 0 : 1;
        const int row0 = u.pm * BM + wr * 64 + fr; const int col0 = colt + wc * 32 + 8 * fq;
        const float sgn = (fq < 2) ? -1.f : 1.f;
#pragma unroll
        for (int ai = 0; ai < 2; ++ai)
#pragma unroll
            for (int m = 0; m < 4; ++m) {
                const int row = row0 + ai * HALF + m * 16;
                bf16_t* rowp = O + (size_t)row * ldc + col0;
                f32x4 cs[4];
                if (mode == 2) { const int l = row & 2047; const int p = (wc & 1) ? (l & 63) : (l >> 6); const f32x4* rp = (const f32x4*)(rope + (p * 16 + 8 * (fq & 1)) * 2);
                    cs[0] = rp[0]; cs[1] = rp[1]; cs[2] = rp[2]; cs[3] = rp[3]; }
#pragma unroll
                for (int bj = 0; bj < 2; ++bj) {
                    f32x4 v0 = acc[ai][bj][m][0], v1 = acc[ai][bj][m][1];
                    if (mode == 1) {
#pragma unroll
                        for (int e = 0; e < 4; ++e) { v0[e] = silu_f(v0[e]); v1[e] = silu_f(v1[e]); }
                    } else if (mode == 2) {
                        f32x4 p0, p1;
#pragma unroll
                        for (int e = 0; e < 4; ++e) { p0[e] = __shfl_xor(v0[e], 32); p1[e] = __shfl_xor(v1[e], 32); }
                        v0[0] = v0[0] * cs[0][0] + sgn * p0[0] * cs[0][1]; v0[1] = v0[1] * cs[0][2] + sgn * p0[1] * cs[0][3];
                        v0[2] = v0[2] * cs[1][0] + sgn * p0[2] * cs[1][1]; v0[3] = v0[3] * cs[1][2] + sgn * p0[3] * cs[1][3];
                        v1[0] = v1[0] * cs[2][0] + sgn * p1[0] * cs[2][1]; v1[1] = v1[1] * cs[2][2] + sgn * p1[1] * cs[2][3];
                        v1[2] = v1[2] * cs[3][0] + sgn * p1[2] * cs[3][1]; v1[3] = v1[3] * cs[3][2] + sgn * p1[3] * cs[3][3];
                    }
                    v0 = v0 * sc; v1 = v1 * sc;
                    u32x4 w; w.x = cvt_pk_bf16(v0[0], v0[1]); w.y = cvt_pk_bf16(v0[2], v0[3]); w.z = cvt_pk_bf16(v1[0], v1[1]); w.w = cvt_pk_bf16(v1[2], v1[3]);
                    *(u32x4*)(rowp + bj * HALF) = w;
                }
            }
    }
};

struct EpiRes {
    static constexpr bool PERM = true, AFTER_DRAIN = false;
    const float* inL; const float* inC; float* outL; float* outC; const float* gate;
    __device__ __forceinline__ void operator()(const f32x4 (&acc)[2][2][4][2], const Unit& u, int wr, int wc, int fr, int fq) const {
        const bool lat = u.pm < 64;
        const float* ib = lat ? inL + (size_t)u.pm * BM * 1024 : inC + (size_t)(u.pm - 64) * BM * 1024;
        float* ob = lat ? outL + (size_t)u.pm * BM * 1024 : outC + (size_t)(u.pm - 64) * BM * 1024;
        const float* g = gate + (lat ? (u.pm >> 3) : 8) * 1024;
        const int col0 = u.pn * BM + wc * 32 + 8 * fq;
        f32x4 gv[2][2];
#pragma unroll
        for (int bj = 0; bj < 2; ++bj)
#pragma unroll
            for (int n = 0; n < 2; ++n) gv[bj][n] = *(const f32x4*)(g + col0 + bj * HALF + n * 4);
#pragma unroll
        for (int ai = 0; ai < 2; ++ai)
#pragma unroll
            for (int mp = 0; mp < 2; ++mp) {
                f32x4 xv[2][2][2];
#pragma unroll
                for (int mm = 0; mm < 2; ++mm) { const size_t off = (size_t)(ai * HALF + wr * 64 + (2 * mp + mm) * 16 + fr) * 1024 + col0;
#pragma unroll
                    for (int bj = 0; bj < 2; ++bj)
#pragma unroll
                        for (int n = 0; n < 2; ++n) xv[mm][bj][n] = __builtin_nontemporal_load((const f32x4*)(ib + off + bj * HALF + n * 4)); }
#pragma unroll
                for (int mm = 0; mm < 2; ++mm) { const int m = 2 * mp + mm; const size_t off = (size_t)(ai * HALF + wr * 64 + m * 16 + fr) * 1024 + col0;
#pragma unroll
                    for (int bj = 0; bj < 2; ++bj)
#pragma unroll
                        for (int n = 0; n < 2; ++n) *(f32x4*)(ob + off + bj * HALF + n * 4) = xv[mm][bj][n] + gv[bj][n] * acc[ai][bj][m][n]; }
                asm volatile("" ::: "memory"); }
    }
};

template <class Epi, class Sched, bool ALIGN_EPI = false, bool SP2 = false>
__device__ __forceinline__ void gemm_phase(PG8_LAS unsigned char* lds, const Gemm g, const Sched& S, const Epi& E, const int wv_) {
    int tid_ = wv_ * 64 + (int)__builtin_amdgcn_mbcnt_hi(~0u, __builtin_amdgcn_mbcnt_lo(~0u, 0u)); asm volatile("" : "+v"(tid_));
    const int tid = tid_, wid = __builtin_amdgcn_readfirstlane(tid >> 6), lane = tid & 63, wr = wid >> 2, wc = wid & 3, fr = lane & 15, fq = lane >> 4;
    const int K = g.K, nt = K / BK;
    unsigned voffA[2], voffB[2];
#pragma unroll
    for (int i = 0; i < 2; ++i) { int R, C; stage_rc(tid * 16 + i * 8192, R, C); const int Rb = Epi::PERM ? ((R & ~31) + perm32(R & 31)) : R;
        voffA[i] = (unsigned)(R * K + C) * 2u; voffB[i] = (unsigned)(Rb * K + C) * 2u; }
    const size_t kstep = (size_t)(BK * 2);
    const size_t hstep = (size_t)HALF * K * 2;
    const size_t tstep = 2 * hstep;
    const unsigned ldsw = (unsigned)wid * 1024u;
    const int aoff = lds_byte(wr * 64 + fr, fq * 8), boff = lds_byte(wc * 32 + fr, fq * 8);
#define PG8_SA(b, h) (((b) * 2 + (h)) * HTB)
#define PG8_SB(b, h) ((4 + (b) * 2 + (h)) * HTB)
#define PG8_STAGE(bufoff, gbase, voff) do { _Pragma("unroll") for (int _i = 0; _i < 2; ++_i) \
        __builtin_amdgcn_global_load_lds((const unsigned*)((const char*)(gbase) + (voff)[_i]), (PG8_LAS unsigned*)(lds + (bufoff) + ldsw + _i * 8192), 16, 0, 0); } while (0)
#define PG8_LDA(dst, b, h) do { _Pragma("unroll") for (int m = 0; m < 4; ++m) _Pragma("unroll") for (int k = 0; k < 2; ++k) dst[m][k] = *(const PG8_LAS bf16x8*)(lds + PG8_SA(b, h) + aoff + m * 2048 + k * 1024); } while (0)
#define PG8_LDB(dst, b, h) do { _Pragma("unroll") for (int n = 0; n < 2; ++n) _Pragma("unroll") for (int k = 0; k < 2; ++k) dst[n][k] = *(const PG8_LAS bf16x8*)(lds + PG8_SB(b, h) + boff + n * 2048 + k * 1024); } while (0)
#define PG8_MMA(ai, bj, At, Bt) do { __builtin_amdgcn_s_setprio(1); _Pragma("unroll") for (int m = 0; m < 4; ++m) _Pragma("unroll") for (int n = 0; n < 2; ++n) _Pragma("unroll") for (int k = 0; k < 2; ++k) \
        acc[ai][bj][m][n] = __builtin_amdgcn_mfma_f32_16x16x32_bf16(Bt[n][k], At[m][k], acc[ai][bj][m][n], 0, 0, 0); __builtin_amdgcn_s_setprio(0); } while (0)
#define PG8_WAIT_V(n) asm volatile("s_waitcnt vmcnt(" #n ")" ::: "memory")
#define PG8_WAIT_L(n) asm volatile("s_waitcnt lgkmcnt(" #n ")" ::: "memory")
#define PG8_BAR __builtin_amdgcn_s_barrier()
#define PG8_SCHED __builtin_amdgcn_sched_barrier(0)
    Unit cur, nxt; int ui = 0;
    if (!S.next(0, cur)) return;
    f32x4 acc[2][2][4][2];
#pragma unroll
    for (int a = 0; a < 2; ++a)
#pragma unroll
        for (int b = 0; b < 2; ++b)
#pragma unroll
            for (int m = 0; m < 4; ++m)
#pragma unroll
                for (int n = 0; n < 2; ++n) acc[a][b][m][n] = (f32x4){0.f, 0.f, 0.f, 0.f};
    bf16x8 At[4][2], B0[2][2], B1[2][2];
    const char* cA = (const char*)g.A + (size_t)cur.pm * tstep; const char* cB = (const char*)g.Bt + (size_t)cur.pn * tstep;
    S.a_ready(cur);
    if constexpr (SP2) {
        PG8_STAGE(PG8_SB(0, 0), cB, voffB); PG8_STAGE(PG8_SB(0, 1), cB + hstep, voffB); PG8_STAGE(PG8_SA(0, 0), cA, voffA); PG8_STAGE(PG8_SA(0, 1), cA + hstep, voffA);
        if (wr == 1) PG8_BAR;
        PG8_WAIT_V(2); PG8_BAR;
        PG8_STAGE(PG8_SB(1, 0), cB + kstep, voffB); PG8_STAGE(PG8_SA(1, 0), cA + kstep, voffA); PG8_STAGE(PG8_SB(1, 1), cB + hstep + kstep, voffB);
        PG8_WAIT_V(6); PG8_BAR;
    } else {
        PG8_STAGE(PG8_SB(0, 0), cB, voffB); PG8_STAGE(PG8_SA(0, 0), cA, voffA); PG8_STAGE(PG8_SB(0, 1), cB + hstep, voffB); PG8_STAGE(PG8_SA(0, 1), cA + hstep, voffA);
        if (wr == 1) PG8_BAR;
        PG8_WAIT_V(4); PG8_BAR;
        PG8_STAGE(PG8_SB(1, 0), cB + kstep, voffB); PG8_STAGE(PG8_SA(1, 0), cA + kstep, voffA); PG8_STAGE(PG8_SB(1, 1), cB + hstep + kstep, voffB);
        PG8_WAIT_V(6); PG8_BAR;
    }
    for (;;) {
        const bool has_next = S.next(ui + 1, nxt);
        const char* nA = has_next ? (const char*)g.A + (size_t)nxt.pm * tstep : cA; const char* nB = has_next ? (const char*)g.Bt + (size_t)nxt.pn * tstep : cB;
        for (int t = 0; t < nt; t += 2) {
            const bool last = (t == nt - 2);
            const char* a1 = cA + (size_t)(t + 1) * kstep;
            const char* a2 = last ? nA : cA + (size_t)(t + 2) * kstep; const char* b2 = last ? nB : cB + (size_t)(t + 2) * kstep;
            const char* a3 = a2 + kstep; const char* b3 = b2 + kstep;
            if (last && has_next) S.a_ready(nxt);
            if constexpr (SP2) {
            PG8_LDB(B0, 0, 0); PG8_LDB(B1, 0, 1); PG8_SCHED; PG8_LDA(At, 0, 0); PG8_STAGE(PG8_SA(1, 1), a1 + hstep, voffA);
            PG8_WAIT_V(8); PG8_WAIT_L(0); PG8_BAR; PG8_MMA(0, 0, At, B0); PG8_MMA(0, 1, At, B1); PG8_BAR; PG8_SCHED;
            PG8_LDA(At, 0, 1); PG8_STAGE(PG8_SB(0, 0), b2, voffB); PG8_STAGE(PG8_SB(0, 1), b2 + hstep, voffB); PG8_STAGE(PG8_SA(0, 0), a2, voffA);
            PG8_WAIT_V(8); PG8_WAIT_L(0); PG8_BAR; PG8_MMA(1, 0, At, B0); PG8_MMA(1, 1, At, B1); PG8_BAR; PG8_SCHED;
            PG8_LDB(B0, 1, 0); PG8_LDB(B1, 1, 1); PG8_SCHED; PG8_LDA(At, 1, 0); PG8_STAGE(PG8_SA(0, 1), a2 + hstep, voffA);
            PG8_WAIT_V(8); PG8_WAIT_L(0); PG8_BAR; PG8_MMA(0, 0, At, B0); PG8_MMA(0, 1, At, B1); PG8_BAR; PG8_SCHED;
            PG8_LDA(At, 1, 1); PG8_STAGE(PG8_SB(1, 0), b3, voffB); PG8_STAGE(PG8_SB(1, 1), b3 + hstep, voffB); PG8_STAGE(PG8_SA(1, 0), a3, voffA);
            PG8_WAIT_V(8); PG8_WAIT_L(0); PG8_BAR; PG8_MMA(1, 0, At, B0); PG8_MMA(1, 1, At, B1); PG8_BAR; PG8_SCHED;
            } else {
            PG8_LDB(B0, 0, 0); PG8_SCHED; PG8_LDA(At, 0, 0); PG8_STAGE(PG8_SA(1, 1), a1 + hstep, voffA);
            PG8_WAIT_L(8); PG8_BAR; PG8_WAIT_L(0); PG8_MMA(0, 0, At, B0); PG8_BAR; PG8_SCHED;
            PG8_LDB(B1, 0, 1); PG8_STAGE(PG8_SB(0, 0), b2, voffB);
            PG8_BAR; PG8_WAIT_L(0); PG8_MMA(0, 1, At, B1); PG8_BAR;
            PG8_LDA(At, 0, 1); PG8_STAGE(PG8_SA(0, 0), a2, voffA);
            PG8_BAR; PG8_WAIT_L(0); PG8_MMA(1, 0, At, B0); PG8_BAR; PG8_SCHED;
            PG8_STAGE(PG8_SB(0, 1), b2 + hstep, voffB);
            PG8_WAIT_V(6); PG8_BAR; PG8_MMA(1, 1, At, B1); PG8_BAR;
            PG8_LDB(B0, 1, 0); PG8_SCHED; PG8_LDA(At, 1, 0); PG8_STAGE(PG8_SA(0, 1), a2 + hstep, voffA);
            PG8_WAIT_L(8); PG8_BAR; PG8_WAIT_L(0); PG8_MMA(0, 0, At, B0); PG8_BAR; PG8_SCHED;
            PG8_LDB(B1, 1, 1); PG8_STAGE(PG8_SB(1, 0), b3, voffB);
            PG8_BAR; PG8_WAIT_L(0); PG8_MMA(0, 1, At, B1); PG8_BAR;
            PG8_LDA(At, 1, 1); PG8_STAGE(PG8_SA(1, 0), a3, voffA);
            PG8_BAR; PG8_WAIT_L(0); PG8_MMA(1, 0, At, B0); PG8_BAR; PG8_SCHED;
            PG8_STAGE(PG8_SB(1, 1), b3 + hstep, voffB);
            PG8_WAIT_V(6); PG8_BAR; PG8_MMA(1, 1, At, B1); PG8_BAR;
            }
        }
        if constexpr (ALIGN_EPI) { if (wr == 0) PG8_BAR; }
        if constexpr (!Epi::AFTER_DRAIN) { E(acc, cur, wr, wc, fr, fq); S.done(cur); }
        if (!has_next) break;
#pragma unroll
        for (int a = 0; a < 2; ++a)
#pragma unroll
            for (int b = 0; b < 2; ++b)
#pragma unroll
                for (int m = 0; m < 4; ++m)
#pragma unroll
                    for (int n = 0; n < 2; ++n) acc[a][b][m][n] = (f32x4){0.f, 0.f, 0.f, 0.f};
        cur = nxt; cA = nA; cB = nB; ++ui;
        if constexpr (ALIGN_EPI) { if (wr == 1) PG8_BAR; }
    }
    PG8_WAIT_V(0);
    if constexpr (!ALIGN_EPI) { if (wr == 0) PG8_BAR; }
    PG8_BAR;
    if constexpr (Epi::AFTER_DRAIN) { E.fused(acc, cur, wr, wc, fr, fq, lds, wid, lane); S.done(cur); }
#undef PG8_SA
#undef PG8_SB
#undef PG8_STAGE
#undef PG8_LDA
#undef PG8_LDB
#undef PG8_MMA
#undef PG8_WAIT_V
#undef PG8_WAIT_L
#undef PG8_BAR
#undef PG8_SCHED
}
}

#define LAS __attribute__((address_space(3)))
typedef unsigned short bf16_t;
typedef short bf16x8 __attribute__((ext_vector_type(8)));
typedef short s16x4 __attribute__((ext_vector_type(4)));
typedef float f32x4 __attribute__((ext_vector_type(4)));
typedef float f32x2 __attribute__((ext_vector_type(2)));
typedef float f32x16 __attribute__((ext_vector_type(16)));
typedef unsigned u32x4 __attribute__((ext_vector_type(4)));
typedef unsigned u32x2 __attribute__((ext_vector_type(2)));

#ifndef DUP_ATTN
#define DUP_ATTN 1
#endif
#ifndef DUP_LRU
#define DUP_LRU 1
#endif
#ifndef DUP_CONV
#define DUP_CONV 1
#endif
#ifndef DUP_GIN
#define DUP_GIN 1
#endif
#ifndef DUP_NORM
#define DUP_NORM 1
#endif
#ifndef DUP_PRO
#define DUP_PRO 1
#endif
#ifndef DUP_GOUT0
#define DUP_GOUT0 1
#endif
#ifndef DUP_LRUBC
#define DUP_LRUBC 1
#endif
#ifndef DUP_ATTEPI
#define DUP_ATTEPI 1
#endif
#ifndef DUP_SYNC
#define DUP_SYNC 1
#endif
#ifndef CTX_SMALL
#define CTX_SMALL 1
#endif
constexpr int NTHREADS = 512, NWAVES = 8;
constexpr int DM = 1024, NB = 8, SEQ = 2048, CTX = 256;
constexpr int ML = NB * SEQ, MC = NB * CTX, MT = ML + MC;
constexpr float EPS = 1e-6f, LOG2E = 1.4426950408889634f;
constexpr int LDS_BYTES = 147456;

constexpr size_t MiB = 1u << 20;
constexpr size_t WS_MODP = 1 * MiB;
constexpr size_t WS_GATE = 5 * MiB;
constexpr size_t WS_ROPE = 5 * MiB + 512 * 1024;
constexpr size_t WS_GW = 6 * MiB;
constexpr size_t WS_WIN[4] = {8 * MiB, 15 * MiB, 21 * MiB, 31 * MiB};
constexpr size_t WS_WOUT[4] = {13 * MiB, 19 * MiB, 29 * MiB, 36 * MiB};
constexpr size_t WS_XC = 38 * MiB;
constexpr size_t WS_XN = 46 * MiB;
constexpr size_t WS_ACT = 82 * MiB;
constexpr size_t WS_HF = 154 * MiB;
constexpr size_t WS_END = 226 * MiB;

struct Args { const float* in[36]; float* out; unsigned char* ws; };

#define LBAR() do { asm volatile("s_waitcnt lgkmcnt(0)" ::: "memory"); __builtin_amdgcn_s_barrier(); asm volatile("" ::: "memory"); } while (0)

__device__ __forceinline__ unsigned f2bf(float f) { unsigned u = __builtin_bit_cast(unsigned, f); return (u + 0x7fffu + ((u >> 16) & 1u)) >> 16; }
__device__ __forceinline__ unsigned pk2(float lo, float hi) { return pg8::cvt_pk_bf16(lo, hi); }
__device__ __forceinline__ float bflo(unsigned w) { return __builtin_bit_cast(float, w << 16); }
__device__ __forceinline__ float bfhi(unsigned w) { return __builtin_bit_cast(float, w & 0xffff0000u); }
__device__ __forceinline__ unsigned char* ows(unsigned char* p) { const unsigned long long v = (unsigned long long)p; unsigned lo = __builtin_amdgcn_readfirstlane((unsigned)v), hi = __builtin_amdgcn_readfirstlane((unsigned)(v >> 32)); asm volatile("" : "+s"(lo), "+s"(hi)); return (unsigned char*)(__attribute__((address_space(1))) unsigned char*)(((unsigned long long)hi << 32) | lo); }
__device__ __forceinline__ int otid(int wv) { int t = wv * 64 + (int)__builtin_amdgcn_mbcnt_hi(~0u, __builtin_amdgcn_mbcnt_lo(~0u, 0u)); asm volatile("" : "+v"(t)); return t; }
__device__ __forceinline__ float wave_sum(float v) {
#pragma unroll
    for (int o = 1; o < 64; o <<= 1) v += __shfl_xor(v, o);
    return v;
}
using pg8::silu_f;

__device__ __forceinline__ void transpose_item(const float* W, int K, int N, bf16_t* WT, LAS float* scr, int item, int lane) {
    const int nblk = N / 32, kb = item / nblk, nb = item % nblk, k0 = 64 * kb, n0 = 32 * nb;
    float tv[32];
#pragma unroll
    for (int i = 0; i < 32; ++i) tv[i] = __builtin_nontemporal_load(W + (size_t)(k0 + 2 * i + (lane >> 5)) * N + n0 + (lane & 31));
#pragma unroll
    for (int i = 0; i < 32; ++i) scr[(2 * i + (lane >> 5)) * 33 + (lane & 31)] = tv[i];
    asm volatile("s_waitcnt lgkmcnt(0)" ::: "memory");
    const int c = lane & 7;
#pragma unroll
    for (int j = 0; j < 4; ++j) { const int n = (lane >> 3) + 8 * j; const LAS float* s = scr + (8 * c) * 33 + n;
        u32x4 o; o.x = pk2(s[0 * 33], s[1 * 33]); o.y = pk2(s[2 * 33], s[3 * 33]); o.z = pk2(s[4 * 33], s[5 * 33]); o.w = pk2(s[6 * 33], s[7 * 33]);
        *(u32x4*)(WT + (size_t)(n0 + n) * K + k0 + 8 * c) = o; }
    asm volatile("s_waitcnt lgkmcnt(0)" ::: "memory");
}

__device__ __forceinline__ void phase_prep(const Args& A, LAS unsigned char* L, int layer, int vbid, int vG, const int wv) {
    const int tid = otid(wv), lane = tid & 63, wave = tid >> 6;
    unsigned char* ws = ows(A.ws);
    const float* Wm = (layer == 0 ? A.in[5] : layer == 1 ? A.in[11] : layer == 2 ? A.in[23] : A.in[30]);
    for (int task = vbid; task < 48; task += vG) {
        const int cc = task >> 3, kc = task & 7;
        LAS float* s = (LAS float*)L;
        for (int idx = tid; idx < 9 * 128; idx += NTHREADS) { const int r = idx >> 7, kk = idx & 127;
            const float v = (r < 8) ? A.in[1][r * DM + kc * 128 + kk] : A.in[3][kc * 128 + kk];
            s[idx] = v / (1.0f + __expf(-v)); }
        LBAR();
        const int col = cc * 512 + tid;
        float acc[9];
#pragma unroll
        for (int r = 0; r < 9; ++r) acc[r] = 0.f;
        const float* wp = Wm + (size_t)(kc * 128) * 3072 + col;
#pragma unroll 32
        for (int kk = 0; kk < 128; ++kk) { const float w = __builtin_nontemporal_load(wp + (size_t)kk * 3072);
#pragma unroll
            for (int r = 0; r < 9; ++r) acc[r] += s[r * 128 + kk] * w; }
        float* mp = (float*)(ws + WS_MODP) + (size_t)((layer * 8 + kc) * 9) * 3072 + col;
#pragma unroll
        for (int r = 0; r < 9; ++r) mp[(size_t)r * 3072] = acc[r];
        LBAR();
    }
    if (layer == 0 && vbid == vG - 1) {
        float* rt = (float*)(ws + WS_ROPE);
        for (int idx = tid; idx < 1024; idx += NTHREADS) { const int p = idx >> 4, j = idx & 15;
            const float inv = 1.0f / __builtin_powf(10000.0f, (float)j * (1.0f / 16.0f));
            const float ang = (float)p * inv; float t = ang * 0.15915494309189535f; t -= __builtin_rintf(t);
            rt[idx * 2] = __builtin_amdgcn_cosf(t); rt[idx * 2 + 1] = __builtin_amdgcn_sinf(t); }
    }
    LAS float* scr = (LAS float*)(L + wave * 16384);
    const int rb = (vbid + vG - (48 % vG)) % vG;
    const int gw = rb * NWAVES + wave, NGW = vG * NWAVES;
    const int Nin = (layer == 0 || layer == 3) ? 2560 : (layer == 1 ? 2048 : 4096);
    const float* win = (layer == 0 ? A.in[7] : layer == 1 ? A.in[13] : layer == 2 ? A.in[25] : A.in[32]);
    const float* wout = (layer == 0 ? A.in[8] : layer == 1 ? A.in[14] : layer == 2 ? A.in[26] : A.in[33]);
    bf16_t* wint = (bf16_t*)(ws + (layer == 0 ? WS_WIN[0] : layer == 1 ? WS_WIN[1] : layer == 2 ? WS_WIN[2] : WS_WIN[3]));
    bf16_t* woutt = (bf16_t*)(ws + (layer == 0 ? WS_WOUT[0] : layer == 1 ? WS_WOUT[1] : layer == 2 ? WS_WOUT[2] : WS_WOUT[3]));
    const int IIN = 16 * (Nin / 32), IO = 16 * 32, IGW = layer == 0 ? 64 * 2 : 0;
    const int nitems = IIN + IO + IGW;
    for (int it = gw; it < nitems; it += NGW) {
        int r = it;
        if (r < IIN) { transpose_item(win, 1024, Nin, wint, scr, r, lane); continue; } r -= IIN;
        if (r < IO) { transpose_item(wout, 1024, 1024, woutt, scr, r, lane); continue; } r -= IO;
        { const int blk = r >> 1, sub = r & 1;
          const int dir = blk >> 5, gate = (blk >> 4) & 1, h = blk & 15;
          const float* src = (gate == 0 ? A.in[17] : A.in[19]) + (size_t)(dir * 16 + h) * 4096;
          transpose_item(src, 64, 64, (bf16_t*)(ws + WS_GW) + (size_t)blk * 4096, scr, sub, lane); }
    }
}

template <int NR> __device__ __forceinline__ void norm_rows(const float* const (&xrow)[NR], bf16_t* const (&orow)[NR], const LAS float* const (&gs)[NR], const LAS float* const (&sh)[NR], int lane) {
    f32x4 v[NR][4]; float s[NR];
#pragma unroll
    for (int i = 0; i < NR; ++i) { const f32x4* xr = (const f32x4*)xrow[i] + lane;
#pragma unroll
        for (int j = 0; j < 4; ++j) v[i][j] = __builtin_nontemporal_load(xr + 64 * j); }
#pragma unroll
    for (int i = 0; i < NR; ++i) { float a = 0.f;
#pragma unroll
        for (int j = 0; j < 4; ++j) a += (v[i][j].x * v[i][j].x + v[i][j].y * v[i][j].y) + (v[i][j].z * v[i][j].z + v[i][j].w * v[i][j].w);
        s[i] = a; }
#pragma unroll
    for (int o = 1; o < 64; o <<= 1) {
#pragma unroll
        for (int i = 0; i < NR; ++i) s[i] += __shfl_xor(s[i], o); }
#pragma unroll
    for (int i = 0; i < NR; ++i) { const float rstd = 1.0f / sqrtf(s[i] * (1.0f / DM) + EPS); u32x2* o8 = (u32x2*)orow[i] + lane;
#pragma unroll
        for (int j = 0; j < 4; ++j) { const f32x4 g = *(const LAS f32x4*)(gs[i] + 256 * j + 4 * lane), b = *(const LAS f32x4*)(sh[i] + 256 * j + 4 * lane);
            const f32x4 y = v[i][j] * rstd * g + b; u32x2 w; w.x = pk2(y.x, y.y); w.y = pk2(y.z, y.w); o8[64 * j] = w; } }
}
__device__ __forceinline__ void phase_norm(const Args& A, int layer, const float* xL, const float* xC, LAS unsigned char* L, const int wv) {
    const int tid = otid(wv), lane = tid & 63, wave = tid >> 6, bid = blockIdx.x, G = gridDim.x;
    const float* norm_g = (layer == 0 ? A.in[4] : layer == 1 ? A.in[10] : layer == 2 ? A.in[22] : A.in[29]);
    const float* mod_b = (layer == 0 ? A.in[6] : layer == 1 ? A.in[12] : layer == 2 ? A.in[24] : A.in[31]);
    unsigned char* ws = ows(A.ws);
    const float* modp = (const float*)(ws + WS_MODP) + (size_t)(layer * 8) * 9 * 3072;
    bf16_t* XN = (bf16_t*)(ws + WS_XN);
    LAS float* tab = (LAS float*)L;
    for (int vb = bid; vb < 256; vb += G) {
        const int batch = vb >> 5;
#pragma unroll
        for (int i8 = 0; i8 < 8; ++i8) { const int idx = tid + i8 * NTHREADS; const int which = idx >> 10, col = idx & 1023; const int r = (which < 2) ? batch : 8; const int mcol = (which & 1) ? col : 1024 + col;
            float v = mod_b[mcol];
#pragma unroll
            for (int kc = 0; kc < 8; ++kc) v += modp[(size_t)(kc * 9 + r) * 3072 + mcol];
            if (!(which & 1)) v = norm_g[col] * (1.0f + v);
            tab[idx] = v; }
        if (vb < 9) { float* gf = (float*)(ws + WS_GATE) + (size_t)(layer * 9 + vb) * 1024;
            for (int col = tid; col < 1024; col += NTHREADS) { float v = mod_b[2048 + col];
#pragma unroll
                for (int kc = 0; kc < 8; ++kc) v += modp[(size_t)(kc * 9 + vb) * 3072 + 2048 + col];
                gf[col] = v; } }
        LBAR();
#pragma unroll 1
        for (int bt = 0; bt < 3; ++bt) {
            const float* xr[3]; bf16_t* orow[3]; const LAS float* gs[3]; const LAS float* sh[3];
#pragma unroll
            for (int i = 0; i < 3; ++i) { const int ri = bt * 3 + i;
                if (ri < 8) { const int row = vb * 64 + wave * 8 + ri; xr[i] = xL + (size_t)row * DM; orow[i] = XN + (size_t)row * DM; gs[i] = tab; sh[i] = tab + 1024; }
                else { const int row = vb * 8 + wave; xr[i] = xC + (size_t)row * DM; orow[i] = XN + (size_t)(ML + row) * DM; gs[i] = tab + 2048; sh[i] = tab + 3072; } }
            norm_rows<3>(xr, orow, gs, sh, lane);
        }
        LBAR();
    }
}

#define MFMA32(a, b, c) __builtin_amdgcn_mfma_f32_32x32x16_bf16((a), (b), (c), 0, 0, 0)
#define MFMA16(a, b, c) __builtin_amdgcn_mfma_f32_16x16x32_bf16((a), (b), (c), 0, 0, 0)
__device__ __forceinline__ int crow(int r, int hi) { return (r & 3) + 8 * (r >> 2) + 4 * hi; }
typedef short v4i16_t __attribute__((ext_vector_type(4)));
__device__ __forceinline__ float max3f(float a, float b, float c) { float r; asm("v_max3_f32 %0, %1, %2, %3" : "=v"(r) : "v"(a), "v"(b), "v"(c)); return r; }
__device__ __forceinline__ s16x4 vtr(LAS const unsigned char* p) { return __builtin_bit_cast(s16x4, __builtin_amdgcn_ds_read_tr16_b64_v4i16((LAS v4i16_t*)p)); }

__device__ __forceinline__ void phase_attn(const bf16_t* ACT, bf16_t* Y, const float* sink, bool need_ctx, LAS unsigned char* L, const int wv) {
    constexpr int LD = 2560, KSTR = 144, TILEB = 64 * KSTR, BUFB = 2 * TILEB;
    const int tid = otid(wv), lane = tid & 63, r32 = lane & 31, hi = lane >> 5, wave = __builtin_amdgcn_readfirstlane(tid >> 6);
    const int g = wave >> 1, half = wave & 1, G = gridDim.x;
    const int skey = tid >> 3, sch = tid & 7;
    const int stoff = skey * KSTR + sch * 16;
    const int koff = r32 * KSTR + hi * 16;
    const int voff = TILEB + (4 * hi + ((lane & 15) >> 2)) * KSTR + (16 * ((lane >> 4) & 1) + 4 * (lane & 3)) * 2;
    const int nunits = need_ctx ? 1152 : 1024;
    for (int u = blockIdx.x; u < nunits; u += G) {
        int b, kvh, qb; bool lat;
        if (u < 1024) { b = u >> 7; kvh = (u >> 5) & 3; qb = u & 31; lat = true; } else { const int e = u - 1024; b = e >> 4; kvh = (e >> 2) & 3; qb = e & 3; lat = false; }
        const int h = kvh * 4 + g;
        const int qpos = qb * 64 + half * 32 + r32;
        const int qrow = lat ? b * SEQ + qpos : ML + b * CTX + qpos;
        int tlo = 4, thi = 4;
        if (lat) { tlo = qb == 0 ? 6 : (qb == 1 ? 5 : 4); thi = qb == 31 ? 7 : (qb == 30 ? 8 : 9); }
        const int n = 4 + (thi - tlo);
        const int kp_base = qb * 64 - 128;
        bf16x8 qf[4];
        { const bf16_t* qp = ACT + (size_t)qrow * LD + h * 64 + hi * 8;
#pragma unroll
          for (int d0 = 0; d0 < 4; ++d0) qf[d0] = *(const bf16x8*)(qp + d0 * 16); }
        float m_run = sink[h] * LOG2E, l_run = hi ? 0.f : 1.f;
        f32x16 o0, o1;
#pragma unroll
        for (int r = 0; r < 16; ++r) { o0[r] = 0.f; o1[r] = 0.f; }
        const size_t kcol = 1024 + kvh * 64 + sch * 8, vcol = 1280 + kvh * 64 + sch * 8;
#define ATT_TROW(s_) (((s_) < 4 ? ML + b * CTX + (s_) * 64 : b * SEQ + kp_base + (tlo + (s_) - 8) * 64) + skey)
        u32x4 kq0, vq0, kq1, vq1, kq2, vq2;
        { const size_t krow = (size_t)ATT_TROW(0); kq0 = *(const u32x4*)(ACT + krow * LD + kcol); vq0 = *(const u32x4*)(ACT + krow * LD + vcol); }
        { const size_t krow = (size_t)ATT_TROW(1); kq1 = *(const u32x4*)(ACT + krow * LD + kcol); vq1 = *(const u32x4*)(ACT + krow * LD + vcol); }
        { const size_t krow = (size_t)ATT_TROW(2); kq2 = *(const u32x4*)(ACT + krow * LD + kcol); vq2 = *(const u32x4*)(ACT + krow * LD + vcol); }
        LBAR();
        *(LAS u32x4*)(L + stoff) = kq0; *(LAS u32x4*)(L + TILEB + stoff) = vq0;
        { const size_t krow = (size_t)ATT_TROW(3); kq0 = *(const u32x4*)(ACT + krow * LD + kcol); vq0 = *(const u32x4*)(ACT + krow * LD + vcol); }
        LBAR();
#define ATT_STEP(s_, KQ, VQ) do { const int s = (s_); \
            const int t = s < 4 ? s : tlo + (s - 4); \
            LAS const unsigned char* B = L + (s & 1) * BUFB; \
 \
              \
            bf16x8 kf[8]; s16x4 vl[8], vh[8]; \
_Pragma("unroll") \
            for (int d0 = 0; d0 < 4; ++d0) { kf[2 * d0] = *(const LAS bf16x8*)(B + koff + d0 * 32); kf[2 * d0 + 1] = *(const LAS bf16x8*)(B + koff + 32 * KSTR + d0 * 32); } \
_Pragma("unroll") \
            for (int i = 0; i < 4; ++i) { LAS const unsigned char* vp = B + voff + i * 16 * KSTR; vl[2 * i] = vtr(vp); vh[2 * i] = vtr(vp + 8 * KSTR); vl[2 * i + 1] = vtr(vp + 64); vh[2 * i + 1] = vtr(vp + 8 * KSTR + 64); } \
            __builtin_amdgcn_sched_barrier(0); \
            f32x16 p0, p1; \
_Pragma("unroll") \
            for (int r = 0; r < 16; ++r) { p0[r] = 0.f; p1[r] = 0.f; } \
_Pragma("unroll") \
            for (int d0 = 0; d0 < 4; ++d0) { p0 = MFMA32(kf[2 * d0], qf[d0], p0); p1 = MFMA32(kf[2 * d0 + 1], qf[d0], p1); } \
            if (t == 4 || t == 8) { const int kp0 = kp_base + (t - 4) * 64 - qpos; \
_Pragma("unroll") \
                for (int r = 0; r < 16; ++r) { const int d0 = kp0 + crow(r, hi), d1 = d0 + 32; \
                    if (d0 > 128 || d0 < -128) p0[r] = -1e30f; if (d1 > 128 || d1 < -128) p1[r] = -1e30f; } } \
            float mt = max3f(p0[0], p0[1], p1[0]), mt2 = max3f(p0[2], p0[3], p1[1]); mt = max3f(mt, p1[2], p1[3]); \
_Pragma("unroll") \
            for (int r = 4; r < 16; r += 4) { mt = max3f(mt, p0[r], p0[r + 1]); mt2 = max3f(mt2, p0[r + 2], p0[r + 3]); mt = max3f(mt, p1[r], p1[r + 1]); mt2 = max3f(mt2, p1[r + 2], p1[r + 3]); } \
            mt = fmaxf(mt, mt2); \
            mt = fmaxf(mt, __shfl_xor(mt, 32)) - m_run; \
 \
            float dl = 0.f; \
            if (s == 0) dl = fmaxf(mt, 0.f); else if (mt > 8.0f) dl = mt; \
            if (__any(dl != 0.f)) { const float alpha = __builtin_amdgcn_exp2f(-dl); m_run += dl; l_run *= alpha; \
_Pragma("unroll") \
                for (int r = 0; r < 16; ++r) { o0[r] *= alpha; o1[r] *= alpha; } } \
            float ls = 0.f, ls2 = 0.f; \
_Pragma("unroll") \
            for (int r = 0; r < 16; ++r) { p0[r] = __builtin_amdgcn_exp2f(p0[r] - m_run); p1[r] = __builtin_amdgcn_exp2f(p1[r] - m_run); ls += p0[r]; ls2 += p1[r]; } \
            ls += ls2; \
            l_run += ls; \
            bf16x8 pb[2][2]; \
_Pragma("unroll") \
            for (int j = 0; j < 2; ++j) { \
                u32x4 w0, w1; \
                w0.x = pk2(p0[8 * j + 0], p0[8 * j + 1]); w0.y = pk2(p0[8 * j + 2], p0[8 * j + 3]); w0.z = pk2(p0[8 * j + 4], p0[8 * j + 5]); w0.w = pk2(p0[8 * j + 6], p0[8 * j + 7]); \
                w1.x = pk2(p1[8 * j + 0], p1[8 * j + 1]); w1.y = pk2(p1[8 * j + 2], p1[8 * j + 3]); w1.z = pk2(p1[8 * j + 4], p1[8 * j + 5]); w1.w = pk2(p1[8 * j + 6], p1[8 * j + 7]); \
                pb[0][j] = __builtin_bit_cast(bf16x8, w0); pb[1][j] = __builtin_bit_cast(bf16x8, w1); \
            } \
 \
_Pragma("unroll") \
            for (int kb = 0; kb < 2; ++kb) \
_Pragma("unroll") \
                for (int j = 0; j < 2; ++j) { const int i = kb * 2 + j; \
                    const bf16x8 a0 = __builtin_shufflevector(vl[2 * i], vh[2 * i], 0, 1, 2, 3, 4, 5, 6, 7), a1 = __builtin_shufflevector(vl[2 * i + 1], vh[2 * i + 1], 0, 1, 2, 3, 4, 5, 6, 7); \
                    o0 = MFMA32(a0, pb[kb][j], o0); o1 = MFMA32(a1, pb[kb][j], o1); \
                } \
            if (s + 1 < n) { LAS unsigned char* Bn = L + ((s + 1) & 1) * BUFB; *(LAS u32x4*)(Bn + stoff) = KQ; *(LAS u32x4*)(Bn + TILEB + stoff) = VQ; } \
            LBAR(); \
            if (s + 4 < n) { const size_t krow = (size_t)ATT_TROW(s + 4); KQ = *(const u32x4*)(ACT + krow * LD + kcol); VQ = *(const u32x4*)(ACT + krow * LD + vcol); } \
        } while (0)
#pragma unroll 1
        for (int s0 = 0; s0 < n; s0 += 3) {
            ATT_STEP(s0, kq1, vq1);
            if (s0 + 1 < n) ATT_STEP(s0 + 1, kq2, vq2);
            if (s0 + 2 < n) ATT_STEP(s0 + 2, kq0, vq0);
        }
#undef ATT_STEP
#undef ATT_TROW
        u32x4 sgq[4];
        { const int qrow0 = qrow - r32;
#pragma unroll
          for (int it = 0; it < 4; ++it) sgq[it] = *(const u32x4*)(ACT + (size_t)(qrow0 + it * 8 + (lane >> 3)) * LD + 1536 + h * 64 + (lane & 7) * 8); }
        const float lt = l_run + __shfl_xor(l_run, 32); const float inv = 1.0f / lt;
        LAS float* stg = (LAS float*)(L + 40960 + wave * 8704);
#pragma unroll
        for (int db = 0; db < 2; ++db)
#pragma unroll
            for (int q4 = 0; q4 < 4; ++q4) { const int d = 32 * db + 8 * q4 + 4 * hi; f32x4 v;
                if (db == 0) v = (f32x4){o0[4 * q4], o0[4 * q4 + 1], o0[4 * q4 + 2], o0[4 * q4 + 3]}; else v = (f32x4){o1[4 * q4], o1[4 * q4 + 1], o1[4 * q4 + 2], o1[4 * q4 + 3]};
                *(LAS f32x4*)(stg + r32 * 68 + d) = v * inv; }
        asm volatile("s_waitcnt lgkmcnt(0)" ::: "memory");
        { const int qrow0 = qrow - r32; const int er = lane >> 3, ec = (lane & 7) * 8;
#pragma unroll
          for (int it = 0; it < 4; ++it) { const int row = it * 8 + er; const size_t grow = (size_t)(qrow0 + row);
              const f32x4 a0 = *(const LAS f32x4*)(stg + row * 68 + ec), a1 = *(const LAS f32x4*)(stg + row * 68 + ec + 4);
              const u32x4 gw = sgq[it];
              u32x4 w; w.x = pk2(a0.x * bflo(gw.x), a0.y * bfhi(gw.x)); w.y = pk2(a0.z * bflo(gw.y), a0.w * bfhi(gw.y)); w.z = pk2(a1.x * bflo(gw.z), a1.y * bfhi(gw.z)); w.w = pk2(a1.z * bflo(gw.w), a1.w * bfhi(gw.w));
              *(u32x4*)(Y + grow * DM + h * 64 + ec) = w; } }
    }
    LBAR();
}

__device__ __forceinline__ void phase_lru(const Args& A, const bf16_t* ACT, bf16_t* Y, float* HF, LAS unsigned char* L, const int wv) {
    constexpr int LD = 2048, TT = 128, USTR = 144;
    const int tid = otid(wv), lane = tid & 63, wave = __builtin_amdgcn_readfirstlane(tid >> 6), G = gridDim.x;
    LAS unsigned char* UL = L;
    LAS unsigned char* XA = L + 19200;
    LAS float* XF = (LAS float*)(L + 19200 + 18432);
    LAS f32x2* AB = (LAS f32x2*)(L + 19200 + 18432 + 16384);
    LAS f32x2* CAR = (LAS f32x2*)(L + 19200 + 18432 + 16384 + 32768);
    LAS float* ST = (LAS float*)(L + 19200 + 18432 + 16384 + 32768 + 4096);
    LAS float* CW = (LAS float*)(L + 19200 + 18432 + 16384 + 32768 + 4096 + 256);
    const bf16_t* gwT = (const bf16_t*)(ows(A.ws) + WS_GW);
    const float* conv_w = A.in[15]; const float* conv_b = A.in[16]; const float* ba = A.in[18]; const float* bx = A.in[20]; const float* lam = A.in[21];
    const int fr = lane & 15, fq = lane >> 4;
    const int stok = tid >> 3, sch = tid & 7;
    const int ch = tid & 31, sc = tid >> 5;
    const int otok = tid >> 2, oq = tid & 3;
    for (int u = blockIdx.x; u < 256; u += G) {
        const int b = u >> 5, hb = u & 31, hblk = hb >> 1, half = hb & 1, cin0 = hblk * 64, c0 = cin0 + half * 32;
#pragma unroll 1
        for (int dir = 0; dir < 2; ++dir) {
            LBAR();
            if (tid < 320) { const int k = tid >> 6, c = tid & 63; CW[tid] = (k < 4) ? conv_w[(size_t)(dir * 4 + k) * DM + cin0 + c] : conv_b[(size_t)dir * DM + cin0 + c]; }
            const int cbk = wave & 1;
            bf16x8 wr_[2], wi_[2];
            { const bf16_t* pr = gwT + ((size_t)((dir * 2 + 0) * 16 + hblk) * 64 + half * 32 + cbk * 16 + fr) * 64 + fq * 8;
              const bf16_t* pi = gwT + ((size_t)((dir * 2 + 1) * 16 + hblk) * 64 + half * 32 + cbk * 16 + fr) * 64 + fq * 8;
              wr_[0] = *(const bf16x8*)pr; wr_[1] = *(const bf16x8*)(pr + 32); wi_[0] = *(const bf16x8*)pi; wi_[1] = *(const bf16x8*)(pi + 32); }
            float eba[4], ebx[4], esp[4];
#pragma unroll
            for (int e = 0; e < 4; ++e) { const int c = dir * DM + c0 + cbk * 16 + 4 * fq + e; eba[e] = ba[c]; ebx[e] = bx[c];
                const float nl = -lam[c]; esp[e] = (fmaxf(nl, 0.f) + log1pf(__expf(-fabsf(nl)))) * (-8.0f * LOG2E); }
            if (tid < 32) ST[tid] = 0.f;
            u32x4 ur[2], uh = (u32x4){0u, 0u, 0u, 0u};
            { const int rowbase = ML + b * CTX;
#pragma unroll
              for (int i2 = 0; i2 < 2; ++i2) { const int S = stok + 64 * i2; const int row = rowbase + (dir ? CTX - 1 - S : S); ur[i2] = *(const u32x4*)(ACT + (size_t)row * LD + cin0 + sch * 8); } }
            f32x4 hf0 = (f32x4){0.f, 0.f, 0.f, 0.f}, hf1 = hf0; u32x4 gv = (u32x4){0u, 0u, 0u, 0u}; size_t orow = 0; int oseq = 0;
#define LRU_OUT() do { const f32x4 h0 = *(const LAS f32x4*)(XF + otok * 32 + oq * 8), h1 = *(const LAS f32x4*)(XF + otok * 32 + oq * 8 + 4); \
                if (dir == 0) { f32x4* hp = (f32x4*)(HF + ((size_t)u * 2304 + oseq) * 32 + oq * 8); hp[0] = h0; hp[1] = h1; } \
                else { const f32x4 s0 = h0 + hf0, s1 = h1 + hf1; u32x4 w; \
                    w.x = pk2(s0.x * bflo(gv.x), s0.y * bfhi(gv.x)); w.y = pk2(s0.z * bflo(gv.y), s0.w * bfhi(gv.y)); w.z = pk2(s1.x * bflo(gv.z), s1.y * bfhi(gv.z)); w.w = pk2(s1.z * bflo(gv.w), s1.w * bfhi(gv.w)); \
                    *(u32x4*)(Y + orow * DM + c0 + oq * 8) = w; } } while (0)
#pragma unroll 1
            for (int tl = 0; tl < 18; ++tl) {
                const int seg = tl < 2 ? 0 : 1, S0 = seg ? (tl - 2) * TT : tl * TT, seglen = seg ? SEQ : CTX, rowbase = seg ? b * SEQ : ML + b * CTX;
                LBAR();
                *(LAS u32x4*)(UL + (3 + stok) * USTR + sch * 16) = ur[0]; *(LAS u32x4*)(UL + (3 + 64 + stok) * USTR + sch * 16) = ur[1];
                if (tid < 24) *(LAS u32x4*)(UL + stok * USTR + sch * 16) = uh;
                if (tl > 0) LRU_OUT();
                LBAR();
                { const int S = S0 + otok; const int pos = dir ? seglen - 1 - S : S; orow = (size_t)(rowbase + pos); oseq = seg ? CTX + pos : pos;
                  if (dir == 1) { const f32x4* hp = (const f32x4*)(HF + ((size_t)u * 2304 + oseq) * 32 + oq * 8); hf0 = hp[0]; hf1 = hp[1]; gv = *(const u32x4*)(ACT + orow * LD + 1024 + c0 + oq * 8); } }
                if (tl + 1 < 18) { const int tn = tl + 1; const int seg2 = tn < 2 ? 0 : 1, S02 = seg2 ? (tn - 2) * TT : tn * TT, seglen2 = seg2 ? SEQ : CTX, rowbase2 = seg2 ? b * SEQ : ML + b * CTX;
#pragma unroll
                    for (int i2 = 0; i2 < 2; ++i2) { const int S = S02 + stok + 64 * i2; const int row = rowbase2 + (dir ? seglen2 - 1 - S : S); ur[i2] = *(const u32x4*)(ACT + (size_t)row * LD + cin0 + sch * 8); }
                    uh = (u32x4){0u, 0u, 0u, 0u};
                    if (tid < 24 && S02 > 0) { const int S = S02 - 3 + stok; const int row = rowbase2 + (dir ? seglen2 - 1 - S : S); uh = *(const u32x4*)(ACT + (size_t)row * LD + cin0 + sch * 8); } }
                for (int rep_ = 0; rep_ < DUP_LRUBC; ++rep_) {
                { float x0[8], x1[8];
                  { const f32x4 ca = *(const LAS f32x4*)(CW + 256 + sch * 8), cc = *(const LAS f32x4*)(CW + 256 + sch * 8 + 4);
                    x0[0] = ca.x; x0[1] = ca.y; x0[2] = ca.z; x0[3] = ca.w; x0[4] = cc.x; x0[5] = cc.y; x0[6] = cc.z; x0[7] = cc.w;
#pragma unroll
                    for (int e = 0; e < 8; ++e) x1[e] = x0[e]; }
#pragma unroll
                  for (int k = 0; k < 4; ++k) { const f32x4 wa = *(const LAS f32x4*)(CW + k * 64 + sch * 8), wb = *(const LAS f32x4*)(CW + k * 64 + sch * 8 + 4);
                      const u32x4 u0 = *(const LAS u32x4*)(UL + (stok + k) * USTR + sch * 16), u1 = *(const LAS u32x4*)(UL + (stok + 64 + k) * USTR + sch * 16);
                      x0[0] += wa.x * bflo(u0.x); x0[1] += wa.y * bfhi(u0.x); x0[2] += wa.z * bflo(u0.y); x0[3] += wa.w * bfhi(u0.y);
                      x0[4] += wb.x * bflo(u0.z); x0[5] += wb.y * bfhi(u0.z); x0[6] += wb.z * bflo(u0.w); x0[7] += wb.w * bfhi(u0.w);
                      x1[0] += wa.x * bflo(u1.x); x1[1] += wa.y * bfhi(u1.x); x1[2] += wa.z * bflo(u1.y); x1[3] += wa.w * bfhi(u1.y);
                      x1[4] += wb.x * bflo(u1.z); x1[5] += wb.y * bfhi(u1.z); x1[6] += wb.z * bflo(u1.w); x1[7] += wb.w * bfhi(u1.w); }
                  u32x4 w; w.x = pk2(x0[0], x0[1]); w.y = pk2(x0[2], x0[3]); w.z = pk2(x0[4], x0[5]); w.w = pk2(x0[6], x0[7]);
                  *(LAS u32x4*)(XA + stok * USTR + sch * 16) = w;
                  w.x = pk2(x1[0], x1[1]); w.y = pk2(x1[2], x1[3]); w.z = pk2(x1[4], x1[5]); w.w = pk2(x1[6], x1[7]);
                  *(LAS u32x4*)(XA + (stok + 64) * USTR + sch * 16) = w;
                  if ((sch >> 2) == half) { LAS f32x4* xf = (LAS f32x4*)(XF + stok * 32 + (sch & 3) * 8); xf[0] = (f32x4){x0[0], x0[1], x0[2], x0[3]}; xf[1] = (f32x4){x0[4], x0[5], x0[6], x0[7]};
                      xf = (LAS f32x4*)(XF + (stok + 64) * 32 + (sch & 3) * 8); xf[0] = (f32x4){x1[0], x1[1], x1[2], x1[3]}; xf[1] = (f32x4){x1[4], x1[5], x1[6], x1[7]}; } }
                LBAR();
#pragma unroll
                for (int i2 = 0; i2 < 2; ++i2) { const int tb = (wave >> 1) + 4 * i2; const int tok = tb * 16 + fr;
                    const bf16x8 x0 = *(const LAS bf16x8*)(XA + tok * USTR + fq * 16), x1 = *(const LAS bf16x8*)(XA + tok * USTR + 64 + fq * 16);
                    f32x4 ar = (f32x4){0.f, 0.f, 0.f, 0.f}, ai = (f32x4){0.f, 0.f, 0.f, 0.f};
                    ar = MFMA16(wr_[0], x0, ar); ar = MFMA16(wr_[1], x1, ar); ai = MFMA16(wi_[0], x0, ai); ai = MFMA16(wi_[1], x1, ai);
                    const f32x4 xv = *(const LAS f32x4*)(XF + tok * 32 + cbk * 16 + 4 * fq);
                    float av[4], bv[4];
#pragma unroll
                    for (int e = 0; e < 4; ++e) { const float r = __builtin_amdgcn_rcpf(1.0f + __builtin_amdgcn_exp2f(-(ar[e] + eba[e]) * LOG2E)); const float ig = __builtin_amdgcn_rcpf(1.0f + __builtin_amdgcn_exp2f(-(ai[e] + ebx[e]) * LOG2E));
                        const float a_ = __builtin_amdgcn_exp2f(r * esp[e]); av[e] = a_; bv[e] = __builtin_amdgcn_sqrtf(fmaxf(1.0f - a_ * a_, 0.f)) * (ig * xv[e]); }
                    LAS f32x4* ab = (LAS f32x4*)(AB + tok * 32 + cbk * 16 + 4 * fq); ab[0] = (f32x4){av[0], bv[0], av[1], bv[1]}; ab[1] = (f32x4){av[2], bv[2], av[3], bv[3]}; }
                LBAR();
                }
                float a8[8], b8[8];
                { float Ap = 1.f, H = 0.f;
#pragma unroll
                  for (int k = 0; k < 8; ++k) { const f32x2 v = AB[(sc * 8 + k) * 32 + ch]; a8[k] = v.x; b8[k] = v.y; H = v.x * H + v.y; Ap *= v.x; }
                  CAR[sc * 32 + ch] = (f32x2){Ap, H}; }
                LBAR();
                float hrun = ST[(tl & 1) * 32 + ch];
                { f32x2 cr[15];
#pragma unroll
                  for (int s = 0; s < 15; ++s) cr[s] = CAR[s * 32 + ch];
#pragma unroll
                  for (int s = 0; s < 15; ++s) hrun = (s < sc) ? cr[s].x * hrun + cr[s].y : hrun; }
#pragma unroll
                for (int k = 0; k < 8; ++k) { hrun = a8[k] * hrun + b8[k]; XF[(sc * 8 + k) * 32 + ch] = hrun; }
                if (sc == 15) ST[((tl + 1) & 1) * 32 + ch] = hrun;
            }
            LBAR();
            LRU_OUT();
            asm volatile("s_waitcnt vmcnt(0)" ::: "memory");
        }
        LBAR();
    }
#undef LRU_OUT
}

__device__ __forceinline__ void cu8(const bf16_t* ACT, size_t row, int col, float* o) {
    const u32x4 a = __builtin_nontemporal_load((const u32x4*)(ACT + row * 4096 + col)), c = __builtin_nontemporal_load((const u32x4*)(ACT + row * 4096 + 2048 + col));
    o[0] = bflo(a.x) * bflo(c.x); o[1] = bfhi(a.x) * bfhi(c.x); o[2] = bflo(a.y) * bflo(c.y); o[3] = bfhi(a.y) * bfhi(c.y);
    o[4] = bflo(a.z) * bflo(c.z); o[5] = bfhi(a.z) * bfhi(c.z); o[6] = bflo(a.w) * bflo(c.w); o[7] = bfhi(a.w) * bfhi(c.w);
}
__device__ __forceinline__ void phase_conv(const Args& A, const bf16_t* ACT, bf16_t* Y, const int wv) {
    const float* conv_w = A.in[27]; const float* conv_b = A.in[28];
    const int nitems = (MT / 8) * 128;
    const int tid = otid(wv);
    for (int item = blockIdx.x * NTHREADS + tid; item < nitems; item += gridDim.x * NTHREADS) {
        const int rg = item >> 7, chunk = item & 127, col = chunk * 8, row0 = rg * 8;
        const int seglen = row0 < ML ? SEQ : CTX;
        const bool first = (row0 % seglen) == 0, last = ((row0 + 8) % seglen) == 0;
        float w0[8], w1[8], w2[8], cb[8];
        { const f32x4* p = (const f32x4*)(conv_w + col); f32x4 a = p[0], c = p[1]; w0[0] = a.x; w0[1] = a.y; w0[2] = a.z; w0[3] = a.w; w0[4] = c.x; w0[5] = c.y; w0[6] = c.z; w0[7] = c.w;
          p = (const f32x4*)(conv_w + DM + col); a = p[0]; c = p[1]; w1[0] = a.x; w1[1] = a.y; w1[2] = a.z; w1[3] = a.w; w1[4] = c.x; w1[5] = c.y; w1[6] = c.z; w1[7] = c.w;
          p = (const f32x4*)(conv_w + 2 * DM + col); a = p[0]; c = p[1]; w2[0] = a.x; w2[1] = a.y; w2[2] = a.z; w2[3] = a.w; w2[4] = c.x; w2[5] = c.y; w2[6] = c.z; w2[7] = c.w;
          p = (const f32x4*)(conv_b + col); a = p[0]; c = p[1]; cb[0] = a.x; cb[1] = a.y; cb[2] = a.z; cb[3] = a.w; cb[4] = c.x; cb[5] = c.y; cb[6] = c.z; cb[7] = c.w; }
        float prev[8], cur[8], nxt[8];
        if (first) {
#pragma unroll
            for (int e = 0; e < 8; ++e) prev[e] = 0.f;
        } else cu8(ACT, (size_t)row0 - 1, col, prev);
        cu8(ACT, (size_t)row0, col, cur);
#pragma unroll
        for (int k = 0; k < 8; ++k) {
            const size_t row = (size_t)row0 + k;
            if (k == 7 && last) {
#pragma unroll
                for (int e = 0; e < 8; ++e) nxt[e] = 0.f;
            } else cu8(ACT, row + 1, col, nxt);
            const u32x4 bgw = __builtin_nontemporal_load((const u32x4*)(ACT + row * 4096 + 1024 + col)), sgw = __builtin_nontemporal_load((const u32x4*)(ACT + row * 4096 + 3072 + col));
            float y[8];
#pragma unroll
            for (int e = 0; e < 8; ++e) y[e] = w0[e] * prev[e] + w1[e] * cur[e] + w2[e] * nxt[e] + cb[e];
            y[0] *= bflo(bgw.x) * bflo(sgw.x); y[1] *= bfhi(bgw.x) * bfhi(sgw.x); y[2] *= bflo(bgw.y) * bflo(sgw.y); y[3] *= bfhi(bgw.y) * bfhi(sgw.y);
            y[4] *= bflo(bgw.z) * bflo(sgw.z); y[5] *= bfhi(bgw.z) * bfhi(sgw.z); y[6] *= bflo(bgw.w) * bflo(sgw.w); y[7] *= bfhi(bgw.w) * bfhi(sgw.w);
            u32x4 w; w.x = pk2(y[0], y[1]); w.y = pk2(y[2], y[3]); w.z = pk2(y[4], y[5]); w.w = pk2(y[6], y[7]);
            *(u32x4*)(Y + row * DM + col) = w;
#pragma unroll
            for (int e = 0; e < 8; ++e) { prev[e] = cur[e]; cur[e] = nxt[e]; }
        }
    }
}

__device__ __forceinline__ void phase_ctx_wout(const bf16_t* Yc, const bf16_t* Wt, const float* xin, float* xout, const float* gate, LAS unsigned char* L, const int wv) {
    constexpr int PITCH = 144, ABYTES = 128 * PITCH, BUFB = 192 * PITCH;
    const int tid = otid(wv), lane = tid & 63, r32 = lane & 31, hi = lane >> 5, wave = wv, G = gridDim.x;
    const int srow = tid >> 3, sch = tid & 7;
    const int aoff = ((wave >> 1) * 32 + r32) * PITCH + hi * 64, boff = ABYTES + ((wave & 1) * 32 + r32) * PITCH + hi * 64;
    for (int t = blockIdx.x; t < 256; t += G) {
        const int tm = t >> 4, tn = t & 15;
        const bf16_t* ga0 = Yc + (size_t)(tm * 128 + srow) * DM + sch * 8; const bf16_t* ga1 = ga0 + (size_t)64 * DM; const bf16_t* gb = Wt + (size_t)(tn * 64 + srow) * DM + sch * 8;
        f32x16 acc;
#pragma unroll
        for (int r = 0; r < 16; ++r) acc[r] = 0.f;
        u32x4 qa0[3], qa1[3], qb[3];
#define CTX_LOAD(q, s_) do { qa0[q] = *(const u32x4*)(ga0 + (s_) * 64); qa1[q] = *(const u32x4*)(ga1 + (s_) * 64); qb[q] = *(const u32x4*)(gb + (s_) * 64); } while (0)
#define CTX_WRITE(q, buf) do { LAS unsigned char* Bn = L + (buf) * BUFB; *(LAS u32x4*)(Bn + srow * PITCH + sch * 16) = qa0[q]; *(LAS u32x4*)(Bn + (64 + srow) * PITCH + sch * 16) = qa1[q]; *(LAS u32x4*)(Bn + ABYTES + srow * PITCH + sch * 16) = qb[q]; } while (0)
#define CTX_STEP(s_, q) do { const int s = (s_); LAS const unsigned char* B = L + (s & 1) * BUFB; bf16x8 a[4], b[4]; \
            _Pragma("unroll") for (int j = 0; j < 4; ++j) { a[j] = *(const LAS bf16x8*)(B + aoff + j * 16); b[j] = *(const LAS bf16x8*)(B + boff + j * 16); } \
            _Pragma("unroll") for (int j = 0; j < 4; ++j) acc = MFMA32(a[j], b[j], acc); \
            if (s + 1 < 16) CTX_WRITE(q, (s + 1) & 1); \
            LBAR(); \
            if (s + 4 < 16) CTX_LOAD(q, s + 4); } while (0)
        CTX_LOAD(0, 0); CTX_LOAD(1, 1); CTX_LOAD(2, 2);
        LBAR();
        CTX_WRITE(0, 0);
        CTX_LOAD(0, 3);
        LBAR();
#pragma unroll 1
        for (int s0 = 0; s0 < 16; s0 += 3) {
            CTX_STEP(s0, 1);
            if (s0 + 1 < 16) CTX_STEP(s0 + 1, 2);
            if (s0 + 2 < 16) CTX_STEP(s0 + 2, 0);
        }
#undef CTX_LOAD
#undef CTX_WRITE
#undef CTX_STEP
        const int m0 = tm * 128 + (wave >> 1) * 32, col = tn * 64 + (wave & 1) * 32 + r32; const float gv = gate[col];
        float xv[16];
#pragma unroll
        for (int r = 0; r < 16; ++r) xv[r] = xin[(size_t)(m0 + crow(r, hi)) * DM + col];
#pragma unroll
        for (int r = 0; r < 16; ++r) xout[(size_t)(m0 + crow(r, hi)) * DM + col] = xv[r] + gv * acc[r];
    }
    LBAR();
}

__device__ __forceinline__ void phase_final(float* out, const float* g, const int wv) {
    const int tid = otid(wv); const int lane = tid & 63, gw = blockIdx.x * NWAVES + (tid >> 6), NGW = gridDim.x * NWAVES;
    f32x4 gv[4];
#pragma unroll
    for (int j = 0; j < 4; ++j) gv[j] = *((const f32x4*)g + 64 * j + lane);
    for (int row0 = gw * 4; row0 < ML; row0 += NGW * 4) {
        f32x4 v[4][4]; float s[4];
#pragma unroll
        for (int i = 0; i < 4; ++i) { const f32x4* xr = (const f32x4*)(out + (size_t)(row0 + i) * DM) + lane;
#pragma unroll
            for (int j = 0; j < 4; ++j) v[i][j] = __builtin_nontemporal_load(xr + 64 * j); }
#pragma unroll
        for (int i = 0; i < 4; ++i) { float a = 0.f;
#pragma unroll
            for (int j = 0; j < 4; ++j) a += (v[i][j].x * v[i][j].x + v[i][j].y * v[i][j].y) + (v[i][j].z * v[i][j].z + v[i][j].w * v[i][j].w);
            s[i] = a; }
#pragma unroll
        for (int o = 1; o < 64; o <<= 1) {
#pragma unroll
            for (int i = 0; i < 4; ++i) s[i] += __shfl_xor(s[i], o); }
#pragma unroll
        for (int i = 0; i < 4; ++i) { const float rstd = 1.0f / sqrtf(s[i] * (1.0f / DM) + EPS); f32x4* xr = (f32x4*)(out + (size_t)(row0 + i) * DM) + lane;
#pragma unroll
            for (int j = 0; j < 4; ++j) xr[64 * j] = v[i][j] * rstd * gv[j]; }
    }
}

#define RLX_AGENT __ATOMIC_RELAXED, __HIP_MEMORY_SCOPE_AGENT
#define XB_TMO      128
#define XB_XCNT(j)  (256  + 64 * (j))
#define XB_XSUB(j)  (1280 + 64 * (j))
#define XB_XGEN(j)  (2304 + 64 * (j))
#define XB_TOP      3328
#define XB_TOPGEN   3392
#define XCD_BAR_WORDS 3456
#define XB_SPIN_CAP (1u << 18)

__device__ __forceinline__ unsigned xb_ld(unsigned* p)              { return __hip_atomic_load(p, __ATOMIC_RELAXED, __HIP_MEMORY_SCOPE_AGENT); }
__device__ __forceinline__ unsigned xb_add(unsigned* p, unsigned v) { return __hip_atomic_fetch_add(p, v, __ATOMIC_RELAXED, __HIP_MEMORY_SCOPE_AGENT); }
__device__ __forceinline__ unsigned xb_xcc_id() { return (unsigned)__builtin_amdgcn_s_getreg((3 << 11) | 20) & 0xFu; }
#define XB_SPIN(cond, bar) do { unsigned _sp = 0; while (cond) { __builtin_amdgcn_s_sleep(1); \
    if ((++_sp & 255u) == 0u) { if (xb_ld(&(bar)[XB_TMO])) break; if (_sp > XB_SPIN_CAP) { atomicAdd(&(bar)[XB_TMO], 1u); break; } } } } while (0)

struct XcdBarrier {
    unsigned* bar; unsigned x;
    volatile LAS unsigned* st;
};

__device__ __forceinline__ XcdBarrier xcd_barrier_post(unsigned* bar, volatile LAS unsigned* st) {
    XcdBarrier b; b.bar = bar; b.x = xb_xcc_id(); b.st = st;
    if (threadIdx.x == 0) (void)xb_add(&bar[XB_XCNT(b.x)], 1u);
    return b;
}
__device__ __forceinline__ void xcd_barrier_complete(unsigned* bar, unsigned x, unsigned& nloc, unsigned& nx) {
    const unsigned G = gridDim.x * gridDim.y * gridDim.z;
    unsigned sum, cnt, mine, sp = 0u;
    for (;;) {
        sum = 0u; cnt = 0u; mine = 0u;
#pragma unroll
        for (unsigned j = 0; j < 16; ++j) { const unsigned c = xb_ld(&bar[XB_XCNT(j)]); sum += c; cnt += (c > 0u) ? 1u : 0u; mine = (j == x) ? c : mine; }
        if (sum == G) break;
        __builtin_amdgcn_s_sleep(1);
        if ((++sp & 255u) == 0u) { if (xb_ld(&bar[XB_TMO])) break; if (sp > XB_SPIN_CAP) { atomicAdd(&bar[XB_TMO], 1u); break; } }
    }
    nloc = mine > 0u ? mine : 1u; nx = cnt > 0u ? cnt : 1u;
}

__device__ __forceinline__ void xcd_barrier(const XcdBarrier& b) {
    asm volatile("s_waitcnt vmcnt(0)" ::: "memory");
    __syncthreads();
    if (threadIdx.x == 0) {
        unsigned* bar = b.bar;
        __builtin_amdgcn_s_waitcnt(0);
        unsigned nloc = b.st[0], nx = b.st[1];
        if (nloc == 0u) { xcd_barrier_complete(bar, b.x, nloc, nx); b.st[0] = nloc; b.st[1] = nx; }
        const unsigned old = xb_add(&bar[XB_XSUB(b.x)], 1u);
        const unsigned gen = old / nloc;
        if (old + 1u == (gen + 1u) * nloc) {
            __builtin_amdgcn_fence(__ATOMIC_RELEASE, "agent");
            asm volatile("s_waitcnt vmcnt(0)" ::: "memory");
            const unsigned og = xb_add(&bar[XB_TOP], 1u);
            const unsigned tg = og / nx;
            if (og + 1u == (tg + 1u) * nx) xb_add(&bar[XB_TOPGEN], 1u);
            else XB_SPIN(xb_ld(&bar[XB_TOPGEN]) == tg, bar);
            __builtin_amdgcn_fence(__ATOMIC_ACQUIRE, "agent");
            xb_add(&bar[XB_XGEN(b.x)], 1u);
            asm volatile("s_waitcnt vmcnt(0)" ::: "memory");
        } else {
            XB_SPIN(xb_ld(&bar[XB_XGEN(b.x)]) == gen, bar);
            __builtin_amdgcn_fence(__ATOMIC_ACQUIRE, "agent");
            asm volatile("s_waitcnt vmcnt(0)" ::: "memory");
        }
    }
    __syncthreads();
}

__global__ void __launch_bounds__(NTHREADS, 2) hybrid_fwd(Args A) {
    extern __shared__ __attribute__((aligned(16))) unsigned char lds[];
    cg::grid_group grid = cg::this_grid();
    LAS unsigned char* L = (LAS unsigned char*)lds;
    unsigned char* ws = A.ws;
    const int G = gridDim.x;
    float* XL = A.out; float* XC = (float*)(ws + WS_XC);
    bf16_t* XN = (bf16_t*)(ws + WS_XN); bf16_t* ACT = (bf16_t*)(ws + WS_ACT);
    const float* gatef = (const float*)(ws + WS_GATE);

    const int wv = __builtin_amdgcn_readfirstlane((int)threadIdx.x >> 6);
    volatile LAS unsigned* MISC = (volatile LAS unsigned*)(L + 131072 + 320);
    if (threadIdx.x < 32) MISC[threadIdx.x] = 0u;
    __syncthreads();
    XcdBarrier xbar = xcd_barrier_post((unsigned*)ws + 4096, MISC + 8);
#define GSYNC() xcd_barrier(xbar)
#pragma unroll 1
    for (int l = 0; l < 4; ++l) { phase_prep(A, L, l, (int)((blockIdx.x + 64 * l) % G), G, wv); LBAR(); }
    if (A.out == nullptr) grid.sync();
    for (int rep = 0; rep < DUP_SYNC; ++rep) GSYNC();
#pragma unroll 1
    for (int layer = 0; layer < 4; ++layer) {
        ws = ows(ws);
        const int kind = layer == 3 ? 0 : layer;
        const int Nin = kind == 0 ? 2560 : (kind == 1 ? 2048 : 4096);
        const float* xinL = layer == 0 ? A.in[0] : XL; const float* xinC = layer == 0 ? A.in[2] : XC;
        for (int rep = 0; rep < DUP_NORM; ++rep) phase_norm(A, layer, xinL, xinC, L, wv);
        GSYNC();
        {
            const bf16_t* Wt = (const bf16_t*)(ws + (layer == 0 ? WS_WIN[0] : layer == 1 ? WS_WIN[1] : layer == 2 ? WS_WIN[2] : WS_WIN[3]));
            pg8::Gemm g{XN, Wt, layer == 3 ? ML : MT, Nin, DM};
            pg8::OrderG S; S.so.init(layer == 3 ? ML : MT, Nin, G, (int)blockIdx.x); S.extra = layer == 3 ? 16 : 0;
            pg8::EpiIn E{ACT, Nin, kind, (const float*)(ws + WS_ROPE)};
            for (int rep = 0; rep < DUP_GIN; ++rep) pg8::gemm_phase<pg8::EpiIn, pg8::OrderG, true, true>(L, g, S, E, wv);
        }
        GSYNC();
        if (kind == 0) { for (int rep = 0; rep < DUP_ATTN; ++rep) phase_attn(ACT, XN, (layer == 0 ? A.in[9] : A.in[34]), layer == 0, L, wv); }
        else if (kind == 1) { for (int rep = 0; rep < DUP_LRU; ++rep) phase_lru(A, ACT, XN, (float*)(ws + WS_HF), L, wv); }
        else { for (int rep = 0; rep < DUP_CONV; ++rep) phase_conv(A, ACT, XN, wv); }
        GSYNC();
        {
            const bf16_t* Wt = (const bf16_t*)(ws + (layer == 0 ? WS_WOUT[0] : layer == 1 ? WS_WOUT[1] : layer == 2 ? WS_WOUT[2] : WS_WOUT[3]));
            const int Mo = (CTX_SMALL || layer == 3) ? ML : MT;
            pg8::Gemm g{XN, Wt, Mo, DM, DM};
            pg8::OrderG S; S.so.init(Mo, DM, G, (int)blockIdx.x); S.extra = 0;
            pg8::EpiRes E{xinL, xinC, XL, XC, gatef + (size_t)layer * 9 * 1024};
            const bool ctx_first = (blockIdx.x & 1) != 0;
#pragma unroll 1
            for (int step = 0; step < 2; ++step) {
                if ((step == 0) == ctx_first) { if (CTX_SMALL && layer < 3) phase_ctx_wout(XN + (size_t)ML * DM, Wt, xinC, XC, gatef + (size_t)(layer * 9 + 8) * 1024, L, wv); }
                else pg8::gemm_phase<pg8::EpiRes, pg8::OrderG, true, true>(L, g, S, E, wv);
            }
        }
        GSYNC();
    }
    phase_final(XL, A.in[35], wv);
}

extern "C" void kernel_launch(void* const* d_in, const int* in_sizes, int n_in, void* d_out, int out_size, void* d_ws, size_t ws_size, hipStream_t stream) {
    static int grid = 0;
    if (grid == 0) {
        if (n_in != 36 || out_size != ML * DM || ws_size < WS_END) { fprintf(stderr, "kernel_launch: unexpected shapes (n_in %d, out %d, ws %zu)\n", n_in, out_size, ws_size); grid = -1; return; }
        int dev = 0, cus = 0, per_cu = 0;
        hipGetDevice(&dev); hipDeviceGetAttribute(&cus, hipDeviceAttributeMultiprocessorCount, dev);
        if (hipFuncSetAttribute((const void*)hybrid_fwd, hipFuncAttributeMaxDynamicSharedMemorySize, LDS_BYTES) != hipSuccess) { fprintf(stderr, "kernel_launch: hipFuncSetAttribute failed\n"); grid = -1; return; }
        if (hipOccupancyMaxActiveBlocksPerMultiprocessor(&per_cu, (const void*)hybrid_fwd, NTHREADS, LDS_BYTES) != hipSuccess || per_cu < 1) { fprintf(stderr, "kernel_launch: occupancy query says %d\n", per_cu); per_cu = 1; }
        (void)hipGetLastError();
        grid = cus * (per_cu > 1 ? 1 : per_cu);
        if (grid > 256) grid = 256;
    }
    if (grid < 0) return;
    if (hipMemsetAsync(d_ws, 0, 65536, stream) != hipSuccess) { fprintf(stderr, "kernel_launch: memset failed\n"); return; }
    Args a{};
    for (int i = 0; i < 36; ++i) a.in[i] = (const float*)d_in[i];
    a.out = (float*)d_out; a.ws = (unsigned char*)d_ws;
    void* args[] = {&a};
    hipError_t e = hipLaunchCooperativeKernel((const void*)hybrid_fwd, dim3(grid), dim3(NTHREADS), args, LDS_BYTES, stream);
    if (e != hipSuccess) fprintf(stderr, "kernel_launch: cooperative launch failed: %s (grid %d)\n", hipGetErrorString(e), grid);
}
```

```cpp
#include <hip/hip_runtime.h>
#include <hip/hip_cooperative_groups.h>
#include <cstdio>
#include <cstdint>
namespace cg = cooperative_groups;

namespace pg8 {
#define PG8_LAS __attribute__((address_space(3)))
typedef unsigned short bf16_t;
typedef short bf16x8 __attribute__((ext_vector_type(8)));
typedef float f32x4 __attribute__((ext_vector_type(4)));
typedef unsigned u32x4 __attribute__((ext_vector_type(4)));
constexpr int BM = 256, BK = 64, HALF = 128, HTB = HALF * BK * 2  , STAGE_BYTES = 8 * HTB, NXCD = 8, WGM = 8;

__host__ __device__ __forceinline__ int lds_byte(int r, int c) { const int st = (r >> 4) * 2 + (c >> 5), rr = r & 15, cc = c & 31, ob = rr * 64 + cc * 2; return st * 1024 + (ob ^ (((ob >> 9) & 1) << 5)); }
__host__ __device__ __forceinline__ void stage_rc(int b, int& R, int& C) { const int st = b / 1024, sb = b % 1024, swz = sb ^ (((sb >> 9) & 1) << 5); R = (st >> 1) * 16 + swz / 64; C = (st & 1) * 32 + (swz % 64) / 2; }
__host__ __device__ __forceinline__ int perm32(int rho) { const int n = rho >> 4, i = rho & 15; return 8 * (i >> 2) + 4 * n + (i & 3); }

struct Unit { int pm, pn; };
struct Gemm { const bf16_t* A; const bf16_t* Bt; int M, N, K; };

struct StaticOrder {
    int nM, nN, nwg, G, c;
    __host__ __device__ void init(int M, int N, int G_, int c_) { nM = M / BM; nN = N / BM; nwg = nM * nN; G = G_; c = c_; }
    __host__ __device__ bool next(int i, Unit& u) const {
        const long L = (long)i * G + c; if (L >= nwg) return false;
        int wgid = (int)L; { const int q = nwg / NXCD, r = nwg % NXCD, xcd = wgid % NXCD, off = wgid / NXCD; wgid = (xcd < r ? xcd * (q + 1) : r * (q + 1) + (xcd - r) * q) + off; }
        const int nig = WGM * nN, gid = wgid / nig, fm = gid * WGM, gsz = (nM - fm) < WGM ? (nM - fm) : WGM;
        u.pm = fm + ((wgid % nig) % gsz); u.pn = (wgid % nig) / gsz; return true;
    }
    __device__ __forceinline__ void a_ready(const Unit&) const {}
    __device__ __forceinline__ void done(const Unit&) const {}
};

__device__ __forceinline__ unsigned cvt_pk_bf16(float lo, float hi) { unsigned r; asm volatile("v_cvt_pk_bf16_f32 %0, %1, %2" : "=v"(r) : "v"(lo), "v"(hi)); return r; }
typedef float f32x2 __attribute__((ext_vector_type(2)));
__device__ __forceinline__ float silu_f(float v) { return v * __builtin_amdgcn_rcpf(1.0f + __builtin_amdgcn_exp2f(-v * 1.4426950408889634f)); }
constexpr float QSCALE = 0.125f * 1.4426950408889634f;

struct OrderG {
    StaticOrder so; int extra;
    __device__ __forceinline__ bool next(int i, Unit& u) const {
        long L = (long)i * so.G + so.c; if (L < so.nwg) return so.next(i, u);
        L -= so.nwg; if (L >= extra) return false; u.pm = 64 + (int)(L >> 1); u.pn = 4 + (int)(L & 1); return true;
    }
    __device__ __forceinline__ void a_ready(const Unit&) const {}
    __device__ __forceinline__ void done(const Unit&) const {}
};

struct EpiIn {
    static constexpr bool PERM = true, AFTER_DRAIN = false;
    bf16_t* O; int ldc; int kind; const float* rope;
    __device__ __forceinline__ void operator()(const f32x4 (&acc)[2][2][4][2], const Unit& u, int wr, int wc, int fr, int fq) const {
        const int colt = u.pn * BM; const bool lat = u.pm < 64;
        int mode = 0; float sc = 1.f;
        if (kind == 0) { if (colt < 1024) { mode = lat ? 2 : 0; sc = QSCALE; } else if (colt < 1280) mode = lat ? 2 : 0; else if (colt < 1536) mode = 0; else mode = 1; }
        else if (kind == 1) mode = colt < 1024 ? 0 : 1;
        else mode = colt < 3072 ? 0 : 1;
        const int row0 = u.pm * BM + wr * 64 + fr; const int col0 = colt + wc * 32 + 8 * fq;
        const float sgn = (fq < 2) ? -1.f : 1.f;
#pragma unroll
        for (int ai = 0; ai < 2; ++ai)
#pragma unroll
            for (int m = 0; m < 4; ++m) {
                const int row = row0 + ai * HALF + m * 16;
                bf16_t* rowp = O + (size_t)row * ldc + col0;
                f32x4 cs[4];
                if (mode == 2) { const int l = row & 2047; const int p = (wc & 1) ? (l & 63) : (l >> 6); const f32x4* rp = (const f32x4*)(rope + (p * 16 + 8 * (fq & 1)) * 2);
                    cs[0] = rp[0]; cs[1] = rp[1]; cs[2] = rp[2]; cs[3] = rp[3]; }
#pragma unroll
                for (int bj = 0; bj < 2; ++bj) {
                    f32x4 v0 = acc[ai][bj][m][0], v1 = acc[ai][bj][m][1];
                    if (mode == 1) {
#pragma unroll
                        for (int e = 0; e < 4; ++e) { v0[e] = silu_f(v0[e]); v1[e] = silu_f(v1[e]); }
                    } else if (mode == 2) {
                        f32x4 p0, p1;
#pragma unroll
                        for (int e = 0; e < 4; ++e) { p0[e] = __shfl_xor(v0[e], 32); p1[e] = __shfl_xor(v1[e], 32); }
                        v0[0] = v0[0] * cs[0][0] + sgn * p0[0] * cs[0][1]; v0[1] = v0[1] * cs[0][2] + sgn * p0[1] * cs[0][3];
                        v0[2] = v0[2] * cs[1][0] + sgn * p0[2] * cs[1][1]; v0[3] = v0[3] * cs[1][2] + sgn * p0[3] * cs[1][3];
                        v1[0] = v1[0] * cs[2][0] + sgn * p1[0] * cs[2][1]; v1[1] = v1[1] * cs[2][2] + sgn * p1[1] * cs[2][3];
                        v1[2] = v1[2] * cs[3][0] + sgn * p1[2] * cs[3][1]; v1[3] = v1[3] * cs[3][2] + sgn * p1[3] * cs[3][3];
                    }
                    v0 = v0 * sc; v1 = v1 * sc;
                    u32x4 w; w.x = cvt_pk_bf16(v0[0], v0[1]); w.y = cvt_pk_bf16(v0[2], v0[3]); w.z = cvt_pk_bf16(v1[0], v1[1]); w.w = cvt_pk_bf16(v1[2], v1[3]);
                    *(u32x4*)(rowp + bj * HALF) = w;
                }
            }
    }
};

struct EpiRes {
    static constexpr bool PERM = true, AFTER_DRAIN = false;
    const float* inL; const float* inC; float* outL; float* outC; const float* gate;
    __device__ __forceinline__ void operator()(const f32x4 (&acc)[2][2][4][2], const Unit& u, int wr, int wc, int fr, int fq) const {
        const bool lat = u.pm < 64;
        const float* ib = lat ? inL + (size_t)u.pm * BM * 1024 : inC + (size_t)(u.pm - 64) * BM * 1024;
        float* ob = lat ? outL + (size_t)u.pm * BM * 1024 : outC + (size_t)(u.pm - 64) * BM * 1024;
        const float* g = gate + (lat ? (u.pm >> 3) : 8) * 1024;
        const int col0 = u.pn * BM + wc * 32 + 8 * fq;
        f32x4 gv[2][2];
#pragma unroll
        for (int bj = 0; bj < 2; ++bj)
#pragma unroll
            for (int n = 0; n < 2; ++n) gv[bj][n] = *(const f32x4*)(g + col0 + bj * HALF + n * 4);
#pragma unroll
        for (int ai = 0; ai < 2; ++ai)
#pragma unroll
            for (int mp = 0; mp < 2; ++mp) {
                f32x4 xv[2][2][2];
#pragma unroll
                for (int mm = 0; mm < 2; ++mm) { const size_t off = (size_t)(ai * HALF + wr * 64 + (2 * mp + mm) * 16 + fr) * 1024 + col0;
#pragma unroll
                    for (int bj = 0; bj < 2; ++bj)
#pragma unroll
                        for (int n = 0; n < 2; ++n) xv[mm][bj][n] = __builtin_nontemporal_load((const f32x4*)(ib + off + bj * HALF + n * 4)); }
#pragma unroll
                for (int mm = 0; mm < 2; ++mm) { const int m = 2 * mp + mm; const size_t off = (size_t)(ai * HALF + wr * 64 + m * 16 + fr) * 1024 + col0;
#pragma unroll
                    for (int bj = 0; bj < 2; ++bj)
#pragma unroll
                        for (int n = 0; n < 2; ++n) *(f32x4*)(ob + off + bj * HALF + n * 4) = xv[mm][bj][n] + gv[bj][n] * acc[ai][bj][m][n]; }
                asm volatile("" ::: "memory"); }
    }
};

template <class Epi, class Sched, bool ALIGN_EPI = false, bool SP2 = false>
__device__ __forceinline__ void gemm_phase(PG8_LAS unsigned char* lds, const Gemm g, const Sched& S, const Epi& E, const int wv_) {
    int tid_ = wv_ * 64 + (int)__builtin_amdgcn_mbcnt_hi(~0u, __builtin_amdgcn_mbcnt_lo(~0u, 0u)); asm volatile("" : "+v"(tid_));
    const int tid = tid_, wid = __builtin_amdgcn_readfirstlane(tid >> 6), lane = tid & 63, wr = wid >> 2, wc = wid & 3, fr = lane & 15, fq = lane >> 4;
    const int K = g.K, nt = K / BK;
    unsigned voffA[2], voffB[2];
#pragma unroll
    for (int i = 0; i < 2; ++i) { int R, C; stage_rc(tid * 16 + i * 8192, R, C); const int Rb = Epi::PERM ? ((R & ~31) + perm32(R & 31)) : R;
        voffA[i] = (unsigned)(R * K + C) * 2u; voffB[i] = (unsigned)(Rb * K + C) * 2u; }
    const size_t kstep = (size_t)(BK * 2);
    const size_t hstep = (size_t)HALF * K * 2;
    const size_t tstep = 2 * hstep;
    const unsigned ldsw = (unsigned)wid * 1024u;
    const int aoff = lds_byte(wr * 64 + fr, fq * 8), boff = lds_byte(wc * 32 + fr, fq * 8);
#define PG8_SA(b, h) (((b) * 2 + (h)) * HTB)
#define PG8_SB(b, h) ((4 + (b) * 2 + (h)) * HTB)
#define PG8_STAGE(bufoff, gbase, voff) do { _Pragma("unroll") for (int _i = 0; _i < 2; ++_i) \
        __builtin_amdgcn_global_load_lds((const unsigned*)((const char*)(gbase) + (voff)[_i]), (PG8_LAS unsigned*)(lds + (bufoff) + ldsw + _i * 8192), 16, 0, 0); } while (0)
#define PG8_LDA(dst, b, h) do { _Pragma("unroll") for (int m = 0; m < 4; ++m) _Pragma("unroll") for (int k = 0; k < 2; ++k) dst[m][k] = *(const PG8_LAS bf16x8*)(lds + PG8_SA(b, h) + aoff + m * 2048 + k * 1024); } while (0)
#define PG8_LDB(dst, b, h) do { _Pragma("unroll") for (int n = 0; n < 2; ++n) _Pragma("unroll") for (int k = 0; k < 2; ++k) dst[n][k] = *(const PG8_LAS bf16x8*)(lds + PG8_SB(b, h) + boff + n * 2048 + k * 1024); } while (0)
#define PG8_MMA(ai, bj, At, Bt) do { __builtin_amdgcn_s_setprio(1); _Pragma("unroll") for (int m = 0; m < 4; ++m) _Pragma("unroll") for (int n = 0; n < 2; ++n) _Pragma("unroll") for (int k = 0; k < 2; ++k) \
        acc[ai][bj][m][n] = __builtin_amdgcn_mfma_f32_16x16x32_bf16(Bt[n][k], At[m][k], acc[ai][bj][m][n], 0, 0, 0); __builtin_amdgcn_s_setprio(0); } while (0)
#define PG8_WAIT_V(n) asm volatile("s_waitcnt vmcnt(" #n ")" ::: "memory")
#define PG8_WAIT_L(n) asm volatile("s_waitcnt lgkmcnt(" #n ")" ::: "memory")
#define PG8_BAR __builtin_amdgcn_s_barrier()
#define PG8_SCHED __builtin_amdgcn_sched_barrier(0)
    Unit cur, nxt; int ui = 0;
    if (!S.next(0, cur)) return;
    f32x4 acc[2][2][4][2];
#pragma unroll
    for (int a = 0; a < 2; ++a)
#pragma unroll
        for (int b = 0; b < 2; ++b)
#pragma unroll
            for (int m = 0; m < 4; ++m)
#pragma unroll
                for (int n = 0; n < 2; ++n) acc[a][b][m][n] = (f32x4){0.f, 0.f, 0.f, 0.f};
    bf16x8 At[4][2], B0[2][2], B1[2][2];
    const char* cA = (const char*)g.A + (size_t)cur.pm * tstep; const char* cB = (const char*)g.Bt + (size_t)cur.pn * tstep;
    S.a_ready(cur);
    if constexpr (SP2) {
        PG8_STAGE(PG8_SB(0, 0), cB, voffB); PG8_STAGE(PG8_SB(0, 1), cB + hstep, voffB); PG8_STAGE(PG8_SA(0, 0), cA, voffA); PG8_STAGE(PG8_SA(0, 1), cA + hstep, voffA);
        if (wr == 1) PG8_BAR;
        PG8_WAIT_V(2); PG8_BAR;
        PG8_STAGE(PG8_SB(1, 0), cB + kstep, voffB); PG8_STAGE(PG8_SA(1, 0), cA + kstep, voffA); PG8_STAGE(PG8_SB(1, 1), cB + hstep + kstep, voffB);
        PG8_WAIT_V(6); PG8_BAR;
    } else {
        PG8_STAGE(PG8_SB(0, 0), cB, voffB); PG8_STAGE(PG8_SA(0, 0), cA, voffA); PG8_STAGE(PG8_SB(0, 1), cB + hstep, voffB); PG8_STAGE(PG8_SA(0, 1), cA + hstep, voffA);
        if (wr == 1) PG8_BAR;
        PG8_WAIT_V(4); PG8_BAR;
        PG8_STAGE(PG8_SB(1, 0), cB + kstep, voffB); PG8_STAGE(PG8_SA(1, 0), cA + kstep, voffA); PG8_STAGE(PG8_SB(1, 1), cB + hstep + kstep, voffB);
        PG8_WAIT_V(6); PG8_BAR;
    }
    for (;;) {
        const bool has_next = S.next(ui + 1, nxt);
        const char* nA = has_next ? (const char*)g.A + (size_t)nxt.pm * tstep : cA; const char* nB = has_next ? (const char*)g.Bt + (size_t)nxt.pn * tstep : cB;
        for (int t = 0; t < nt; t += 2) {
            const bool last = (t == nt - 2);
            const char* a1 = cA + (size_t)(t + 1) * kstep;
            const char* a2 = last ? nA : cA + (size_t)(t + 2) * kstep; const char* b2 = last ? nB : cB + (size_t)(t + 2) * kstep;
            const char* a3 = a2 + kstep; const char* b3 = b2 + kstep;
            if (last && has_next) S.a_ready(nxt);
            if constexpr (SP2) {
            PG8_LDB(B0, 0, 0); PG8_LDB(B1, 0, 1); PG8_SCHED; PG8_LDA(At, 0, 0); PG8_STAGE(PG8_SA(1, 1), a1 + hstep, voffA);
            PG8_WAIT_V(8); PG8_WAIT_L(0); PG8_BAR; PG8_MMA(0, 0, At, B0); PG8_MMA(0, 1, At, B1); PG8_BAR; PG8_SCHED;
            PG8_LDA(At, 0, 1); PG8_STAGE(PG8_SB(0, 0), b2, voffB); PG8_STAGE(PG8_SB(0, 1), b2 + hstep, voffB); PG8_STAGE(PG8_SA(0, 0), a2, voffA);
            PG8_WAIT_V(8); PG8_WAIT_L(0); PG8_BAR; PG8_MMA(1, 0, At, B0); PG8_MMA(1, 1, At, B1); PG8_BAR; PG8_SCHED;
            PG8_LDB(B0, 1, 0); PG8_LDB(B1, 1, 1); PG8_SCHED; PG8_LDA(At, 1, 0); PG8_STAGE(PG8_SA(0, 1), a2 + hstep, voffA);
            PG8_WAIT_V(8); PG8_WAIT_L(0); PG8_BAR; PG8_MMA(0, 0, At, B0); PG8_MMA(0, 1, At, B1); PG8_BAR; PG8_SCHED;
            PG8_LDA(At, 1, 1); PG8_STAGE(PG8_SB(1, 0), b3, voffB); PG8_STAGE(PG8_SB(1, 1), b3 + hstep, voffB); PG8_STAGE(PG8_SA(1, 0), a3, voffA);
            PG8_WAIT_V(8); PG8_WAIT_L(0); PG8_BAR; PG8_MMA(1, 0, At, B0); PG8_MMA(1, 1, At, B1); PG8_BAR; PG8_SCHED;
            } else {
            PG8_LDB(B0, 0, 0); PG8_SCHED; PG8_LDA(At, 0, 0); PG8_STAGE(PG8_SA(1, 1), a1 + hstep, voffA);
            PG8_WAIT_L(8); PG8_BAR; PG8_WAIT_L(0); PG8_MMA(0, 0, At, B0); PG8_BAR; PG8_SCHED;
            PG8_LDB(B1, 0, 1); PG8_STAGE(PG8_SB(0, 0), b2, voffB);
            PG8_BAR; PG8_WAIT_L(0); PG8_MMA(0, 1, At, B1); PG8_BAR;
            PG8_LDA(At, 0, 1); PG8_STAGE(PG8_SA(0, 0), a2, voffA);
            PG8_BAR; PG8_WAIT_L(0); PG8_MMA(1, 0, At, B0); PG8_BAR; PG8_SCHED;
            PG8_STAGE(PG8_SB(0, 1), b2 + hstep, voffB);
            PG8_WAIT_V(6); PG8_BAR; PG8_MMA(1, 1, At, B1); PG8_BAR;
            PG8_LDB(B0, 1, 0); PG8_SCHED; PG8_LDA(At, 1, 0); PG8_STAGE(PG8_SA(0, 1), a2 + hstep, voffA);
            PG8_WAIT_L(8); PG8_BAR; PG8_WAIT_L(0); PG8_MMA(0, 0, At, B0); PG8_BAR; PG8_SCHED;
            PG8_LDB(B1, 1, 1); PG8_STAGE(PG8_SB(1, 0), b3, voffB);
            PG8_BAR; PG8_WAIT_L(0); PG8_MMA(0, 1, At, B1); PG8_BAR;
            PG8_LDA(At, 1, 1); PG8_STAGE(PG8_SA(1, 0), a3, voffA);
            PG8_BAR; PG8_WAIT_L(0); PG8_MMA(1, 0, At, B0); PG8_BAR; PG8_SCHED;
            PG8_STAGE(PG8_SB(1, 1), b3 + hstep, voffB);
            PG8_WAIT_V(6); PG8_BAR; PG8_MMA(1, 1, At, B1); PG8_BAR;
            }
        }
        if constexpr (ALIGN_EPI) { if (wr == 0) PG8_BAR; }
        if constexpr (!Epi::AFTER_DRAIN) { E(acc, cur, wr, wc, fr, fq); S.done(cur); }
        if (!has_next) break;
#pragma unroll
        for (int a = 0; a < 2; ++a)
#pragma unroll
            for (int b = 0; b < 2; ++b)
#pragma unroll
                for (int m = 0; m < 4; ++m)
#pragma unroll
                    for (int n = 0; n < 2; ++n) acc[a][b][m][n] = (f32x4){0.f, 0.f, 0.f, 0.f};
        cur = nxt; cA = nA; cB = nB; ++ui;
        if constexpr (ALIGN_EPI) { if (wr == 1) PG8_BAR; }
    }
    PG8_WAIT_V(0);
    if constexpr (!ALIGN_EPI) { if (wr == 0) PG8_BAR; }
    PG8_BAR;
    if constexpr (Epi::AFTER_DRAIN) { E.fused(acc, cur, wr, wc, fr, fq, lds, wid, lane); S.done(cur); }
#undef PG8_SA
#undef PG8_SB
#undef PG8_STAGE
#undef PG8_LDA
#undef PG8_LDB
#undef PG8_MMA
#undef PG8_WAIT_V
#undef PG8_WAIT_L
#undef PG8_BAR
#undef PG8_SCHED
}
}

#define LAS __attribute__((address_space(3)))
typedef unsigned short bf16_t;
typedef short bf16x8 __attribute__((ext_vector_type(8)));
typedef short s16x4 __attribute__((ext_vector_type(4)));
typedef float f32x4 __attribute__((ext_vector_type(4)));
typedef float f32x2 __attribute__((ext_vector_type(2)));
typedef float f32x16 __attribute__((ext_vector_type(16)));
typedef unsigned u32x4 __attribute__((ext_vector_type(4)));
typedef unsigned u32x2 __attribute__((ext_vector_type(2)));

#ifndef DUP_ATTN
#define DUP_ATTN 1
#endif
#ifndef DUP_LRU
#define DUP_LRU 1
#endif
#ifndef DUP_CONV
#define DUP_CONV 1
#endif
#ifndef DUP_GIN
#define DUP_GIN 1
#endif
#ifndef DUP_NORM
#define DUP_NORM 1
#endif
#ifndef DUP_PRO
#define DUP_PRO 1
#endif
#ifndef DUP_GOUT0
#define DUP_GOUT0 1
#endif
#ifndef DUP_LRUBC
#define DUP_LRUBC 1
#endif
#ifndef DUP_ATTEPI
#define DUP_ATTEPI 1
#endif
#ifndef DUP_SYNC
#define DUP_SYNC 1
#endif
#ifndef CTX_SMALL
#define CTX_SMALL 1
#endif
constexpr int NTHREADS = 512, NWAVES = 8;
constexpr int DM = 1024, NB = 8, SEQ = 2048, CTX = 256;
constexpr int ML = NB * SEQ, MC = NB * CTX, MT = ML + MC;
constexpr float EPS = 1e-6f, LOG2E = 1.4426950408889634f;
constexpr int LDS_BYTES = 147456;

constexpr size_t MiB = 1u << 20;
constexpr size_t WS_MODP = 1 * MiB;
constexpr size_t WS_GATE = 5 * MiB;
constexpr size_t WS_ROPE = 5 * MiB + 512 * 1024;
constexpr size_t WS_GW = 6 * MiB;
constexpr size_t WS_WIN[4] = {8 * MiB, 15 * MiB, 21 * MiB, 31 * MiB};
constexpr size_t WS_WOUT[4] = {13 * MiB, 19 * MiB, 29 * MiB, 36 * MiB};
constexpr size_t WS_XC = 38 * MiB;
constexpr size_t WS_XN = 46 * MiB;
constexpr size_t WS_ACT = 82 * MiB;
constexpr size_t WS_HF = 154 * MiB;
constexpr size_t WS_END = 226 * MiB;

struct Args { const float* in[36]; float* out; unsigned char* ws; };

#define LBAR() do { asm volatile("s_waitcnt lgkmcnt(0)" ::: "memory"); __builtin_amdgcn_s_barrier(); asm volatile("" ::: "memory"); } while (0)

__device__ __forceinline__ unsigned f2bf(float f) { unsigned u = __builtin_bit_cast(unsigned, f); return (u + 0x7fffu + ((u >> 16) & 1u)) >> 16; }
__device__ __forceinline__ unsigned pk2(float lo, float hi) { return pg8::cvt_pk_bf16(lo, hi); }
__device__ __forceinline__ float bflo(unsigned w) { return __builtin_bit_cast(float, w << 16); }
__device__ __forceinline__ float bfhi(unsigned w) { return __builtin_bit_cast(float, w & 0xffff0000u); }
__device__ __forceinline__ unsigned char* ows(unsigned char* p) { const unsigned long long v = (unsigned long long)p; unsigned lo = __builtin_amdgcn_readfirstlane((unsigned)v), hi = __builtin_amdgcn_readfirstlane((unsigned)(v >> 32)); asm volatile("" : "+s"(lo), "+s"(hi)); return (unsigned char*)(__attribute__((address_space(1))) unsigned char*)(((unsigned long long)hi << 32) | lo); }
__device__ __forceinline__ int otid(int wv) { int t = wv * 64 + (int)__builtin_amdgcn_mbcnt_hi(~0u, __builtin_amdgcn_mbcnt_lo(~0u, 0u)); asm volatile("" : "+v"(t)); return t; }
__device__ __forceinline__ float wave_sum(float v) {
#pragma unroll
    for (int o = 1; o < 64; o <<= 1) v += __shfl_xor(v, o);
    return v;
}
using pg8::silu_f;

__device__ __forceinline__ void transpose_item(const float* W, int K, int N, bf16_t* WT, LAS float* scr, int item, int lane) {
    const int nblk = N / 32, kb = item / nblk, nb = item % nblk, k0 = 64 * kb, n0 = 32 * nb;
    float tv[32];
#pragma unroll
    for (int i = 0; i < 32; ++i) tv[i] = __builtin_nontemporal_load(W + (size_t)(k0 + 2 * i + (lane >> 5)) * N + n0 + (lane & 31));
#pragma unroll
    for (int i = 0; i < 32; ++i) scr[(2 * i + (lane >> 5)) * 33 + (lane & 31)] = tv[i];
    asm volatile("s_waitcnt lgkmcnt(0)" ::: "memory");
    const int c = lane & 7;
#pragma unroll
    for (int j = 0; j < 4; ++j) { const int n = (lane >> 3) + 8 * j; const LAS float* s = scr + (8 * c) * 33 + n;
        u32x4 o; o.x = pk2(s[0 * 33], s[1 * 33]); o.y = pk2(s[2 * 33], s[3 * 33]); o.z = pk2(s[4 * 33], s[5 * 33]); o.w = pk2(s[6 * 33], s[7 * 33]);
        *(u32x4*)(WT + (size_t)(n0 + n) * K + k0 + 8 * c) = o; }
    asm volatile("s_waitcnt lgkmcnt(0)" ::: "memory");
}

__device__ __forceinline__ void phase_prep(const Args& A, LAS unsigned char* L, int layer, int vbid, int vG, const int wv) {
    const int tid = otid(wv), lane = tid & 63, wave = tid >> 6;
    unsigned char* ws = ows(A.ws);
    const float* Wm = (layer == 0 ? A.in[5] : layer == 1 ? A.in[11] : layer == 2 ? A.in[23] : A.in[30]);
    for (int task = vbid; task < 48; task += vG) {
        const int cc = task >> 3, kc = task & 7;
        LAS float* s = (LAS float*)L;
        for (int idx = tid; idx < 9 * 128; idx += NTHREADS) { const int r = idx >> 7, kk = idx & 127;
            const float v = (r < 8) ? A.in[1][r * DM + kc * 128 + kk] : A.in[3][kc * 128 + kk];
            s[idx] = v / (1.0f + __expf(-v)); }
        LBAR();
        const int col = cc * 512 + tid;
        float acc[9];
#pragma unroll
        for (int r = 0; r < 9; ++r) acc[r] = 0.f;
        const float* wp = Wm + (size_t)(kc * 128) * 3072 + col;
#pragma unroll 32
        for (int kk = 0; kk < 128; ++kk) { const float w = __builtin_nontemporal_load(wp + (size_t)kk * 3072);
#pragma unroll
            for (int r = 0; r < 9; ++r) acc[r] += s[r * 128 + kk] * w; }
        float* mp = (float*)(ws + WS_MODP) + (size_t)((layer * 8 + kc) * 9) * 3072 + col;
#pragma unroll
        for (int r = 0; r < 9; ++r) mp[(size_t)r * 3072] = acc[r];
        LBAR();
    }
    if (layer == 0 && vbid == vG - 1) {
        float* rt = (float*)(ws + WS_ROPE);
        for (int idx = tid; idx < 1024; idx += NTHREADS) { const int p = idx >> 4, j = idx & 15;
            const float inv = 1.0f / __builtin_powf(10000.0f, (float)j * (1.0f / 16.0f));
            const float ang = (float)p * inv; float t = ang * 0.15915494309189535f; t -= __builtin_rintf(t);
            rt[idx * 2] = __builtin_amdgcn_cosf(t); rt[idx * 2 + 1] = __builtin_amdgcn_sinf(t); }
    }
    LAS float* scr = (LAS float*)(L + wave * 16384);
    const int rb = (vbid + vG - (48 % vG)) % vG;
    const int gw = rb * NWAVES + wave, NGW = vG * NWAVES;
    const int Nin = (layer == 0 || layer == 3) ? 2560 : (layer == 1 ? 2048 : 4096);
    const float* win = (layer == 0 ? A.in[7] : layer == 1 ? A.in[13] : layer == 2 ? A.in[25] : A.in[32]);
    const float* wout = (layer == 0 ? A.in[8] : layer == 1 ? A.in[14] : layer == 2 ? A.in[26] : A.in[33]);
    bf16_t* wint = (bf16_t*)(ws + (layer == 0 ? WS_WIN[0] : layer == 1 ? WS_WIN[1] : layer == 2 ? WS_WIN[2] : WS_WIN[3]));
    bf16_t* woutt = (bf16_t*)(ws + (layer == 0 ? WS_WOUT[0] : layer == 1 ? WS_WOUT[1] : layer == 2 ? WS_WOUT[2] : WS_WOUT[3]));
    const int IIN = 16 * (Nin / 32), IO = 16 * 32, IGW = layer == 0 ? 64 * 2 : 0;
    const int nitems = IIN + IO + IGW;
    for (int it = gw; it < nitems; it += NGW) {
        int r = it;
        if (r < IIN) { transpose_item(win, 1024, Nin, wint, scr, r, lane); continue; } r -= IIN;
        if (r < IO) { transpose_item(wout, 1024, 1024, woutt, scr, r, lane); continue; } r -= IO;
        { const int blk = r >> 1, sub = r & 1;
          const int dir = blk >> 5, gate = (blk >> 4) & 1, h = blk & 15;
          const float* src = (gate == 0 ? A.in[17] : A.in[19]) + (size_t)(dir * 16 + h) * 4096;
          transpose_item(src, 64, 64, (bf16_t*)(ws + WS_GW) + (size_t)blk * 4096, scr, sub, lane); }
    }
}

template <int NR> __device__ __forceinline__ void norm_rows(const float* const (&xrow)[NR], bf16_t* const (&orow)[NR], const LAS float* const (&gs)[NR], const LAS float* const (&sh)[NR], int lane) {
    f32x4 v[NR][4]; float s[NR];
#pragma unroll
    for (int i = 0; i < NR; ++i) { const f32x4* xr = (const f32x4*)xrow[i] + lane;
#pragma unroll
        for (int j = 0; j < 4; ++j) v[i][j] = __builtin_nontemporal_load(xr + 64 * j); }
#pragma unroll
    for (int i = 0; i < NR; ++i) { float a = 0.f;
#pragma unroll
        for (int j = 0; j < 4; ++j) a += (v[i][j].x * v[i][j].x + v[i][j].y * v[i][j].y) + (v[i][j].z * v[i][j].z + v[i][j].w * v[i][j].w);
        s[i] = a; }
#pragma unroll
    for (int o = 1; o < 64; o <<= 1) {
#pragma unroll
        for (int i = 0; i < NR; ++i) s[i] += __shfl_xor(s[i], o); }
#pragma unroll
    for (int i = 0; i < NR; ++i) { const float rstd = 1.0f / sqrtf(s[i] * (1.0f / DM) + EPS); u32x2* o8 = (u32x2*)orow[i] + lane;
#pragma unroll
        for (int j = 0; j < 4; ++j) { const f32x4 g = *(const LAS f32x4*)(gs[i] + 256 * j + 4 * lane), b = *(const LAS f32x4*)(sh[i] + 256 * j + 4 * lane);
            const f32x4 y = v[i][j] * rstd * g + b; u32x2 w; w.x = pk2(y.x, y.y); w.y = pk2(y.z, y.w); o8[64 * j] = w; } }
}
__device__ __forceinline__ void phase_norm(const Args& A, int layer, const float* xL, const float* xC, LAS unsigned char* L, const int wv) {
    const int tid = otid(wv), lane = tid & 63, wave = tid >> 6, bid = blockIdx.x, G = gridDim.x;
    const float* norm_g = (layer == 0 ? A.in[4] : layer == 1 ? A.in[10] : layer == 2 ? A.in[22] : A.in[29]);
    const float* mod_b = (layer == 0 ? A.in[6] : layer == 1 ? A.in[12] : layer == 2 ? A.in[24] : A.in[31]);
    unsigned char* ws = ows(A.ws);
    const float* modp = (const float*)(ws + WS_MODP) + (size_t)(layer * 8) * 9 * 3072;
    bf16_t* XN = (bf16_t*)(ws + WS_XN);
    LAS float* tab = (LAS float*)L;
    for (int vb = bid; vb < 256; vb += G) {
        const int batch = vb >> 5;
        { float bv[8], pv[8][8], gn[8];
#pragma unroll
          for (int i8 = 0; i8 < 8; ++i8) { const int idx = tid + i8 * NTHREADS; const int which = idx >> 10, col = idx & 1023; const int r = (which < 2) ? batch : 8; const int mcol = (which & 1) ? col : 1024 + col;
              bv[i8] = mod_b[mcol];
#pragma unroll
              for (int kc = 0; kc < 8; ++kc) pv[i8][kc] = modp[(size_t)(kc * 9 + r) * 3072 + mcol];
              gn[i8] = (which & 1) ? 0.f : norm_g[col]; }
#pragma unroll
          for (int i8 = 0; i8 < 8; ++i8) { const int idx = tid + i8 * NTHREADS; const int which = idx >> 10;
              float v = bv[i8];
#pragma unroll
              for (int kc = 0; kc < 8; ++kc) v += pv[i8][kc];
              if (!(which & 1)) v = gn[i8] * (1.0f + v);
              tab[idx] = v; } }
        if (vb < 9) { float* gf = (float*)(ws + WS_GATE) + (size_t)(layer * 9 + vb) * 1024;
            float gb[2], gp[2][8];
#pragma unroll
            for (int c2 = 0; c2 < 2; ++c2) { const int col = tid + c2 * NTHREADS; gb[c2] = mod_b[2048 + col];
#pragma unroll
                for (int kc = 0; kc < 8; ++kc) gp[c2][kc] = modp[(size_t)(kc * 9 + vb) * 3072 + 2048 + col]; }
#pragma unroll
            for (int c2 = 0; c2 < 2; ++c2) { float v = gb[c2];
#pragma unroll
                for (int kc = 0; kc < 8; ++kc) v += gp[c2][kc];
                gf[tid + c2 * NTHREADS] = v; } }
        LBAR();
#pragma unroll 1
        for (int bt = 0; bt < 3; ++bt) {
            const float* xr[3]; bf16_t* orow[3]; const LAS float* gs[3]; const LAS float* sh[3];
#pragma unroll
            for (int i = 0; i < 3; ++i) { const int ri = bt * 3 + i;
                if (ri < 8) { const int row = vb * 64 + wave * 8 + ri; xr[i] = xL + (size_t)row * DM; orow[i] = XN + (size_t)row * DM; gs[i] = tab; sh[i] = tab + 1024; }
                else { const int row = vb * 8 + wave; xr[i] = xC + (size_t)row * DM; orow[i] = XN + (size_t)(ML + row) * DM; gs[i] = tab + 2048; sh[i] = tab + 3072; } }
            norm_rows<3>(xr, orow, gs, sh, lane);
        }
        LBAR();
    }
}

#define MFMA32(a, b, c) __builtin_amdgcn_mfma_f32_32x32x16_bf16((a), (b), (c), 0, 0, 0)
#define MFMA16(a, b, c) __builtin_amdgcn_mfma_f32_16x16x32_bf16((a), (b), (c), 0, 0, 0)
__device__ __forceinline__ int crow(int r, int hi) { return (r & 3) + 8 * (r >> 2) + 4 * hi; }
typedef short v4i16_t __attribute__((ext_vector_type(4)));
__device__ __forceinline__ float max3f(float a, float b, float c) { float r; asm("v_max3_f32 %0, %1, %2, %3" : "=v"(r) : "v"(a), "v"(b), "v"(c)); return r; }
__device__ __forceinline__ s16x4 vtr(LAS const unsigned char* p) { return __builtin_bit_cast(s16x4, __builtin_amdgcn_ds_read_tr16_b64_v4i16((LAS v4i16_t*)p)); }

__device__ __forceinline__ void phase_attn(const bf16_t* ACT, bf16_t* Y, const float* sink, bool need_ctx, LAS unsigned char* L, const int wv) {
    constexpr int LD = 2560, KSTR = 144, TILEB = 64 * KSTR, BUFB = 2 * TILEB;
    const int tid = otid(wv), lane = tid & 63, r32 = lane & 31, hi = lane >> 5, wave = __builtin_amdgcn_readfirstlane(tid >> 6);
    const int g = wave >> 1, half = wave & 1, G = gridDim.x;
    const int skey = tid >> 3, sch = tid & 7;
    const int stoff = skey * KSTR + sch * 16;
    const int koff = r32 * KSTR + hi * 16;
    const int voff = TILEB + (4 * hi + ((lane & 15) >> 2)) * KSTR + (16 * ((lane >> 4) & 1) + 4 * (lane & 3)) * 2;
    const int nunits = need_ctx ? 1152 : 1024;
    for (int u = blockIdx.x; u < nunits; u += G) {
        int b, kvh, qb; bool lat;
        if (u < 1024) { b = u >> 7; kvh = (u >> 5) & 3; qb = u & 31; lat = true; } else { const int e = u - 1024; b = e >> 4; kvh = (e >> 2) & 3; qb = e & 3; lat = false; }
        const int h = kvh * 4 + g;
        const int qpos = qb * 64 + half * 32 + r32;
        const int qrow = lat ? b * SEQ + qpos : ML + b * CTX + qpos;
        int tlo = 4, thi = 4;
        if (lat) { tlo = qb == 0 ? 6 : (qb == 1 ? 5 : 4); thi = qb == 31 ? 7 : (qb == 30 ? 8 : 9); }
        const int n = 4 + (thi - tlo);
        const int kp_base = qb * 64 - 128;
        bf16x8 qf[4];
        { const bf16_t* qp = ACT + (size_t)qrow * LD + h * 64 + hi * 8;
#pragma unroll
          for (int d0 = 0; d0 < 4; ++d0) qf[d0] = *(const bf16x8*)(qp + d0 * 16); }
        float m_run = sink[h] * LOG2E, l_run = hi ? 0.f : 1.f;
        f32x16 o0, o1;
#pragma unroll
        for (int r = 0; r < 16; ++r) { o0[r] = 0.f; o1[r] = 0.f; }
        const size_t kcol = 1024 + kvh * 64 + sch * 8, vcol = 1280 + kvh * 64 + sch * 8;
#define ATT_TROW(s_) (((s_) < 4 ? ML + b * CTX + (s_) * 64 : b * SEQ + kp_base + (tlo + (s_) - 8) * 64) + skey)
        u32x4 kq0, vq0, kq1, vq1, kq2, vq2;
        { const size_t krow = (size_t)ATT_TROW(0); kq0 = *(const u32x4*)(ACT + krow * LD + kcol); vq0 = *(const u32x4*)(ACT + krow * LD + vcol); }
        { const size_t krow = (size_t)ATT_TROW(1); kq1 = *(const u32x4*)(ACT + krow * LD + kcol); vq1 = *(const u32x4*)(ACT + krow * LD + vcol); }
        { const size_t krow = (size_t)ATT_TROW(2); kq2 = *(const u32x4*)(ACT + krow * LD + kcol); vq2 = *(const u32x4*)(ACT + krow * LD + vcol); }
        LBAR();
        *(LAS u32x4*)(L + stoff) = kq0; *(LAS u32x4*)(L + TILEB + stoff) = vq0;
        { const size_t krow = (size_t)ATT_TROW(3); kq0 = *(const u32x4*)(ACT + krow * LD + kcol); vq0 = *(const u32x4*)(ACT + krow * LD + vcol); }
        LBAR();
#define ATT_STEP(s_, KQ, VQ) do { const int s = (s_); \
            const int t = s < 4 ? s : tlo + (s - 4); \
            LAS const unsigned char* B = L + (s & 1) * BUFB; \
 \
              \
            bf16x8 kf[8]; s16x4 vl[8], vh[8]; \
_Pragma("unroll") \
            for (int d0 = 0; d0 < 4; ++d0) { kf[2 * d0] = *(const LAS bf16x8*)(B + koff + d0 * 32); kf[2 * d0 + 1] = *(const LAS bf16x8*)(B + koff + 32 * KSTR + d0 * 32); } \
_Pragma("unroll") \
            for (int i = 0; i < 4; ++i) { LAS const unsigned char* vp = B + voff + i * 16 * KSTR; vl[2 * i] = vtr(vp); vh[2 * i] = vtr(vp + 8 * KSTR); vl[2 * i + 1] = vtr(vp + 64); vh[2 * i + 1] = vtr(vp + 8 * KSTR + 64); } \
            __builtin_amdgcn_sched_barrier(0); \
            f32x16 p0, p1; \
_Pragma("unroll") \
            for (int r = 0; r < 16; ++r) { p0[r] = 0.f; p1[r] = 0.f; } \
_Pragma("unroll") \
            for (int d0 = 0; d0 < 4; ++d0) { p0 = MFMA32(kf[2 * d0], qf[d0], p0); p1 = MFMA32(kf[2 * d0 + 1], qf[d0], p1); } \
            if (t == 4 || t == 8) { const int kp0 = kp_base + (t - 4) * 64 - qpos; \
_Pragma("unroll") \
                for (int r = 0; r < 16; ++r) { const int d0 = kp0 + crow(r, hi), d1 = d0 + 32; \
                    if (d0 > 128 || d0 < -128) p0[r] = -1e30f; if (d1 > 128 || d1 < -128) p1[r] = -1e30f; } } \
            float mt = max3f(p0[0], p0[1], p1[0]), mt2 = max3f(p0[2], p0[3], p1[1]); mt = max3f(mt, p1[2], p1[3]); \
_Pragma("unroll") \
            for (int r = 4; r < 16; r += 4) { mt = max3f(mt, p0[r], p0[r + 1]); mt2 = max3f(mt2, p0[r + 2], p0[r + 3]); mt = max3f(mt, p1[r], p1[r + 1]); mt2 = max3f(mt2, p1[r + 2], p1[r + 3]); } \
            mt = fmaxf(mt, mt2); \
            mt = fmaxf(mt, __shfl_xor(mt, 32)) - m_run; \
 \
            float dl = 0.f; \
            if (s == 0) dl = fmaxf(mt, 0.f); else if (mt > 8.0f) dl = mt; \
            if (__any(dl != 0.f)) { const float alpha = __builtin_amdgcn_exp2f(-dl); m_run += dl; l_run *= alpha; \
_Pragma("unroll") \
                for (int r = 0; r < 16; ++r) { o0[r] *= alpha; o1[r] *= alpha; } } \
            float ls = 0.f, ls2 = 0.f; \
_Pragma("unroll") \
            for (int r = 0; r < 16; ++r) { p0[r] = __builtin_amdgcn_exp2f(p0[r] - m_run); p1[r] = __builtin_amdgcn_exp2f(p1[r] - m_run); ls += p0[r]; ls2 += p1[r]; } \
            ls += ls2; \
            l_run += ls; \
            bf16x8 pb[2][2]; \
_Pragma("unroll") \
            for (int j = 0; j < 2; ++j) { \
                u32x4 w0, w1; \
                w0.x = pk2(p0[8 * j + 0], p0[8 * j + 1]); w0.y = pk2(p0[8 * j + 2], p0[8 * j + 3]); w0.z = pk2(p0[8 * j + 4], p0[8 * j + 5]); w0.w = pk2(p0[8 * j + 6], p0[8 * j + 7]); \
                w1.x = pk2(p1[8 * j + 0], p1[8 * j + 1]); w1.y = pk2(p1[8 * j + 2], p1[8 * j + 3]); w1.z = pk2(p1[8 * j + 4], p1[8 * j + 5]); w1.w = pk2(p1[8 * j + 6], p1[8 * j + 7]); \
                pb[0][j] = __builtin_bit_cast(bf16x8, w0); pb[1][j] = __builtin_bit_cast(bf16x8, w1); \
            } \
 \
_Pragma("unroll") \
            for (int kb = 0; kb < 2; ++kb) \
_Pragma("unroll") \
                for (int j = 0; j < 2; ++j) { const int i = kb * 2 + j; \
                    const bf16x8 a0 = __builtin_shufflevector(vl[2 * i], vh[2 * i], 0, 1, 2, 3, 4, 5, 6, 7), a1 = __builtin_shufflevector(vl[2 * i + 1], vh[2 * i + 1], 0, 1, 2, 3, 4, 5, 6, 7); \
                    o0 = MFMA32(a0, pb[kb][j], o0); o1 = MFMA32(a1, pb[kb][j], o1); \
                } \
            if (s + 1 < n) { LAS unsigned char* Bn = L + ((s + 1) & 1) * BUFB; *(LAS u32x4*)(Bn + stoff) = KQ; *(LAS u32x4*)(Bn + TILEB + stoff) = VQ; } \
            LBAR(); \
            if (s + 4 < n) { const size_t krow = (size_t)ATT_TROW(s + 4); KQ = *(const u32x4*)(ACT + krow * LD + kcol); VQ = *(const u32x4*)(ACT + krow * LD + vcol); } \
        } while (0)
#pragma unroll 1
        for (int s0 = 0; s0 < n; s0 += 3) {
            ATT_STEP(s0, kq1, vq1);
            if (s0 + 1 < n) ATT_STEP(s0 + 1, kq2, vq2);
            if (s0 + 2 < n) ATT_STEP(s0 + 2, kq0, vq0);
        }
#undef ATT_STEP
#undef ATT_TROW
        u32x4 sgq[4];
        { const int qrow0 = qrow - r32;
#pragma unroll
          for (int it = 0; it < 4; ++it) sgq[it] = *(const u32x4*)(ACT + (size_t)(qrow0 + it * 8 + (lane >> 3)) * LD + 1536 + h * 64 + (lane & 7) * 8); }
        const float lt = l_run + __shfl_xor(l_run, 32); const float inv = 1.0f / lt;
        LAS float* stg = (LAS float*)(L + 40960 + wave * 8704);
#pragma unroll
        for (int db = 0; db < 2; ++db)
#pragma unroll
            for (int q4 = 0; q4 < 4; ++q4) { const int d = 32 * db + 8 * q4 + 4 * hi; f32x4 v;
                if (db == 0) v = (f32x4){o0[4 * q4], o0[4 * q4 + 1], o0[4 * q4 + 2], o0[4 * q4 + 3]}; else v = (f32x4){o1[4 * q4], o1[4 * q4 + 1], o1[4 * q4 + 2], o1[4 * q4 + 3]};
                *(LAS f32x4*)(stg + r32 * 68 + d) = v * inv; }
        asm volatile("s_waitcnt lgkmcnt(0)" ::: "memory");
        { const int qrow0 = qrow - r32; const int er = lane >> 3, ec = (lane & 7) * 8;
#pragma unroll
          for (int it = 0; it < 4; ++it) { const int row = it * 8 + er; const size_t grow = (size_t)(qrow0 + row);
              const f32x4 a0 = *(const LAS f32x4*)(stg + row * 68 + ec), a1 = *(const LAS f32x4*)(stg + row * 68 + ec + 4);
              const u32x4 gw = sgq[it];
              u32x4 w; w.x = pk2(a0.x * bflo(gw.x), a0.y * bfhi(gw.x)); w.y = pk2(a0.z * bflo(gw.y), a0.w * bfhi(gw.y)); w.z = pk2(a1.x * bflo(gw.z), a1.y * bfhi(gw.z)); w.w = pk2(a1.z * bflo(gw.w), a1.w * bfhi(gw.w));
              *(u32x4*)(Y + grow * DM + h * 64 + ec) = w; } }
    }
    LBAR();
}

__device__ __forceinline__ void phase_lru(const Args& A, const bf16_t* ACT, bf16_t* Y, float* HF, LAS unsigned char* L, const int wv) {
    constexpr int LD = 2048, TT = 128, USTR = 144;
    const int tid = otid(wv), lane = tid & 63, wave = __builtin_amdgcn_readfirstlane(tid >> 6), G = gridDim.x;
    LAS unsigned char* UL = L;
    LAS unsigned char* XA = L + 19200;
    LAS float* XF = (LAS float*)(L + 19200 + 18432);
    LAS f32x2* AB = (LAS f32x2*)(L + 19200 + 18432 + 16384);
    LAS f32x2* CAR = (LAS f32x2*)(L + 19200 + 18432 + 16384 + 32768);
    LAS float* ST = (LAS float*)(L + 19200 + 18432 + 16384 + 32768 + 4096);
    LAS float* CW = (LAS float*)(L + 19200 + 18432 + 16384 + 32768 + 4096 + 256);
    const bf16_t* gwT = (const bf16_t*)(ows(A.ws) + WS_GW);
    const float* conv_w = A.in[15]; const float* conv_b = A.in[16]; const float* ba = A.in[18]; const float* bx = A.in[20]; const float* lam = A.in[21];
    const int fr = lane & 15, fq = lane >> 4;
    const int stok = tid >> 3, sch = tid & 7;
    const int ch = tid & 31, sc = tid >> 5;
    const int otok = tid >> 2, oq = tid & 3;
    for (int u = blockIdx.x; u < 256; u += G) {
        const int b = u >> 5, hb = u & 31, hblk = hb >> 1, half = hb & 1, cin0 = hblk * 64, c0 = cin0 + half * 32;
#pragma unroll 1
        for (int dir = 0; dir < 2; ++dir) {
            LBAR();
            if (tid < 320) { const int k = tid >> 6, c = tid & 63; CW[tid] = (k < 4) ? conv_w[(size_t)(dir * 4 + k) * DM + cin0 + c] : conv_b[(size_t)dir * DM + cin0 + c]; }
            const int cbk = wave & 1;
            bf16x8 wr_[2], wi_[2];
            { const bf16_t* pr = gwT + ((size_t)((dir * 2 + 0) * 16 + hblk) * 64 + half * 32 + cbk * 16 + fr) * 64 + fq * 8;
              const bf16_t* pi = gwT + ((size_t)((dir * 2 + 1) * 16 + hblk) * 64 + half * 32 + cbk * 16 + fr) * 64 + fq * 8;
              wr_[0] = *(const bf16x8*)pr; wr_[1] = *(const bf16x8*)(pr + 32); wi_[0] = *(const bf16x8*)pi; wi_[1] = *(const bf16x8*)(pi + 32); }
            float eba[4], ebx[4], esp[4];
#pragma unroll
            for (int e = 0; e < 4; ++e) { const int c = dir * DM + c0 + cbk * 16 + 4 * fq + e; eba[e] = ba[c]; ebx[e] = bx[c];
                const float nl = -lam[c]; esp[e] = (fmaxf(nl, 0.f) + log1pf(__expf(-fabsf(nl)))) * (-8.0f * LOG2E); }
            if (tid < 32) ST[tid] = 0.f;
            u32x4 ur[2], uh = (u32x4){0u, 0u, 0u, 0u};
            { const int rowbase = ML + b * CTX;
#pragma unroll
              for (int i2 = 0; i2 < 2; ++i2) { const int S = stok + 64 * i2; const int row = rowbase + (dir ? CTX - 1 - S : S); ur[i2] = *(const u32x4*)(ACT + (size_t)row * LD + cin0 + sch * 8); } }
            f32x4 hf0 = (f32x4){0.f, 0.f, 0.f, 0.f}, hf1 = hf0; u32x4 gv = (u32x4){0u, 0u, 0u, 0u}; size_t orow = 0; int oseq = 0;
#define LRU_OUT() do { const f32x4 h0 = *(const LAS f32x4*)(XF + otok * 32 + oq * 8), h1 = *(const LAS f32x4*)(XF + otok * 32 + oq * 8 + 4); \
                if (dir == 0) { f32x4* hp = (f32x4*)(HF + ((size_t)u * 2304 + oseq) * 32 + oq * 8); hp[0] = h0; hp[1] = h1; } \
                else { const f32x4 s0 = h0 + hf0, s1 = h1 + hf1; u32x4 w; \
                    w.x = pk2(s0.x * bflo(gv.x), s0.y * bfhi(gv.x)); w.y = pk2(s0.z * bflo(gv.y), s0.w * bfhi(gv.y)); w.z = pk2(s1.x * bflo(gv.z), s1.y * bfhi(gv.z)); w.w = pk2(s1.z * bflo(gv.w), s1.w * bfhi(gv.w)); \
                    *(u32x4*)(Y + orow * DM + c0 + oq * 8) = w; } } while (0)
#pragma unroll 1
            for (int tl = 0; tl < 18; ++tl) {
                const int seg = tl < 2 ? 0 : 1, S0 = seg ? (tl - 2) * TT : tl * TT, seglen = seg ? SEQ : CTX, rowbase = seg ? b * SEQ : ML + b * CTX;
                LBAR();
                *(LAS u32x4*)(UL + (3 + stok) * USTR + sch * 16) = ur[0]; *(LAS u32x4*)(UL + (3 + 64 + stok) * USTR + sch * 16) = ur[1];
                if (tid < 24) *(LAS u32x4*)(UL + stok * USTR + sch * 16) = uh;
                if (tl > 0) LRU_OUT();
                LBAR();
                { const int S = S0 + otok; const int pos = dir ? seglen - 1 - S : S; orow = (size_t)(rowbase + pos); oseq = seg ? CTX + pos : pos;
                  if (dir == 1) { const f32x4* hp = (const f32x4*)(HF + ((size_t)u * 2304 + oseq) * 32 + oq * 8); hf0 = hp[0]; hf1 = hp[1]; gv = *(const u32x4*)(ACT + orow * LD + 1024 + c0 + oq * 8); } }
                if (tl + 1 < 18) { const int tn = tl + 1; const int seg2 = tn < 2 ? 0 : 1, S02 = seg2 ? (tn - 2) * TT : tn * TT, seglen2 = seg2 ? SEQ : CTX, rowbase2 = seg2 ? b * SEQ : ML + b * CTX;
#pragma unroll
                    for (int i2 = 0; i2 < 2; ++i2) { const int S = S02 + stok + 64 * i2; const int row = rowbase2 + (dir ? seglen2 - 1 - S : S); ur[i2] = *(const u32x4*)(ACT + (size_t)row * LD + cin0 + sch * 8); }
                    uh = (u32x4){0u, 0u, 0u, 0u};
                    if (tid < 24 && S02 > 0) { const int S = S02 - 3 + stok; const int row = rowbase2 + (dir ? seglen2 - 1 - S : S); uh = *(const u32x4*)(ACT + (size_t)row * LD + cin0 + sch * 8); } }
                for (int rep_ = 0; rep_ < DUP_LRUBC; ++rep_) {
                { float x0[8], x1[8];
                  { const f32x4 ca = *(const LAS f32x4*)(CW + 256 + sch * 8), cc = *(const LAS f32x4*)(CW + 256 + sch * 8 + 4);
                    x0[0] = ca.x; x0[1] = ca.y; x0[2] = ca.z; x0[3] = ca.w; x0[4] = cc.x; x0[5] = cc.y; x0[6] = cc.z; x0[7] = cc.w;
#pragma unroll
                    for (int e = 0; e < 8; ++e) x1[e] = x0[e]; }
#pragma unroll
                  for (int k = 0; k < 4; ++k) { const f32x4 wa = *(const LAS f32x4*)(CW + k * 64 + sch * 8), wb = *(const LAS f32x4*)(CW + k * 64 + sch * 8 + 4);
                      const u32x4 u0 = *(const LAS u32x4*)(UL + (stok + k) * USTR + sch * 16), u1 = *(const LAS u32x4*)(UL + (stok + 64 + k) * USTR + sch * 16);
                      x0[0] += wa.x * bflo(u0.x); x0[1] += wa.y * bfhi(u0.x); x0[2] += wa.z * bflo(u0.y); x0[3] += wa.w * bfhi(u0.y);
                      x0[4] += wb.x * bflo(u0.z); x0[5] += wb.y * bfhi(u0.z); x0[6] += wb.z * bflo(u0.w); x0[7] += wb.w * bfhi(u0.w);
                      x1[0] += wa.x * bflo(u1.x); x1[1] += wa.y * bfhi(u1.x); x1[2] += wa.z * bflo(u1.y); x1[3] += wa.w * bfhi(u1.y);
                      x1[4] += wb.x * bflo(u1.z); x1[5] += wb.y * bfhi(u1.z); x1[6] += wb.z * bflo(u1.w); x1[7] += wb.w * bfhi(u1.w); }
                  u32x4 w; w.x = pk2(x0[0], x0[1]); w.y = pk2(x0[2], x0[3]); w.z = pk2(x0[4], x0[5]); w.w = pk2(x0[6], x0[7]);
                  *(LAS u32x4*)(XA + stok * USTR + sch * 16) = w;
                  w.x = pk2(x1[0], x1[1]); w.y = pk2(x1[2], x1[3]); w.z = pk2(x1[4], x1[5]); w.w = pk2(x1[6], x1[7]);
                  *(LAS u32x4*)(XA + (stok + 64) * USTR + sch * 16) = w;
                  if ((sch >> 2) == half) { LAS f32x4* xf = (LAS f32x4*)(XF + stok * 32 + (sch & 3) * 8); xf[0] = (f32x4){x0[0], x0[1], x0[2], x0[3]}; xf[1] = (f32x4){x0[4], x0[5], x0[6], x0[7]};
                      xf = (LAS f32x4*)(XF + (stok + 64) * 32 + (sch & 3) * 8); xf[0] = (f32x4){x1[0], x1[1], x1[2], x1[3]}; xf[1] = (f32x4){x1[4], x1[5], x1[6], x1[7]}; } }
                LBAR();
#pragma unroll
                for (int i2 = 0; i2 < 2; ++i2) { const int tb = (wave >> 1) + 4 * i2; const int tok = tb * 16 + fr;
                    const bf16x8 x0 = *(const LAS bf16x8*)(XA + tok * USTR + fq * 16), x1 = *(const LAS bf16x8*)(XA + tok * USTR + 64 + fq * 16);
                    f32x4 ar = (f32x4){0.f, 0.f, 0.f, 0.f}, ai = (f32x4){0.f, 0.f, 0.f, 0.f};
                    ar = MFMA16(wr_[0], x0, ar); ar = MFMA16(wr_[1], x1, ar); ai = MFMA16(wi_[0], x0, ai); ai = MFMA16(wi_[1], x1, ai);
                    const f32x4 xv = *(const LAS f32x4*)(XF + tok * 32 + cbk * 16 + 4 * fq);
                    float av[4], bv[4];
#pragma unroll
                    for (int e = 0; e < 4; ++e) { const float r = __builtin_amdgcn_rcpf(1.0f + __builtin_amdgcn_exp2f(-(ar[e] + eba[e]) * LOG2E)); const float ig = __builtin_amdgcn_rcpf(1.0f + __builtin_amdgcn_exp2f(-(ai[e] + ebx[e]) * LOG2E));
                        const float a_ = __builtin_amdgcn_exp2f(r * esp[e]); av[e] = a_; bv[e] = __builtin_amdgcn_sqrtf(fmaxf(1.0f - a_ * a_, 0.f)) * (ig * xv[e]); }
                    LAS f32x4* ab = (LAS f32x4*)(AB + tok * 32 + cbk * 16 + 4 * fq); ab[0] = (f32x4){av[0], bv[0], av[1], bv[1]}; ab[1] = (f32x4){av[2], bv[2], av[3], bv[3]}; }
                LBAR();
                }
                float a8[8], b8[8];
                { float Ap = 1.f, H = 0.f;
#pragma unroll
                  for (int k = 0; k < 8; ++k) { const f32x2 v = AB[(sc * 8 + k) * 32 + ch]; a8[k] = v.x; b8[k] = v.y; H = v.x * H + v.y; Ap *= v.x; }
                  CAR[sc * 32 + ch] = (f32x2){Ap, H}; }
                LBAR();
                float hrun = ST[(tl & 1) * 32 + ch];
                { f32x2 cr[15];
#pragma unroll
                  for (int s = 0; s < 15; ++s) cr[s] = CAR[s * 32 + ch];
#pragma unroll
                  for (int s = 0; s < 15; ++s) hrun = (s < sc) ? cr[s].x * hrun + cr[s].y : hrun; }
#pragma unroll
                for (int k = 0; k < 8; ++k) { hrun = a8[k] * hrun + b8[k]; XF[(sc * 8 + k) * 32 + ch] = hrun; }
                if (sc == 15) ST[((tl + 1) & 1) * 32 + ch] = hrun;
            }
            LBAR();
            LRU_OUT();
            asm volatile("s_waitcnt vmcnt(0)" ::: "memory");
        }
        LBAR();
    }
#undef LRU_OUT
}

__device__ __forceinline__ void cu8(const bf16_t* ACT, size_t row, int col, float* o) {
    const u32x4 a = __builtin_nontemporal_load((const u32x4*)(ACT + row * 4096 + col)), c = __builtin_nontemporal_load((const u32x4*)(ACT + row * 4096 + 2048 + col));
    o[0] = bflo(a.x) * bflo(c.x); o[1] = bfhi(a.x) * bfhi(c.x); o[2] = bflo(a.y) * bflo(c.y); o[3] = bfhi(a.y) * bfhi(c.y);
    o[4] = bflo(a.z) * bflo(c.z); o[5] = bfhi(a.z) * bfhi(c.z); o[6] = bflo(a.w) * bflo(c.w); o[7] = bfhi(a.w) * bfhi(c.w);
}
__device__ __forceinline__ void phase_conv(const Args& A, const bf16_t* ACT, bf16_t* Y, const int wv) {
    const float* conv_w = A.in[27]; const float* conv_b = A.in[28];
    const int nitems = (MT / 8) * 128;
    const int tid = otid(wv);
    for (int item = blockIdx.x * NTHREADS + tid; item < nitems; item += gridDim.x * NTHREADS) {
        const int rg = item >> 7, chunk = item & 127, col = chunk * 8, row0 = rg * 8;
        const int seglen = row0 < ML ? SEQ : CTX;
        const bool first = (row0 % seglen) == 0, last = ((row0 + 8) % seglen) == 0;
        float w0[8], w1[8], w2[8], cb[8];
        { const f32x4* p = (const f32x4*)(conv_w + col); f32x4 a = p[0], c = p[1]; w0[0] = a.x; w0[1] = a.y; w0[2] = a.z; w0[3] = a.w; w0[4] = c.x; w0[5] = c.y; w0[6] = c.z; w0[7] = c.w;
          p = (const f32x4*)(conv_w + DM + col); a = p[0]; c = p[1]; w1[0] = a.x; w1[1] = a.y; w1[2] = a.z; w1[3] = a.w; w1[4] = c.x; w1[5] = c.y; w1[6] = c.z; w1[7] = c.w;
          p = (const f32x4*)(conv_w + 2 * DM + col); a = p[0]; c = p[1]; w2[0] = a.x; w2[1] = a.y; w2[2] = a.z; w2[3] = a.w; w2[4] = c.x; w2[5] = c.y; w2[6] = c.z; w2[7] = c.w;
          p = (const f32x4*)(conv_b + col); a = p[0]; c = p[1]; cb[0] = a.x; cb[1] = a.y; cb[2] = a.z; cb[3] = a.w; cb[4] = c.x; cb[5] = c.y; cb[6] = c.z; cb[7] = c.w; }
        float prev[8], cur[8], nxt[8];
        if (first) {
#pragma unroll
            for (int e = 0; e < 8; ++e) prev[e] = 0.f;
        } else cu8(ACT, (size_t)row0 - 1, col, prev);
        cu8(ACT, (size_t)row0, col, cur);
#pragma unroll
        for (int k = 0; k < 8; ++k) {
            const size_t row = (size_t)row0 + k;
            if (k == 7 && last) {
#pragma unroll
                for (int e = 0; e < 8; ++e) nxt[e] = 0.f;
            } else cu8(ACT, row + 1, col, nxt);
            const u32x4 bgw = __builtin_nontemporal_load((const u32x4*)(ACT + row * 4096 + 1024 + col)), sgw = __builtin_nontemporal_load((const u32x4*)(ACT + row * 4096 + 3072 + col));
            float y[8];
#pragma unroll
            for (int e = 0; e < 8; ++e) y[e] = w0[e] * prev[e] + w1[e] * cur[e] + w2[e] * nxt[e] + cb[e];
            y[0] *= bflo(bgw.x) * bflo(sgw.x); y[1] *= bfhi(bgw.x) * bfhi(sgw.x); y[2] *= bflo(bgw.y) * bflo(sgw.y); y[3] *= bfhi(bgw.y) * bfhi(sgw.y);
            y[4] *= bflo(bgw.z) * bflo(sgw.z); y[5] *= bfhi(bgw.z) * bfhi(sgw.z); y[6] *= bflo(bgw.w) * bflo(sgw.w); y[7] *= bfhi(bgw.w) * bfhi(sgw.w);
            u32x4 w; w.x = pk2(y[0], y[1]); w.y = pk2(y[2], y[3]); w.z = pk2(y[4], y[5]); w.w = pk2(y[6], y[7]);
            *(u32x4*)(Y + row * DM + col) = w;
#pragma unroll
            for (int e = 0; e < 8; ++e) { prev[e] = cur[e]; cur[e] = nxt[e]; }
        }
    }
}

__device__ __forceinline__ void phase_ctx_wout(const bf16_t* Yc, const bf16_t* Wt, const float* xin, float* xout, const float* gate, LAS unsigned char* L, const int wv) {
    constexpr int PITCH = 144, ABYTES = 128 * PITCH, BUFB = 192 * PITCH;
    const int tid = otid(wv), lane = tid & 63, r32 = lane & 31, hi = lane >> 5, wave = wv, G = gridDim.x;
    const int srow = tid >> 3, sch = tid & 7;
    const int aoff = ((wave >> 1) * 32 + r32) * PITCH + hi * 64, boff = ABYTES + ((wave & 1) * 32 + r32) * PITCH + hi * 64;
    for (int t = blockIdx.x; t < 256; t += G) {
        const int tm = t >> 4, tn = t & 15;
        const bf16_t* ga0 = Yc + (size_t)(tm * 128 + srow) * DM + sch * 8; const bf16_t* ga1 = ga0 + (size_t)64 * DM; const bf16_t* gb = Wt + (size_t)(tn * 64 + srow) * DM + sch * 8;
        f32x16 acc;
#pragma unroll
        for (int r = 0; r < 16; ++r) acc[r] = 0.f;
        u32x4 qa0[3], qa1[3], qb[3];
#define CTX_LOAD(q, s_) do { qa0[q] = *(const u32x4*)(ga0 + (s_) * 64); qa1[q] = *(const u32x4*)(ga1 + (s_) * 64); qb[q] = *(const u32x4*)(gb + (s_) * 64); } while (0)
#define CTX_WRITE(q, buf) do { LAS unsigned char* Bn = L + (buf) * BUFB; *(LAS u32x4*)(Bn + srow * PITCH + sch * 16) = qa0[q]; *(LAS u32x4*)(Bn + (64 + srow) * PITCH + sch * 16) = qa1[q]; *(LAS u32x4*)(Bn + ABYTES + srow * PITCH + sch * 16) = qb[q]; } while (0)
#define CTX_STEP(s_, q) do { const int s = (s_); LAS const unsigned char* B = L + (s & 1) * BUFB; bf16x8 a[4], b[4]; \
            _Pragma("unroll") for (int j = 0; j < 4; ++j) { a[j] = *(const LAS bf16x8*)(B + aoff + j * 16); b[j] = *(const LAS bf16x8*)(B + boff + j * 16); } \
            _Pragma("unroll") for (int j = 0; j < 4; ++j) acc = MFMA32(a[j], b[j], acc); \
            if (s + 1 < 16) CTX_WRITE(q, (s + 1) & 1); \
            LBAR(); \
            if (s + 4 < 16) CTX_LOAD(q, s + 4); } while (0)
        CTX_LOAD(0, 0); CTX_LOAD(1, 1); CTX_LOAD(2, 2);
        LBAR();
        CTX_WRITE(0, 0);
        CTX_LOAD(0, 3);
        LBAR();
#pragma unroll 1
        for (int s0 = 0; s0 < 16; s0 += 3) {
            CTX_STEP(s0, 1);
            if (s0 + 1 < 16) CTX_STEP(s0 + 1, 2);
            if (s0 + 2 < 16) CTX_STEP(s0 + 2, 0);
        }
#undef CTX_LOAD
#undef CTX_WRITE
#undef CTX_STEP
        const int m0 = tm * 128 + (wave >> 1) * 32, col = tn * 64 + (wave & 1) * 32 + r32; const float gv = gate[col];
        float xv[16];
#pragma unroll
        for (int r = 0; r < 16; ++r) xv[r] = xin[(size_t)(m0 + crow(r, hi)) * DM + col];
#pragma unroll
        for (int r = 0; r < 16; ++r) xout[(size_t)(m0 + crow(r, hi)) * DM + col] = xv[r] + gv * acc[r];
    }
    LBAR();
}

__device__ __forceinline__ void phase_final(float* out, const float* g, const int wv) {
    const int tid = otid(wv); const int lane = tid & 63, gw = blockIdx.x * NWAVES + (tid >> 6), NGW = gridDim.x * NWAVES;
    f32x4 gv[4];
#pragma unroll
    for (int j = 0; j < 4; ++j) gv[j] = *((const f32x4*)g + 64 * j + lane);
    for (int row0 = gw * 4; row0 < ML; row0 += NGW * 4) {
        f32x4 v[4][4]; float s[4];
#pragma unroll
        for (int i = 0; i < 4; ++i) { const f32x4* xr = (const f32x4*)(out + (size_t)(row0 + i) * DM) + lane;
#pragma unroll
            for (int j = 0; j < 4; ++j) v[i][j] = __builtin_nontemporal_load(xr + 64 * j); }
#pragma unroll
        for (int i = 0; i < 4; ++i) { float a = 0.f;
#pragma unroll
            for (int j = 0; j < 4; ++j) a += (v[i][j].x * v[i][j].x + v[i][j].y * v[i][j].y) + (v[i][j].z * v[i][j].z + v[i][j].w * v[i][j].w);
            s[i] = a; }
#pragma unroll
        for (int o = 1; o < 64; o <<= 1) {
#pragma unroll
            for (int i = 0; i < 4; ++i) s[i] += __shfl_xor(s[i], o); }
#pragma unroll
        for (int i = 0; i < 4; ++i) { const float rstd = 1.0f / sqrtf(s[i] * (1.0f / DM) + EPS); f32x4* xr = (f32x4*)(out + (size_t)(row0 + i) * DM) + lane;
#pragma unroll
            for (int j = 0; j < 4; ++j) xr[64 * j] = v[i][j] * rstd * gv[j]; }
    }
}

#define RLX_AGENT __ATOMIC_RELAXED, __HIP_MEMORY_SCOPE_AGENT
#define XB_TMO      128
#define XB_XCNT(j)  (256  + 64 * (j))
#define XB_XSUB(j)  (1280 + 64 * (j))
#define XB_XGEN(j)  (2304 + 64 * (j))
#define XB_TOP      3328
#define XB_TOPGEN   3392
#define XCD_BAR_WORDS 3456
#define XB_SPIN_CAP (1u << 18)

__device__ __forceinline__ unsigned xb_ld(unsigned* p)              { return __hip_atomic_load(p, __ATOMIC_RELAXED, __HIP_MEMORY_SCOPE_AGENT); }
__device__ __forceinline__ unsigned xb_add(unsigned* p, unsigned v) { return __hip_atomic_fetch_add(p, v, __ATOMIC_RELAXED, __HIP_MEMORY_SCOPE_AGENT); }
__device__ __forceinline__ unsigned xb_xcc_id() { return (unsigned)__builtin_amdgcn_s_getreg((3 << 11) | 20) & 0xFu; }
#define XB_SPIN(cond, bar) do { unsigned _sp = 0; while (cond) { __builtin_amdgcn_s_sleep(1); \
    if ((++_sp & 255u) == 0u) { if (xb_ld(&(bar)[XB_TMO])) break; if (_sp > XB_SPIN_CAP) { atomicAdd(&(bar)[XB_TMO], 1u); break; } } } } while (0)

struct XcdBarrier {
    unsigned* bar; unsigned x;
    volatile LAS unsigned* st;
};

__device__ __forceinline__ XcdBarrier xcd_barrier_post(unsigned* bar, volatile LAS unsigned* st) {
    XcdBarrier b; b.bar = bar; b.x = xb_xcc_id(); b.st = st;
    if (threadIdx.x == 0) (void)xb_add(&bar[XB_XCNT(b.x)], 1u);
    return b;
}
__device__ __forceinline__ void xcd_barrier_complete(unsigned* bar, unsigned x, unsigned& nloc, unsigned& nx) {
    const unsigned G = gridDim.x * gridDim.y * gridDim.z;
    unsigned sum, cnt, mine, sp = 0u;
    for (;;) {
        sum = 0u; cnt = 0u; mine = 0u;
#pragma unroll
        for (unsigned j = 0; j < 16; ++j) { const unsigned c = xb_ld(&bar[XB_XCNT(j)]); sum += c; cnt += (c > 0u) ? 1u : 0u; mine = (j == x) ? c : mine; }
        if (sum == G) break;
        __builtin_amdgcn_s_sleep(1);
        if ((++sp & 255u) == 0u) { if (xb_ld(&bar[XB_TMO])) break; if (sp > XB_SPIN_CAP) { atomicAdd(&bar[XB_TMO], 1u); break; } }
    }
    nloc = mine > 0u ? mine : 1u; nx = cnt > 0u ? cnt : 1u;
}

__device__ __forceinline__ void xcd_barrier(const XcdBarrier& b) {
    asm volatile("s_waitcnt vmcnt(0)" ::: "memory");
    __syncthreads();
    if (threadIdx.x == 0) {
        unsigned* bar = b.bar;
        __builtin_amdgcn_s_waitcnt(0);
        unsigned nloc = b.st[0], nx = b.st[1];
        if (nloc == 0u) { xcd_barrier_complete(bar, b.x, nloc, nx); b.st[0] = nloc; b.st[1] = nx; }
        const unsigned old = xb_add(&bar[XB_XSUB(b.x)], 1u);
        const unsigned gen = old / nloc;
        if (old + 1u == (gen + 1u) * nloc) {
            __builtin_amdgcn_fence(__ATOMIC_RELEASE, "agent");
            asm volatile("s_waitcnt vmcnt(0)" ::: "memory");
            const unsigned og = xb_add(&bar[XB_TOP], 1u);
            const unsigned tg = og / nx;
            if (og + 1u == (tg + 1u) * nx) xb_add(&bar[XB_TOPGEN], 1u);
            else XB_SPIN(xb_ld(&bar[XB_TOPGEN]) == tg, bar);
            __builtin_amdgcn_fence(__ATOMIC_ACQUIRE, "agent");
            xb_add(&bar[XB_XGEN(b.x)], 1u);
            asm volatile("s_waitcnt vmcnt(0)" ::: "memory");
        } else {
            XB_SPIN(xb_ld(&bar[XB_XGEN(b.x)]) == gen, bar);
            __builtin_amdgcn_fence(__ATOMIC_ACQUIRE, "agent");
            asm volatile("s_waitcnt vmcnt(0)" ::: "memory");
        }
    }
    __syncthreads();
}

__global__ void __launch_bounds__(NTHREADS, 2) hybrid_fwd(Args A) {
    extern __shared__ __attribute__((aligned(16))) unsigned char lds[];
    cg::grid_group grid = cg::this_grid();
    LAS unsigned char* L = (LAS unsigned char*)lds;
    unsigned char* ws = A.ws;
    const int G = gridDim.x;
    float* XL = A.out; float* XC = (float*)(ws + WS_XC);
    bf16_t* XN = (bf16_t*)(ws + WS_XN); bf16_t* ACT = (bf16_t*)(ws + WS_ACT);
    const float* gatef = (const float*)(ws + WS_GATE);

    const int wv = __builtin_amdgcn_readfirstlane((int)threadIdx.x >> 6);
    volatile LAS unsigned* MISC = (volatile LAS unsigned*)(L + 131072 + 320);
    if (threadIdx.x < 32) MISC[threadIdx.x] = 0u;
    __syncthreads();
    XcdBarrier xbar = xcd_barrier_post((unsigned*)ws + 4096, MISC + 8);
#define GSYNC() xcd_barrier(xbar)
#pragma unroll 1
    for (int l = 0; l < 4; ++l) { phase_prep(A, L, l, (int)((blockIdx.x + 64 * l) % G), G, wv); LBAR(); }
    if (A.out == nullptr) grid.sync();
    for (int rep = 0; rep < DUP_SYNC; ++rep) GSYNC();
#pragma unroll 1
    for (int layer = 0; layer < 4; ++layer) {
        ws = ows(ws);
        const int kind = layer == 3 ? 0 : layer;
        const int Nin = kind == 0 ? 2560 : (kind == 1 ? 2048 : 4096);
        const float* xinL = layer == 0 ? A.in[0] : XL; const float* xinC = layer == 0 ? A.in[2] : XC;
        for (int rep = 0; rep < DUP_NORM; ++rep) phase_norm(A, layer, xinL, xinC, L, wv);
        GSYNC();
        {
            const bf16_t* Wt = (const bf16_t*)(ws + (layer == 0 ? WS_WIN[0] : layer == 1 ? WS_WIN[1] : layer == 2 ? WS_WIN[2] : WS_WIN[3]));
            pg8::Gemm g{XN, Wt, layer == 3 ? ML : MT, Nin, DM};
            pg8::OrderG S; S.so.init(layer == 3 ? ML : MT, Nin, G, (int)blockIdx.x); S.extra = layer == 3 ? 16 : 0;
            pg8::EpiIn E{ACT, Nin, kind, (const float*)(ws + WS_ROPE)};
            for (int rep = 0; rep < DUP_GIN; ++rep) pg8::gemm_phase<pg8::EpiIn, pg8::OrderG, true, true>(L, g, S, E, wv);
        }
        GSYNC();
        if (kind == 0) { for (int rep = 0; rep < DUP_ATTN; ++rep) phase_attn(ACT, XN, (layer == 0 ? A.in[9] : A.in[34]), layer == 0, L, wv); }
        else if (kind == 1) { for (int rep = 0; rep < DUP_LRU; ++rep) phase_lru(A, ACT, XN, (float*)(ws + WS_HF), L, wv); }
        else { for (int rep = 0; rep < DUP_CONV; ++rep) phase_conv(A, ACT, XN, wv); }
        GSYNC();
        {
            const bf16_t* Wt = (const bf16_t*)(ws + (layer == 0 ? WS_WOUT[0] : layer == 1 ? WS_WOUT[1] : layer == 2 ? WS_WOUT[2] : WS_WOUT[3]));
            const int Mo = (CTX_SMALL || layer == 3) ? ML : MT;
            pg8::Gemm g{XN, Wt, Mo, DM, DM};
            pg8::OrderG S; S.so.init(Mo, DM, G, (int)blockIdx.x); S.extra = 0;
            pg8::EpiRes E{xinL, xinC, XL, XC, gatef + (size_t)layer * 9 * 1024};
            const bool ctx_first = (blockIdx.x & 1) != 0;
#pragma unroll 1
            for (int step = 0; step < 2; ++step) {
                if ((step == 0) == ctx_first) { if (CTX_SMALL && layer < 3) phase_ctx_wout(XN + (size_t)ML * DM, Wt, xinC, XC, gatef + (size_t)(layer * 9 + 8) * 1024, L, wv); }
                else pg8::gemm_phase<pg8::EpiRes, pg8::OrderG, true, true>(L, g, S, E, wv);
            }
        }
        GSYNC();
    }
    phase_final(XL, A.in[35], wv);
}

extern "C" void kernel_launch(void* const* d_in, const int* in_sizes, int n_in, void* d_out, int out_size, void* d_ws, size_t ws_size, hipStream_t stream) {
    static int grid = 0;
    if (grid == 0) {
        if (n_in != 36 || out_size != ML * DM || ws_size < WS_END) { fprintf(stderr, "kernel_launch: unexpected shapes (n_in %d, out %d, ws %zu)\n", n_in, out_size, ws_size); grid = -1; return; }
        int dev = 0, cus = 0, per_cu = 0;
        hipGetDevice(&dev); hipDeviceGetAttribute(&cus, hipDeviceAttributeMultiprocessorCount, dev);
        if (hipFuncSetAttribute((const void*)hybrid_fwd, hipFuncAttributeMaxDynamicSharedMemorySize, LDS_BYTES) != hipSuccess) { fprintf(stderr, "kernel_launch: hipFuncSetAttribute failed\n"); grid = -1; return; }
        if (hipOccupancyMaxActiveBlocksPerMultiprocessor(&per_cu, (const void*)hybrid_fwd, NTHREADS, LDS_BYTES) != hipSuccess || per_cu < 1) { fprintf(stderr, "kernel_launch: occupancy query says %d\n", per_cu); per_cu = 1; }
        (void)hipGetLastError();
        grid = cus * (per_cu > 1 ? 1 : per_cu);
        if (grid > 256) grid = 256;
    }
    if (grid < 0) return;
    if (hipMemsetAsync(d_ws, 0, 65536, stream) != hipSuccess) { fprintf(stderr, "kernel_launch: memset failed\n"); return; }
    Args a{};
    for (int i = 0; i < 36; ++i) a.in[i] = (const float*)d_in[i];
    a.out = (float*)d_out; a.ws = (unsigned char*)d_ws;
    void* args[] = {&a};
    hipError_t e = hipLaunchCooperativeKernel((const void*)hybrid_fwd, dim3(grid), dim3(NTHREADS), args, LDS_BYTES, stream);
    if (e != hipSuccess) fprintf(stderr, "kernel_launch: cooperative launch failed: %s (grid %d)\n", hipGetErrorString(e), grid);
}
```

```cpp
#include <hip/hip_runtime.h>
#include <hip/hip_cooperative_groups.h>
#include <cstdio>
#include <cstdint>
namespace cg = cooperative_groups;

namespace pg8 {
#define PG8_LAS __attribute__((address_space(3)))
typedef unsigned short bf16_t;
typedef short bf16x8 __attribute__((ext_vector_type(8)));
typedef float f32x4 __attribute__((ext_vector_type(4)));
typedef unsigned u32x4 __attribute__((ext_vector_type(4)));
constexpr int BM = 256, BK = 64, HALF = 128, HTB = HALF * BK * 2  , STAGE_BYTES = 8 * HTB, NXCD = 8, WGM = 8;

__host__ __device__ __forceinline__ int lds_byte(int r, int c) { const int st = (r >> 4) * 2 + (c >> 5), rr = r & 15, cc = c & 31, ob = rr * 64 + cc * 2; return st * 1024 + (ob ^ (((ob >> 9) & 1) << 5)); }
__host__ __device__ __forceinline__ void stage_rc(int b, int& R, int& C) { const int st = b / 1024, sb = b % 1024, swz = sb ^ (((sb >> 9) & 1) << 5); R = (st >> 1) * 16 + swz / 64; C = (st & 1) * 32 + (swz % 64) / 2; }
__host__ __device__ __forceinline__ int perm32(int rho) { const int n = rho >> 4, i = rho & 15; return 8 * (i >> 2) + 4 * n + (i & 3); }

struct Unit { int pm, pn; };
struct Gemm { const bf16_t* A; const bf16_t* Bt; int M, N, K; };

struct StaticOrder {
    int nM, nN, nwg, G, c;
    __host__ __device__ void init(int M, int N, int G_, int c_) { nM = M / BM; nN = N / BM; nwg = nM * nN; G = G_; c = c_; }
    __host__ __device__ bool next(int i, Unit& u) const {
        const long L = (long)i * G + c; if (L >= nwg) return false;
        int wgid = (int)L; { const int q = nwg / NXCD, r = nwg % NXCD, xcd = wgid % NXCD, off = wgid / NXCD; wgid = (xcd < r ? xcd * (q + 1) : r * (q + 1) + (xcd - r) * q) + off; }
        const int nig = WGM * nN, gid = wgid / nig, fm = gid * WGM, gsz = (nM - fm) < WGM ? (nM - fm) : WGM;
        u.pm = fm + ((wgid % nig) % gsz); u.pn = (wgid % nig) / gsz; return true;
    }
    __device__ __forceinline__ void a_ready(const Unit&) const {}
    __device__ __forceinline__ void done(const Unit&) const {}
};

__device__ __forceinline__ unsigned cvt_pk_bf16(float lo, float hi) { unsigned r; asm volatile("v_cvt_pk_bf16_f32 %0, %1, %2" : "=v"(r) : "v"(lo), "v"(hi)); return r; }
typedef float f32x2 __attribute__((ext_vector_type(2)));
__device__ __forceinline__ float silu_f(float v) { return v * __builtin_amdgcn_rcpf(1.0f + __builtin_amdgcn_exp2f(-v * 1.4426950408889634f)); }
constexpr float QSCALE = 0.125f * 1.4426950408889634f;

struct OrderG {
    StaticOrder so; int extra;
    __device__ __forceinline__ bool next(int i, Unit& u) const {
        long L = (long)i * so.G + so.c; if (L < so.nwg) return so.next(i, u);
        L -= so.nwg; if (L >= extra) return false; u.pm = 64 + (int)(L >> 1); u.pn = 4 + (int)(L & 1); return true;
    }
    __device__ __forceinline__ void a_ready(const Unit&) const {}
    __device__ __forceinline__ void done(const Unit&) const {}
};

struct EpiIn {
    static constexpr bool PERM = true, AFTER_DRAIN = false;
    bf16_t* O; int ldc; int kind; const float* rope;
    __device__ __forceinline__ void operator()(const f32x4 (&acc)[2][2][4][2], const Unit& u, int wr, int wc, int fr, int fq) const {
        const int colt = u.pn * BM; const bool lat = u.pm < 64;
        int mode = 0; float sc = 1.f;
        if (kind == 0) { if (colt < 1024) { mode = lat ? 2 : 0; sc = QSCALE; } else if (colt < 1280) mode = lat ? 2 : 0; else if (colt < 1536) mode = 0; else mode = 1; }
        else if (kind == 1) mode = colt < 1024 ? 0 : 1;
        else mode = colt < 3072 ? 0 : 1;
        const int row0 = u.pm * BM + wr * 64 + fr; const int col0 = colt + wc * 32 + 8 * fq;
        const float sgn = (fq < 2) ? -1.f : 1.f;
#pragma unroll
        for (int ai = 0; ai < 2; ++ai)
#pragma unroll
            for (int m = 0; m < 4; ++m) {
                const int row = row0 + ai * HALF + m * 16;
                bf16_t* rowp = O + (size_t)row * ldc + col0;
                f32x4 cs[4];
                if (mode == 2) { const int l = row & 2047; const int p = (wc & 1) ? (l & 63) : (l >> 6); const f32x4* rp = (const f32x4*)(rope + (p * 16 + 8 * (fq & 1)) * 2);
                    cs[0] = rp[0]; cs[1] = rp[1]; cs[2] = rp[2]; cs[3] = rp[3]; }
#pragma unroll
                for (int bj = 0; bj < 2; ++bj) {
                    f32x4 v0 = acc[ai][bj][m][0], v1 = acc[ai][bj][m][1];
                    if (mode == 1) {
#pragma unroll
                        for (int e = 0; e < 4; ++e) { v0[e] = silu_f(v0[e]); v1[e] = silu_f(v1[e]); }
                    } else if (mode == 2) {
                        f32x4 p0, p1;
#pragma unroll
                        for (int e = 0; e < 4; ++e) { p0[e] = __shfl_xor(v0[e], 32); p1[e] = __shfl_xor(v1[e], 32); }
                        v0[0] = v0[0] * cs[0][0] + sgn * p0[0] * cs[0][1]; v0[1] = v0[1] * cs[0][2] + sgn * p0[1] * cs[0][3];
                        v0[2] = v0[2] * cs[1][0] + sgn * p0[2] * cs[1][1]; v0[3] = v0[3] * cs[1][2] + sgn * p0[3] * cs[1][3];
                        v1[0] = v1[0] * cs[2][0] + sgn * p1[0] * cs[2][1]; v1[1] = v1[1] * cs[2][2] + sgn * p1[1] * cs[2][3];
                        v1[2] = v1[2] * cs[3][0] + sgn * p1[2] * cs[3][1]; v1[3] = v1[3] * cs[3][2] + sgn * p1[3] * cs[3][3];
                    }
                    v0 = v0 * sc; v1 = v1 * sc;
                    u32x4 w; w.x = cvt_pk_bf16(v0[0], v0[1]); w.y = cvt_pk_bf16(v0[2], v0[3]); w.z = cvt_pk_bf16(v1[0], v1[1]); w.w = cvt_pk_bf16(v1[2], v1[3]);
                    *(u32x4*)(rowp + bj * HALF) = w;
                }
            }
    }
};

struct EpiRes {
    static constexpr bool PERM = true, AFTER_DRAIN = false;
    const float* inL; const float* inC; float* outL; float* outC; const float* gate;
    __device__ __forceinline__ void operator()(const f32x4 (&acc)[2][2][4][2], const Unit& u, int wr, int wc, int fr, int fq) const {
        const bool lat = u.pm < 64;
        const float* ib = lat ? inL + (size_t)u.pm * BM * 1024 : inC + (size_t)(u.pm - 64) * BM * 1024;
        float* ob = lat ? outL + (size_t)u.pm * BM * 1024 : outC + (size_t)(u.pm - 64) * BM * 1024;
        const float* g = gate + (lat ? (u.pm >> 3) : 8) * 1024;
        const int col0 = u.pn * BM + wc * 32 + 8 * fq;
        f32x4 gv[2][2];
#pragma unroll
        for (int bj = 0; bj < 2; ++bj)
#pragma unroll
            for (int n = 0; n < 2; ++n) gv[bj][n] = *(const f32x4*)(g + col0 + bj * HALF + n * 4);
#pragma unroll
        for (int ai = 0; ai < 2; ++ai)
#pragma unroll
            for (int mp = 0; mp < 2; ++mp) {
                f32x4 xv[2][2][2];
#pragma unroll
                for (int mm = 0; mm < 2; ++mm) { const size_t off = (size_t)(ai * HALF + wr * 64 + (2 * mp + mm) * 16 + fr) * 1024 + col0;
#pragma unroll
                    for (int bj = 0; bj < 2; ++bj)
#pragma unroll
                        for (int n = 0; n < 2; ++n) xv[mm][bj][n] = __builtin_nontemporal_load((const f32x4*)(ib + off + bj * HALF + n * 4)); }
#pragma unroll
                for (int mm = 0; mm < 2; ++mm) { const int m = 2 * mp + mm; const size_t off = (size_t)(ai * HALF + wr * 64 + m * 16 + fr) * 1024 + col0;
#pragma unroll
                    for (int bj = 0; bj < 2; ++bj)
#pragma unroll
                        for (int n = 0; n < 2; ++n) *(f32x4*)(ob + off + bj * HALF + n * 4) = xv[mm][bj][n] + gv[bj][n] * acc[ai][bj][m][n]; }
                asm volatile("" ::: "memory"); }
    }
};

template <class Epi, class Sched, bool ALIGN_EPI = false, bool SP2 = false>
__device__ __forceinline__ void gemm_phase(PG8_LAS unsigned char* lds, const Gemm g, const Sched& S, const Epi& E, const int wv_) {
    int tid_ = wv_ * 64 + (int)__builtin_amdgcn_mbcnt_hi(~0u, __builtin_amdgcn_mbcnt_lo(~0u, 0u)); asm volatile("" : "+v"(tid_));
    const int tid = tid_, wid = __builtin_amdgcn_readfirstlane(tid >> 6), lane = tid & 63, wr = wid >> 2, wc = wid & 3, fr = lane & 15, fq = lane >> 4;
    const int K = g.K, nt = K / BK;
    unsigned voffA[2], voffB[2];
#pragma unroll
    for (int i = 0; i < 2; ++i) { int R, C; stage_rc(tid * 16 + i * 8192, R, C); const int Rb = Epi::PERM ? ((R & ~31) + perm32(R & 31)) : R;
        voffA[i] = (unsigned)(R * K + C) * 2u; voffB[i] = (unsigned)(Rb * K + C) * 2u; }
    const size_t kstep = (size_t)(BK * 2);
    const size_t hstep = (size_t)HALF * K * 2;
    const size_t tstep = 2 * hstep;
    const unsigned ldsw = (unsigned)wid * 1024u;
    const int aoff = lds_byte(wr * 64 + fr, fq * 8), boff = lds_byte(wc * 32 + fr, fq * 8);
#define PG8_SA(b, h) (((b) * 2 + (h)) * HTB)
#define PG8_SB(b, h) ((4 + (b) * 2 + (h)) * HTB)
#define PG8_STAGE(bufoff, gbase, voff) do { _Pragma("unroll") for (int _i = 0; _i < 2; ++_i) \
        __builtin_amdgcn_global_load_lds((const unsigned*)((const char*)(gbase) + (voff)[_i]), (PG8_LAS unsigned*)(lds + (bufoff) + ldsw + _i * 8192), 16, 0, 0); } while (0)
#define PG8_LDA(dst, b, h) do { _Pragma("unroll") for (int m = 0; m < 4; ++m) _Pragma("unroll") for (int k = 0; k < 2; ++k) dst[m][k] = *(const PG8_LAS bf16x8*)(lds + PG8_SA(b, h) + aoff + m * 2048 + k * 1024); } while (0)
#define PG8_LDB(dst, b, h) do { _Pragma("unroll") for (int n = 0; n < 2; ++n) _Pragma("unroll") for (int k = 0; k < 2; ++k) dst[n][k] = *(const PG8_LAS bf16x8*)(lds + PG8_SB(b, h) + boff + n * 2048 + k * 1024); } while (0)
#define PG8_MMA(ai, bj, At, Bt) do { __builtin_amdgcn_s_setprio(1); _Pragma("unroll") for (int m = 0; m < 4; ++m) _Pragma("unroll") for (int n = 0; n < 2; ++n) _Pragma("unroll") for (int k = 0; k < 2; ++k) \
        acc[ai][bj][m][n] = __builtin_amdgcn_mfma_f32_16x16x32_bf16(Bt[n][k], At[m][k], acc[ai][bj][m][n], 0, 0, 0); __builtin_amdgcn_s_setprio(0); } while (0)
#define PG8_WAIT_V(n) asm volatile("s_waitcnt vmcnt(" #n ")" ::: "memory")
#define PG8_WAIT_L(n) asm volatile("s_waitcnt lgkmcnt(" #n ")" ::: "memory")
#define PG8_BAR __builtin_amdgcn_s_barrier()
#define PG8_SCHED __builtin_amdgcn_sched_barrier(0)
    Unit cur, nxt; int ui = 0;
    if (!S.next(0, cur)) return;
    f32x4 acc[2][2][4][2];
#pragma unroll
    for (int a = 0; a < 2; ++a)
#pragma unroll
        for (int b = 0; b < 2; ++b)
#pragma unroll
            for (int m = 0; m < 4; ++m)
#pragma unroll
                for (int n = 0; n < 2; ++n) acc[a][b][m][n] = (f32x4){0.f, 0.f, 0.f, 0.f};
    bf16x8 At[4][2], B0[2][2], B1[2][2];
    const char* cA = (const char*)g.A + (size_t)cur.pm * tstep; const char* cB = (const char*)g.Bt + (size_t)cur.pn * tstep;
    S.a_ready(cur);
    if constexpr (SP2) {
        PG8_STAGE(PG8_SB(0, 0), cB, voffB); PG8_STAGE(PG8_SB(0, 1), cB + hstep, voffB); PG8_STAGE(PG8_SA(0, 0), cA, voffA); PG8_STAGE(PG8_SA(0, 1), cA + hstep, voffA);
        if (wr == 1) PG8_BAR;
        PG8_WAIT_V(2); PG8_BAR;
        PG8_STAGE(PG8_SB(1, 0), cB + kstep, voffB); PG8_STAGE(PG8_SA(1, 0), cA + kstep, voffA); PG8_STAGE(PG8_SB(1, 1), cB + hstep + kstep, voffB);
        PG8_WAIT_V(6); PG8_BAR;
    } else {
        PG8_STAGE(PG8_SB(0, 0), cB, voffB); PG8_STAGE(PG8_SA(0, 0), cA, voffA); PG8_STAGE(PG8_SB(0, 1), cB + hstep, voffB); PG8_STAGE(PG8_SA(0, 1), cA + hstep, voffA);
        if (wr == 1) PG8_BAR;
        PG8_WAIT_V(4); PG8_BAR;
        PG8_STAGE(PG8_SB(1, 0), cB + kstep, voffB); PG8_STAGE(PG8_SA(1, 0), cA + kstep, voffA); PG8_STAGE(PG8_SB(1, 1), cB + hstep + kstep, voffB);
        PG8_WAIT_V(6); PG8_BAR;
    }
    for (;;) {
        const bool has_next = S.next(ui + 1, nxt);
        const char* nA = has_next ? (const char*)g.A + (size_t)nxt.pm * tstep : cA; const char* nB = has_next ? (const char*)g.Bt + (size_t)nxt.pn * tstep : cB;
        for (int t = 0; t < nt; t += 2) {
            const bool last = (t == nt - 2);
            const char* a1 = cA + (size_t)(t + 1) * kstep;
            const char* a2 = last ? nA : cA + (size_t)(t + 2) * kstep; const char* b2 = last ? nB : cB + (size_t)(t + 2) * kstep;
            const char* a3 = a2 + kstep; const char* b3 = b2 + kstep;
            if (last && has_next) S.a_ready(nxt);
            if constexpr (SP2) {
            PG8_LDB(B0, 0, 0); PG8_LDB(B1, 0, 1); PG8_SCHED; PG8_LDA(At, 0, 0); PG8_STAGE(PG8_SA(1, 1), a1 + hstep, voffA);
            PG8_WAIT_V(8); PG8_WAIT_L(0); PG8_BAR; PG8_MMA(0, 0, At, B0); PG8_MMA(0, 1, At, B1); PG8_BAR; PG8_SCHED;
            PG8_LDA(At, 0, 1); PG8_STAGE(PG8_SB(0, 0), b2, voffB); PG8_STAGE(PG8_SB(0, 1), b2 + hstep, voffB); PG8_STAGE(PG8_SA(0, 0), a2, voffA);
            PG8_WAIT_V(8); PG8_WAIT_L(0); PG8_BAR; PG8_MMA(1, 0, At, B0); PG8_MMA(1, 1, At, B1); PG8_BAR; PG8_SCHED;
            PG8_LDB(B0, 1, 0); PG8_LDB(B1, 1, 1); PG8_SCHED; PG8_LDA(At, 1, 0); PG8_STAGE(PG8_SA(0, 1), a2 + hstep, voffA);
            PG8_WAIT_V(8); PG8_WAIT_L(0); PG8_BAR; PG8_MMA(0, 0, At, B0); PG8_MMA(0, 1, At, B1); PG8_BAR; PG8_SCHED;
            PG8_LDA(At, 1, 1); PG8_STAGE(PG8_SB(1, 0), b3, voffB); PG8_STAGE(PG8_SB(1, 1), b3 + hstep, voffB); PG8_STAGE(PG8_SA(1, 0), a3, voffA);
            PG8_WAIT_V(8); PG8_WAIT_L(0); PG8_BAR; PG8_MMA(1, 0, At, B0); PG8_MMA(1, 1, At, B1); PG8_BAR; PG8_SCHED;
            } else {
            PG8_LDB(B0, 0, 0); PG8_SCHED; PG8_LDA(At, 0, 0); PG8_STAGE(PG8_SA(1, 1), a1 + hstep, voffA);
            PG8_WAIT_L(8); PG8_BAR; PG8_WAIT_L(0); PG8_MMA(0, 0, At, B0); PG8_BAR; PG8_SCHED;
            PG8_LDB(B1, 0, 1); PG8_STAGE(PG8_SB(0, 0), b2, voffB);
            PG8_BAR; PG8_WAIT_L(0); PG8_MMA(0, 1, At, B1); PG8_BAR;
            PG8_LDA(At, 0, 1); PG8_STAGE(PG8_SA(0, 0), a2, voffA);
            PG8_BAR; PG8_WAIT_L(0); PG8_MMA(1, 0, At, B0); PG8_BAR; PG8_SCHED;
            PG8_STAGE(PG8_SB(0, 1), b2 + hstep, voffB);
            PG8_WAIT_V(6); PG8_BAR; PG8_MMA(1, 1, At, B1); PG8_BAR;
            PG8_LDB(B0, 1, 0); PG8_SCHED; PG8_LDA(At, 1, 0); PG8_STAGE(PG8_SA(0, 1), a2 + hstep, voffA);
            PG8_WAIT_L(8); PG8_BAR; PG8_WAIT_L(0); PG8_MMA(0, 0, At, B0); PG8_BAR; PG8_SCHED;
            PG8_LDB(B1, 1, 1); PG8_STAGE(PG8_SB(1, 0), b3, voffB);
            PG8_BAR; PG8_WAIT_L(0); PG8_MMA(0, 1, At, B1); PG8_BAR;
            PG8_LDA(At, 1, 1); PG8_STAGE(PG8_SA(1, 0), a3, voffA);
            PG8_BAR; PG8_WAIT_L(0); PG8_MMA(1, 0, At, B0); PG8_BAR; PG8_SCHED;
            PG8_STAGE(PG8_SB(1, 1), b3 + hstep, voffB);
            PG8_WAIT_V(6); PG8_BAR; PG8_MMA(1, 1, At, B1); PG8_BAR;
            }
        }
        if constexpr (ALIGN_EPI) { if (wr == 0) PG8_BAR; }
        if constexpr (!Epi::AFTER_DRAIN) { E(acc, cur, wr, wc, fr, fq); S.done(cur); }
        if (!has_next) break;
#pragma unroll
        for (int a = 0; a < 2; ++a)
#pragma unroll
            for (int b = 0; b < 2; ++b)
#pragma unroll
                for (int m = 0; m < 4; ++m)
#pragma unroll
                    for (int n = 0; n < 2; ++n) acc[a][b][m][n] = (f32x4){0.f, 0.f, 0.f, 0.f};
        cur = nxt; cA = nA; cB = nB; ++ui;
        if constexpr (ALIGN_EPI) { if (wr == 1) PG8_BAR; }
    }
    PG8_WAIT_V(0);
    if constexpr (!ALIGN_EPI) { if (wr == 0) PG8_BAR; }
    PG8_BAR;
    if constexpr (Epi::AFTER_DRAIN) { E.fused(acc, cur, wr, wc, fr, fq, lds, wid, lane); S.done(cur); }
#undef PG8_SA
#undef PG8_SB
#undef PG8_STAGE
#undef PG8_LDA
#undef PG8_LDB
#undef PG8_MMA
#undef PG8_WAIT_V
#undef PG8_WAIT_L
#undef PG8_BAR
#undef PG8_SCHED
}
}

#define LAS __attribute__((address_space(3)))
typedef unsigned short bf16_t;
typedef short bf16x8 __attribute__((ext_vector_type(8)));
typedef short s16x4 __attribute__((ext_vector_type(4)));
typedef float f32x4 __attribute__((ext_vector_type(4)));
typedef float f32x2 __attribute__((ext_vector_type(2)));
typedef float f32x16 __attribute__((ext_vector_type(16)));
typedef unsigned u32x4 __attribute__((ext_vector_type(4)));
typedef unsigned u32x2 __attribute__((ext_vector_type(2)));

#ifndef DUP_ATTN
#define DUP_ATTN 1
#endif
#ifndef DUP_LRU
#define DUP_LRU 1
#endif
#ifndef DUP_CONV
#define DUP_CONV 1
#endif
#ifndef DUP_GIN
#define DUP_GIN 1
#endif
#ifndef DUP_NORM
#define DUP_NORM 1
#endif
#ifndef DUP_PRO
#define DUP_PRO 1
#endif
#ifndef DUP_GOUT0
#define DUP_GOUT0 1
#endif
#ifndef DUP_LRUBC
#define DUP_LRUBC 1
#endif
#ifndef DUP_ATTEPI
#define DUP_ATTEPI 1
#endif
#ifndef DUP_SYNC
#define DUP_SYNC 1
#endif
#ifndef CTX_SMALL
#define CTX_SMALL 1
#endif
constexpr int NTHREADS = 512, NWAVES = 8;
constexpr int DM = 1024, NB = 8, SEQ = 2048, CTX = 256;
constexpr int ML = NB * SEQ, MC = NB * CTX, MT = ML + MC;
constexpr float EPS = 1e-6f, LOG2E = 1.4426950408889634f;
constexpr int LDS_BYTES = 147456;

constexpr size_t MiB = 1u << 20;
constexpr size_t WS_MODP = 1 * MiB;
constexpr size_t WS_GATE = 5 * MiB;
constexpr size_t WS_ROPE = 5 * MiB + 512 * 1024;
constexpr size_t WS_GW = 6 * MiB;
constexpr size_t WS_WIN[4] = {8 * MiB, 15 * MiB, 21 * MiB, 31 * MiB};
constexpr size_t WS_WOUT[4] = {13 * MiB, 19 * MiB, 29 * MiB, 36 * MiB};
constexpr size_t WS_XC = 38 * MiB;
constexpr size_t WS_XN = 46 * MiB;
constexpr size_t WS_ACT = 82 * MiB;
constexpr size_t WS_HF = 154 * MiB;
constexpr size_t WS_END = 226 * MiB;

struct Args { const float* in[36]; float* out; unsigned char* ws; };

#define LBAR() do { asm volatile("s_waitcnt lgkmcnt(0)" ::: "memory"); __builtin_amdgcn_s_barrier(); asm volatile("" ::: "memory"); } while (0)

__device__ __forceinline__ unsigned f2bf(float f) { unsigned u = __builtin_bit_cast(unsigned, f); return (u + 0x7fffu + ((u >> 16) & 1u)) >> 16; }
__device__ __forceinline__ unsigned pk2(float lo, float hi) { return pg8::cvt_pk_bf16(lo, hi); }
__device__ __forceinline__ float bflo(unsigned w) { return __builtin_bit_cast(float, w << 16); }
__device__ __forceinline__ float bfhi(unsigned w) { return __builtin_bit_cast(float, w & 0xffff0000u); }
__device__ __forceinline__ unsigned char* ows(unsigned char* p) { unsigned long long v = (unsigned long long)p; asm volatile("" : "+s"(v)); return (unsigned char*)(__attribute__((address_space(1))) unsigned char*)v; }
__device__ __forceinline__ int otid(int wv) { int t = wv * 64 + (int)__builtin_amdgcn_mbcnt_hi(~0u, __builtin_amdgcn_mbcnt_lo(~0u, 0u)); asm volatile("" : "+v"(t)); return t; }
__device__ __forceinline__ float wave_sum(float v) {
#pragma unroll
    for (int o = 1; o < 64; o <<= 1) v += __shfl_xor(v, o);
    return v;
}
using pg8::silu_f;

__device__ __forceinline__ void transpose_item(const float* W, int K, int N, bf16_t* WT, LAS float* scr, int item, int lane) {
    const int nblk = N / 32, kb = item / nblk, nb = item % nblk, k0 = 64 * kb, n0 = 32 * nb;
    float tv[32];
#pragma unroll
    for (int i = 0; i < 32; ++i) tv[i] = __builtin_nontemporal_load(W + (size_t)(k0 + 2 * i + (lane >> 5)) * N + n0 + (lane & 31));
#pragma unroll
    for (int i = 0; i < 32; ++i) scr[(2 * i + (lane >> 5)) * 33 + (lane & 31)] = tv[i];
    asm volatile("s_waitcnt lgkmcnt(0)" ::: "memory");
    const int c = lane & 7;
#pragma unroll
    for (int j = 0; j < 4; ++j) { const int n = (lane >> 3) + 8 * j; const LAS float* s = scr + (8 * c) * 33 + n;
        u32x4 o; o.x = pk2(s[0 * 33], s[1 * 33]); o.y = pk2(s[2 * 33], s[3 * 33]); o.z = pk2(s[4 * 33], s[5 * 33]); o.w = pk2(s[6 * 33], s[7 * 33]);
        *(u32x4*)(WT + (size_t)(n0 + n) * K + k0 + 8 * c) = o; }
    asm volatile("s_waitcnt lgkmcnt(0)" ::: "memory");
}

__device__ __forceinline__ void phase_prep(const Args& A, LAS unsigned char* L, int layer, int vbid, int vG, const int wv) {
    const int tid = otid(wv), lane = tid & 63, wave = tid >> 6;
    unsigned char* ws = A.ws;
    const float* Wm = (layer == 0 ? A.in[5] : layer == 1 ? A.in[11] : layer == 2 ? A.in[23] : A.in[30]);
    for (int task = vbid; task < 48; task += vG) {
        const int cc = task >> 3, kc = task & 7;
        LAS float* s = (LAS float*)L;
        for (int idx = tid; idx < 9 * 128; idx += NTHREADS) { const int r = idx >> 7, kk = idx & 127;
            const float v = (r < 8) ? A.in[1][r * DM + kc * 128 + kk] : A.in[3][kc * 128 + kk];
            s[idx] = v / (1.0f + __expf(-v)); }
        LBAR();
        const int col = cc * 512 + tid;
        float acc[9];
#pragma unroll
        for (int r = 0; r < 9; ++r) acc[r] = 0.f;
        const float* wp = Wm + (size_t)(kc * 128) * 3072 + col;
#pragma unroll 32
        for (int kk = 0; kk < 128; ++kk) { const float w = __builtin_nontemporal_load(wp + (size_t)kk * 3072);
#pragma unroll
            for (int r = 0; r < 9; ++r) acc[r] += s[r * 128 + kk] * w; }
        float* mp = (float*)(ws + WS_MODP) + (size_t)((layer * 8 + kc) * 9) * 3072 + col;
#pragma unroll
        for (int r = 0; r < 9; ++r) mp[(size_t)r * 3072] = acc[r];
        LBAR();
    }
    if (layer == 0 && vbid == vG - 1) {
        float* rt = (float*)(ws + WS_ROPE);
        for (int idx = tid; idx < 1024; idx += NTHREADS) { const int p = idx >> 4, j = idx & 15;
            const float inv = 1.0f / __builtin_powf(10000.0f, (float)j * (1.0f / 16.0f));
            const float ang = (float)p * inv; float t = ang * 0.15915494309189535f; t -= __builtin_rintf(t);
            rt[idx * 2] = __builtin_amdgcn_cosf(t); rt[idx * 2 + 1] = __builtin_amdgcn_sinf(t); }
    }
    LAS float* scr = (LAS float*)(L + wave * 16384);
    const int rb = (vbid + vG - (48 % vG)) % vG;
    const int gw = rb * NWAVES + wave, NGW = vG * NWAVES;
    const int Nin = (layer == 0 || layer == 3) ? 2560 : (layer == 1 ? 2048 : 4096);
    const float* win = (layer == 0 ? A.in[7] : layer == 1 ? A.in[13] : layer == 2 ? A.in[25] : A.in[32]);
    const float* wout = (layer == 0 ? A.in[8] : layer == 1 ? A.in[14] : layer == 2 ? A.in[26] : A.in[33]);
    bf16_t* wint = (bf16_t*)(ws + (layer == 0 ? WS_WIN[0] : layer == 1 ? WS_WIN[1] : layer == 2 ? WS_WIN[2] : WS_WIN[3]));
    bf16_t* woutt = (bf16_t*)(ws + (layer == 0 ? WS_WOUT[0] : layer == 1 ? WS_WOUT[1] : layer == 2 ? WS_WOUT[2] : WS_WOUT[3]));
    const int IIN = 16 * (Nin / 32), IO = 16 * 32, IGW = layer == 0 ? 64 * 2 : 0;
    const int nitems = IIN + IO + IGW;
    for (int it = gw; it < nitems; it += NGW) {
        int r = it;
        if (r < IIN) { transpose_item(win, 1024, Nin, wint, scr, r, lane); continue; } r -= IIN;
        if (r < IO) { transpose_item(wout, 1024, 1024, woutt, scr, r, lane); continue; } r -= IO;
        { const int blk = r >> 1, sub = r & 1;
          const int dir = blk >> 5, gate = (blk >> 4) & 1, h = blk & 15;
          const float* src = (gate == 0 ? A.in[17] : A.in[19]) + (size_t)(dir * 16 + h) * 4096;
          transpose_item(src, 64, 64, (bf16_t*)(ws + WS_GW) + (size_t)blk * 4096, scr, sub, lane); }
    }
}

template <int NR> __device__ __forceinline__ void norm_load(const float* const (&xrow)[NR], f32x4 (&v)[NR][4], int lane) {
#pragma unroll
    for (int i = 0; i < NR; ++i) { const f32x4* xr = (const f32x4*)xrow[i] + lane;
#pragma unroll
        for (int j = 0; j < 4; ++j) v[i][j] = __builtin_nontemporal_load(xr + 64 * j); }
}
template <int NR> __device__ __forceinline__ void norm_proc(const f32x4 (&v)[NR][4], bf16_t* const (&orow)[NR], const LAS float* const (&gs)[NR], const LAS float* const (&sh)[NR], int lane) {
    float s[NR];
#pragma unroll
    for (int i = 0; i < NR; ++i) { float a = 0.f;
#pragma unroll
        for (int j = 0; j < 4; ++j) a += (v[i][j].x * v[i][j].x + v[i][j].y * v[i][j].y) + (v[i][j].z * v[i][j].z + v[i][j].w * v[i][j].w);
        s[i] = a; }
#pragma unroll
    for (int o = 1; o < 64; o <<= 1) {
#pragma unroll
        for (int i = 0; i < NR; ++i) s[i] += __shfl_xor(s[i], o); }
#pragma unroll
    for (int i = 0; i < NR; ++i) { const float rstd = 1.0f / sqrtf(s[i] * (1.0f / DM) + EPS); u32x2* o8 = (u32x2*)orow[i] + lane;
#pragma unroll
        for (int j = 0; j < 4; ++j) { const f32x4 g = *(const LAS f32x4*)(gs[i] + 256 * j + 4 * lane), b = *(const LAS f32x4*)(sh[i] + 256 * j + 4 * lane);
            const f32x4 y = v[i][j] * rstd * g + b; u32x2 w; w.x = pk2(y.x, y.y); w.y = pk2(y.z, y.w); o8[64 * j] = w; } }
}
__device__ __forceinline__ void phase_norm(const Args& A, int layer, const float* xL, const float* xC, LAS unsigned char* L, const int wv) {
    const int tid = otid(wv), lane = tid & 63, wave = tid >> 6, bid = blockIdx.x, G = gridDim.x;
    const float* norm_g = (layer == 0 ? A.in[4] : layer == 1 ? A.in[10] : layer == 2 ? A.in[22] : A.in[29]);
    const float* mod_b = (layer == 0 ? A.in[6] : layer == 1 ? A.in[12] : layer == 2 ? A.in[24] : A.in[31]);
    unsigned char* ws = ows(A.ws);
    const float* modp = (const float*)(ws + WS_MODP) + (size_t)(layer * 8) * 9 * 3072;
    bf16_t* XN = (bf16_t*)(ws + WS_XN);
    LAS float* tab = (LAS float*)L;
    for (int vb = bid; vb < 256; vb += G) {
        const int batch = vb >> 5;
        const float* xr[3][3]; bf16_t* orow[3][3]; const LAS float* gs[3][3]; const LAS float* sh[3][3];
#pragma unroll
          for (int bt = 0; bt < 3; ++bt)
#pragma unroll
            for (int i = 0; i < 3; ++i) { const int ri = bt * 3 + i;
                if (ri < 8) { const int row = vb * 64 + wave * 8 + ri; xr[bt][i] = xL + (size_t)row * DM; orow[bt][i] = XN + (size_t)row * DM; gs[bt][i] = tab; sh[bt][i] = tab + 1024; }
                else { const int row = vb * 8 + wave; xr[bt][i] = xC + (size_t)row * DM; orow[bt][i] = XN + (size_t)(ML + row) * DM; gs[bt][i] = tab + 2048; sh[bt][i] = tab + 3072; } }
          f32x4 va[3][4], vbb[3][4];
          norm_load<3>(xr[0], va, lane);
        { float bv[8], pv[8][8], gn[8];
#pragma unroll
          for (int i8 = 0; i8 < 8; ++i8) { const int idx = tid + i8 * NTHREADS; const int which = idx >> 10, col = idx & 1023; const int r = (which < 2) ? batch : 8; const int mcol = (which & 1) ? col : 1024 + col;
              bv[i8] = mod_b[mcol];
#pragma unroll
              for (int kc = 0; kc < 8; ++kc) pv[i8][kc] = modp[(size_t)(kc * 9 + r) * 3072 + mcol];
              gn[i8] = (which & 1) ? 0.f : norm_g[col]; }
#pragma unroll
          for (int i8 = 0; i8 < 8; ++i8) { const int idx = tid + i8 * NTHREADS; const int which = idx >> 10;
              float v = bv[i8];
#pragma unroll
              for (int kc = 0; kc < 8; ++kc) v += pv[i8][kc];
              if (!(which & 1)) v = gn[i8] * (1.0f + v);
              tab[idx] = v; } }
        if (vb < 9) { float* gf = (float*)(ws + WS_GATE) + (size_t)(layer * 9 + vb) * 1024;
            float gb[2], gp[2][8];
#pragma unroll
            for (int c2 = 0; c2 < 2; ++c2) { const int col = tid + c2 * NTHREADS; gb[c2] = mod_b[2048 + col];
#pragma unroll
                for (int kc = 0; kc < 8; ++kc) gp[c2][kc] = modp[(size_t)(kc * 9 + vb) * 3072 + 2048 + col]; }
#pragma unroll
            for (int c2 = 0; c2 < 2; ++c2) { float v = gb[c2];
#pragma unroll
                for (int kc = 0; kc < 8; ++kc) v += gp[c2][kc];
                gf[tid + c2 * NTHREADS] = v; } }
        norm_load<3>(xr[1], vbb, lane);
        LBAR();
        {
          norm_proc<3>(va, orow[0], gs[0], sh[0], lane);
          norm_load<3>(xr[2], va, lane);
          norm_proc<3>(vbb, orow[1], gs[1], sh[1], lane);
          norm_proc<3>(va, orow[2], gs[2], sh[2], lane); }
        LBAR();
    }
}

#define MFMA32(a, b, c) __builtin_amdgcn_mfma_f32_32x32x16_bf16((a), (b), (c), 0, 0, 0)
#define MFMA16(a, b, c) __builtin_amdgcn_mfma_f32_16x16x32_bf16((a), (b), (c), 0, 0, 0)
__device__ __forceinline__ int crow(int r, int hi) { return (r & 3) + 8 * (r >> 2) + 4 * hi; }
typedef short v4i16_t __attribute__((ext_vector_type(4)));
__device__ __forceinline__ float max3f(float a, float b, float c) { float r; asm("v_max3_f32 %0, %1, %2, %3" : "=v"(r) : "v"(a), "v"(b), "v"(c)); return r; }
__device__ __forceinline__ s16x4 vtr(LAS const unsigned char* p) { return __builtin_bit_cast(s16x4, __builtin_amdgcn_ds_read_tr16_b64_v4i16((LAS v4i16_t*)p)); }

__device__ __forceinline__ void phase_attn(const bf16_t* ACT, bf16_t* Y, const float* sink, bool need_ctx, LAS unsigned char* L, const int wv) {
    constexpr int LD = 2560, KSTR = 144, TILEB = 64 * KSTR, BUFB = 2 * TILEB;
    const int tid = otid(wv), lane = tid & 63, r32 = lane & 31, hi = lane >> 5, wave = __builtin_amdgcn_readfirstlane(tid >> 6);
    const int g = wave >> 1, half = wave & 1, G = gridDim.x;
    const int skey = tid >> 3, sch = tid & 7;
    const int stoff = skey * KSTR + sch * 16;
    const int koff = r32 * KSTR + hi * 16;
    const int voff = TILEB + (4 * hi + ((lane & 15) >> 2)) * KSTR + (16 * ((lane >> 4) & 1) + 4 * (lane & 3)) * 2;
    const int nunits = need_ctx ? 1152 : 1024;
    for (int u = blockIdx.x; u < nunits; u += G) {
        int b, kvh, qb; bool lat;
        if (u < 1024) { b = u >> 7; kvh = (u >> 5) & 3; qb = u & 31; lat = true; } else { const int e = u - 1024; b = e >> 4; kvh = (e >> 2) & 3; qb = e & 3; lat = false; }
        const int h = kvh * 4 + g;
        const int qpos = qb * 64 + half * 32 + r32;
        const int qrow = lat ? b * SEQ + qpos : ML + b * CTX + qpos;
        int tlo = 4, thi = 4;
        if (lat) { tlo = qb == 0 ? 6 : (qb == 1 ? 5 : 4); thi = qb == 31 ? 7 : (qb == 30 ? 8 : 9); }
        const int n = 4 + (thi - tlo);
        const int kp_base = qb * 64 - 128;
        bf16x8 qf[4];
        { const bf16_t* qp = ACT + (size_t)qrow * LD + h * 64 + hi * 8;
#pragma unroll
          for (int d0 = 0; d0 < 4; ++d0) qf[d0] = *(const bf16x8*)(qp + d0 * 16); }
        float m_run = sink[h] * LOG2E, l_run = hi ? 0.f : 1.f;
        f32x16 o0, o1;
#pragma unroll
        for (int r = 0; r < 16; ++r) { o0[r] = 0.f; o1[r] = 0.f; }
        const size_t kcol = 1024 + kvh * 64 + sch * 8, vcol = 1280 + kvh * 64 + sch * 8;
#define ATT_TROW(s_) (((s_) < 4 ? ML + b * CTX + (s_) * 64 : b * SEQ + kp_base + (tlo + (s_) - 8) * 64) + skey)
        u32x4 kq0, vq0, kq1, vq1, kq2, vq2;
        { const size_t krow = (size_t)ATT_TROW(0); kq0 = *(const u32x4*)(ACT + krow * LD + kcol); vq0 = *(const u32x4*)(ACT + krow * LD + vcol); }
        { const size_t krow = (size_t)ATT_TROW(1); kq1 = *(const u32x4*)(ACT + krow * LD + kcol); vq1 = *(const u32x4*)(ACT + krow * LD + vcol); }
        { const size_t krow = (size_t)ATT_TROW(2); kq2 = *(const u32x4*)(ACT + krow * LD + kcol); vq2 = *(const u32x4*)(ACT + krow * LD + vcol); }
        LBAR();
        *(LAS u32x4*)(L + stoff) = kq0; *(LAS u32x4*)(L + TILEB + stoff) = vq0;
        { const size_t krow = (size_t)ATT_TROW(3); kq0 = *(const u32x4*)(ACT + krow * LD + kcol); vq0 = *(const u32x4*)(ACT + krow * LD + vcol); }
        LBAR();
#define ATT_STEP(s_, KQ, VQ) do { const int s = (s_); \
            const int t = s < 4 ? s : tlo + (s - 4); \
            LAS const unsigned char* B = L + (s & 1) * BUFB; \
 \
              \
            bf16x8 kf[8]; s16x4 vl[8], vh[8]; \
_Pragma("unroll") \
            for (int d0 = 0; d0 < 4; ++d0) { kf[2 * d0] = *(const LAS bf16x8*)(B + koff + d0 * 32); kf[2 * d0 + 1] = *(const LAS bf16x8*)(B + koff + 32 * KSTR + d0 * 32); } \
_Pragma("unroll") \
            for (int i = 0; i < 4; ++i) { LAS const unsigned char* vp = B + voff + i * 16 * KSTR; vl[2 * i] = vtr(vp); vh[2 * i] = vtr(vp + 8 * KSTR); vl[2 * i + 1] = vtr(vp + 64); vh[2 * i + 1] = vtr(vp + 8 * KSTR + 64); } \
            __builtin_amdgcn_sched_barrier(0); \
            f32x16 p0, p1; \
_Pragma("unroll") \
            for (int r = 0; r < 16; ++r) { p0[r] = 0.f; p1[r] = 0.f; } \
_Pragma("unroll") \
            for (int d0 = 0; d0 < 4; ++d0) { p0 = MFMA32(kf[2 * d0], qf[d0], p0); p1 = MFMA32(kf[2 * d0 + 1], qf[d0], p1); } \
            if (t == 4 || t == 8) { const int kp0 = kp_base + (t - 4) * 64 - qpos; \
_Pragma("unroll") \
                for (int r = 0; r < 16; ++r) { const int d0 = kp0 + crow(r, hi), d1 = d0 + 32; \
                    if (d0 > 128 || d0 < -128) p0[r] = -1e30f; if (d1 > 128 || d1 < -128) p1[r] = -1e30f; } } \
            float mt = max3f(p0[0], p0[1], p1[0]), mt2 = max3f(p0[2], p0[3], p1[1]); mt = max3f(mt, p1[2], p1[3]); \
_Pragma("unroll") \
            for (int r = 4; r < 16; r += 4) { mt = max3f(mt, p0[r], p0[r + 1]); mt2 = max3f(mt2, p0[r + 2], p0[r + 3]); mt = max3f(mt, p1[r], p1[r + 1]); mt2 = max3f(mt2, p1[r + 2], p1[r + 3]); } \
            mt = fmaxf(mt, mt2); \
            mt = fmaxf(mt, __shfl_xor(mt, 32)) - m_run; \
 \
            float dl = 0.f; \
            if (s == 0) dl = fmaxf(mt, 0.f); else if (mt > 8.0f) dl = mt; \
            if (__any(dl != 0.f)) { const float alpha = __builtin_amdgcn_exp2f(-dl); m_run += dl; l_run *= alpha; \
_Pragma("unroll") \
                for (int r = 0; r < 16; ++r) { o0[r] *= alpha; o1[r] *= alpha; } } \
            float ls = 0.f, ls2 = 0.f; \
_Pragma("unroll") \
            for (int r = 0; r < 16; ++r) { p0[r] = __builtin_amdgcn_exp2f(p0[r] - m_run); p1[r] = __builtin_amdgcn_exp2f(p1[r] - m_run); ls += p0[r]; ls2 += p1[r]; } \
            ls += ls2; \
            l_run += ls; \
            bf16x8 pb[2][2]; \
_Pragma("unroll") \
            for (int j = 0; j < 2; ++j) { \
                u32x4 w0, w1; \
                w0.x = pk2(p0[8 * j + 0], p0[8 * j + 1]); w0.y = pk2(p0[8 * j + 2], p0[8 * j + 3]); w0.z = pk2(p0[8 * j + 4], p0[8 * j + 5]); w0.w = pk2(p0[8 * j + 6], p0[8 * j + 7]); \
                w1.x = pk2(p1[8 * j + 0], p1[8 * j + 1]); w1.y = pk2(p1[8 * j + 2], p1[8 * j + 3]); w1.z = pk2(p1[8 * j + 4], p1[8 * j + 5]); w1.w = pk2(p1[8 * j + 6], p1[8 * j + 7]); \
                pb[0][j] = __builtin_bit_cast(bf16x8, w0); pb[1][j] = __builtin_bit_cast(bf16x8, w1); \
            } \
 \
_Pragma("unroll") \
            for (int kb = 0; kb < 2; ++kb) \
_Pragma("unroll") \
                for (int j = 0; j < 2; ++j) { const int i = kb * 2 + j; \
                    const bf16x8 a0 = __builtin_shufflevector(vl[2 * i], vh[2 * i], 0, 1, 2, 3, 4, 5, 6, 7), a1 = __builtin_shufflevector(vl[2 * i + 1], vh[2 * i + 1], 0, 1, 2, 3, 4, 5, 6, 7); \
                    o0 = MFMA32(a0, pb[kb][j], o0); o1 = MFMA32(a1, pb[kb][j], o1); \
                } \
            if (s + 1 < n) { LAS unsigned char* Bn = L + ((s + 1) & 1) * BUFB; *(LAS u32x4*)(Bn + stoff) = KQ; *(LAS u32x4*)(Bn + TILEB + stoff) = VQ; } \
            LBAR(); \
            if (s + 4 < n) { const size_t krow = (size_t)ATT_TROW(s + 4); KQ = *(const u32x4*)(ACT + krow * LD + kcol); VQ = *(const u32x4*)(ACT + krow * LD + vcol); } \
        } while (0)
#pragma unroll 1
        for (int s0 = 0; s0 < n; s0 += 3) {
            ATT_STEP(s0, kq1, vq1);
            if (s0 + 1 < n) ATT_STEP(s0 + 1, kq2, vq2);
            if (s0 + 2 < n) ATT_STEP(s0 + 2, kq0, vq0);
        }
#undef ATT_STEP
#undef ATT_TROW
        u32x4 sgq[4];
        { const int qrow0 = qrow - r32;
#pragma unroll
          for (int it = 0; it < 4; ++it) sgq[it] = *(const u32x4*)(ACT + (size_t)(qrow0 + it * 8 + (lane >> 3)) * LD + 1536 + h * 64 + (lane & 7) * 8); }
        const float lt = l_run + __shfl_xor(l_run, 32); const float inv = 1.0f / lt;
        LAS float* stg = (LAS float*)(L + 40960 + wave * 8704);
#pragma unroll
        for (int db = 0; db < 2; ++db)
#pragma unroll
            for (int q4 = 0; q4 < 4; ++q4) { const int d = 32 * db + 8 * q4 + 4 * hi; f32x4 v;
                if (db == 0) v = (f32x4){o0[4 * q4], o0[4 * q4 + 1], o0[4 * q4 + 2], o0[4 * q4 + 3]}; else v = (f32x4){o1[4 * q4], o1[4 * q4 + 1], o1[4 * q4 + 2], o1[4 * q4 + 3]};
                *(LAS f32x4*)(stg + r32 * 68 + d) = v * inv; }
        asm volatile("s_waitcnt lgkmcnt(0)" ::: "memory");
        { const int qrow0 = qrow - r32; const int er = lane >> 3, ec = (lane & 7) * 8;
#pragma unroll
          for (int it = 0; it < 4; ++it) { const int row = it * 8 + er; const size_t grow = (size_t)(qrow0 + row);
              const f32x4 a0 = *(const LAS f32x4*)(stg + row * 68 + ec), a1 = *(const LAS f32x4*)(stg + row * 68 + ec + 4);
              const u32x4 gw = sgq[it];
              u32x4 w; w.x = pk2(a0.x * bflo(gw.x), a0.y * bfhi(gw.x)); w.y = pk2(a0.z * bflo(gw.y), a0.w * bfhi(gw.y)); w.z = pk2(a1.x * bflo(gw.z), a1.y * bfhi(gw.z)); w.w = pk2(a1.z * bflo(gw.w), a1.w * bfhi(gw.w));
              *(u32x4*)(Y + grow * DM + h * 64 + ec) = w; } }
    }
    LBAR();
}

__device__ __forceinline__ void phase_lru(const Args& A, const bf16_t* ACT, bf16_t* Y, float* HF, LAS unsigned char* L, const int wv) {
    constexpr int LD = 2048, TT = 128, USTR = 144;
    const int tid = otid(wv), lane = tid & 63, wave = __builtin_amdgcn_readfirstlane(tid >> 6), G = gridDim.x;
    LAS unsigned char* UL = L;
    LAS unsigned char* XA = L + 19200;
    LAS float* XF = (LAS float*)(L + 19200 + 18432);
    LAS f32x2* AB = (LAS f32x2*)(L + 19200 + 18432 + 16384);
    LAS f32x2* CAR = (LAS f32x2*)(L + 19200 + 18432 + 16384 + 32768);
    LAS float* ST = (LAS float*)(L + 19200 + 18432 + 16384 + 32768 + 4096);
    LAS float* CW = (LAS float*)(L + 19200 + 18432 + 16384 + 32768 + 4096 + 256);
    const bf16_t* gwT = (const bf16_t*)(ows(A.ws) + WS_GW);
    const float* conv_w = A.in[15]; const float* conv_b = A.in[16]; const float* ba = A.in[18]; const float* bx = A.in[20]; const float* lam = A.in[21];
    const int fr = lane & 15, fq = lane >> 4;
    const int stok = tid >> 3, sch = tid & 7;
    const int ch = tid & 31, sc = tid >> 5;
    const int otok = tid >> 2, oq = tid & 3;
    for (int u = blockIdx.x; u < 256; u += G) {
        const int b = u >> 5, hb = u & 31, hblk = hb >> 1, half = hb & 1, cin0 = hblk * 64, c0 = cin0 + half * 32;
#pragma unroll 1
        for (int dir = 0; dir < 2; ++dir) {
            LBAR();
            if (tid < 320) { const int k = tid >> 6, c = tid & 63; CW[tid] = (k < 4) ? conv_w[(size_t)(dir * 4 + k) * DM + cin0 + c] : conv_b[(size_t)dir * DM + cin0 + c]; }
            const int cbk = wave & 1;
            bf16x8 wr_[2], wi_[2];
            { const bf16_t* pr = gwT + ((size_t)((dir * 2 + 0) * 16 + hblk) * 64 + half * 32 + cbk * 16 + fr) * 64 + fq * 8;
              const bf16_t* pi = gwT + ((size_t)((dir * 2 + 1) * 16 + hblk) * 64 + half * 32 + cbk * 16 + fr) * 64 + fq * 8;
              wr_[0] = *(const bf16x8*)pr; wr_[1] = *(const bf16x8*)(pr + 32); wi_[0] = *(const bf16x8*)pi; wi_[1] = *(const bf16x8*)(pi + 32); }
            float eba[4], ebx[4], esp[4];
#pragma unroll
            for (int e = 0; e < 4; ++e) { const int c = dir * DM + c0 + cbk * 16 + 4 * fq + e; eba[e] = ba[c]; ebx[e] = bx[c];
                const float nl = -lam[c]; esp[e] = (fmaxf(nl, 0.f) + log1pf(__expf(-fabsf(nl)))) * (-8.0f * LOG2E); }
            if (tid < 32) ST[tid] = 0.f;
            u32x4 ur[2], uh = (u32x4){0u, 0u, 0u, 0u};
            { const int rowbase = ML + b * CTX;
#pragma unroll
              for (int i2 = 0; i2 < 2; ++i2) { const int S = stok + 64 * i2; const int row = rowbase + (dir ? CTX - 1 - S : S); ur[i2] = *(const u32x4*)(ACT + (size_t)row * LD + cin0 + sch * 8); } }
            f32x4 hf0 = (f32x4){0.f, 0.f, 0.f, 0.f}, hf1 = hf0; u32x4 gv = (u32x4){0u, 0u, 0u, 0u}; size_t orow = 0; int oseq = 0;
#define LRU_OUT() do { const f32x4 h0 = *(const LAS f32x4*)(XF + otok * 32 + oq * 8), h1 = *(const LAS f32x4*)(XF + otok * 32 + oq * 8 + 4); \
                if (dir == 0) { f32x4* hp = (f32x4*)(HF + ((size_t)u * 2304 + oseq) * 32 + oq * 8); hp[0] = h0; hp[1] = h1; } \
                else { const f32x4 s0 = h0 + hf0, s1 = h1 + hf1; u32x4 w; \
                    w.x = pk2(s0.x * bflo(gv.x), s0.y * bfhi(gv.x)); w.y = pk2(s0.z * bflo(gv.y), s0.w * bfhi(gv.y)); w.z = pk2(s1.x * bflo(gv.z), s1.y * bfhi(gv.z)); w.w = pk2(s1.z * bflo(gv.w), s1.w * bfhi(gv.w)); \
                    *(u32x4*)(Y + orow * DM + c0 + oq * 8) = w; } } while (0)
#pragma unroll 1
            for (int tl = 0; tl < 18; ++tl) {
                const int seg = tl < 2 ? 0 : 1, S0 = seg ? (tl - 2) * TT : tl * TT, seglen = seg ? SEQ : CTX, rowbase = seg ? b * SEQ : ML + b * CTX;
                LBAR();
                *(LAS u32x4*)(UL + (3 + stok) * USTR + sch * 16) = ur[0]; *(LAS u32x4*)(UL + (3 + 64 + stok) * USTR + sch * 16) = ur[1];
                if (tid < 24) *(LAS u32x4*)(UL + stok * USTR + sch * 16) = uh;
                if (tl > 0) LRU_OUT();
                LBAR();
                { const int S = S0 + otok; const int pos = dir ? seglen - 1 - S : S; orow = (size_t)(rowbase + pos); oseq = seg ? CTX + pos : pos;
                  if (dir == 1) { const f32x4* hp = (const f32x4*)(HF + ((size_t)u * 2304 + oseq) * 32 + oq * 8); hf0 = hp[0]; hf1 = hp[1]; gv = *(const u32x4*)(ACT + orow * LD + 1024 + c0 + oq * 8); } }
                if (tl + 1 < 18) { const int tn = tl + 1; const int seg2 = tn < 2 ? 0 : 1, S02 = seg2 ? (tn - 2) * TT : tn * TT, seglen2 = seg2 ? SEQ : CTX, rowbase2 = seg2 ? b * SEQ : ML + b * CTX;
#pragma unroll
                    for (int i2 = 0; i2 < 2; ++i2) { const int S = S02 + stok + 64 * i2; const int row = rowbase2 + (dir ? seglen2 - 1 - S : S); ur[i2] = *(const u32x4*)(ACT + (size_t)row * LD + cin0 + sch * 8); }
                    uh = (u32x4){0u, 0u, 0u, 0u};
                    if (tid < 24 && S02 > 0) { const int S = S02 - 3 + stok; const int row = rowbase2 + (dir ? seglen2 - 1 - S : S); uh = *(const u32x4*)(ACT + (size_t)row * LD + cin0 + sch * 8); } }
                for (int rep_ = 0; rep_ < DUP_LRUBC; ++rep_) {
                { float x0[8], x1[8];
                  { const f32x4 ca = *(const LAS f32x4*)(CW + 256 + sch * 8), cc = *(const LAS f32x4*)(CW + 256 + sch * 8 + 4);
                    x0[0] = ca.x; x0[1] = ca.y; x0[2] = ca.z; x0[3] = ca.w; x0[4] = cc.x; x0[5] = cc.y; x0[6] = cc.z; x0[7] = cc.w;
#pragma unroll
                    for (int e = 0; e < 8; ++e) x1[e] = x0[e]; }
#pragma unroll
                  for (int k = 0; k < 4; ++k) { const f32x4 wa = *(const LAS f32x4*)(CW + k * 64 + sch * 8), wb = *(const LAS f32x4*)(CW + k * 64 + sch * 8 + 4);
                      const u32x4 u0 = *(const LAS u32x4*)(UL + (stok + k) * USTR + sch * 16), u1 = *(const LAS u32x4*)(UL + (stok + 64 + k) * USTR + sch * 16);
                      x0[0] += wa.x * bflo(u0.x); x0[1] += wa.y * bfhi(u0.x); x0[2] += wa.z * bflo(u0.y); x0[3] += wa.w * bfhi(u0.y);
                      x0[4] += wb.x * bflo(u0.z); x0[5] += wb.y * bfhi(u0.z); x0[6] += wb.z * bflo(u0.w); x0[7] += wb.w * bfhi(u0.w);
                      x1[0] += wa.x * bflo(u1.x); x1[1] += wa.y * bfhi(u1.x); x1[2] += wa.z * bflo(u1.y); x1[3] += wa.w * bfhi(u1.y);
                      x1[4] += wb.x * bflo(u1.z); x1[5] += wb.y * bfhi(u1.z); x1[6] += wb.z * bflo(u1.w); x1[7] += wb.w * bfhi(u1.w); }
                  u32x4 w; w.x = pk2(x0[0], x0[1]); w.y = pk2(x0[2], x0[3]); w.z = pk2(x0[4], x0[5]); w.w = pk2(x0[6], x0[7]);
                  *(LAS u32x4*)(XA + stok * USTR + sch * 16) = w;
                  w.x = pk2(x1[0], x1[1]); w.y = pk2(x1[2], x1[3]); w.z = pk2(x1[4], x1[5]); w.w = pk2(x1[6], x1[7]);
                  *(LAS u32x4*)(XA + (stok + 64) * USTR + sch * 16) = w;
                  if ((sch >> 2) == half) { LAS f32x4* xf = (LAS f32x4*)(XF + stok * 32 + (sch & 3) * 8); xf[0] = (f32x4){x0[0], x0[1], x0[2], x0[3]}; xf[1] = (f32x4){x0[4], x0[5], x0[6], x0[7]};
                      xf = (LAS f32x4*)(XF + (stok + 64) * 32 + (sch & 3) * 8); xf[0] = (f32x4){x1[0], x1[1], x1[2], x1[3]}; xf[1] = (f32x4){x1[4], x1[5], x1[6], x1[7]}; } }
                LBAR();
#pragma unroll
                for (int i2 = 0; i2 < 2; ++i2) { const int tb = (wave >> 1) + 4 * i2; const int tok = tb * 16 + fr;
                    const bf16x8 x0 = *(const LAS bf16x8*)(XA + tok * USTR + fq * 16), x1 = *(const LAS bf16x8*)(XA + tok * USTR + 64 + fq * 16);
                    f32x4 ar = (f32x4){0.f, 0.f, 0.f, 0.f}, ai = (f32x4){0.f, 0.f, 0.f, 0.f};
                    ar = MFMA16(wr_[0], x0, ar); ar = MFMA16(wr_[1], x1, ar); ai = MFMA16(wi_[0], x0, ai); ai = MFMA16(wi_[1], x1, ai);
                    const f32x4 xv = *(const LAS f32x4*)(XF + tok * 32 + cbk * 16 + 4 * fq);
                    float av[4], bv[4];
#pragma unroll
                    for (int e = 0; e < 4; ++e) { const float r = __builtin_amdgcn_rcpf(1.0f + __builtin_amdgcn_exp2f(-(ar[e] + eba[e]) * LOG2E)); const float ig = __builtin_amdgcn_rcpf(1.0f + __builtin_amdgcn_exp2f(-(ai[e] + ebx[e]) * LOG2E));
                        const float a_ = __builtin_amdgcn_exp2f(r * esp[e]); av[e] = a_; bv[e] = __builtin_amdgcn_sqrtf(fmaxf(1.0f - a_ * a_, 0.f)) * (ig * xv[e]); }
                    LAS f32x4* ab = (LAS f32x4*)(AB + tok * 32 + cbk * 16 + 4 * fq); ab[0] = (f32x4){av[0], bv[0], av[1], bv[1]}; ab[1] = (f32x4){av[2], bv[2], av[3], bv[3]}; }
                LBAR();
                }
                float a8[8], b8[8];
                { float Ap = 1.f, H = 0.f;
#pragma unroll
                  for (int k = 0; k < 8; ++k) { const f32x2 v = AB[(sc * 8 + k) * 32 + ch]; a8[k] = v.x; b8[k] = v.y; H = v.x * H + v.y; Ap *= v.x; }
                  CAR[sc * 32 + ch] = (f32x2){Ap, H}; }
                LBAR();
                float hrun = ST[(tl & 1) * 32 + ch];
                { f32x2 cr[15];
#pragma unroll
                  for (int s = 0; s < 15; ++s) cr[s] = CAR[s * 32 + ch];
#pragma unroll
                  for (int s = 0; s < 15; ++s) hrun = (s < sc) ? cr[s].x * hrun + cr[s].y : hrun; }
#pragma unroll
                for (int k = 0; k < 8; ++k) { hrun = a8[k] * hrun + b8[k]; XF[(sc * 8 + k) * 32 + ch] = hrun; }
                if (sc == 15) ST[((tl + 1) & 1) * 32 + ch] = hrun;
            }
            LBAR();
            LRU_OUT();
            asm volatile("s_waitcnt vmcnt(0)" ::: "memory");
        }
        LBAR();
    }
#undef LRU_OUT
}

__device__ __forceinline__ void cu8(const bf16_t* ACT, size_t row, int col, float* o) {
    const u32x4 a = __builtin_nontemporal_load((const u32x4*)(ACT + row * 4096 + col)), c = __builtin_nontemporal_load((const u32x4*)(ACT + row * 4096 + 2048 + col));
    o[0] = bflo(a.x) * bflo(c.x); o[1] = bfhi(a.x) * bfhi(c.x); o[2] = bflo(a.y) * bflo(c.y); o[3] = bfhi(a.y) * bfhi(c.y);
    o[4] = bflo(a.z) * bflo(c.z); o[5] = bfhi(a.z) * bfhi(c.z); o[6] = bflo(a.w) * bflo(c.w); o[7] = bfhi(a.w) * bfhi(c.w);
}
__device__ __forceinline__ void phase_conv(const Args& A, const bf16_t* ACT, bf16_t* Y, const int wv) {
    const float* conv_w = A.in[27]; const float* conv_b = A.in[28];
    const int nitems = (MT / 8) * 128;
    const int tid = otid(wv);
    for (int item = blockIdx.x * NTHREADS + tid; item < nitems; item += gridDim.x * NTHREADS) {
        const int rg = item >> 7, chunk = item & 127, col = chunk * 8, row0 = rg * 8;
        const int seglen = row0 < ML ? SEQ : CTX;
        const bool first = (row0 % seglen) == 0, last = ((row0 + 8) % seglen) == 0;
        float w0[8], w1[8], w2[8], cb[8];
        { const f32x4* p = (const f32x4*)(conv_w + col); f32x4 a = p[0], c = p[1]; w0[0] = a.x; w0[1] = a.y; w0[2] = a.z; w0[3] = a.w; w0[4] = c.x; w0[5] = c.y; w0[6] = c.z; w0[7] = c.w;
          p = (const f32x4*)(conv_w + DM + col); a = p[0]; c = p[1]; w1[0] = a.x; w1[1] = a.y; w1[2] = a.z; w1[3] = a.w; w1[4] = c.x; w1[5] = c.y; w1[6] = c.z; w1[7] = c.w;
          p = (const f32x4*)(conv_w + 2 * DM + col); a = p[0]; c = p[1]; w2[0] = a.x; w2[1] = a.y; w2[2] = a.z; w2[3] = a.w; w2[4] = c.x; w2[5] = c.y; w2[6] = c.z; w2[7] = c.w;
          p = (const f32x4*)(conv_b + col); a = p[0]; c = p[1]; cb[0] = a.x; cb[1] = a.y; cb[2] = a.z; cb[3] = a.w; cb[4] = c.x; cb[5] = c.y; cb[6] = c.z; cb[7] = c.w; }
        float prev[8], cur[8], nxt[8];
        if (first) {
#pragma unroll
            for (int e = 0; e < 8; ++e) prev[e] = 0.f;
        } else cu8(ACT, (size_t)row0 - 1, col, prev);
        cu8(ACT, (size_t)row0, col, cur);
#pragma unroll
        for (int k = 0; k < 8; ++k) {
            const size_t row = (size_t)row0 + k;
            if (k == 7 && last) {
#pragma unroll
                for (int e = 0; e < 8; ++e) nxt[e] = 0.f;
            } else cu8(ACT, row + 1, col, nxt);
            const u32x4 bgw = __builtin_nontemporal_load((const u32x4*)(ACT + row * 4096 + 1024 + col)), sgw = __builtin_nontemporal_load((const u32x4*)(ACT + row * 4096 + 3072 + col));
            float y[8];
#pragma unroll
            for (int e = 0; e < 8; ++e) y[e] = w0[e] * prev[e] + w1[e] * cur[e] + w2[e] * nxt[e] + cb[e];
            y[0] *= bflo(bgw.x) * bflo(sgw.x); y[1] *= bfhi(bgw.x) * bfhi(sgw.x); y[2] *= bflo(bgw.y) * bflo(sgw.y); y[3] *= bfhi(bgw.y) * bfhi(sgw.y);
            y[4] *= bflo(bgw.z) * bflo(sgw.z); y[5] *= bfhi(bgw.z) * bfhi(sgw.z); y[6] *= bflo(bgw.w) * bflo(sgw.w); y[7] *= bfhi(bgw.w) * bfhi(sgw.w);
            u32x4 w; w.x = pk2(y[0], y[1]); w.y = pk2(y[2], y[3]); w.z = pk2(y[4], y[5]); w.w = pk2(y[6], y[7]);
            *(u32x4*)(Y + row * DM + col) = w;
#pragma unroll
            for (int e = 0; e < 8; ++e) { prev[e] = cur[e]; cur[e] = nxt[e]; }
        }
    }
}

__device__ __forceinline__ void phase_ctx_wout(const bf16_t* Yc, const bf16_t* Wt, const float* xin, float* xout, const float* gate, LAS unsigned char* L, const int wv) {
    constexpr int PITCH = 144, ABYTES = 128 * PITCH, BUFB = 192 * PITCH;
    const int tid = otid(wv), lane = tid & 63, r32 = lane & 31, hi = lane >> 5, wave = wv, G = gridDim.x;
    const int srow = tid >> 3, sch = tid & 7;
    const int aoff = ((wave >> 1) * 32 + r32) * PITCH + hi * 64, boff = ABYTES + ((wave & 1) * 32 + r32) * PITCH + hi * 64;
    for (int t = blockIdx.x; t < 256; t += G) {
        const int tm = t >> 4, tn = t & 15;
        const bf16_t* ga0 = Yc + (size_t)(tm * 128 + srow) * DM + sch * 8; const bf16_t* ga1 = ga0 + (size_t)64 * DM; const bf16_t* gb = Wt + (size_t)(tn * 64 + srow) * DM + sch * 8;
        f32x16 acc;
#pragma unroll
        for (int r = 0; r < 16; ++r) acc[r] = 0.f;
        u32x4 qa0[3], qa1[3], qb[3];
#define CTX_LOAD(q, s_) do { qa0[q] = *(const u32x4*)(ga0 + (s_) * 64); qa1[q] = *(const u32x4*)(ga1 + (s_) * 64); qb[q] = *(const u32x4*)(gb + (s_) * 64); } while (0)
#define CTX_WRITE(q, buf) do { LAS unsigned char* Bn = L + (buf) * BUFB; *(LAS u32x4*)(Bn + srow * PITCH + sch * 16) = qa0[q]; *(LAS u32x4*)(Bn + (64 + srow) * PITCH + sch * 16) = qa1[q]; *(LAS u32x4*)(Bn + ABYTES + srow * PITCH + sch * 16) = qb[q]; } while (0)
#define CTX_STEP(s_, q) do { const int s = (s_); LAS const unsigned char* B = L + (s & 1) * BUFB; bf16x8 a[4], b[4]; \
            _Pragma("unroll") for (int j = 0; j < 4; ++j) { a[j] = *(const LAS bf16x8*)(B + aoff + j * 16); b[j] = *(const LAS bf16x8*)(B + boff + j * 16); } \
            _Pragma("unroll") for (int j = 0; j < 4; ++j) acc = MFMA32(a[j], b[j], acc); \
            if (s + 1 < 16) CTX_WRITE(q, (s + 1) & 1); \
            LBAR(); \
            if (s + 4 < 16) CTX_LOAD(q, s + 4); } while (0)
        CTX_LOAD(0, 0); CTX_LOAD(1, 1); CTX_LOAD(2, 2);
        LBAR();
        CTX_WRITE(0, 0);
        CTX_LOAD(0, 3);
        LBAR();
#pragma unroll 1
        for (int s0 = 0; s0 < 16; s0 += 3) {
            CTX_STEP(s0, 1);
            if (s0 + 1 < 16) CTX_STEP(s0 + 1, 2);
            if (s0 + 2 < 16) CTX_STEP(s0 + 2, 0);
        }
#undef CTX_LOAD
#undef CTX_WRITE
#undef CTX_STEP
        const int m0 = tm * 128 + (wave >> 1) * 32, col = tn * 64 + (wave & 1) * 32 + r32; const float gv = gate[col];
        float xv[16];
#pragma unroll
        for (int r = 0; r < 16; ++r) xv[r] = xin[(size_t)(m0 + crow(r, hi)) * DM + col];
#pragma unroll
        for (int r = 0; r < 16; ++r) xout[(size_t)(m0 + crow(r, hi)) * DM + col] = xv[r] + gv * acc[r];
    }
    LBAR();
}

__device__ __forceinline__ void phase_final(float* out, const float* g, const int wv) {
    const int tid = otid(wv); const int lane = tid & 63, gw = blockIdx.x * NWAVES + (tid >> 6), NGW = gridDim.x * NWAVES;
    f32x4 gv[4];
#pragma unroll
    for (int j = 0; j < 4; ++j) gv[j] = *((const f32x4*)g + 64 * j + lane);
    for (int row0 = gw * 4; row0 < ML; row0 += NGW * 4) {
        f32x4 v[4][4]; float s[4];
#pragma unroll
        for (int i = 0; i < 4; ++i) { const f32x4* xr = (const f32x4*)(out + (size_t)(row0 + i) * DM) + lane;
#pragma unroll
            for (int j = 0; j < 4; ++j) v[i][j] = __builtin_nontemporal_load(xr + 64 * j); }
#pragma unroll
        for (int i = 0; i < 4; ++i) { float a = 0.f;
#pragma unroll
            for (int j = 0; j < 4; ++j) a += (v[i][j].x * v[i][j].x + v[i][j].y * v[i][j].y) + (v[i][j].z * v[i][j].z + v[i][j].w * v[i][j].w);
            s[i] = a; }
#pragma unroll
        for (int o = 1; o < 64; o <<= 1) {
#pragma unroll
            for (int i = 0; i < 4; ++i) s[i] += __shfl_xor(s[i], o); }
#pragma unroll
        for (int i = 0; i < 4; ++i) { const float rstd = 1.0f / sqrtf(s[i] * (1.0f / DM) + EPS); f32x4* xr = (f32x4*)(out + (size_t)(row0 + i) * DM) + lane;
#pragma unroll
            for (int j = 0; j < 4; ++j) xr[64 * j] = v[i][j] * rstd * gv[j]; }
    }
}

#define RLX_AGENT __ATOMIC_RELAXED, __HIP_MEMORY_SCOPE_AGENT
#define XB_TMO      128
#define XB_XCNT(j)  (256  + 64 * (j))
#define XB_XSUB(j)  (1280 + 64 * (j))
#define XB_XGEN(j)  (2304 + 64 * (j))
#define XB_TOP      3328
#define XB_TOPGEN   3392
#define XCD_BAR_WORDS 3456
#define XB_SPIN_CAP (1u << 18)

__device__ __forceinline__ unsigned xb_ld(unsigned* p)              { return __hip_atomic_load(p, __ATOMIC_RELAXED, __HIP_MEMORY_SCOPE_AGENT); }
__device__ __forceinline__ unsigned xb_add(unsigned* p, unsigned v) { return __hip_atomic_fetch_add(p, v, __ATOMIC_RELAXED, __HIP_MEMORY_SCOPE_AGENT); }
__device__ __forceinline__ unsigned xb_xcc_id() { return (unsigned)__builtin_amdgcn_s_getreg((3 << 11) | 20) & 0xFu; }
#define XB_SPIN(cond, bar) do { unsigned _sp = 0; while (cond) { __builtin_amdgcn_s_sleep(1); \
    if ((++_sp & 255u) == 0u) { if (xb_ld(&(bar)[XB_TMO])) break; if (_sp > XB_SPIN_CAP) { atomicAdd(&(bar)[XB_TMO], 1u); break; } } } } while (0)

struct XcdBarrier {
    unsigned* bar; unsigned x;
    volatile LAS unsigned* st;
};

__device__ __forceinline__ XcdBarrier xcd_barrier_post(unsigned* bar, volatile LAS unsigned* st) {
    XcdBarrier b; b.bar = bar; b.x = xb_xcc_id(); b.st = st;
    if (threadIdx.x == 0) (void)xb_add(&bar[XB_XCNT(b.x)], 1u);
    return b;
}
__device__ __forceinline__ void xcd_barrier_complete(unsigned* bar, unsigned x, unsigned& nloc, unsigned& nx) {
    const unsigned G = gridDim.x * gridDim.y * gridDim.z;
    unsigned sum, cnt, mine, sp = 0u;
    for (;;) {
        sum = 0u; cnt = 0u; mine = 0u;
#pragma unroll
        for (unsigned j = 0; j < 16; ++j) { const unsigned c = xb_ld(&bar[XB_XCNT(j)]); sum += c; cnt += (c > 0u) ? 1u : 0u; mine = (j == x) ? c : mine; }
        if (sum == G) break;
        __builtin_amdgcn_s_sleep(1);
        if ((++sp & 255u) == 0u) { if (xb_ld(&bar[XB_TMO])) break; if (sp > XB_SPIN_CAP) { atomicAdd(&bar[XB_TMO], 1u); break; } }
    }
    nloc = mine > 0u ? mine : 1u; nx = cnt > 0u ? cnt : 1u;
}

__device__ __forceinline__ void xcd_barrier(const XcdBarrier& b) {
    asm volatile("s_waitcnt vmcnt(0)" ::: "memory");
    __syncthreads();
    if (threadIdx.x == 0) {
        unsigned* bar = b.bar;
        __builtin_amdgcn_s_waitcnt(0);
        unsigned nloc = b.st[0], nx = b.st[1];
        if (nloc == 0u) { xcd_barrier_complete(bar, b.x, nloc, nx); b.st[0] = nloc; b.st[1] = nx; }
        const unsigned old = xb_add(&bar[XB_XSUB(b.x)], 1u);
        const unsigned gen = old / nloc;
        if (old + 1u == (gen + 1u) * nloc) {
            __builtin_amdgcn_fence(__ATOMIC_RELEASE, "agent");
            asm volatile("s_waitcnt vmcnt(0)" ::: "memory");
            const unsigned og = xb_add(&bar[XB_TOP], 1u);
            const unsigned tg = og / nx;
            if (og + 1u == (tg + 1u) * nx) xb_add(&bar[XB_TOPGEN], 1u);
            else XB_SPIN(xb_ld(&bar[XB_TOPGEN]) == tg, bar);
            __builtin_amdgcn_fence(__ATOMIC_ACQUIRE, "agent");
            xb_add(&bar[XB_XGEN(b.x)], 1u);
            asm volatile("s_waitcnt vmcnt(0)" ::: "memory");
        } else {
            XB_SPIN(xb_ld(&bar[XB_XGEN(b.x)]) == gen, bar);
            __builtin_amdgcn_fence(__ATOMIC_ACQUIRE, "agent");
            asm volatile("s_waitcnt vmcnt(0)" ::: "memory");
        }
    }
    __syncthreads();
}

__global__ void __launch_bounds__(NTHREADS, 2) hybrid_fwd(Args A) {
    extern __shared__ __attribute__((aligned(16))) unsigned char lds[];
    cg::grid_group grid = cg::this_grid();
    LAS unsigned char* L = (LAS unsigned char*)lds;
    unsigned char* ws = A.ws;
    const int G = gridDim.x;
    float* XL = A.out; float* XC = (float*)(ws + WS_XC);
    bf16_t* XN = (bf16_t*)(ws + WS_XN); bf16_t* ACT = (bf16_t*)(ws + WS_ACT);
    const float* gatef = (const float*)(ws + WS_GATE);

    const int wv = __builtin_amdgcn_readfirstlane((int)threadIdx.x >> 6);
    volatile LAS unsigned* MISC = (volatile LAS unsigned*)(L + 131072 + 320);
    if (threadIdx.x < 32) MISC[threadIdx.x] = 0u;
    __syncthreads();
    XcdBarrier xbar = xcd_barrier_post((unsigned*)ws + 4096, MISC + 8);
#define GSYNC() xcd_barrier(xbar)
#pragma unroll 1
    for (int l = 0; l < 4; ++l) { phase_prep(A, L, l, (int)((blockIdx.x + 64 * l) % G), G, wv); LBAR(); }
    if (A.out == nullptr) grid.sync();
    for (int rep = 0; rep < DUP_SYNC; ++rep) GSYNC();
#pragma unroll 1
    for (int layer = 0; layer < 4; ++layer) {
        ws = ows(ws);
        const int kind = layer == 3 ? 0 : layer;
        const int Nin = kind == 0 ? 2560 : (kind == 1 ? 2048 : 4096);
        const float* xinL = layer == 0 ? A.in[0] : XL; const float* xinC = layer == 0 ? A.in[2] : XC;
        for (int rep = 0; rep < DUP_NORM; ++rep) phase_norm(A, layer, xinL, xinC, L, wv);
        GSYNC();
        {
            const bf16_t* Wt = (const bf16_t*)(ws + (layer == 0 ? WS_WIN[0] : layer == 1 ? WS_WIN[1] : layer == 2 ? WS_WIN[2] : WS_WIN[3]));
            pg8::Gemm g{XN, Wt, layer == 3 ? ML : MT, Nin, DM};
            pg8::OrderG S; S.so.init(layer == 3 ? ML : MT, Nin, G, (int)blockIdx.x); S.extra = layer == 3 ? 16 : 0;
            pg8::EpiIn E{ACT, Nin, kind, (const float*)(ws + WS_ROPE)};
            for (int rep = 0; rep < DUP_GIN; ++rep) pg8::gemm_phase<pg8::EpiIn, pg8::OrderG, true, true>(L, g, S, E, wv);
        }
        GSYNC();
        if (kind == 0) { for (int rep = 0; rep < DUP_ATTN; ++rep) phase_attn(ACT, XN, (layer == 0 ? A.in[9] : A.in[34]), layer == 0, L, wv); }
        else if (kind == 1) { for (int rep = 0; rep < DUP_LRU; ++rep) phase_lru(A, ACT, XN, (float*)(ws + WS_HF), L, wv); }
        else { for (int rep = 0; rep < DUP_CONV; ++rep) phase_conv(A, ACT, XN, wv); }
        GSYNC();
        {
            const bf16_t* Wt = (const bf16_t*)(ws + (layer == 0 ? WS_WOUT[0] : layer == 1 ? WS_WOUT[1] : layer == 2 ? WS_WOUT[2] : WS_WOUT[3]));
            const int Mo = (CTX_SMALL || layer == 3) ? ML : MT;
            pg8::Gemm g{XN, Wt, Mo, DM, DM};
            pg8::OrderG S; S.so.init(Mo, DM, G, (int)blockIdx.x); S.extra = 0;
            pg8::EpiRes E{xinL, xinC, XL, XC, gatef + (size_t)layer * 9 * 1024};
            const bool ctx_first = (blockIdx.x & 1) != 0;
#pragma unroll 1
            for (int step = 0; step < 2; ++step) {
                if ((step == 0) == ctx_first) { if (CTX_SMALL && layer < 3) phase_ctx_wout(XN + (size_t)ML * DM, Wt, xinC, XC, gatef + (size_t)(layer * 9 + 8) * 1024, L, wv); }
                else pg8::gemm_phase<pg8::EpiRes, pg8::OrderG, true, true>(L, g, S, E, wv);
            }
        }
        GSYNC();
    }
    phase_final(XL, A.in[35], wv);
}

extern "C" void kernel_launch(void* const* d_in, const int* in_sizes, int n_in, void* d_out, int out_size, void* d_ws, size_t ws_size, hipStream_t stream) {
    static int grid = 0;
    if (grid == 0) {
        if (n_in != 36 || out_size != ML * DM || ws_size < WS_END) { fprintf(stderr, "kernel_launch: unexpected shapes (n_in %d, out %d, ws %zu)\n", n_in, out_size, ws_size); grid = -1; return; }
        int dev = 0, cus = 0, per_cu = 0;
        hipGetDevice(&dev); hipDeviceGetAttribute(&cus, hipDeviceAttributeMultiprocessorCount, dev);
        if (hipFuncSetAttribute((const void*)hybrid_fwd, hipFuncAttributeMaxDynamicSharedMemorySize, LDS_BYTES) != hipSuccess) { fprintf(stderr, "kernel_launch: hipFuncSetAttribute failed\n"); grid = -1; return; }
        if (hipOccupancyMaxActiveBlocksPerMultiprocessor(&per_cu, (const void*)hybrid_fwd, NTHREADS, LDS_BYTES) != hipSuccess || per_cu < 1) { fprintf(stderr, "kernel_launch: occupancy query says %d\n", per_cu); per_cu = 1; }
        (void)hipGetLastError();
        grid = cus * (per_cu > 1 ? 1 : per_cu);
        if (grid > 256) grid = 256;
    }
    if (grid < 0) return;
    if (hipMemsetAsync(d_ws, 0, 65536, stream) != hipSuccess) { fprintf(stderr, "kernel_launch: memset failed\n"); return; }
    Args a{};
    for (int i = 0; i < 36; ++i) a.in[i] = (const float*)d_in[i];
    a.out = (float*)d_out; a.ws = (unsigned char*)d_ws;
    void* args[] = {&a};
    hipError_t e = hipLaunchCooperativeKernel((const void*)hybrid_fwd, dim3(grid), dim3(NTHREADS), args, LDS_BYTES, stream);
    if (e != hipSuccess) fprintf(stderr, "kernel_launch: cooperative launch failed: %s (grid %d)\n", hipGetErrorString(e), grid);
}
```

```cpp
#include <hip/hip_runtime.h>
#include <hip/hip_cooperative_groups.h>
#include <cstdio>
#include <cstdint>
namespace cg = cooperative_groups;

namespace pg8 {
#define PG8_LAS __attribute__((address_space(3)))
typedef unsigned short bf16_t;
typedef short bf16x8 __attribute__((ext_vector_type(8)));
typedef float f32x4 __attribute__((ext_vector_type(4)));
typedef unsigned u32x4 __attribute__((ext_vector_type(4)));
constexpr int BM = 256, BK = 64, HALF = 128, HTB = HALF * BK * 2  , STAGE_BYTES = 8 * HTB, NXCD = 8, WGM = 8;

__host__ __device__ __forceinline__ int lds_byte(int r, int c) { const int st = (r >> 4) * 2 + (c >> 5), rr = r & 15, cc = c & 31, ob = rr * 64 + cc * 2; return st * 1024 + (ob ^ (((ob >> 9) & 1) << 5)); }
__host__ __device__ __forceinline__ void stage_rc(int b, int& R, int& C) { const int st = b / 1024, sb = b % 1024, swz = sb ^ (((sb >> 9) & 1) << 5); R = (st >> 1) * 16 + swz / 64; C = (st & 1) * 32 + (swz % 64) / 2; }
__host__ __device__ __forceinline__ int perm32(int rho) { const int n = rho >> 4, i = rho & 15; return 8 * (i >> 2) + 4 * n + (i & 3); }

struct Unit { int pm, pn; };
struct Gemm { const bf16_t* A; const bf16_t* Bt; int M, N, K; };

struct StaticOrder {
    int nM, nN, nwg, G, c;
    __host__ __device__ void init(int M, int N, int G_, int c_) { nM = M / BM; nN = N / BM; nwg = nM * nN; G = G_; c = c_; }
    __host__ __device__ bool next(int i, Unit& u) const {
        const long L = (long)i * G + c; if (L >= nwg) return false;
        int wgid = (int)L; { const int q = nwg / NXCD, r = nwg % NXCD, xcd = wgid % NXCD, off = wgid / NXCD; wgid = (xcd < r ? xcd * (q + 1) : r * (q + 1) + (xcd - r) * q) + off; }
        const int nig = WGM * nN, gid = wgid / nig, fm = gid * WGM, gsz = (nM - fm) < WGM ? (nM - fm) : WGM;
        u.pm = fm + ((wgid % nig) % gsz); u.pn = (wgid % nig) / gsz; return true;
    }
    __device__ __forceinline__ void a_ready(const Unit&) const {}
    __device__ __forceinline__ void done(const Unit&) const {}
};

__device__ __forceinline__ unsigned cvt_pk_bf16(float lo, float hi) { unsigned r; asm volatile("v_cvt_pk_bf16_f32 %0, %1, %2" : "=v"(r) : "v"(lo), "v"(hi)); return r; }
typedef float f32x2 __attribute__((ext_vector_type(2)));
__device__ __forceinline__ float silu_f(float v) { return v * __builtin_amdgcn_rcpf(1.0f + __builtin_amdgcn_exp2f(-v * 1.4426950408889634f)); }
constexpr float QSCALE = 0.125f * 1.4426950408889634f;

struct OrderG {
    StaticOrder so; int extra;
    __device__ __forceinline__ bool next(int i, Unit& u) const {
        long L = (long)i * so.G + so.c; if (L < so.nwg) return so.next(i, u);
        L -= so.nwg; if (L >= extra) return false; u.pm = 64 + (int)(L >> 1); u.pn = 4 + (int)(L & 1); return true;
    }
    __device__ __forceinline__ void a_ready(const Unit&) const {}
    __device__ __forceinline__ void done(const Unit&) const {}
};

struct EpiIn {
    static constexpr bool PERM = true, AFTER_DRAIN = false;
    bf16_t* O; int ldc; int kind; const float* rope;
    __device__ __forceinline__ void operator()(const f32x4 (&acc)[2][2][4][2], const Unit& u, int wr, int wc, int fr, int fq) const {
        const int colt = u.pn * BM; const bool lat = u.pm < 64;
        int mode = 0; float sc = 1.f;
        if (kind == 0) { if (colt < 1024) { mode = lat ? 2 : 0; sc = QSCALE; } else if (colt < 1280) mode = lat ? 2 : 0; else if (colt < 1536) mode = 0; else mode = 1; }
        else if (kind == 1) mode = colt < 1024 ? 0 : 1;
        else mode = colt < 3072 ? 0 : 1;
        const int row0 = u.pm * BM + wr * 64 + fr; const int col0 = colt + wc * 32 + 8 * fq;
        const float sgn = (fq < 2) ? -1.f : 1.f;
#pragma unroll
        for (int ai = 0; ai < 2; ++ai)
#pragma unroll
            for (int m = 0; m < 4; ++m) {
                const int row = row0 + ai * HALF + m * 16;
                bf16_t* rowp = O + (size_t)row * ldc + col0;
                f32x4 cs[4];
                if (mode == 2) { const int l = row & 2047; const int p = (wc & 1) ? (l & 63) : (l >> 6); const f32x4* rp = (const f32x4*)(rope + (p * 16 + 8 * (fq & 1)) * 2);
                    cs[0] = rp[0]; cs[1] = rp[1]; cs[2] = rp[2]; cs[3] = rp[3]; }
#pragma unroll
                for (int bj = 0; bj < 2; ++bj) {
                    f32x4 v0 = acc[ai][bj][m][0], v1 = acc[ai][bj][m][1];
                    if (mode == 1) {
#pragma unroll
                        for (int e = 0; e < 4; ++e) { v0[e] = silu_f(v0[e]); v1[e] = silu_f(v1[e]); }
                    } else if (mode == 2) {
                        f32x4 p0, p1;
#pragma unroll
                        for (int e = 0; e < 4; ++e) { p0[e] = __shfl_xor(v0[e], 32); p1[e] = __shfl_xor(v1[e], 32); }
                        v0[0] = v0[0] * cs[0][0] + sgn * p0[0] * cs[0][1]; v0[1] = v0[1] * cs[0][2] + sgn * p0[1] * cs[0][3];
                        v0[2] = v0[2] * cs[1][0] + sgn * p0[2] * cs[1][1]; v0[3] = v0[3] * cs[1][2] + sgn * p0[3] * cs[1][3];
                        v1[0] = v1[0] * cs[2][0] + sgn * p1[0] * cs[2][1]; v1[1] = v1[1] * cs[2][2] + sgn * p1[1] * cs[2][3];
                        v1[2] = v1[2] * cs[3][0] + sgn * p1[2] * cs[3][1]; v1[3] = v1[3] * cs[3][2] + sgn * p1[3] * cs[3][3];
                    }
                    v0 = v0 * sc; v1 = v1 * sc;
                    u32x4 w; w.x = cvt_pk_bf16(v0[0], v0[1]); w.y = cvt_pk_bf16(v0[2], v0[3]); w.z = cvt_pk_bf16(v1[0], v1[1]); w.w = cvt_pk_bf16(v1[2], v1[3]);
                    *(u32x4*)(rowp + bj * HALF) = w;
                }
            }
    }
};

struct EpiRes {
    static constexpr bool PERM = true, AFTER_DRAIN = false;
    const float* inL; const float* inC; float* outL; float* outC; const float* gate;
    __device__ __forceinline__ void operator()(const f32x4 (&acc)[2][2][4][2], const Unit& u, int wr, int wc, int fr, int fq) const {
        const bool lat = u.pm < 64;
        const float* ib = lat ? inL + (size_t)u.pm * BM * 1024 : inC + (size_t)(u.pm - 64) * BM * 1024;
        float* ob = lat ? outL + (size_t)u.pm * BM * 1024 : outC + (size_t)(u.pm - 64) * BM * 1024;
        const float* g = gate + (lat ? (u.pm >> 3) : 8) * 1024;
        const int col0 = u.pn * BM + wc * 32 + 8 * fq;
        f32x4 gv[2][2];
#pragma unroll
        for (int bj = 0; bj < 2; ++bj)
#pragma unroll
            for (int n = 0; n < 2; ++n) gv[bj][n] = *(const f32x4*)(g + col0 + bj * HALF + n * 4);
#pragma unroll
        for (int ai = 0; ai < 2; ++ai)
#pragma unroll
            for (int mp = 0; mp < 2; ++mp) {
                f32x4 xv[2][2][2];
#pragma unroll
                for (int mm = 0; mm < 2; ++mm) { const size_t off = (size_t)(ai * HALF + wr * 64 + (2 * mp + mm) * 16 + fr) * 1024 + col0;
#pragma unroll
                    for (int bj = 0; bj < 2; ++bj)
#pragma unroll
                        for (int n = 0; n < 2; ++n) xv[mm][bj][n] = __builtin_nontemporal_load((const f32x4*)(ib + off + bj * HALF + n * 4)); }
#pragma unroll
                for (int mm = 0; mm < 2; ++mm) { const int m = 2 * mp + mm; const size_t off = (size_t)(ai * HALF + wr * 64 + m * 16 + fr) * 1024 + col0;
#pragma unroll
                    for (int bj = 0; bj < 2; ++bj)
#pragma unroll
                        for (int n = 0; n < 2; ++n) *(f32x4*)(ob + off + bj * HALF + n * 4) = xv[mm][bj][n] + gv[bj][n] * acc[ai][bj][m][n]; }
                asm volatile("" ::: "memory"); }
    }
};

template <class Epi, class Sched, bool ALIGN_EPI = false, bool SP2 = false>
__device__ __forceinline__ void gemm_phase(PG8_LAS unsigned char* lds, const Gemm g, const Sched& S, const Epi& E, const int wv_) {
    int tid_ = wv_ * 64 + (int)__builtin_amdgcn_mbcnt_hi(~0u, __builtin_amdgcn_mbcnt_lo(~0u, 0u)); asm volatile("" : "+v"(tid_));
    const int tid = tid_, wid = __builtin_amdgcn_readfirstlane(tid >> 6), lane = tid & 63, wr = wid >> 2, wc = wid & 3, fr = lane & 15, fq = lane >> 4;
    const int K = g.K, nt = K / BK;
    unsigned voffA[2], voffB[2];
#pragma unroll
    for (int i = 0; i < 2; ++i) { int R, C; stage_rc(tid * 16 + i * 8192, R, C); const int Rb = Epi::PERM ? ((R & ~31) + perm32(R & 31)) : R;
        voffA[i] = (unsigned)(R * K + C) * 2u; voffB[i] = (unsigned)(Rb * K + C) * 2u; }
    const size_t kstep = (size_t)(BK * 2);
    const size_t hstep = (size_t)HALF * K * 2;
    const size_t tstep = 2 * hstep;
    const unsigned ldsw = (unsigned)wid * 1024u;
    const int aoff = lds_byte(wr * 64 + fr, fq * 8), boff = lds_byte(wc * 32 + fr, fq * 8);
#define PG8_SA(b, h) (((b) * 2 + (h)) * HTB)
#define PG8_SB(b, h) ((4 + (b) * 2 + (h)) * HTB)
#define PG8_STAGE(bufoff, gbase, voff) do { _Pragma("unroll") for (int _i = 0; _i < 2; ++_i) \
        __builtin_amdgcn_global_load_lds((const unsigned*)((const char*)(gbase) + (voff)[_i]), (PG8_LAS unsigned*)(lds + (bufoff) + ldsw + _i * 8192), 16, 0, 0); } while (0)
#define PG8_LDA(dst, b, h) do { _Pragma("unroll") for (int m = 0; m < 4; ++m) _Pragma("unroll") for (int k = 0; k < 2; ++k) dst[m][k] = *(const PG8_LAS bf16x8*)(lds + PG8_SA(b, h) + aoff + m * 2048 + k * 1024); } while (0)
#define PG8_LDB(dst, b, h) do { _Pragma("unroll") for (int n = 0; n < 2; ++n) _Pragma("unroll") for (int k = 0; k < 2; ++k) dst[n][k] = *(const PG8_LAS bf16x8*)(lds + PG8_SB(b, h) + boff + n * 2048 + k * 1024); } while (0)
#define PG8_MMA(ai, bj, At, Bt) do { __builtin_amdgcn_s_setprio(1); _Pragma("unroll") for (int m = 0; m < 4; ++m) _Pragma("unroll") for (int n = 0; n < 2; ++n) _Pragma("unroll") for (int k = 0; k < 2; ++k) \
        acc[ai][bj][m][n] = __builtin_amdgcn_mfma_f32_16x16x32_bf16(Bt[n][k], At[m][k], acc[ai][bj][m][n], 0, 0, 0); __builtin_amdgcn_s_setprio(0); } while (0)
#define PG8_WAIT_V(n) asm volatile("s_waitcnt vmcnt(" #n ")" ::: "memory")
#define PG8_WAIT_L(n) asm volatile("s_waitcnt lgkmcnt(" #n ")" ::: "memory")
#define PG8_BAR __builtin_amdgcn_s_barrier()
#define PG8_SCHED __builtin_amdgcn_sched_barrier(0)
    Unit cur, nxt; int ui = 0;
    if (!S.next(0, cur)) return;
    f32x4 acc[2][2][4][2];
#pragma unroll
    for (int a = 0; a < 2; ++a)
#pragma unroll
        for (int b = 0; b < 2; ++b)
#pragma unroll
            for (int m = 0; m < 4; ++m)
#pragma unroll
                for (int n = 0; n < 2; ++n) acc[a][b][m][n] = (f32x4){0.f, 0.f, 0.f, 0.f};
    bf16x8 At[4][2], B0[2][2], B1[2][2];
    const char* cA = (const char*)g.A + (size_t)cur.pm * tstep; const char* cB = (const char*)g.Bt + (size_t)cur.pn * tstep;
    S.a_ready(cur);
    if constexpr (SP2) {
        PG8_STAGE(PG8_SB(0, 0), cB, voffB); PG8_STAGE(PG8_SB(0, 1), cB + hstep, voffB); PG8_STAGE(PG8_SA(0, 0), cA, voffA); PG8_STAGE(PG8_SA(0, 1), cA + hstep, voffA);
        if (wr == 1) PG8_BAR;
        PG8_WAIT_V(2); PG8_BAR;
        PG8_STAGE(PG8_SB(1, 0), cB + kstep, voffB); PG8_STAGE(PG8_SA(1, 0), cA + kstep, voffA); PG8_STAGE(PG8_SB(1, 1), cB + hstep + kstep, voffB);
        PG8_WAIT_V(6); PG8_BAR;
    } else {
        PG8_STAGE(PG8_SB(0, 0), cB, voffB); PG8_STAGE(PG8_SA(0, 0), cA, voffA); PG8_STAGE(PG8_SB(0, 1), cB + hstep, voffB); PG8_STAGE(PG8_SA(0, 1), cA + hstep, voffA);
        if (wr == 1) PG8_BAR;
        PG8_WAIT_V(4); PG8_BAR;
        PG8_STAGE(PG8_SB(1, 0), cB + kstep, voffB); PG8_STAGE(PG8_SA(1, 0), cA + kstep, voffA); PG8_STAGE(PG8_SB(1, 1), cB + hstep + kstep, voffB);
        PG8_WAIT_V(6); PG8_BAR;
    }
    for (;;) {
        const bool has_next = S.next(ui + 1, nxt);
        const char* nA = has_next ? (const char*)g.A + (size_t)nxt.pm * tstep : cA; const char* nB = has_next ? (const char*)g.Bt + (size_t)nxt.pn * tstep : cB;
        for (int t = 0; t < nt; t += 2) {
            const bool last = (t == nt - 2);
            const char* a1 = cA + (size_t)(t + 1) * kstep;
            const char* a2 = last ? nA : cA + (size_t)(t + 2) * kstep; const char* b2 = last ? nB : cB + (size_t)(t + 2) * kstep;
            const char* a3 = a2 + kstep; const char* b3 = b2 + kstep;
            if (last && has_next) S.a_ready(nxt);
            if constexpr (SP2) {
            PG8_LDB(B0, 0, 0); PG8_LDB(B1, 0, 1); PG8_SCHED; PG8_LDA(At, 0, 0); PG8_STAGE(PG8_SA(1, 1), a1 + hstep, voffA);
            PG8_WAIT_V(8); PG8_WAIT_L(0); PG8_BAR; PG8_MMA(0, 0, At, B0); PG8_MMA(0, 1, At, B1); PG8_BAR; PG8_SCHED;
            PG8_LDA(At, 0, 1); PG8_STAGE(PG8_SB(0, 0), b2, voffB); PG8_STAGE(PG8_SB(0, 1), b2 + hstep, voffB); PG8_STAGE(PG8_SA(0, 0), a2, voffA);
            PG8_WAIT_V(8); PG8_WAIT_L(0); PG8_BAR; PG8_MMA(1, 0, At, B0); PG8_MMA(1, 1, At, B1); PG8_BAR; PG8_SCHED;
            PG8_LDB(B0, 1, 0); PG8_LDB(B1, 1, 1); PG8_SCHED; PG8_LDA(At, 1, 0); PG8_STAGE(PG8_SA(0, 1), a2 + hstep, voffA);
            PG8_WAIT_V(8); PG8_WAIT_L(0); PG8_BAR; PG8_MMA(0, 0, At, B0); PG8_MMA(0, 1, At, B1); PG8_BAR; PG8_SCHED;
            PG8_LDA(At, 1, 1); PG8_STAGE(PG8_SB(1, 0), b3, voffB); PG8_STAGE(PG8_SB(1, 1), b3 + hstep, voffB); PG8_STAGE(PG8_SA(1, 0), a3, voffA);
            PG8_WAIT_V(8); PG8_WAIT_L(0); PG8_BAR; PG8_MMA(1, 0, At, B0); PG8_MMA(1, 1, At, B1); PG8_BAR; PG8_SCHED;
            } else {
            PG8_LDB(B0, 0, 0); PG8_SCHED; PG8_LDA(At, 0, 0); PG8_STAGE(PG8_SA(1, 1), a1 + hstep, voffA);
            PG8_WAIT_L(8); PG8_BAR; PG8_WAIT_L(0); PG8_MMA(0, 0, At, B0); PG8_BAR; PG8_SCHED;
            PG8_LDB(B1, 0, 1); PG8_STAGE(PG8_SB(0, 0), b2, voffB);
            PG8_BAR; PG8_WAIT_L(0); PG8_MMA(0, 1, At, B1); PG8_BAR;
            PG8_LDA(At, 0, 1); PG8_STAGE(PG8_SA(0, 0), a2, voffA);
            PG8_BAR; PG8_WAIT_L(0); PG8_MMA(1, 0, At, B0); PG8_BAR; PG8_SCHED;
            PG8_STAGE(PG8_SB(0, 1), b2 + hstep, voffB);
            PG8_WAIT_V(6); PG8_BAR; PG8_MMA(1, 1, At, B1); PG8_BAR;
            PG8_LDB(B0, 1, 0); PG8_SCHED; PG8_LDA(At, 1, 0); PG8_STAGE(PG8_SA(0, 1), a2 + hstep, voffA);
            PG8_WAIT_L(8); PG8_BAR; PG8_WAIT_L(0); PG8_MMA(0, 0, At, B0); PG8_BAR; PG8_SCHED;
            PG8_LDB(B1, 1, 1); PG8_STAGE(PG8_SB(1, 0), b3, voffB);
            PG8_BAR; PG8_WAIT_L(0); PG8_MMA(0, 1, At, B1); PG8_BAR;
            PG8_LDA(At, 1, 1); PG8_STAGE(PG8_SA(1, 0), a3, voffA);
            PG8_BAR; PG8_WAIT_L(0); PG8_MMA(1, 0, At, B0); PG8_BAR; PG8_SCHED;
            PG8_STAGE(PG8_SB(1, 1), b3 + hstep, voffB);
            PG8_WAIT_V(6); PG8_BAR; PG8_MMA(1, 1, At, B1); PG8_BAR;
            }
        }
        if constexpr (ALIGN_EPI) { if (wr == 0) PG8_BAR; }
        if constexpr (!Epi::AFTER_DRAIN) { E(acc, cur, wr, wc, fr, fq); S.done(cur); }
        if (!has_next) break;
#pragma unroll
        for (int a = 0; a < 2; ++a)
#pragma unroll
            for (int b = 0; b < 2; ++b)
#pragma unroll
                for (int m = 0; m < 4; ++m)
#pragma unroll
                    for (int n = 0; n < 2; ++n) acc[a][b][m][n] = (f32x4){0.f, 0.f, 0.f, 0.f};
        cur = nxt; cA = nA; cB = nB; ++ui;
        if constexpr (ALIGN_EPI) { if (wr == 1) PG8_BAR; }
    }
    PG8_WAIT_V(0);
    if constexpr (!ALIGN_EPI) { if (wr == 0) PG8_BAR; }
    PG8_BAR;
    if constexpr (Epi::AFTER_DRAIN) { E.fused(acc, cur, wr, wc, fr, fq, lds, wid, lane); S.done(cur); }
#undef PG8_SA
#undef PG8_SB
#undef PG8_STAGE
#undef PG8_LDA
#undef PG8_LDB
#undef PG8_MMA
#undef PG8_WAIT_V
#undef PG8_WAIT_L
#undef PG8_BAR
#undef PG8_SCHED
}
}

#define LAS __attribute__((address_space(3)))
typedef unsigned short bf16_t;
typedef short bf16x8 __attribute__((ext_vector_type(8)));
typedef short s16x4 __attribute__((ext_vector_type(4)));
typedef float f32x4 __attribute__((ext_vector_type(4)));
typedef float f32x2 __attribute__((ext_vector_type(2)));
typedef float f32x16 __attribute__((ext_vector_type(16)));
typedef unsigned u32x4 __attribute__((ext_vector_type(4)));
typedef unsigned u32x2 __attribute__((ext_vector_type(2)));

#ifndef DUP_ATTN
#define DUP_ATTN 1
#endif
#ifndef DUP_LRU
#define DUP_LRU 1
#endif
#ifndef DUP_CONV
#define DUP_CONV 1
#endif
#ifndef DUP_GIN
#define DUP_GIN 1
#endif
#ifndef DUP_NORM
#define DUP_NORM 1
#endif
#ifndef DUP_PRO
#define DUP_PRO 1
#endif
#ifndef DUP_GOUT0
#define DUP_GOUT0 1
#endif
#ifndef DUP_LRUBC
#define DUP_LRUBC 1
#endif
#ifndef DUP_ATTEPI
#define DUP_ATTEPI 1
#endif
#ifndef DUP_SYNC
#define DUP_SYNC 1
#endif
#ifndef CTX_SMALL
#define CTX_SMALL 1
#endif
constexpr int NTHREADS = 512, NWAVES = 8;
constexpr int DM = 1024, NB = 8, SEQ = 2048, CTX = 256;
constexpr int ML = NB * SEQ, MC = NB * CTX, MT = ML + MC;
constexpr float EPS = 1e-6f, LOG2E = 1.4426950408889634f;
constexpr int LDS_BYTES = 147456;

constexpr size_t MiB = 1u << 20;
constexpr size_t WS_MODP = 1 * MiB;
constexpr size_t WS_GATE = 5 * MiB;
constexpr size_t WS_ROPE = 5 * MiB + 512 * 1024;
constexpr size_t WS_GW = 6 * MiB;
constexpr size_t WS_WIN[4] = {8 * MiB, 15 * MiB, 21 * MiB, 31 * MiB};
constexpr size_t WS_WOUT[4] = {13 * MiB, 19 * MiB, 29 * MiB, 36 * MiB};
constexpr size_t WS_XC = 38 * MiB;
constexpr size_t WS_XN = 46 * MiB;
constexpr size_t WS_ACT = 82 * MiB;
constexpr size_t WS_HF = 154 * MiB;
constexpr size_t WS_END = 226 * MiB;

struct Args { const float* in[36]; float* out; unsigned char* ws; };

#define LBAR() do { asm volatile("s_waitcnt lgkmcnt(0)" ::: "memory"); __builtin_amdgcn_s_barrier(); asm volatile("" ::: "memory"); } while (0)

__device__ __forceinline__ unsigned f2bf(float f) { unsigned u = __builtin_bit_cast(unsigned, f); return (u + 0x7fffu + ((u >> 16) & 1u)) >> 16; }
__device__ __forceinline__ unsigned pk2(float lo, float hi) { return pg8::cvt_pk_bf16(lo, hi); }
__device__ __forceinline__ float bflo(unsigned w) { return __builtin_bit_cast(float, w << 16); }
__device__ __forceinline__ float bfhi(unsigned w) { return __builtin_bit_cast(float, w & 0xffff0000u); }
__device__ __forceinline__ unsigned char* ows(unsigned char* p) { unsigned long long v = (unsigned long long)p; asm volatile("" : "+s"(v)); return (unsigned char*)(__attribute__((address_space(1))) unsigned char*)v; }
__device__ __forceinline__ int otid(int wv) { int t = wv * 64 + (int)__builtin_amdgcn_mbcnt_hi(~0u, __builtin_amdgcn_mbcnt_lo(~0u, 0u)); asm volatile("" : "+v"(t)); return t; }
__device__ __forceinline__ float wave_sum(float v) {
#pragma unroll
    for (int o = 1; o < 64; o <<= 1) v += __shfl_xor(v, o);
    return v;
}
using pg8::silu_f;

__device__ __forceinline__ void transpose_item(const float* W, int K, int N, bf16_t* WT, LAS float* scr, int item, int lane) {
    const int nblk = N / 32, kb = item / nblk, nb = item % nblk, k0 = 64 * kb, n0 = 32 * nb;
    float tv[32];
#pragma unroll
    for (int i = 0; i < 32; ++i) tv[i] = __builtin_nontemporal_load(W + (size_t)(k0 + 2 * i + (lane >> 5)) * N + n0 + (lane & 31));
#pragma unroll
    for (int i = 0; i < 32; ++i) scr[(2 * i + (lane >> 5)) * 33 + (lane & 31)] = tv[i];
    asm volatile("s_waitcnt lgkmcnt(0)" ::: "memory");
    const int c = lane & 7;
#pragma unroll
    for (int j = 0; j < 4; ++j) { const int n = (lane >> 3) + 8 * j; const LAS float* s = scr + (8 * c) * 33 + n;
        u32x4 o; o.x = pk2(s[0 * 33], s[1 * 33]); o.y = pk2(s[2 * 33], s[3 * 33]); o.z = pk2(s[4 * 33], s[5 * 33]); o.w = pk2(s[6 * 33], s[7 * 33]);
        *(u32x4*)(WT + (size_t)(n0 + n) * K + k0 + 8 * c) = o; }
    asm volatile("s_waitcnt lgkmcnt(0)" ::: "memory");
}

__device__ __forceinline__ void phase_prep(const Args& A, LAS unsigned char* L, int layer, int vbid, int vG, const int wv) {
    const int tid = otid(wv), lane = tid & 63, wave = tid >> 6;
    unsigned char* ws = A.ws;
    const float* Wm = (layer == 0 ? A.in[5] : layer == 1 ? A.in[11] : layer == 2 ? A.in[23] : A.in[30]);
    for (int task = vbid; task < 48; task += vG) {
        const int cc = task >> 3, kc = task & 7;
        const int col = cc * 512 + tid;
        const float* wp = Wm + (size_t)(kc * 128) * 3072 + col;
        float wv_[128];
#pragma unroll
        for (int kk = 0; kk < 128; ++kk) wv_[kk] = __builtin_nontemporal_load(wp + (size_t)kk * 3072);
        LAS float* s = (LAS float*)L;
        for (int idx = tid; idx < 9 * 128; idx += NTHREADS) { const int r = idx >> 7, kk = idx & 127;
            const float v = (r < 8) ? A.in[1][r * DM + kc * 128 + kk] : A.in[3][kc * 128 + kk];
            s[idx] = v / (1.0f + __expf(-v)); }
        LBAR();
        float acc[9];
#pragma unroll
        for (int r = 0; r < 9; ++r) acc[r] = 0.f;
#pragma unroll
        for (int kk = 0; kk < 128; ++kk) { const float w = wv_[kk];
#pragma unroll
            for (int r = 0; r < 9; ++r) acc[r] += s[r * 128 + kk] * w; }
        float* mp = (float*)(ws + WS_MODP) + (size_t)((layer * 8 + kc) * 9) * 3072 + col;
#pragma unroll
        for (int r = 0; r < 9; ++r) mp[(size_t)r * 3072] = acc[r];
        LBAR();
    }
    if (layer == 0 && vbid == vG - 1) {
        float* rt = (float*)(ws + WS_ROPE);
        for (int idx = tid; idx < 1024; idx += NTHREADS) { const int p = idx >> 4, j = idx & 15;
            const float inv = 1.0f / __builtin_powf(10000.0f, (float)j * (1.0f / 16.0f));
            const float ang = (float)p * inv; float t = ang * 0.15915494309189535f; t -= __builtin_rintf(t);
            rt[idx * 2] = __builtin_amdgcn_cosf(t); rt[idx * 2 + 1] = __builtin_amdgcn_sinf(t); }
    }
    LAS float* scr = (LAS float*)(L + wave * 16384);
    const int rb = (vbid + vG - (48 % vG)) % vG;
    const int gw = rb * NWAVES + wave, NGW = vG * NWAVES;
    const int Nin = (layer == 0 || layer == 3) ? 2560 : (layer == 1 ? 2048 : 4096);
    const float* win = (layer == 0 ? A.in[7] : layer == 1 ? A.in[13] : layer == 2 ? A.in[25] : A.in[32]);
    const float* wout = (layer == 0 ? A.in[8] : layer == 1 ? A.in[14] : layer == 2 ? A.in[26] : A.in[33]);
    bf16_t* wint = (bf16_t*)(ws + (layer == 0 ? WS_WIN[0] : layer == 1 ? WS_WIN[1] : layer == 2 ? WS_WIN[2] : WS_WIN[3]));
    bf16_t* woutt = (bf16_t*)(ws + (layer == 0 ? WS_WOUT[0] : layer == 1 ? WS_WOUT[1] : layer == 2 ? WS_WOUT[2] : WS_WOUT[3]));
    const int IIN = 16 * (Nin / 32), IO = 16 * 32, IGW = layer == 0 ? 64 * 2 : 0;
    const int nitems = IIN + IO + IGW;
    for (int it = gw; it < nitems; it += NGW) {
        int r = it;
        if (r < IIN) { transpose_item(win, 1024, Nin, wint, scr, r, lane); continue; } r -= IIN;
        if (r < IO) { transpose_item(wout, 1024, 1024, woutt, scr, r, lane); continue; } r -= IO;
        { const int blk = r >> 1, sub = r & 1;
          const int dir = blk >> 5, gate = (blk >> 4) & 1, h = blk & 15;
          const float* src = (gate == 0 ? A.in[17] : A.in[19]) + (size_t)(dir * 16 + h) * 4096;
          transpose_item(src, 64, 64, (bf16_t*)(ws + WS_GW) + (size_t)blk * 4096, scr, sub, lane); }
    }
}

template <int NR> __device__ __forceinline__ void norm_load(const float* const (&xrow)[NR], f32x4 (&v)[NR][4], int lane) {
#pragma unroll
    for (int i = 0; i < NR; ++i) { const f32x4* xr = (const f32x4*)xrow[i] + lane;
#pragma unroll
        for (int j = 0; j < 4; ++j) v[i][j] = __builtin_nontemporal_load(xr + 64 * j); }
}
template <int NR> __device__ __forceinline__ void norm_proc(const f32x4 (&v)[NR][4], bf16_t* const (&orow)[NR], const LAS float* const (&gs)[NR], const LAS float* const (&sh)[NR], int lane) {
    float s[NR];
#pragma unroll
    for (int i = 0; i < NR; ++i) { float a = 0.f;
#pragma unroll
        for (int j = 0; j < 4; ++j) a += (v[i][j].x * v[i][j].x + v[i][j].y * v[i][j].y) + (v[i][j].z * v[i][j].z + v[i][j].w * v[i][j].w);
        s[i] = a; }
#pragma unroll
    for (int o = 1; o < 64; o <<= 1) {
#pragma unroll
        for (int i = 0; i < NR; ++i) s[i] += __shfl_xor(s[i], o); }
#pragma unroll
    for (int i = 0; i < NR; ++i) { const float rstd = 1.0f / sqrtf(s[i] * (1.0f / DM) + EPS); u32x2* o8 = (u32x2*)orow[i] + lane;
#pragma unroll
        for (int j = 0; j < 4; ++j) { const f32x4 g = *(const LAS f32x4*)(gs[i] + 256 * j + 4 * lane), b = *(const LAS f32x4*)(sh[i] + 256 * j + 4 * lane);
            const f32x4 y = v[i][j] * rstd * g + b; u32x2 w; w.x = pk2(y.x, y.y); w.y = pk2(y.z, y.w); o8[64 * j] = w; } }
}
__device__ __forceinline__ void phase_norm(const Args& A, int layer, const float* xL, const float* xC, LAS unsigned char* L, const int wv) {
    const int tid = otid(wv), lane = tid & 63, wave = tid >> 6, bid = blockIdx.x, G = gridDim.x;
    const float* norm_g = (layer == 0 ? A.in[4] : layer == 1 ? A.in[10] : layer == 2 ? A.in[22] : A.in[29]);
    const float* mod_b = (layer == 0 ? A.in[6] : layer == 1 ? A.in[12] : layer == 2 ? A.in[24] : A.in[31]);
    unsigned char* ws = ows(A.ws);
    const float* modp = (const float*)(ws + WS_MODP) + (size_t)(layer * 8) * 9 * 3072;
    bf16_t* XN = (bf16_t*)(ws + WS_XN);
    LAS float* tab = (LAS float*)L;
    for (int vb = bid; vb < 256; vb += G) {
        const int batch = vb >> 5;
        const float* xr[3][3]; bf16_t* orow[3][3]; const LAS float* gs[3][3]; const LAS float* sh[3][3];
#pragma unroll
          for (int bt = 0; bt < 3; ++bt)
#pragma unroll
            for (int i = 0; i < 3; ++i) { const int ri = bt * 3 + i;
                if (ri < 8) { const int row = vb * 64 + wave * 8 + ri; xr[bt][i] = xL + (size_t)row * DM; orow[bt][i] = XN + (size_t)row * DM; gs[bt][i] = tab; sh[bt][i] = tab + 1024; }
                else { const int row = vb * 8 + wave; xr[bt][i] = xC + (size_t)row * DM; orow[bt][i] = XN + (size_t)(ML + row) * DM; gs[bt][i] = tab + 2048; sh[bt][i] = tab + 3072; } }
          f32x4 va[3][4], vbb[3][4];
          norm_load<3>(xr[0], va, lane);
        { float bv[8], pv[8][8], gn[8];
#pragma unroll
          for (int i8 = 0; i8 < 8; ++i8) { const int idx = tid + i8 * NTHREADS; const int which = idx >> 10, col = idx & 1023; const int r = (which < 2) ? batch : 8; const int mcol = (which & 1) ? col : 1024 + col;
              bv[i8] = mod_b[mcol];
#pragma unroll
              for (int kc = 0; kc < 8; ++kc) pv[i8][kc] = modp[(size_t)(kc * 9 + r) * 3072 + mcol];
              gn[i8] = (which & 1) ? 0.f : norm_g[col]; }
#pragma unroll
          for (int i8 = 0; i8 < 8; ++i8) { const int idx = tid + i8 * NTHREADS; const int which = idx >> 10;
              float v = bv[i8];
#pragma unroll
              for (int kc = 0; kc < 8; ++kc) v += pv[i8][kc];
              if (!(which & 1)) v = gn[i8] * (1.0f + v);
              tab[idx] = v; } }
        if (vb < 9) { float* gf = (float*)(ws + WS_GATE) + (size_t)(layer * 9 + vb) * 1024;
            float gb[2], gp[2][8];
#pragma unroll
            for (int c2 = 0; c2 < 2; ++c2) { const int col = tid + c2 * NTHREADS; gb[c2] = mod_b[2048 + col];
#pragma unroll
                for (int kc = 0; kc < 8; ++kc) gp[c2][kc] = modp[(size_t)(kc * 9 + vb) * 3072 + 2048 + col]; }
#pragma unroll
            for (int c2 = 0; c2 < 2; ++c2) { float v = gb[c2];
#pragma unroll
                for (int kc = 0; kc < 8; ++kc) v += gp[c2][kc];
                gf[tid + c2 * NTHREADS] = v; } }
        norm_load<3>(xr[1], vbb, lane);
        LBAR();
        {
          norm_proc<3>(va, orow[0], gs[0], sh[0], lane);
          norm_load<3>(xr[2], va, lane);
          norm_proc<3>(vbb, orow[1], gs[1], sh[1], lane);
          norm_proc<3>(va, orow[2], gs[2], sh[2], lane); }
        LBAR();
    }
}

#define MFMA32(a, b, c) __builtin_amdgcn_mfma_f32_32x32x16_bf16((a), (b), (c), 0, 0, 0)
#define MFMA16(a, b, c) __builtin_amdgcn_mfma_f32_16x16x32_bf16((a), (b), (c), 0, 0, 0)
__device__ __forceinline__ int crow(int r, int hi) { return (r & 3) + 8 * (r >> 2) + 4 * hi; }
typedef short v4i16_t __attribute__((ext_vector_type(4)));
__device__ __forceinline__ float max3f(float a, float b, float c) { float r; asm("v_max3_f32 %0, %1, %2, %3" : "=v"(r) : "v"(a), "v"(b), "v"(c)); return r; }
__device__ __forceinline__ s16x4 vtr(LAS const unsigned char* p) { return __builtin_bit_cast(s16x4, __builtin_amdgcn_ds_read_tr16_b64_v4i16((LAS v4i16_t*)p)); }

__device__ __forceinline__ void phase_attn(const bf16_t* ACT, bf16_t* Y, const float* sink, bool need_ctx, LAS unsigned char* L, const int wv) {
    constexpr int LD = 2560, KSTR = 144, TILEB = 64 * KSTR, BUFB = 2 * TILEB;
    const int tid = otid(wv), lane = tid & 63, r32 = lane & 31, hi = lane >> 5, wave = __builtin_amdgcn_readfirstlane(tid >> 6);
    const int g = wave >> 1, half = wave & 1, G = gridDim.x;
    const int skey = tid >> 3, sch = tid & 7;
    const int stoff = skey * KSTR + sch * 16;
    const int koff = r32 * KSTR + hi * 16;
    const int voff = TILEB + (4 * hi + ((lane & 15) >> 2)) * KSTR + (16 * ((lane >> 4) & 1) + 4 * (lane & 3)) * 2;
    const int nunits = need_ctx ? 1152 : 1024;
    for (int u = blockIdx.x; u < nunits; u += G) {
        int b, kvh, qb; bool lat;
        if (u < 1024) { b = u >> 7; kvh = (u >> 5) & 3; qb = u & 31; lat = true; } else { const int e = u - 1024; b = e >> 4; kvh = (e >> 2) & 3; qb = e & 3; lat = false; }
        const int h = kvh * 4 + g;
        const int qpos = qb * 64 + half * 32 + r32;
        const int qrow = lat ? b * SEQ + qpos : ML + b * CTX + qpos;
        int tlo = 4, thi = 4;
        if (lat) { tlo = qb == 0 ? 6 : (qb == 1 ? 5 : 4); thi = qb == 31 ? 7 : (qb == 30 ? 8 : 9); }
        const int n = 4 + (thi - tlo);
        const int kp_base = qb * 64 - 128;
        bf16x8 qf[4];
        { const bf16_t* qp = ACT + (size_t)qrow * LD + h * 64 + hi * 8;
#pragma unroll
          for (int d0 = 0; d0 < 4; ++d0) qf[d0] = *(const bf16x8*)(qp + d0 * 16); }
        float m_run = sink[h] * LOG2E, l_run = hi ? 0.f : 1.f;
        f32x16 o0, o1;
#pragma unroll
        for (int r = 0; r < 16; ++r) { o0[r] = 0.f; o1[r] = 0.f; }
        const size_t kcol = 1024 + kvh * 64 + sch * 8, vcol = 1280 + kvh * 64 + sch * 8;
#define ATT_TROW(s_) (((s_) < 4 ? ML + b * CTX + (s_) * 64 : b * SEQ + kp_base + (tlo + (s_) - 8) * 64) + skey)
        u32x4 kq0, vq0, kq1, vq1, kq2, vq2;
        { const size_t krow = (size_t)ATT_TROW(0); kq0 = *(const u32x4*)(ACT + krow * LD + kcol); vq0 = *(const u32x4*)(ACT + krow * LD + vcol); }
        { const size_t krow = (size_t)ATT_TROW(1); kq1 = *(const u32x4*)(ACT + krow * LD + kcol); vq1 = *(const u32x4*)(ACT + krow * LD + vcol); }
        { const size_t krow = (size_t)ATT_TROW(2); kq2 = *(const u32x4*)(ACT + krow * LD + kcol); vq2 = *(const u32x4*)(ACT + krow * LD + vcol); }
        LBAR();
        *(LAS u32x4*)(L + stoff) = kq0; *(LAS u32x4*)(L + TILEB + stoff) = vq0;
        { const size_t krow = (size_t)ATT_TROW(3); kq0 = *(const u32x4*)(ACT + krow * LD + kcol); vq0 = *(const u32x4*)(ACT + krow * LD + vcol); }
        LBAR();
#define ATT_STEP(s_, KQ, VQ) do { const int s = (s_); \
            const int t = s < 4 ? s : tlo + (s - 4); \
            LAS const unsigned char* B = L + (s & 1) * BUFB; \
 \
              \
            bf16x8 kf[8]; s16x4 vl[8], vh[8]; \
_Pragma("unroll") \
            for (int d0 = 0; d0 < 4; ++d0) { kf[2 * d0] = *(const LAS bf16x8*)(B + koff + d0 * 32); kf[2 * d0 + 1] = *(const LAS bf16x8*)(B + koff + 32 * KSTR + d0 * 32); } \
_Pragma("unroll") \
            for (int i = 0; i < 4; ++i) { LAS const unsigned char* vp = B + voff + i * 16 * KSTR; vl[2 * i] = vtr(vp); vh[2 * i] = vtr(vp + 8 * KSTR); vl[2 * i + 1] = vtr(vp + 64); vh[2 * i + 1] = vtr(vp + 8 * KSTR + 64); } \
            __builtin_amdgcn_sched_barrier(0); \
            f32x16 p0, p1; \
_Pragma("unroll") \
            for (int r = 0; r < 16; ++r) { p0[r] = 0.f; p1[r] = 0.f; } \
_Pragma("unroll") \
            for (int d0 = 0; d0 < 4; ++d0) { p0 = MFMA32(kf[2 * d0], qf[d0], p0); p1 = MFMA32(kf[2 * d0 + 1], qf[d0], p1); } \
            if (t == 4 || t == 8) { const int kp0 = kp_base + (t - 4) * 64 - qpos; \
_Pragma("unroll") \
                for (int r = 0; r < 16; ++r) { const int d0 = kp0 + crow(r, hi), d1 = d0 + 32; \
                    if (d0 > 128 || d0 < -128) p0[r] = -1e30f; if (d1 > 128 || d1 < -128) p1[r] = -1e30f; } } \
            float mt = max3f(p0[0], p0[1], p1[0]), mt2 = max3f(p0[2], p0[3], p1[1]); mt = max3f(mt, p1[2], p1[3]); \
_Pragma("unroll") \
            for (int r = 4; r < 16; r += 4) { mt = max3f(mt, p0[r], p0[r + 1]); mt2 = max3f(mt2, p0[r + 2], p0[r + 3]); mt = max3f(mt, p1[r], p1[r + 1]); mt2 = max3f(mt2, p1[r + 2], p1[r + 3]); } \
            mt = fmaxf(mt, mt2); \
            mt = fmaxf(mt, __shfl_xor(mt, 32)) - m_run; \
 \
            float dl = 0.f; \
            if (s == 0) dl = fmaxf(mt, 0.f); else if (mt > 8.0f) dl = mt; \
            if (__any(dl != 0.f)) { const float alpha = __builtin_amdgcn_exp2f(-dl); m_run += dl; l_run *= alpha; \
_Pragma("unroll") \
                for (int r = 0; r < 16; ++r) { o0[r] *= alpha; o1[r] *= alpha; } } \
            float ls = 0.f, ls2 = 0.f; \
_Pragma("unroll") \
            for (int r = 0; r < 16; ++r) { p0[r] = __builtin_amdgcn_exp2f(p0[r] - m_run); p1[r] = __builtin_amdgcn_exp2f(p1[r] - m_run); ls += p0[r]; ls2 += p1[r]; } \
            ls += ls2; \
            l_run += ls; \
            bf16x8 pb[2][2]; \
_Pragma("unroll") \
            for (int j = 0; j < 2; ++j) { \
                u32x4 w0, w1; \
                w0.x = pk2(p0[8 * j + 0], p0[8 * j + 1]); w0.y = pk2(p0[8 * j + 2], p0[8 * j + 3]); w0.z = pk2(p0[8 * j + 4], p0[8 * j + 5]); w0.w = pk2(p0[8 * j + 6], p0[8 * j + 7]); \
                w1.x = pk2(p1[8 * j + 0], p1[8 * j + 1]); w1.y = pk2(p1[8 * j + 2], p1[8 * j + 3]); w1.z = pk2(p1[8 * j + 4], p1[8 * j + 5]); w1.w = pk2(p1[8 * j + 6], p1[8 * j + 7]); \
                pb[0][j] = __builtin_bit_cast(bf16x8, w0); pb[1][j] = __builtin_bit_cast(bf16x8, w1); \
            } \
 \
_Pragma("unroll") \
            for (int kb = 0; kb < 2; ++kb) \
_Pragma("unroll") \
                for (int j = 0; j < 2; ++j) { const int i = kb * 2 + j; \
                    const bf16x8 a0 = __builtin_shufflevector(vl[2 * i], vh[2 * i], 0, 1, 2, 3, 4, 5, 6, 7), a1 = __builtin_shufflevector(vl[2 * i + 1], vh[2 * i + 1], 0, 1, 2, 3, 4, 5, 6, 7); \
                    o0 = MFMA32(a0, pb[kb][j], o0); o1 = MFMA32(a1, pb[kb][j], o1); \
                } \
            if (s + 1 < n) { LAS unsigned char* Bn = L + ((s + 1) & 1) * BUFB; *(LAS u32x4*)(Bn + stoff) = KQ; *(LAS u32x4*)(Bn + TILEB + stoff) = VQ; } \
            LBAR(); \
            if (s + 4 < n) { const size_t krow = (size_t)ATT_TROW(s + 4); KQ = *(const u32x4*)(ACT + krow * LD + kcol); VQ = *(const u32x4*)(ACT + krow * LD + vcol); } \
        } while (0)
#pragma unroll 1
        for (int s0 = 0; s0 < n; s0 += 3) {
            ATT_STEP(s0, kq1, vq1);
            if (s0 + 1 < n) ATT_STEP(s0 + 1, kq2, vq2);
            if (s0 + 2 < n) ATT_STEP(s0 + 2, kq0, vq0);
        }
#undef ATT_STEP
#undef ATT_TROW
        u32x4 sgq[4];
        { const int qrow0 = qrow - r32;
#pragma unroll
          for (int it = 0; it < 4; ++it) sgq[it] = *(const u32x4*)(ACT + (size_t)(qrow0 + it * 8 + (lane >> 3)) * LD + 1536 + h * 64 + (lane & 7) * 8); }
        const float lt = l_run + __shfl_xor(l_run, 32); const float inv = 1.0f / lt;
        LAS float* stg = (LAS float*)(L + 40960 + wave * 8704);
#pragma unroll
        for (int db = 0; db < 2; ++db)
#pragma unroll
            for (int q4 = 0; q4 < 4; ++q4) { const int d = 32 * db + 8 * q4 + 4 * hi; f32x4 v;
                if (db == 0) v = (f32x4){o0[4 * q4], o0[4 * q4 + 1], o0[4 * q4 + 2], o0[4 * q4 + 3]}; else v = (f32x4){o1[4 * q4], o1[4 * q4 + 1], o1[4 * q4 + 2], o1[4 * q4 + 3]};
                *(LAS f32x4*)(stg + r32 * 68 + d) = v * inv; }
        asm volatile("s_waitcnt lgkmcnt(0)" ::: "memory");
        { const int qrow0 = qrow - r32; const int er = lane >> 3, ec = (lane & 7) * 8;
#pragma unroll
          for (int it = 0; it < 4; ++it) { const int row = it * 8 + er; const size_t grow = (size_t)(qrow0 + row);
              const f32x4 a0 = *(const LAS f32x4*)(stg + row * 68 + ec), a1 = *(const LAS f32x4*)(stg + row * 68 + ec + 4);
              const u32x4 gw = sgq[it];
              u32x4 w; w.x = pk2(a0.x * bflo(gw.x), a0.y * bfhi(gw.x)); w.y = pk2(a0.z * bflo(gw.y), a0.w * bfhi(gw.y)); w.z = pk2(a1.x * bflo(gw.z), a1.y * bfhi(gw.z)); w.w = pk2(a1.z * bflo(gw.w), a1.w * bfhi(gw.w));
              *(u32x4*)(Y + grow * DM + h * 64 + ec) = w; } }
    }
    LBAR();
}

__device__ __forceinline__ void phase_lru(const Args& A, const bf16_t* ACT, bf16_t* Y, float* HF, LAS unsigned char* L, const int wv) {
    constexpr int LD = 2048, TT = 128, USTR = 144;
    const int tid = otid(wv), lane = tid & 63, wave = __builtin_amdgcn_readfirstlane(tid >> 6), G = gridDim.x;
    LAS unsigned char* UL = L;
    LAS unsigned char* XA = L + 19200;
    LAS float* XF = (LAS float*)(L + 19200 + 18432);
    LAS f32x2* AB = (LAS f32x2*)(L + 19200 + 18432 + 16384);
    LAS f32x2* CAR = (LAS f32x2*)(L + 19200 + 18432 + 16384 + 32768);
    LAS float* ST = (LAS float*)(L + 19200 + 18432 + 16384 + 32768 + 4096);
    LAS float* CW = (LAS float*)(L + 19200 + 18432 + 16384 + 32768 + 4096 + 256);
    const bf16_t* gwT = (const bf16_t*)(ows(A.ws) + WS_GW);
    const float* conv_w = A.in[15]; const float* conv_b = A.in[16]; const float* ba = A.in[18]; const float* bx = A.in[20]; const float* lam = A.in[21];
    const int fr = lane & 15, fq = lane >> 4;
    const int stok = tid >> 3, sch = tid & 7;
    const int ch = tid & 31, sc = tid >> 5;
    const int otok = tid >> 2, oq = tid & 3;
    for (int u = blockIdx.x; u < 256; u += G) {
        const int b = u >> 5, hb = u & 31, hblk = hb >> 1, half = hb & 1, cin0 = hblk * 64, c0 = cin0 + half * 32;
#pragma unroll 1
        for (int dir = 0; dir < 2; ++dir) {
            LBAR();
            if (tid < 320) { const int k = tid >> 6, c = tid & 63; CW[tid] = (k < 4) ? conv_w[(size_t)(dir * 4 + k) * DM + cin0 + c] : conv_b[(size_t)dir * DM + cin0 + c]; }
            const int cbk = wave & 1;
            bf16x8 wr_[2], wi_[2];
            { const bf16_t* pr = gwT + ((size_t)((dir * 2 + 0) * 16 + hblk) * 64 + half * 32 + cbk * 16 + fr) * 64 + fq * 8;
              const bf16_t* pi = gwT + ((size_t)((dir * 2 + 1) * 16 + hblk) * 64 + half * 32 + cbk * 16 + fr) * 64 + fq * 8;
              wr_[0] = *(const bf16x8*)pr; wr_[1] = *(const bf16x8*)(pr + 32); wi_[0] = *(const bf16x8*)pi; wi_[1] = *(const bf16x8*)(pi + 32); }
            float eba[4], ebx[4], esp[4];
#pragma unroll
            for (int e = 0; e < 4; ++e) { const int c = dir * DM + c0 + cbk * 16 + 4 * fq + e; eba[e] = ba[c]; ebx[e] = bx[c];
                const float nl = -lam[c]; esp[e] = (fmaxf(nl, 0.f) + log1pf(__expf(-fabsf(nl)))) * (-8.0f * LOG2E); }
            if (tid < 32) ST[tid] = 0.f;
            u32x4 ur[2], uh = (u32x4){0u, 0u, 0u, 0u};
            { const int rowbase = ML + b * CTX;
#pragma unroll
              for (int i2 = 0; i2 < 2; ++i2) { const int S = stok + 64 * i2; const int row = rowbase + (dir ? CTX - 1 - S : S); ur[i2] = *(const u32x4*)(ACT + (size_t)row * LD + cin0 + sch * 8); } }
            f32x4 hf0 = (f32x4){0.f, 0.f, 0.f, 0.f}, hf1 = hf0; u32x4 gv = (u32x4){0u, 0u, 0u, 0u}; size_t orow = 0; int oseq = 0;
#define LRU_OUT() do { const f32x4 h0 = *(const LAS f32x4*)(XF + otok * 32 + oq * 8), h1 = *(const LAS f32x4*)(XF + otok * 32 + oq * 8 + 4); \
                if (dir == 0) { f32x4* hp = (f32x4*)(HF + ((size_t)u * 2304 + oseq) * 32 + oq * 8); hp[0] = h0; hp[1] = h1; } \
                else { const f32x4 s0 = h0 + hf0, s1 = h1 + hf1; u32x4 w; \
                    w.x = pk2(s0.x * bflo(gv.x), s0.y * bfhi(gv.x)); w.y = pk2(s0.z * bflo(gv.y), s0.w * bfhi(gv.y)); w.z = pk2(s1.x * bflo(gv.z), s1.y * bfhi(gv.z)); w.w = pk2(s1.z * bflo(gv.w), s1.w * bfhi(gv.w)); \
                    *(u32x4*)(Y + orow * DM + c0 + oq * 8) = w; } } while (0)
#pragma unroll 1
            for (int tl = 0; tl < 18; ++tl) {
                const int seg = tl < 2 ? 0 : 1, S0 = seg ? (tl - 2) * TT : tl * TT, seglen = seg ? SEQ : CTX, rowbase = seg ? b * SEQ : ML + b * CTX;
                LBAR();
                *(LAS u32x4*)(UL + (3 + stok) * USTR + sch * 16) = ur[0]; *(LAS u32x4*)(UL + (3 + 64 + stok) * USTR + sch * 16) = ur[1];
                if (tid < 24) *(LAS u32x4*)(UL + stok * USTR + sch * 16) = uh;
                if (tl > 0) LRU_OUT();
                LBAR();
                { const int S = S0 + otok; const int pos = dir ? seglen - 1 - S : S; orow = (size_t)(rowbase + pos); oseq = seg ? CTX + pos : pos;
                  if (dir == 1) { const f32x4* hp = (const f32x4*)(HF + ((size_t)u * 2304 + oseq) * 32 + oq * 8); hf0 = hp[0]; hf1 = hp[1]; gv = *(const u32x4*)(ACT + orow * LD + 1024 + c0 + oq * 8); } }
                if (tl + 1 < 18) { const int tn = tl + 1; const int seg2 = tn < 2 ? 0 : 1, S02 = seg2 ? (tn - 2) * TT : tn * TT, seglen2 = seg2 ? SEQ : CTX, rowbase2 = seg2 ? b * SEQ : ML + b * CTX;
#pragma unroll
                    for (int i2 = 0; i2 < 2; ++i2) { const int S = S02 + stok + 64 * i2; const int row = rowbase2 + (dir ? seglen2 - 1 - S : S); ur[i2] = *(const u32x4*)(ACT + (size_t)row * LD + cin0 + sch * 8); }
                    uh = (u32x4){0u, 0u, 0u, 0u};
                    if (tid < 24 && S02 > 0) { const int S = S02 - 3 + stok; const int row = rowbase2 + (dir ? seglen2 - 1 - S : S); uh = *(const u32x4*)(ACT + (size_t)row * LD + cin0 + sch * 8); } }
                for (int rep_ = 0; rep_ < DUP_LRUBC; ++rep_) {
                { float x0[8], x1[8];
                  { const f32x4 ca = *(const LAS f32x4*)(CW + 256 + sch * 8), cc = *(const LAS f32x4*)(CW + 256 + sch * 8 + 4);
                    x0[0] = ca.x; x0[1] = ca.y; x0[2] = ca.z; x0[3] = ca.w; x0[4] = cc.x; x0[5] = cc.y; x0[6] = cc.z; x0[7] = cc.w;
#pragma unroll
                    for (int e = 0; e < 8; ++e) x1[e] = x0[e]; }
#pragma unroll
                  for (int k = 0; k < 4; ++k) { const f32x4 wa = *(const LAS f32x4*)(CW + k * 64 + sch * 8), wb = *(const LAS f32x4*)(CW + k * 64 + sch * 8 + 4);
                      const u32x4 u0 = *(const LAS u32x4*)(UL + (stok + k) * USTR + sch * 16), u1 = *(const LAS u32x4*)(UL + (stok + 64 + k) * USTR + sch * 16);
                      x0[0] += wa.x * bflo(u0.x); x0[1] += wa.y * bfhi(u0.x); x0[2] += wa.z * bflo(u0.y); x0[3] += wa.w * bfhi(u0.y);
                      x0[4] += wb.x * bflo(u0.z); x0[5] += wb.y * bfhi(u0.z); x0[6] += wb.z * bflo(u0.w); x0[7] += wb.w * bfhi(u0.w);
                      x1[0] += wa.x * bflo(u1.x); x1[1] += wa.y * bfhi(u1.x); x1[2] += wa.z * bflo(u1.y); x1[3] += wa.w * bfhi(u1.y);
                      x1[4] += wb.x * bflo(u1.z); x1[5] += wb.y * bfhi(u1.z); x1[6] += wb.z * bflo(u1.w); x1[7] += wb.w * bfhi(u1.w); }
                  u32x4 w; w.x = pk2(x0[0], x0[1]); w.y = pk2(x0[2], x0[3]); w.z = pk2(x0[4], x0[5]); w.w = pk2(x0[6], x0[7]);
                  *(LAS u32x4*)(XA + stok * USTR + sch * 16) = w;
                  w.x = pk2(x1[0], x1[1]); w.y = pk2(x1[2], x1[3]); w.z = pk2(x1[4], x1[5]); w.w = pk2(x1[6], x1[7]);
                  *(LAS u32x4*)(XA + (stok + 64) * USTR + sch * 16) = w;
                  if ((sch >> 2) == half) { LAS f32x4* xf = (LAS f32x4*)(XF + stok * 32 + (sch & 3) * 8); xf[0] = (f32x4){x0[0], x0[1], x0[2], x0[3]}; xf[1] = (f32x4){x0[4], x0[5], x0[6], x0[7]};
                      xf = (LAS f32x4*)(XF + (stok + 64) * 32 + (sch & 3) * 8); xf[0] = (f32x4){x1[0], x1[1], x1[2], x1[3]}; xf[1] = (f32x4){x1[4], x1[5], x1[6], x1[7]}; } }
                LBAR();
#pragma unroll
                for (int i2 = 0; i2 < 2; ++i2) { const int tb = (wave >> 1) + 4 * i2; const int tok = tb * 16 + fr;
                    const bf16x8 x0 = *(const LAS bf16x8*)(XA + tok * USTR + fq * 16), x1 = *(const LAS bf16x8*)(XA + tok * USTR + 64 + fq * 16);
                    f32x4 ar = (f32x4){0.f, 0.f, 0.f, 0.f}, ai = (f32x4){0.f, 0.f, 0.f, 0.f};
                    ar = MFMA16(wr_[0], x0, ar); ar = MFMA16(wr_[1], x1, ar); ai = MFMA16(wi_[0], x0, ai); ai = MFMA16(wi_[1], x1, ai);
                    const f32x4 xv = *(const LAS f32x4*)(XF + tok * 32 + cbk * 16 + 4 * fq);
                    float av[4], bv[4];
#pragma unroll
                    for (int e = 0; e < 4; ++e) { const float r = __builtin_amdgcn_rcpf(1.0f + __builtin_amdgcn_exp2f(-(ar[e] + eba[e]) * LOG2E)); const float ig = __builtin_amdgcn_rcpf(1.0f + __builtin_amdgcn_exp2f(-(ai[e] + ebx[e]) * LOG2E));
                        const float a_ = __builtin_amdgcn_exp2f(r * esp[e]); av[e] = a_; bv[e] = __builtin_amdgcn_sqrtf(fmaxf(1.0f - a_ * a_, 0.f)) * (ig * xv[e]); }
                    LAS f32x4* ab = (LAS f32x4*)(AB + tok * 32 + cbk * 16 + 4 * fq); ab[0] = (f32x4){av[0], bv[0], av[1], bv[1]}; ab[1] = (f32x4){av[2], bv[2], av[3], bv[3]}; }
                LBAR();
                }
                float a8[8], b8[8];
                { float Ap = 1.f, H = 0.f;
#pragma unroll
                  for (int k = 0; k < 8; ++k) { const f32x2 v = AB[(sc * 8 + k) * 32 + ch]; a8[k] = v.x; b8[k] = v.y; H = v.x * H + v.y; Ap *= v.x; }
                  CAR[sc * 32 + ch] = (f32x2){Ap, H}; }
                LBAR();
                float hrun = ST[(tl & 1) * 32 + ch];
                { f32x2 cr[15];
#pragma unroll
                  for (int s = 0; s < 15; ++s) cr[s] = CAR[s * 32 + ch];
#pragma unroll
                  for (int s = 0; s < 15; ++s) hrun = (s < sc) ? cr[s].x * hrun + cr[s].y : hrun; }
#pragma unroll
                for (int k = 0; k < 8; ++k) { hrun = a8[k] * hrun + b8[k]; XF[(sc * 8 + k) * 32 + ch] = hrun; }
                if (sc == 15) ST[((tl + 1) & 1) * 32 + ch] = hrun;
            }
            LBAR();
            LRU_OUT();
            asm volatile("s_waitcnt vmcnt(0)" ::: "memory");
        }
        LBAR();
    }
#undef LRU_OUT
}

__device__ __forceinline__ void cu8(const bf16_t* ACT, size_t row, int col, float* o) {
    const u32x4 a = __builtin_nontemporal_load((const u32x4*)(ACT + row * 4096 + col)), c = __builtin_nontemporal_load((const u32x4*)(ACT + row * 4096 + 2048 + col));
    o[0] = bflo(a.x) * bflo(c.x); o[1] = bfhi(a.x) * bfhi(c.x); o[2] = bflo(a.y) * bflo(c.y); o[3] = bfhi(a.y) * bfhi(c.y);
    o[4] = bflo(a.z) * bflo(c.z); o[5] = bfhi(a.z) * bfhi(c.z); o[6] = bflo(a.w) * bflo(c.w); o[7] = bfhi(a.w) * bfhi(c.w);
}
__device__ __forceinline__ void phase_conv(const Args& A, const bf16_t* ACT, bf16_t* Y, const int wv) {
    const float* conv_w = A.in[27]; const float* conv_b = A.in[28];
    const int nitems = (MT / 8) * 128;
    const int tid = otid(wv);
    for (int item = blockIdx.x * NTHREADS + tid; item < nitems; item += gridDim.x * NTHREADS) {
        const int rg = item >> 7, chunk = item & 127, col = chunk * 8, row0 = rg * 8;
        const int seglen = row0 < ML ? SEQ : CTX;
        const bool first = (row0 % seglen) == 0, last = ((row0 + 8) % seglen) == 0;
        float w0[8], w1[8], w2[8], cb[8];
        { const f32x4* p = (const f32x4*)(conv_w + col); f32x4 a = p[0], c = p[1]; w0[0] = a.x; w0[1] = a.y; w0[2] = a.z; w0[3] = a.w; w0[4] = c.x; w0[5] = c.y; w0[6] = c.z; w0[7] = c.w;
          p = (const f32x4*)(conv_w + DM + col); a = p[0]; c = p[1]; w1[0] = a.x; w1[1] = a.y; w1[2] = a.z; w1[3] = a.w; w1[4] = c.x; w1[5] = c.y; w1[6] = c.z; w1[7] = c.w;
          p = (const f32x4*)(conv_w + 2 * DM + col); a = p[0]; c = p[1]; w2[0] = a.x; w2[1] = a.y; w2[2] = a.z; w2[3] = a.w; w2[4] = c.x; w2[5] = c.y; w2[6] = c.z; w2[7] = c.w;
          p = (const f32x4*)(conv_b + col); a = p[0]; c = p[1]; cb[0] = a.x; cb[1] = a.y; cb[2] = a.z; cb[3] = a.w; cb[4] = c.x; cb[5] = c.y; cb[6] = c.z; cb[7] = c.w; }
        float prev[8], cur[8], nxt[8];
        if (first) {
#pragma unroll
            for (int e = 0; e < 8; ++e) prev[e] = 0.f;
        } else cu8(ACT, (size_t)row0 - 1, col, prev);
        cu8(ACT, (size_t)row0, col, cur);
#pragma unroll
        for (int k = 0; k < 8; ++k) {
            const size_t row = (size_t)row0 + k;
            if (k == 7 && last) {
#pragma unroll
                for (int e = 0; e < 8; ++e) nxt[e] = 0.f;
            } else cu8(ACT, row + 1, col, nxt);
            const u32x4 bgw = __builtin_nontemporal_load((const u32x4*)(ACT + row * 4096 + 1024 + col)), sgw = __builtin_nontemporal_load((const u32x4*)(ACT + row * 4096 + 3072 + col));
            float y[8];
#pragma unroll
            for (int e = 0; e < 8; ++e) y[e] = w0[e] * prev[e] + w1[e] * cur[e] + w2[e] * nxt[e] + cb[e];
            y[0] *= bflo(bgw.x) * bflo(sgw.x); y[1] *= bfhi(bgw.x) * bfhi(sgw.x); y[2] *= bflo(bgw.y) * bflo(sgw.y); y[3] *= bfhi(bgw.y) * bfhi(sgw.y);
            y[4] *= bflo(bgw.z) * bflo(sgw.z); y[5] *= bfhi(bgw.z) * bfhi(sgw.z); y[6] *= bflo(bgw.w) * bflo(sgw.w); y[7] *= bfhi(bgw.w) * bfhi(sgw.w);
            u32x4 w; w.x = pk2(y[0], y[1]); w.y = pk2(y[2], y[3]); w.z = pk2(y[4], y[5]); w.w = pk2(y[6], y[7]);
            *(u32x4*)(Y + row * DM + col) = w;
#pragma unroll
            for (int e = 0; e < 8; ++e) { prev[e] = cur[e]; cur[e] = nxt[e]; }
        }
    }
}

__device__ __forceinline__ void phase_ctx_wout(const bf16_t* Yc, const bf16_t* Wt, const float* xin, float* xout, const float* gate, LAS unsigned char* L, const int wv) {
    constexpr int PITCH = 144, ABYTES = 128 * PITCH, BUFB = 192 * PITCH;
    const int tid = otid(wv), lane = tid & 63, r32 = lane & 31, hi = lane >> 5, wave = wv, G = gridDim.x;
    const int srow = tid >> 3, sch = tid & 7;
    const int aoff = ((wave >> 1) * 32 + r32) * PITCH + hi * 64, boff = ABYTES + ((wave & 1) * 32 + r32) * PITCH + hi * 64;
    for (int t = blockIdx.x; t < 256; t += G) {
        const int tm = t >> 4, tn = t & 15;
        const bf16_t* ga0 = Yc + (size_t)(tm * 128 + srow) * DM + sch * 8; const bf16_t* ga1 = ga0 + (size_t)64 * DM; const bf16_t* gb = Wt + (size_t)(tn * 64 + srow) * DM + sch * 8;
        f32x16 acc;
#pragma unroll
        for (int r = 0; r < 16; ++r) acc[r] = 0.f;
        u32x4 qa0[3], qa1[3], qb[3];
#define CTX_LOAD(q, s_) do { qa0[q] = *(const u32x4*)(ga0 + (s_) * 64); qa1[q] = *(const u32x4*)(ga1 + (s_) * 64); qb[q] = *(const u32x4*)(gb + (s_) * 64); } while (0)
#define CTX_WRITE(q, buf) do { LAS unsigned char* Bn = L + (buf) * BUFB; *(LAS u32x4*)(Bn + srow * PITCH + sch * 16) = qa0[q]; *(LAS u32x4*)(Bn + (64 + srow) * PITCH + sch * 16) = qa1[q]; *(LAS u32x4*)(Bn + ABYTES + srow * PITCH + sch * 16) = qb[q]; } while (0)
#define CTX_STEP(s_, q) do { const int s = (s_); LAS const unsigned char* B = L + (s & 1) * BUFB; bf16x8 a[4], b[4]; \
            _Pragma("unroll") for (int j = 0; j < 4; ++j) { a[j] = *(const LAS bf16x8*)(B + aoff + j * 16); b[j] = *(const LAS bf16x8*)(B + boff + j * 16); } \
            _Pragma("unroll") for (int j = 0; j < 4; ++j) acc = MFMA32(a[j], b[j], acc); \
            if (s + 1 < 16) CTX_WRITE(q, (s + 1) & 1); \
            LBAR(); \
            if (s + 4 < 16) CTX_LOAD(q, s + 4); } while (0)
        CTX_LOAD(0, 0); CTX_LOAD(1, 1); CTX_LOAD(2, 2);
        LBAR();
        CTX_WRITE(0, 0);
        CTX_LOAD(0, 3);
        LBAR();
#pragma unroll 1
        for (int s0 = 0; s0 < 16; s0 += 3) {
            CTX_STEP(s0, 1);
            if (s0 + 1 < 16) CTX_STEP(s0 + 1, 2);
            if (s0 + 2 < 16) CTX_STEP(s0 + 2, 0);
        }
#undef CTX_LOAD
#undef CTX_WRITE
#undef CTX_STEP
        const int m0 = tm * 128 + (wave >> 1) * 32, col = tn * 64 + (wave & 1) * 32 + r32; const float gv = gate[col];
        float xv[16];
#pragma unroll
        for (int r = 0; r < 16; ++r) xv[r] = xin[(size_t)(m0 + crow(r, hi)) * DM + col];
#pragma unroll
        for (int r = 0; r < 16; ++r) xout[(size_t)(m0 + crow(r, hi)) * DM + col] = xv[r] + gv * acc[r];
    }
    LBAR();
}

__device__ __forceinline__ void phase_final(float* out, const float* g, const int wv) {
    const int tid = otid(wv); const int lane = tid & 63, gw = blockIdx.x * NWAVES + (tid >> 6), NGW = gridDim.x * NWAVES;
    f32x4 gv[4];
#pragma unroll
    for (int j = 0; j < 4; ++j) gv[j] = *((const f32x4*)g + 64 * j + lane);
    for (int row0 = gw * 4; row0 < ML; row0 += NGW * 4) {
        f32x4 v[4][4]; float s[4];
#pragma unroll
        for (int i = 0; i < 4; ++i) { const f32x4* xr = (const f32x4*)(out + (size_t)(row0 + i) * DM) + lane;
#pragma unroll
            for (int j = 0; j < 4; ++j) v[i][j] = __builtin_nontemporal_load(xr + 64 * j); }
#pragma unroll
        for (int i = 0; i < 4; ++i) { float a = 0.f;
#pragma unroll
            for (int j = 0; j < 4; ++j) a += (v[i][j].x * v[i][j].x + v[i][j].y * v[i][j].y) + (v[i][j].z * v[i][j].z + v[i][j].w * v[i][j].w);
            s[i] = a; }
#pragma unroll
        for (int o = 1; o < 64; o <<= 1) {
#pragma unroll
            for (int i = 0; i < 4; ++i) s[i] += __shfl_xor(s[i], o); }
#pragma unroll
        for (int i = 0; i < 4; ++i) { const float rstd = 1.0f / sqrtf(s[i] * (1.0f / DM) + EPS); f32x4* xr = (f32x4*)(out + (size_t)(row0 + i) * DM) + lane;
#pragma unroll
            for (int j = 0; j < 4; ++j) xr[64 * j] = v[i][j] * rstd * gv[j]; }
    }
}

#define RLX_AGENT __ATOMIC_RELAXED, __HIP_MEMORY_SCOPE_AGENT
#define XB_TMO      128
#define XB_XCNT(j)  (256  + 64 * (j))
#define XB_XSUB(j)  (1280 + 64 * (j))
#define XB_XGEN(j)  (2304 + 64 * (j))
#define XB_TOP      3328
#define XB_TOPGEN   3392
#define XCD_BAR_WORDS 3456
#define XB_SPIN_CAP (1u << 18)

__device__ __forceinline__ unsigned xb_ld(unsigned* p)              { return __hip_atomic_load(p, __ATOMIC_RELAXED, __HIP_MEMORY_SCOPE_AGENT); }
__device__ __forceinline__ unsigned xb_add(unsigned* p, unsigned v) { return __hip_atomic_fetch_add(p, v, __ATOMIC_RELAXED, __HIP_MEMORY_SCOPE_AGENT); }
__device__ __forceinline__ unsigned xb_xcc_id() { return (unsigned)__builtin_amdgcn_s_getreg((3 << 11) | 20) & 0xFu; }
#define XB_SPIN(cond, bar) do { unsigned _sp = 0; while (cond) { __builtin_amdgcn_s_sleep(1); \
    if ((++_sp & 255u) == 0u) { if (xb_ld(&(bar)[XB_TMO])) break; if (_sp > XB_SPIN_CAP) { atomicAdd(&(bar)[XB_TMO], 1u); break; } } } } while (0)

struct XcdBarrier {
    unsigned* bar; unsigned x;
    volatile LAS unsigned* st;
};

__device__ __forceinline__ XcdBarrier xcd_barrier_post(unsigned* bar, volatile LAS unsigned* st) {
    XcdBarrier b; b.bar = bar; b.x = xb_xcc_id(); b.st = st;
    if (threadIdx.x == 0) (void)xb_add(&bar[XB_XCNT(b.x)], 1u);
    return b;
}
__device__ __forceinline__ void xcd_barrier_complete(unsigned* bar, unsigned x, unsigned& nloc, unsigned& nx) {
    const unsigned G = gridDim.x * gridDim.y * gridDim.z;
    unsigned sum, cnt, mine, sp = 0u;
    for (;;) {
        sum = 0u; cnt = 0u; mine = 0u;
#pragma unroll
        for (unsigned j = 0; j < 16; ++j) { const unsigned c = xb_ld(&bar[XB_XCNT(j)]); sum += c; cnt += (c > 0u) ? 1u : 0u; mine = (j == x) ? c : mine; }
        if (sum == G) break;
        __builtin_amdgcn_s_sleep(1);
        if ((++sp & 255u) == 0u) { if (xb_ld(&bar[XB_TMO])) break; if (sp > XB_SPIN_CAP) { atomicAdd(&bar[XB_TMO], 1u); break; } }
    }
    nloc = mine > 0u ? mine : 1u; nx = cnt > 0u ? cnt : 1u;
}

__device__ __forceinline__ void xcd_barrier(const XcdBarrier& b) {
    asm volatile("s_waitcnt vmcnt(0)" ::: "memory");
    __syncthreads();
    if (threadIdx.x == 0) {
        unsigned* bar = b.bar;
        __builtin_amdgcn_s_waitcnt(0);
        unsigned nloc = b.st[0], nx = b.st[1];
        if (nloc == 0u) { xcd_barrier_complete(bar, b.x, nloc, nx); b.st[0] = nloc; b.st[1] = nx; }
        const unsigned old = xb_add(&bar[XB_XSUB(b.x)], 1u);
        const unsigned gen = old / nloc;
        if (old + 1u == (gen + 1u) * nloc) {
            __builtin_amdgcn_fence(__ATOMIC_RELEASE, "agent");
            asm volatile("s_waitcnt vmcnt(0)" ::: "memory");
            const unsigned og = xb_add(&bar[XB_TOP], 1u);
            const unsigned tg = og / nx;
            if (og + 1u == (tg + 1u) * nx) xb_add(&bar[XB_TOPGEN], 1u);
            else XB_SPIN(xb_ld(&bar[XB_TOPGEN]) == tg, bar);
            __builtin_amdgcn_fence(__ATOMIC_ACQUIRE, "agent");
            xb_add(&bar[XB_XGEN(b.x)], 1u);
            asm volatile("s_waitcnt vmcnt(0)" ::: "memory");
        } else {
            XB_SPIN(xb_ld(&bar[XB_XGEN(b.x)]) == gen, bar);
            __builtin_amdgcn_fence(__ATOMIC_ACQUIRE, "agent");
            asm volatile("s_waitcnt vmcnt(0)" ::: "memory");
        }
    }
    __syncthreads();
}

__global__ void __launch_bounds__(NTHREADS, 2) hybrid_fwd(Args A) {
    extern __shared__ __attribute__((aligned(16))) unsigned char lds[];
    cg::grid_group grid = cg::this_grid();
    LAS unsigned char* L = (LAS unsigned char*)lds;
    unsigned char* ws = A.ws;
    const int G = gridDim.x;
    float* XL = A.out; float* XC = (float*)(ws + WS_XC);
    bf16_t* XN = (bf16_t*)(ws + WS_XN); bf16_t* ACT = (bf16_t*)(ws + WS_ACT);
    const float* gatef = (const float*)(ws + WS_GATE);

    const int wv = __builtin_amdgcn_readfirstlane((int)threadIdx.x >> 6);
    volatile LAS unsigned* MISC = (volatile LAS unsigned*)(L + 131072 + 320);
    if (threadIdx.x < 32) MISC[threadIdx.x] = 0u;
    __syncthreads();
    XcdBarrier xbar = xcd_barrier_post((unsigned*)ws + 4096, MISC + 8);
#define GSYNC() xcd_barrier(xbar)
#pragma unroll 1
    for (int l = 0; l < 4; ++l) { phase_prep(A, L, l, (int)((blockIdx.x + 64 * l) % G), G, wv); LBAR(); }
    if (A.out == nullptr) grid.sync();
    for (int rep = 0; rep < DUP_SYNC; ++rep) GSYNC();
#pragma unroll 1
    for (int layer = 0; layer < 4; ++layer) {
        ws = ows(ws);
        const int kind = layer == 3 ? 0 : layer;
        const int Nin = kind == 0 ? 2560 : (kind == 1 ? 2048 : 4096);
        const float* xinL = layer == 0 ? A.in[0] : XL; const float* xinC = layer == 0 ? A.in[2] : XC;
        for (int rep = 0; rep < DUP_NORM; ++rep) phase_norm(A, layer, xinL, xinC, L, wv);
        GSYNC();
        {
            const bf16_t* Wt = (const bf16_t*)(ws + (layer == 0 ? WS_WIN[0] : layer == 1 ? WS_WIN[1] : layer == 2 ? WS_WIN[2] : WS_WIN[3]));
            pg8::Gemm g{XN, Wt, layer == 3 ? ML : MT, Nin, DM};
            pg8::OrderG S; S.so.init(layer == 3 ? ML : MT, Nin, G, (int)blockIdx.x); S.extra = layer == 3 ? 16 : 0;
            pg8::EpiIn E{ACT, Nin, kind, (const float*)(ws + WS_ROPE)};
            for (int rep = 0; rep < DUP_GIN; ++rep) pg8::gemm_phase<pg8::EpiIn, pg8::OrderG, true, true>(L, g, S, E, wv);
        }
        GSYNC();
        if (kind == 0) { for (int rep = 0; rep < DUP_ATTN; ++rep) phase_attn(ACT, XN, (layer == 0 ? A.in[9] : A.in[34]), layer == 0, L, wv); }
        else if (kind == 1) { for (int rep = 0; rep < DUP_LRU; ++rep) phase_lru(A, ACT, XN, (float*)(ws + WS_HF), L, wv); }
        else { for (int rep = 0; rep < DUP_CONV; ++rep) phase_conv(A, ACT, XN, wv); }
        GSYNC();
        {
            const bf16_t* Wt = (const bf16_t*)(ws + (layer == 0 ? WS_WOUT[0] : layer == 1 ? WS_WOUT[1] : layer == 2 ? WS_WOUT[2] : WS_WOUT[3]));
            const int Mo = (CTX_SMALL || layer == 3) ? ML : MT;
            pg8::Gemm g{XN, Wt, Mo, DM, DM};
            pg8::OrderG S; S.so.init(Mo, DM, G, (int)blockIdx.x); S.extra = 0;
            pg8::EpiRes E{xinL, xinC, XL, XC, gatef + (size_t)layer * 9 * 1024};
            const bool ctx_first = (blockIdx.x & 1) != 0;
#pragma unroll 1
            for (int step = 0; step < 2; ++step) {
                if ((step == 0) == ctx_first) { if (CTX_SMALL && layer < 3) phase_ctx_wout(XN + (size_t)ML * DM, Wt, xinC, XC, gatef + (size_t)(layer * 9 + 8) * 1024, L, wv); }
                else pg8::gemm_phase<pg8::EpiRes, pg8::OrderG, true, true>(L, g, S, E, wv);
            }
        }
        GSYNC();
    }
    phase_final(XL, A.in[35], wv);
}

extern "C" void kernel_launch(void* const* d_in, const int* in_sizes, int n_in, void* d_out, int out_size, void* d_ws, size_t ws_size, hipStream_t stream) {
    static int grid = 0;
    if (grid == 0) {
        if (n_in != 36 || out_size != ML * DM || ws_size < WS_END) { fprintf(stderr, "kernel_launch: unexpected shapes (n_in %d, out %d, ws %zu)\n", n_in, out_size, ws_size); grid = -1; return; }
        int dev = 0, cus = 0, per_cu = 0;
        hipGetDevice(&dev); hipDeviceGetAttribute(&cus, hipDeviceAttributeMultiprocessorCount, dev);
        if (hipFuncSetAttribute((const void*)hybrid_fwd, hipFuncAttributeMaxDynamicSharedMemorySize, LDS_BYTES) != hipSuccess) { fprintf(stderr, "kernel_launch: hipFuncSetAttribute failed\n"); grid = -1; return; }
        if (hipOccupancyMaxActiveBlocksPerMultiprocessor(&per_cu, (const void*)hybrid_fwd, NTHREADS, LDS_BYTES) != hipSuccess || per_cu < 1) { fprintf(stderr, "kernel_launch: occupancy query says %d\n", per_cu); per_cu = 1; }
        (void)hipGetLastError();
        grid = cus * (per_cu > 1 ? 1 : per_cu);
        if (grid > 256) grid = 256;
    }
    if (grid < 0) return;
    if (hipMemsetAsync(d_ws, 0, 65536, stream) != hipSuccess) { fprintf(stderr, "kernel_launch: memset failed\n"); return; }
    Args a{};
    for (int i = 0; i < 36; ++i) a.in[i] = (const float*)d_in[i];
    a.out = (float*)d_out; a.ws = (unsigned char*)d_ws;
    void* args[] = {&a};
    hipError_t e = hipLaunchCooperativeKernel((const void*)hybrid_fwd, dim3(grid), dim3(NTHREADS), args, LDS_BYTES, stream);
    if (e != hipSuccess) fprintf(stderr, "kernel_launch: cooperative launch failed: %s (grid %d)\n", hipGetErrorString(e), grid);
}
```

```cpp
#include <hip/hip_runtime.h>
#include <hip/hip_cooperative_groups.h>
#include <cstdio>
#include <cstdint>
namespace cg = cooperative_groups;

namespace pg8 {
#define PG8_LAS __attribute__((address_space(3)))
typedef unsigned short bf16_t;
typedef short bf16x8 __attribute__((ext_vector_type(8)));
typedef float f32x4 __attribute__((ext_vector_type(4)));
typedef unsigned u32x4 __attribute__((ext_vector_type(4)));
constexpr int BM = 256, BK = 64, HALF = 128, HTB = HALF * BK * 2  , STAGE_BYTES = 8 * HTB, NXCD = 8, WGM = 8;

__host__ __device__ __forceinline__ int lds_byte(int r, int c) { const int st = (r >> 4) * 2 + (c >> 5), rr = r & 15, cc = c & 31, ob = rr * 64 + cc * 2; return st * 1024 + (ob ^ (((ob >> 9) & 1) << 5)); }
__host__ __device__ __forceinline__ void stage_rc(int b, int& R, int& C) { const int st = b / 1024, sb = b % 1024, swz = sb ^ (((sb >> 9) & 1) << 5); R = (st >> 1) * 16 + swz / 64; C = (st & 1) * 32 + (swz % 64) / 2; }
__host__ __device__ __forceinline__ int perm32(int rho) { const int n = rho >> 4, i = rho & 15; return 8 * (i >> 2) + 4 * n + (i & 3); }

struct Unit { int pm, pn; };
struct Gemm { const bf16_t* A; const bf16_t* Bt; int M, N, K; };

struct StaticOrder {
    int nM, nN, nwg, G, c;
    __host__ __device__ void init(int M, int N, int G_, int c_) { nM = M / BM; nN = N / BM; nwg = nM * nN; G = G_; c = c_; }
    __host__ __device__ bool next(int i, Unit& u) const {
        const long L = (long)i * G + c; if (L >= nwg) return false;
        int wgid = (int)L; { const int q = nwg / NXCD, r = nwg % NXCD, xcd = wgid % NXCD, off = wgid / NXCD; wgid = (xcd < r ? xcd * (q + 1) : r * (q + 1) + (xcd - r) * q) + off; }
        const int nig = WGM * nN, gid = wgid / nig, fm = gid * WGM, gsz = (nM - fm) < WGM ? (nM - fm) : WGM;
        u.pm = fm + ((wgid % nig) % gsz); u.pn = (wgid % nig) / gsz; return true;
    }
    __device__ __forceinline__ void a_ready(const Unit&) const {}
    __device__ __forceinline__ void done(const Unit&) const {}
};

__device__ __forceinline__ unsigned cvt_pk_bf16(float lo, float hi) { unsigned r; asm volatile("v_cvt_pk_bf16_f32 %0, %1, %2" : "=v"(r) : "v"(lo), "v"(hi)); return r; }
typedef float f32x2 __attribute__((ext_vector_type(2)));
__device__ __forceinline__ float silu_f(float v) { return v * __builtin_amdgcn_rcpf(1.0f + __builtin_amdgcn_exp2f(-v * 1.4426950408889634f)); }
constexpr float QSCALE = 0.125f * 1.4426950408889634f;

struct OrderG {
    StaticOrder so; int extra;
    __device__ __forceinline__ bool next(int i, Unit& u) const {
        long L = (long)i * so.G + so.c; if (L < so.nwg) return so.next(i, u);
        L -= so.nwg; if (L >= extra) return false; u.pm = 64 + (int)(L >> 1); u.pn = 4 + (int)(L & 1); return true;
    }
    __device__ __forceinline__ void a_ready(const Unit&) const {}
    __device__ __forceinline__ void done(const Unit&) const {}
};

struct EpiIn {
    static constexpr bool PERM = true, AFTER_DRAIN = false;
    bf16_t* O; int ldc; int kind; const float* rope;
    __device__ __forceinline__ void operator()(const f32x4 (&acc)[2][2][4][2], const Unit& u, int wr, int wc, int fr, int fq) const {
        const int colt = u.pn * BM; const bool lat = u.pm < 64;
        int mode = 0; float sc = 1.f;
        if (kind == 0) { if (colt < 1024) { mode = lat ? 2 : 0; sc = QSCALE; } else if (colt < 1280) mode = lat ? 2 : 0; else if (colt < 1536) mode = 0; else mode = 1; }
        else if (kind == 1) mode = colt < 1024 ? 0 : 1;
        else mode = colt < 3072 ? 0 : 1;
        const int row0 = u.pm * BM + wr * 64 + fr; const int col0 = colt + wc * 32 + 8 * fq;
        const float sgn = (fq < 2) ? -1.f : 1.f;
#pragma unroll
        for (int ai = 0; ai < 2; ++ai)
#pragma unroll
            for (int m = 0; m < 4; ++m) {
                const int row = row0 + ai * HALF + m * 16;
                bf16_t* rowp = O + (size_t)row * ldc + col0;
                f32x4 cs[4];
                if (mode == 2) { const int l = row & 2047; const int p = (wc & 1) ? (l & 63) : (l >> 6); const f32x4* rp = (const f32x4*)(rope + (p * 16 + 8 * (fq & 1)) * 2);
                    cs[0] = rp[0]; cs[1] = rp[1]; cs[2] = rp[2]; cs[3] = rp[3]; }
#pragma unroll
                for (int bj = 0; bj < 2; ++bj) {
                    f32x4 v0 = acc[ai][bj][m][0], v1 = acc[ai][bj][m][1];
                    if (mode == 1) {
#pragma unroll
                        for (int e = 0; e < 4; ++e) { v0[e] = silu_f(v0[e]); v1[e] = silu_f(v1[e]); }
                    } else if (mode == 2) {
                        f32x4 p0, p1;
#pragma unroll
                        for (int e = 0; e < 4; ++e) { p0[e] = __shfl_xor(v0[e], 32); p1[e] = __shfl_xor(v1[e], 32); }
                        v0[0] = v0[0] * cs[0][0] + sgn * p0[0] * cs[0][1]; v0[1] = v0[1] * cs[0][2] + sgn * p0[1] * cs[0][3];
                        v0[2] = v0[2] * cs[1][0] + sgn * p0[2] * cs[1][1]; v0[3] = v0[3] * cs[1][2] + sgn * p0[3] * cs[1][3];
                        v1[0] = v1[0] * cs[2][0] + sgn * p1[0] * cs[2][1]; v1[1] = v1[1] * cs[2][2] + sgn * p1[1] * cs[2][3];
                        v1[2] = v1[2] * cs[3][0] + sgn * p1[2] * cs[3][1]; v1[3] = v1[3] * cs[3][2] + sgn * p1[3] * cs[3][3];
                    }
                    v0 = v0 * sc; v1 = v1 * sc;
                    u32x4 w; w.x = cvt_pk_bf16(v0[0], v0[1]); w.y = cvt_pk_bf16(v0[2], v0[3]); w.z = cvt_pk_bf16(v1[0], v1[1]); w.w = cvt_pk_bf16(v1[2], v1[3]);
                    *(u32x4*)(rowp + bj * HALF) = w;
                }
            }
    }
};

struct EpiRes {
    static constexpr bool PERM = true, AFTER_DRAIN = false;
    const float* inL; const float* inC; float* outL; float* outC; const float* gate;
    __device__ __forceinline__ void operator()(const f32x4 (&acc)[2][2][4][2], const Unit& u, int wr, int wc, int fr, int fq) const {
        const bool lat = u.pm < 64;
        const float* ib = lat ? inL + (size_t)u.pm * BM * 1024 : inC + (size_t)(u.pm - 64) * BM * 1024;
        float* ob = lat ? outL + (size_t)u.pm * BM * 1024 : outC + (size_t)(u.pm - 64) * BM * 1024;
        const float* g = gate + (lat ? (u.pm >> 3) : 8) * 1024;
        const int col0 = u.pn * BM + wc * 32 + 8 * fq;
        f32x4 gv[2][2];
#pragma unroll
        for (int bj = 0; bj < 2; ++bj)
#pragma unroll
            for (int n = 0; n < 2; ++n) gv[bj][n] = *(const f32x4*)(g + col0 + bj * HALF + n * 4);
#pragma unroll
        for (int ai = 0; ai < 2; ++ai)
#pragma unroll
            for (int mp = 0; mp < 2; ++mp) {
                f32x4 xv[2][2][2];
#pragma unroll
                for (int mm = 0; mm < 2; ++mm) { const size_t off = (size_t)(ai * HALF + wr * 64 + (2 * mp + mm) * 16 + fr) * 1024 + col0;
#pragma unroll
                    for (int bj = 0; bj < 2; ++bj)
#pragma unroll
                        for (int n = 0; n < 2; ++n) xv[mm][bj][n] = __builtin_nontemporal_load((const f32x4*)(ib + off + bj * HALF + n * 4)); }
#pragma unroll
                for (int mm = 0; mm < 2; ++mm) { const int m = 2 * mp + mm; const size_t off = (size_t)(ai * HALF + wr * 64 + m * 16 + fr) * 1024 + col0;
#pragma unroll
                    for (int bj = 0; bj < 2; ++bj)
#pragma unroll
                        for (int n = 0; n < 2; ++n) *(f32x4*)(ob + off + bj * HALF + n * 4) = xv[mm][bj][n] + gv[bj][n] * acc[ai][bj][m][n]; }
                asm volatile("" ::: "memory"); }
    }
};

template <class Epi, class Sched, bool ALIGN_EPI = false, bool SP2 = false>
__device__ __forceinline__ void gemm_phase(PG8_LAS unsigned char* lds, const Gemm g, const Sched& S, const Epi& E, const int wv_) {
    int tid_ = wv_ * 64 + (int)__builtin_amdgcn_mbcnt_hi(~0u, __builtin_amdgcn_mbcnt_lo(~0u, 0u)); asm volatile("" : "+v"(tid_));
    const int tid = tid_, wid = __builtin_amdgcn_readfirstlane(tid >> 6), lane = tid & 63, wr = wid >> 2, wc = wid & 3, fr = lane & 15, fq = lane >> 4;
    const int K = g.K, nt = K / BK;
    unsigned voffA[2], voffB[2];
#pragma unroll
    for (int i = 0; i < 2; ++i) { int R, C; stage_rc(tid * 16 + i * 8192, R, C); const int Rb = Epi::PERM ? ((R & ~31) + perm32(R & 31)) : R;
        voffA[i] = (unsigned)(R * K + C) * 2u; voffB[i] = (unsigned)(Rb * K + C) * 2u; }
    const size_t kstep = (size_t)(BK * 2);
    const size_t hstep = (size_t)HALF * K * 2;
    const size_t tstep = 2 * hstep;
    const unsigned ldsw = (unsigned)wid * 1024u;
    const int aoff = lds_byte(wr * 64 + fr, fq * 8), boff = lds_byte(wc * 32 + fr, fq * 8);
#define PG8_SA(b, h) (((b) * 2 + (h)) * HTB)
#define PG8_SB(b, h) ((4 + (b) * 2 + (h)) * HTB)
#define PG8_STAGE(bufoff, gbase, voff) do { _Pragma("unroll") for (int _i = 0; _i < 2; ++_i) \
        __builtin_amdgcn_global_load_lds((const unsigned*)((const char*)(gbase) + (voff)[_i]), (PG8_LAS unsigned*)(lds + (bufoff) + ldsw + _i * 8192), 16, 0, 0); } while (0)
#define PG8_LDA(dst, b, h) do { _Pragma("unroll") for (int m = 0; m < 4; ++m) _Pragma("unroll") for (int k = 0; k < 2; ++k) dst[m][k] = *(const PG8_LAS bf16x8*)(lds + PG8_SA(b, h) + aoff + m * 2048 + k * 1024); } while (0)
#define PG8_LDB(dst, b, h) do { _Pragma("unroll") for (int n = 0; n < 2; ++n) _Pragma("unroll") for (int k = 0; k < 2; ++k) dst[n][k] = *(const PG8_LAS bf16x8*)(lds + PG8_SB(b, h) + boff + n * 2048 + k * 1024); } while (0)
#define PG8_MMA(ai, bj, At, Bt) do { __builtin_amdgcn_s_setprio(1); _Pragma("unroll") for (int m = 0; m < 4; ++m) _Pragma("unroll") for (int n = 0; n < 2; ++n) _Pragma("unroll") for (int k = 0; k < 2; ++k) \
        acc[ai][bj][m][n] = __builtin_amdgcn_mfma_f32_16x16x32_bf16(Bt[n][k], At[m][k], acc[ai][bj][m][n], 0, 0, 0); __builtin_amdgcn_s_setprio(0); } while (0)
#define PG8_WAIT_V(n) asm volatile("s_waitcnt vmcnt(" #n ")" ::: "memory")
#define PG8_WAIT_L(n) asm volatile("s_waitcnt lgkmcnt(" #n ")" ::: "memory")
#define PG8_BAR __builtin_amdgcn_s_barrier()
#define PG8_SCHED __builtin_amdgcn_sched_barrier(0)
    Unit cur, nxt; int ui = 0;
    if (!S.next(0, cur)) return;
    f32x4 acc[2][2][4][2];
#pragma unroll
    for (int a = 0; a < 2; ++a)
#pragma unroll
        for (int b = 0; b < 2; ++b)
#pragma unroll
            for (int m = 0; m < 4; ++m)
#pragma unroll
                for (int n = 0; n < 2; ++n) acc[a][b][m][n] = (f32x4){0.f, 0.f, 0.f, 0.f};
    bf16x8 At[4][2], B0[2][2], B1[2][2];
    const char* cA = (const char*)g.A + (size_t)cur.pm * tstep; const char* cB = (const char*)g.Bt + (size_t)cur.pn * tstep;
    S.a_ready(cur);
    if constexpr (SP2) {
        PG8_STAGE(PG8_SB(0, 0), cB, voffB); PG8_STAGE(PG8_SB(0, 1), cB + hstep, voffB); PG8_STAGE(PG8_SA(0, 0), cA, voffA); PG8_STAGE(PG8_SA(0, 1), cA + hstep, voffA);
        if (wr == 1) PG8_BAR;
        PG8_WAIT_V(2); PG8_BAR;
        PG8_STAGE(PG8_SB(1, 0), cB + kstep, voffB); PG8_STAGE(PG8_SA(1, 0), cA + kstep, voffA); PG8_STAGE(PG8_SB(1, 1), cB + hstep + kstep, voffB);
        PG8_WAIT_V(6); PG8_BAR;
    } else {
        PG8_STAGE(PG8_SB(0, 0), cB, voffB); PG8_STAGE(PG8_SA(0, 0), cA, voffA); PG8_STAGE(PG8_SB(0, 1), cB + hstep, voffB); PG8_STAGE(PG8_SA(0, 1), cA + hstep, voffA);
        if (wr == 1) PG8_BAR;
        PG8_WAIT_V(4); PG8_BAR;
        PG8_STAGE(PG8_SB(1, 0), cB + kstep, voffB); PG8_STAGE(PG8_SA(1, 0), cA + kstep, voffA); PG8_STAGE(PG8_SB(1, 1), cB + hstep + kstep, voffB);
        PG8_WAIT_V(6); PG8_BAR;
    }
    for (;;) {
        const bool has_next = S.next(ui + 1, nxt);
        const char* nA = has_next ? (const char*)g.A + (size_t)nxt.pm * tstep : cA; const char* nB = has_next ? (const char*)g.Bt + (size_t)nxt.pn * tstep : cB;
        for (int t = 0; t < nt; t += 2) {
            const bool last = (t == nt - 2);
            const char* a1 = cA + (size_t)(t + 1) * kstep;
            const char* a2 = last ? nA : cA + (size_t)(t + 2) * kstep; const char* b2 = last ? nB : cB + (size_t)(t + 2) * kstep;
            const char* a3 = a2 + kstep; const char* b3 = b2 + kstep;
            if (last && has_next) S.a_ready(nxt);
            if constexpr (SP2) {
            PG8_LDB(B0, 0, 0); PG8_LDB(B1, 0, 1); PG8_SCHED; PG8_LDA(At, 0, 0); PG8_STAGE(PG8_SA(1, 1), a1 + hstep, voffA);
            PG8_WAIT_V(8); PG8_WAIT_L(0); PG8_BAR; PG8_MMA(0, 0, At, B0); PG8_MMA(0, 1, At, B1); PG8_BAR; PG8_SCHED;
            PG8_LDA(At, 0, 1); PG8_STAGE(PG8_SB(0, 0), b2, voffB); PG8_STAGE(PG8_SB(0, 1), b2 + hstep, voffB); PG8_STAGE(PG8_SA(0, 0), a2, voffA);
            PG8_WAIT_V(8); PG8_WAIT_L(0); PG8_BAR; PG8_MMA(1, 0, At, B0); PG8_MMA(1, 1, At, B1); PG8_BAR; PG8_SCHED;
            PG8_LDB(B0, 1, 0); PG8_LDB(B1, 1, 1); PG8_SCHED; PG8_LDA(At, 1, 0); PG8_STAGE(PG8_SA(0, 1), a2 + hstep, voffA);
            PG8_WAIT_V(8); PG8_WAIT_L(0); PG8_BAR; PG8_MMA(0, 0, At, B0); PG8_MMA(0, 1, At, B1); PG8_BAR; PG8_SCHED;
            PG8_LDA(At, 1, 1); PG8_STAGE(PG8_SB(1, 0), b3, voffB); PG8_STAGE(PG8_SB(1, 1), b3 + hstep, voffB); PG8_STAGE(PG8_SA(1, 0), a3, voffA);
            PG8_WAIT_V(8); PG8_WAIT_L(0); PG8_BAR; PG8_MMA(1, 0, At, B0); PG8_MMA(1, 1, At, B1); PG8_BAR; PG8_SCHED;
            } else {
            PG8_LDB(B0, 0, 0); PG8_SCHED; PG8_LDA(At, 0, 0); PG8_STAGE(PG8_SA(1, 1), a1 + hstep, voffA);
            PG8_WAIT_L(8); PG8_BAR; PG8_WAIT_L(0); PG8_MMA(0, 0, At, B0); PG8_BAR; PG8_SCHED;
            PG8_LDB(B1, 0, 1); PG8_STAGE(PG8_SB(0, 0), b2, voffB);
            PG8_BAR; PG8_WAIT_L(0); PG8_MMA(0, 1, At, B1); PG8_BAR;
            PG8_LDA(At, 0, 1); PG8_STAGE(PG8_SA(0, 0), a2, voffA);
            PG8_BAR; PG8_WAIT_L(0); PG8_MMA(1, 0, At, B0); PG8_BAR; PG8_SCHED;
            PG8_STAGE(PG8_SB(0, 1), b2 + hstep, voffB);
            PG8_WAIT_V(6); PG8_BAR; PG8_MMA(1, 1, At, B1); PG8_BAR;
            PG8_LDB(B0, 1, 0); PG8_SCHED; PG8_LDA(At, 1, 0); PG8_STAGE(PG8_SA(0, 1), a2 + hstep, voffA);
            PG8_WAIT_L(8); PG8_BAR; PG8_WAIT_L(0); PG8_MMA(0, 0, At, B0); PG8_BAR; PG8_SCHED;
            PG8_LDB(B1, 1, 1); PG8_STAGE(PG8_SB(1, 0), b3, voffB);
            PG8_BAR; PG8_WAIT_L(0); PG8_MMA(0, 1, At, B1); PG8_BAR;
            PG8_LDA(At, 1, 1); PG8_STAGE(PG8_SA(1, 0), a3, voffA);
            PG8_BAR; PG8_WAIT_L(0); PG8_MMA(1, 0, At, B0); PG8_BAR; PG8_SCHED;
            PG8_STAGE(PG8_SB(1, 1), b3 + hstep, voffB);
            PG8_WAIT_V(6); PG8_BAR; PG8_MMA(1, 1, At, B1); PG8_BAR;
            }
        }
        if constexpr (ALIGN_EPI) { if (wr == 0) PG8_BAR; }
        if constexpr (!Epi::AFTER_DRAIN) { E(acc, cur, wr, wc, fr, fq); S.done(cur); }
        if (!has_next) break;
#pragma unroll
        for (int a = 0; a < 2; ++a)
#pragma unroll
            for (int b = 0; b < 2; ++b)
#pragma unroll
                for (int m = 0; m < 4; ++m)
#pragma unroll
                    for (int n = 0; n < 2; ++n) acc[a][b][m][n] = (f32x4){0.f, 0.f, 0.f, 0.f};
        cur = nxt; cA = nA; cB = nB; ++ui;
        if constexpr (ALIGN_EPI) { if (wr == 1) PG8_BAR; }
    }
    PG8_WAIT_V(0);
    if constexpr (!ALIGN_EPI) { if (wr == 0) PG8_BAR; }
    PG8_BAR;
    if constexpr (Epi::AFTER_DRAIN) { E.fused(acc, cur, wr, wc, fr, fq, lds, wid, lane); S.done(cur); }
#undef PG8_SA
#undef PG8_SB
#undef PG8_STAGE
#undef PG8_LDA
#undef PG8_LDB
#undef PG8_MMA
#undef PG8_WAIT_V
#undef PG8_WAIT_L
#undef PG8_BAR
#undef PG8_SCHED
}
}

#define LAS __attribute__((address_space(3)))
typedef unsigned short bf16_t;
typedef short bf16x8 __attribute__((ext_vector_type(8)));
typedef short s16x4 __attribute__((ext_vector_type(4)));
typedef float f32x4 __attribute__((ext_vector_type(4)));
typedef float f32x2 __attribute__((ext_vector_type(2)));
typedef float f32x16 __attribute__((ext_vector_type(16)));
typedef unsigned u32x4 __attribute__((ext_vector_type(4)));
typedef unsigned u32x2 __attribute__((ext_vector_type(2)));

#ifndef DUP_ATTN
#define DUP_ATTN 1
#endif
#ifndef DUP_LRU
#define DUP_LRU 1
#endif
#ifndef DUP_CONV
#define DUP_CONV 1
#endif
#ifndef DUP_GIN
#define DUP_GIN 1
#endif
#ifndef DUP_NORM
#define DUP_NORM 1
#endif
#ifndef DUP_PRO
#define DUP_PRO 1
#endif
#ifndef DUP_GOUT0
#define DUP_GOUT0 1
#endif
#ifndef DUP_LRUBC
#define DUP_LRUBC 1
#endif
#ifndef DUP_ATTEPI
#define DUP_ATTEPI 1
#endif
#ifndef DUP_SYNC
#define DUP_SYNC 1
#endif
#ifndef CTX_SMALL
#define CTX_SMALL 1
#endif
constexpr int NTHREADS = 512, NWAVES = 8;
constexpr int DM = 1024, NB = 8, SEQ = 2048, CTX = 256;
constexpr int ML = NB * SEQ, MC = NB * CTX, MT = ML + MC;
constexpr float EPS = 1e-6f, LOG2E = 1.4426950408889634f;
constexpr int LDS_BYTES = 147456;

constexpr size_t MiB = 1u << 20;
constexpr size_t WS_MODP = 1 * MiB;
constexpr size_t WS_GATE = 5 * MiB;
constexpr size_t WS_ROPE = 5 * MiB + 512 * 1024;
constexpr size_t WS_GW = 6 * MiB;
constexpr size_t WS_WIN[4] = {8 * MiB, 15 * MiB, 21 * MiB, 31 * MiB};
constexpr size_t WS_WOUT[4] = {13 * MiB, 19 * MiB, 29 * MiB, 36 * MiB};
constexpr size_t WS_XC = 38 * MiB;
constexpr size_t WS_XN = 46 * MiB;
constexpr size_t WS_ACT = 82 * MiB;
constexpr size_t WS_HF = 154 * MiB;
constexpr size_t WS_END = 226 * MiB;

struct Args { const float* in[36]; float* out; unsigned char* ws; };

#define LBAR() do { asm volatile("s_waitcnt lgkmcnt(0)" ::: "memory"); __builtin_amdgcn_s_barrier(); asm volatile("" ::: "memory"); } while (0)

__device__ __forceinline__ unsigned f2bf(float f) { unsigned u = __builtin_bit_cast(unsigned, f); return (u + 0x7fffu + ((u >> 16) & 1u)) >> 16; }
__device__ __forceinline__ unsigned pk2(float lo, float hi) { return pg8::cvt_pk_bf16(lo, hi); }
__device__ __forceinline__ float bflo(unsigned w) { return __builtin_bit_cast(float, w << 16); }
__device__ __forceinline__ float bfhi(unsigned w) { return __builtin_bit_cast(float, w & 0xffff0000u); }
__device__ __forceinline__ unsigned char* ows(unsigned char* p) { unsigned long long v = (unsigned long long)p; asm volatile("" : "+s"(v)); return (unsigned char*)(__attribute__((address_space(1))) unsigned char*)v; }
__device__ __forceinline__ int otid(int wv) { int t = wv * 64 + (int)__builtin_amdgcn_mbcnt_hi(~0u, __builtin_amdgcn_mbcnt_lo(~0u, 0u)); asm volatile("" : "+v"(t)); return t; }
__device__ __forceinline__ float wave_sum(float v) {
#pragma unroll
    for (int o = 1; o < 64; o <<= 1) v += __shfl_xor(v, o);
    return v;
}
using pg8::silu_f;

__device__ __forceinline__ void transpose_item(const float* W, int K, int N, bf16_t* WT, LAS float* scr, int item, int lane) {
    const int nblk = N / 32, kb = item / nblk, nb = item % nblk, k0 = 64 * kb, n0 = 32 * nb;
    float tv[32];
#pragma unroll
    for (int i = 0; i < 32; ++i) tv[i] = __builtin_nontemporal_load(W + (size_t)(k0 + 2 * i + (lane >> 5)) * N + n0 + (lane & 31));
#pragma unroll
    for (int i = 0; i < 32; ++i) scr[(2 * i + (lane >> 5)) * 33 + (lane & 31)] = tv[i];
    asm volatile("s_waitcnt lgkmcnt(0)" ::: "memory");
    const int c = lane & 7;
#pragma unroll
    for (int j = 0; j < 4; ++j) { const int n = (lane >> 3) + 8 * j; const LAS float* s = scr + (8 * c) * 33 + n;
        u32x4 o; o.x = pk2(s[0 * 33], s[1 * 33]); o.y = pk2(s[2 * 33], s[3 * 33]); o.z = pk2(s[4 * 33], s[5 * 33]); o.w = pk2(s[6 * 33], s[7 * 33]);
        *(u32x4*)(WT + (size_t)(n0 + n) * K + k0 + 8 * c) = o; }
    asm volatile("s_waitcnt lgkmcnt(0)" ::: "memory");
}

__device__ __forceinline__ void phase_prep(const Args& A, LAS unsigned char* L, int layer, int vbid, int vG, const int wv) {
    const int tid = otid(wv), lane = tid & 63, wave = tid >> 6;
    unsigned char* ws = A.ws;
    const float* Wm = (layer == 0 ? A.in[5] : layer == 1 ? A.in[11] : layer == 2 ? A.in[23] : A.in[30]);
    for (int task = vbid; task < 48; task += vG) {
        const int cc = task >> 3, kc = task & 7;
        const int col = cc * 512 + tid;
        const float* wp = Wm + (size_t)(kc * 128) * 3072 + col;
        float wv_[128];
#pragma unroll
        for (int kk = 0; kk < 128; ++kk) wv_[kk] = __builtin_nontemporal_load(wp + (size_t)kk * 3072);
        LAS float* s = (LAS float*)L;
        for (int idx = tid; idx < 9 * 128; idx += NTHREADS) { const int r = idx >> 7, kk = idx & 127;
            const float v = (r < 8) ? A.in[1][r * DM + kc * 128 + kk] : A.in[3][kc * 128 + kk];
            s[idx] = v / (1.0f + __expf(-v)); }
        LBAR();
        float acc[9];
#pragma unroll
        for (int r = 0; r < 9; ++r) acc[r] = 0.f;
#pragma unroll
        for (int kk = 0; kk < 128; ++kk) { const float w = wv_[kk];
#pragma unroll
            for (int r = 0; r < 9; ++r) acc[r] += s[r * 128 + kk] * w; }
        float* mp = (float*)(ws + WS_MODP) + (size_t)((layer * 8 + kc) * 9) * 3072 + col;
#pragma unroll
        for (int r = 0; r < 9; ++r) mp[(size_t)r * 3072] = acc[r];
        LBAR();
    }
    if (layer == 0 && vbid == vG - 1) {
        float* rt = (float*)(ws + WS_ROPE);
        for (int idx = tid; idx < 1024; idx += NTHREADS) { const int p = idx >> 4, j = idx & 15;
            const float inv = 1.0f / __builtin_powf(10000.0f, (float)j * (1.0f / 16.0f));
            const float ang = (float)p * inv; float t = ang * 0.15915494309189535f; t -= __builtin_rintf(t);
            rt[idx * 2] = __builtin_amdgcn_cosf(t); rt[idx * 2 + 1] = __builtin_amdgcn_sinf(t); }
    }
    LAS float* scr = (LAS float*)(L + wave * 16384);
    const int rb = (vbid + vG - (48 % vG)) % vG;
    const int gw = rb * NWAVES + wave, NGW = vG * NWAVES;
    const int Nin = (layer == 0 || layer == 3) ? 2560 : (layer == 1 ? 2048 : 4096);
    const float* win = (layer == 0 ? A.in[7] : layer == 1 ? A.in[13] : layer == 2 ? A.in[25] : A.in[32]);
    const float* wout = (layer == 0 ? A.in[8] : layer == 1 ? A.in[14] : layer == 2 ? A.in[26] : A.in[33]);
    bf16_t* wint = (bf16_t*)(ws + (layer == 0 ? WS_WIN[0] : layer == 1 ? WS_WIN[1] : layer == 2 ? WS_WIN[2] : WS_WIN[3]));
    bf16_t* woutt = (bf16_t*)(ws + (layer == 0 ? WS_WOUT[0] : layer == 1 ? WS_WOUT[1] : layer == 2 ? WS_WOUT[2] : WS_WOUT[3]));
    const int IIN = 16 * (Nin / 32), IO = 16 * 32, IGW = layer == 0 ? 64 * 2 : 0;
    const int nitems = IIN + IO + IGW;
    for (int it = gw; it < nitems; it += NGW) {
        int r = it;
        if (r < IIN) { transpose_item(win, 1024, Nin, wint, scr, r, lane); continue; } r -= IIN;
        if (r < IO) { transpose_item(wout, 1024, 1024, woutt, scr, r, lane); continue; } r -= IO;
        { const int blk = r >> 1, sub = r & 1;
          const int dir = blk >> 5, gate = (blk >> 4) & 1, h = blk & 15;
          const float* src = (gate == 0 ? A.in[17] : A.in[19]) + (size_t)(dir * 16 + h) * 4096;
          transpose_item(src, 64, 64, (bf16_t*)(ws + WS_GW) + (size_t)blk * 4096, scr, sub, lane); }
    }
}

template <int NR> __device__ __forceinline__ void norm_load(const float* const (&xrow)[NR], f32x4 (&v)[NR][4], int lane) {
#pragma unroll
    for (int i = 0; i < NR; ++i) { const f32x4* xr = (const f32x4*)xrow[i] + lane;
#pragma unroll
        for (int j = 0; j < 4; ++j) v[i][j] = __builtin_nontemporal_load(xr + 64 * j); }
}
template <int NR> __device__ __forceinline__ void norm_proc(const f32x4 (&v)[NR][4], bf16_t* const (&orow)[NR], const LAS float* const (&gs)[NR], const LAS float* const (&sh)[NR], int lane) {
    float s[NR];
#pragma unroll
    for (int i = 0; i < NR; ++i) { float a = 0.f;
#pragma unroll
        for (int j = 0; j < 4; ++j) a += (v[i][j].x * v[i][j].x + v[i][j].y * v[i][j].y) + (v[i][j].z * v[i][j].z + v[i][j].w * v[i][j].w);
        s[i] = a; }
#pragma unroll
    for (int o = 1; o < 64; o <<= 1) {
#pragma unroll
        for (int i = 0; i < NR; ++i) s[i] += __shfl_xor(s[i], o); }
#pragma unroll
    for (int i = 0; i < NR; ++i) { const float rstd = 1.0f / sqrtf(s[i] * (1.0f / DM) + EPS); u32x2* o8 = (u32x2*)orow[i] + lane;
#pragma unroll
        for (int j = 0; j < 4; ++j) { const f32x4 g = *(const LAS f32x4*)(gs[i] + 256 * j + 4 * lane), b = *(const LAS f32x4*)(sh[i] + 256 * j + 4 * lane);
            const f32x4 y = v[i][j] * rstd * g + b; u32x2 w; w.x = pk2(y.x, y.y); w.y = pk2(y.z, y.w); o8[64 * j] = w; } }
}
__device__ __forceinline__ void phase_norm(const Args& A, int layer, const float* xL, const float* xC, LAS unsigned char* L, const int wv) {
    const int tid = otid(wv), lane = tid & 63, wave = tid >> 6, bid = blockIdx.x, G = gridDim.x;
    const float* norm_g = (layer == 0 ? A.in[4] : layer == 1 ? A.in[10] : layer == 2 ? A.in[22] : A.in[29]);
    const float* mod_b = (layer == 0 ? A.in[6] : layer == 1 ? A.in[12] : layer == 2 ? A.in[24] : A.in[31]);
    unsigned char* ws = ows(A.ws);
    const float* modp = (const float*)(ws + WS_MODP) + (size_t)(layer * 8) * 9 * 3072;
    bf16_t* XN = (bf16_t*)(ws + WS_XN);
    LAS float* tab = (LAS float*)L;
    for (int vb = bid; vb < 256; vb += G) {
        const int batch = vb >> 5;
        const float* xr[3][3]; bf16_t* orow[3][3]; const LAS float* gs[3][3]; const LAS float* sh[3][3];
#pragma unroll
          for (int bt = 0; bt < 3; ++bt)
#pragma unroll
            for (int i = 0; i < 3; ++i) { const int ri = bt * 3 + i;
                if (ri < 8) { const int row = vb * 64 + wave * 8 + ri; xr[bt][i] = xL + (size_t)row * DM; orow[bt][i] = XN + (size_t)row * DM; gs[bt][i] = tab; sh[bt][i] = tab + 1024; }
                else { const int row = vb * 8 + wave; xr[bt][i] = xC + (size_t)row * DM; orow[bt][i] = XN + (size_t)(ML + row) * DM; gs[bt][i] = tab + 2048; sh[bt][i] = tab + 3072; } }
          f32x4 va[3][4], vbb[3][4];
          norm_load<3>(xr[0], va, lane);
        { float bv[8], pv[8][8], gn[8];
#pragma unroll
          for (int i8 = 0; i8 < 8; ++i8) { const int idx = tid + i8 * NTHREADS; const int which = idx >> 10, col = idx & 1023; const int r = (which < 2) ? batch : 8; const int mcol = (which & 1) ? col : 1024 + col;
              bv[i8] = mod_b[mcol];
#pragma unroll
              for (int kc = 0; kc < 8; ++kc) pv[i8][kc] = modp[(size_t)(kc * 9 + r) * 3072 + mcol];
              gn[i8] = (which & 1) ? 0.f : norm_g[col]; }
#pragma unroll
          for (int i8 = 0; i8 < 8; ++i8) { const int idx = tid + i8 * NTHREADS; const int which = idx >> 10;
              float v = bv[i8];
#pragma unroll
              for (int kc = 0; kc < 8; ++kc) v += pv[i8][kc];
              if (!(which & 1)) v = gn[i8] * (1.0f + v);
              tab[idx] = v; } }
        if (vb < 9) { float* gf = (float*)(ws + WS_GATE) + (size_t)(layer * 9 + vb) * 1024;
            float gb[2], gp[2][8];
#pragma unroll
            for (int c2 = 0; c2 < 2; ++c2) { const int col = tid + c2 * NTHREADS; gb[c2] = mod_b[2048 + col];
#pragma unroll
                for (int kc = 0; kc < 8; ++kc) gp[c2][kc] = modp[(size_t)(kc * 9 + vb) * 3072 + 2048 + col]; }
#pragma unroll
            for (int c2 = 0; c2 < 2; ++c2) { float v = gb[c2];
#pragma unroll
                for (int kc = 0; kc < 8; ++kc) v += gp[c2][kc];
                gf[tid + c2 * NTHREADS] = v; } }
        norm_load<3>(xr[1], vbb, lane);
        LBAR();
        {
          norm_proc<3>(va, orow[0], gs[0], sh[0], lane);
          norm_load<3>(xr[2], va, lane);
          norm_proc<3>(vbb, orow[1], gs[1], sh[1], lane);
          norm_proc<3>(va, orow[2], gs[2], sh[2], lane); }
        LBAR();
    }
}

#define MFMA32(a, b, c) __builtin_amdgcn_mfma_f32_32x32x16_bf16((a), (b), (c), 0, 0, 0)
#define MFMA16(a, b, c) __builtin_amdgcn_mfma_f32_16x16x32_bf16((a), (b), (c), 0, 0, 0)
__device__ __forceinline__ int crow(int r, int hi) { return (r & 3) + 8 * (r >> 2) + 4 * hi; }
typedef short v4i16_t __attribute__((ext_vector_type(4)));
__device__ __forceinline__ float max3f(float a, float b, float c) { float r; asm("v_max3_f32 %0, %1, %2, %3" : "=v"(r) : "v"(a), "v"(b), "v"(c)); return r; }
__device__ __forceinline__ s16x4 vtr(LAS const unsigned char* p) { return __builtin_bit_cast(s16x4, __builtin_amdgcn_ds_read_tr16_b64_v4i16((LAS v4i16_t*)p)); }

__device__ __forceinline__ void phase_attn(const bf16_t* ACT, bf16_t* Y, const float* sink, bool need_ctx, LAS unsigned char* L, const int wv) {
    constexpr int LD = 2560, KSTR = 144, TILEB = 64 * KSTR, BUFB = 2 * TILEB;
    const int tid = otid(wv), lane = tid & 63, r32 = lane & 31, hi = lane >> 5, wave = __builtin_amdgcn_readfirstlane(tid >> 6);
    const int g = wave >> 1, half = wave & 1, G = gridDim.x;
    const int skey = tid >> 3, sch = tid & 7;
    const int stoff = skey * KSTR + sch * 16;
    const int koff = r32 * KSTR + hi * 16;
    const int voff = TILEB + (4 * hi + ((lane & 15) >> 2)) * KSTR + (16 * ((lane >> 4) & 1) + 4 * (lane & 3)) * 2;
    const int nunits = need_ctx ? 1152 : 1024;
    for (int u = blockIdx.x; u < nunits; u += G) {
        int b, kvh, qb; bool lat;
        if (u < 1024) { b = u >> 7; kvh = (u >> 5) & 3; qb = u & 31; lat = true; } else { const int e = u - 1024; b = e >> 4; kvh = (e >> 2) & 3; qb = e & 3; lat = false; }
        const int h = kvh * 4 + g;
        const int qpos = qb * 64 + half * 32 + r32;
        const int qrow = lat ? b * SEQ + qpos : ML + b * CTX + qpos;
        int tlo = 4, thi = 4;
        if (lat) { tlo = qb == 0 ? 6 : (qb == 1 ? 5 : 4); thi = qb == 31 ? 7 : (qb == 30 ? 8 : 9); }
        const int n = 4 + (thi - tlo);
        const int kp_base = qb * 64 - 128;
        bf16x8 qf[4];
        { const bf16_t* qp = ACT + (size_t)qrow * LD + h * 64 + hi * 8;
#pragma unroll
          for (int d0 = 0; d0 < 4; ++d0) qf[d0] = *(const bf16x8*)(qp + d0 * 16); }
        float m_run = sink[h] * LOG2E, l_run = hi ? 0.f : 1.f;
        f32x16 o0, o1;
#pragma unroll
        for (int r = 0; r < 16; ++r) { o0[r] = 0.f; o1[r] = 0.f; }
        const size_t kcol = 1024 + kvh * 64 + sch * 8, vcol = 1280 + kvh * 64 + sch * 8;
#define ATT_TROW(s_) (((s_) < 4 ? ML + b * CTX + (s_) * 64 : b * SEQ + kp_base + (tlo + (s_) - 8) * 64) + skey)
        u32x4 kq0, vq0, kq1, vq1, kq2, vq2;
        { const size_t krow = (size_t)ATT_TROW(0); kq0 = *(const u32x4*)(ACT + krow * LD + kcol); vq0 = *(const u32x4*)(ACT + krow * LD + vcol); }
        { const size_t krow = (size_t)ATT_TROW(1); kq1 = *(const u32x4*)(ACT + krow * LD + kcol); vq1 = *(const u32x4*)(ACT + krow * LD + vcol); }
        { const size_t krow = (size_t)ATT_TROW(2); kq2 = *(const u32x4*)(ACT + krow * LD + kcol); vq2 = *(const u32x4*)(ACT + krow * LD + vcol); }
        LBAR();
        *(LAS u32x4*)(L + stoff) = kq0; *(LAS u32x4*)(L + TILEB + stoff) = vq0;
        { const size_t krow = (size_t)ATT_TROW(3); kq0 = *(const u32x4*)(ACT + krow * LD + kcol); vq0 = *(const u32x4*)(ACT + krow * LD + vcol); }
        LBAR();
#define ATT_STEP(s_, KQ, VQ) do { const int s = (s_); \
            const int t = s < 4 ? s : tlo + (s - 4); \
            LAS const unsigned char* B = L + (s & 1) * BUFB; \
 \
              \
            bf16x8 kf[8]; s16x4 vl[8], vh[8]; \
_Pragma("unroll") \
            for (int d0 = 0; d0 < 4; ++d0) { kf[2 * d0] = *(const LAS bf16x8*)(B + koff + d0 * 32); kf[2 * d0 + 1] = *(const LAS bf16x8*)(B + koff + 32 * KSTR + d0 * 32); } \
_Pragma("unroll") \
            for (int i = 0; i < 4; ++i) { LAS const unsigned char* vp = B + voff + i * 16 * KSTR; vl[2 * i] = vtr(vp); vh[2 * i] = vtr(vp + 8 * KSTR); vl[2 * i + 1] = vtr(vp + 64); vh[2 * i + 1] = vtr(vp + 8 * KSTR + 64); } \
            __builtin_amdgcn_sched_barrier(0); \
            f32x16 p0, p1; \
_Pragma("unroll") \
            for (int r = 0; r < 16; ++r) { p0[r] = 0.f; p1[r] = 0.f; } \
_Pragma("unroll") \
            for (int d0 = 0; d0 < 4; ++d0) { p0 = MFMA32(kf[2 * d0], qf[d0], p0); p1 = MFMA32(kf[2 * d0 + 1], qf[d0], p1); } \
            if (t == 4 || t == 8) { const int kp0 = kp_base + (t - 4) * 64 - qpos; \
_Pragma("unroll") \
                for (int r = 0; r < 16; ++r) { const int d0 = kp0 + crow(r, hi), d1 = d0 + 32; \
                    if (d0 > 128 || d0 < -128) p0[r] = -1e30f; if (d1 > 128 || d1 < -128) p1[r] = -1e30f; } } \
            float mt = max3f(p0[0], p0[1], p1[0]), mt2 = max3f(p0[2], p0[3], p1[1]); mt = max3f(mt, p1[2], p1[3]); \
_Pragma("unroll") \
            for (int r = 4; r < 16; r += 4) { mt = max3f(mt, p0[r], p0[r + 1]); mt2 = max3f(mt2, p0[r + 2], p0[r + 3]); mt = max3f(mt, p1[r], p1[r + 1]); mt2 = max3f(mt2, p1[r + 2], p1[r + 3]); } \
            mt = fmaxf(mt, mt2); \
            mt = fmaxf(mt, __shfl_xor(mt, 32)) - m_run; \
 \
            float dl = 0.f; \
            if (s == 0) dl = fmaxf(mt, 0.f); else if (mt > 8.0f) dl = mt; \
            if (__any(dl != 0.f)) { const float alpha = __builtin_amdgcn_exp2f(-dl); m_run += dl; l_run *= alpha; \
_Pragma("unroll") \
                for (int r = 0; r < 16; ++r) { o0[r] *= alpha; o1[r] *= alpha; } } \
            float ls = 0.f, ls2 = 0.f; \
_Pragma("unroll") \
            for (int r = 0; r < 16; ++r) { p0[r] = __builtin_amdgcn_exp2f(p0[r] - m_run); p1[r] = __builtin_amdgcn_exp2f(p1[r] - m_run); ls += p0[r]; ls2 += p1[r]; } \
            ls += ls2; \
            l_run += ls; \
            bf16x8 pb[2][2]; \
_Pragma("unroll") \
            for (int j = 0; j < 2; ++j) { \
                u32x4 w0, w1; \
                w0.x = pk2(p0[8 * j + 0], p0[8 * j + 1]); w0.y = pk2(p0[8 * j + 2], p0[8 * j + 3]); w0.z = pk2(p0[8 * j + 4], p0[8 * j + 5]); w0.w = pk2(p0[8 * j + 6], p0[8 * j + 7]); \
                w1.x = pk2(p1[8 * j + 0], p1[8 * j + 1]); w1.y = pk2(p1[8 * j + 2], p1[8 * j + 3]); w1.z = pk2(p1[8 * j + 4], p1[8 * j + 5]); w1.w = pk2(p1[8 * j + 6], p1[8 * j + 7]); \
                pb[0][j] = __builtin_bit_cast(bf16x8, w0); pb[1][j] = __builtin_bit_cast(bf16x8, w1); \
            } \
 \
_Pragma("unroll") \
            for (int kb = 0; kb < 2; ++kb) \
_Pragma("unroll") \
                for (int j = 0; j < 2; ++j) { const int i = kb * 2 + j; \
                    const bf16x8 a0 = __builtin_shufflevector(vl[2 * i], vh[2 * i], 0, 1, 2, 3, 4, 5, 6, 7), a1 = __builtin_shufflevector(vl[2 * i + 1], vh[2 * i + 1], 0, 1, 2, 3, 4, 5, 6, 7); \
                    o0 = MFMA32(a0, pb[kb][j], o0); o1 = MFMA32(a1, pb[kb][j], o1); \
                } \
            if (s + 1 < n) { LAS unsigned char* Bn = L + ((s + 1) & 1) * BUFB; *(LAS u32x4*)(Bn + stoff) = KQ; *(LAS u32x4*)(Bn + TILEB + stoff) = VQ; } \
            LBAR(); \
            if (s + 4 < n) { const size_t krow = (size_t)ATT_TROW(s + 4); KQ = *(const u32x4*)(ACT + krow * LD + kcol); VQ = *(const u32x4*)(ACT + krow * LD + vcol); } \
        } while (0)
#pragma unroll 1
        for (int s0 = 0; s0 < n; s0 += 3) {
            ATT_STEP(s0, kq1, vq1);
            if (s0 + 1 < n) ATT_STEP(s0 + 1, kq2, vq2);
            if (s0 + 2 < n) ATT_STEP(s0 + 2, kq0, vq0);
        }
#undef ATT_STEP
#undef ATT_TROW
        u32x4 sgq[4];
        { const int qrow0 = qrow - r32;
#pragma unroll
          for (int it = 0; it < 4; ++it) sgq[it] = *(const u32x4*)(ACT + (size_t)(qrow0 + it * 8 + (lane >> 3)) * LD + 1536 + h * 64 + (lane & 7) * 8); }
        const float lt = l_run + __shfl_xor(l_run, 32); const float inv = 1.0f / lt;
        LAS float* stg = (LAS float*)(L + 40960 + wave * 8704);
#pragma unroll
        for (int db = 0; db < 2; ++db)
#pragma unroll
            for (int q4 = 0; q4 < 4; ++q4) { const int d = 32 * db + 8 * q4 + 4 * hi; f32x4 v;
                if (db == 0) v = (f32x4){o0[4 * q4], o0[4 * q4 + 1], o0[4 * q4 + 2], o0[4 * q4 + 3]}; else v = (f32x4){o1[4 * q4], o1[4 * q4 + 1], o1[4 * q4 + 2], o1[4 * q4 + 3]};
                *(LAS f32x4*)(stg + r32 * 68 + d) = v * inv; }
        asm volatile("s_waitcnt lgkmcnt(0)" ::: "memory");
        { const int qrow0 = qrow - r32; const int er = lane >> 3, ec = (lane & 7) * 8;
#pragma unroll
          for (int it = 0; it < 4; ++it) { const int row = it * 8 + er; const size_t grow = (size_t)(qrow0 + row);
              const f32x4 a0 = *(const LAS f32x4*)(stg + row * 68 + ec), a1 = *(const LAS f32x4*)(stg + row * 68 + ec + 4);
              const u32x4 gw = sgq[it];
              u32x4 w; w.x = pk2(a0.x * bflo(gw.x), a0.y * bfhi(gw.x)); w.y = pk2(a0.z * bflo(gw.y), a0.w * bfhi(gw.y)); w.z = pk2(a1.x * bflo(gw.z), a1.y * bfhi(gw.z)); w.w = pk2(a1.z * bflo(gw.w), a1.w * bfhi(gw.w));
              *(u32x4*)(Y + grow * DM + h * 64 + ec) = w; } }
    }
    LBAR();
}

__device__ __forceinline__ void phase_lru(const Args& A, const bf16_t* ACT, bf16_t* Y, float* HF, LAS unsigned char* L, const int wv) {
    constexpr int LD = 2048, TT = 128, USTR = 144;
    const int tid = otid(wv), lane = tid & 63, wave = __builtin_amdgcn_readfirstlane(tid >> 6), G = gridDim.x;
    LAS unsigned char* UL = L;
    LAS unsigned char* XA = L + 19200;
    LAS float* XF = (LAS float*)(L + 19200 + 18432);
    LAS f32x2* AB = (LAS f32x2*)(L + 19200 + 18432 + 18432);
    LAS f32x2* CAR = (LAS f32x2*)(L + 19200 + 18432 + 18432 + 34816);
    LAS float* ST = (LAS float*)(L + 19200 + 18432 + 18432 + 34816 + 4096);
    LAS float* CW = (LAS float*)(L + 19200 + 18432 + 18432 + 34816 + 4096 + 256);
    const bf16_t* gwT = (const bf16_t*)(ows(A.ws) + WS_GW);
    const float* conv_w = A.in[15]; const float* conv_b = A.in[16]; const float* ba = A.in[18]; const float* bx = A.in[20]; const float* lam = A.in[21];
    const int fr = lane & 15, fq = lane >> 4;
    const int stok = tid >> 3, sch = tid & 7;
    const int ch = tid & 31, sc = tid >> 5;
    const int otok = tid >> 2, oq = tid & 3;
    for (int u = blockIdx.x; u < 256; u += G) {
        const int b = u >> 5, hb = u & 31, hblk = hb >> 1, half = hb & 1, cin0 = hblk * 64, c0 = cin0 + half * 32;
#pragma unroll 1
        for (int dir = 0; dir < 2; ++dir) {
            LBAR();
            if (tid < 320) { const int k = tid >> 6, c = tid & 63; CW[tid] = (k < 4) ? conv_w[(size_t)(dir * 4 + k) * DM + cin0 + c] : conv_b[(size_t)dir * DM + cin0 + c]; }
            const int cbk = wave & 1;
            bf16x8 wr_[2], wi_[2];
            { const bf16_t* pr = gwT + ((size_t)((dir * 2 + 0) * 16 + hblk) * 64 + half * 32 + cbk * 16 + fr) * 64 + fq * 8;
              const bf16_t* pi = gwT + ((size_t)((dir * 2 + 1) * 16 + hblk) * 64 + half * 32 + cbk * 16 + fr) * 64 + fq * 8;
              wr_[0] = *(const bf16x8*)pr; wr_[1] = *(const bf16x8*)(pr + 32); wi_[0] = *(const bf16x8*)pi; wi_[1] = *(const bf16x8*)(pi + 32); }
            float eba[4], ebx[4], esp[4];
#pragma unroll
            for (int e = 0; e < 4; ++e) { const int c = dir * DM + c0 + cbk * 16 + 4 * fq + e; eba[e] = ba[c]; ebx[e] = bx[c];
                const float nl = -lam[c]; esp[e] = (fmaxf(nl, 0.f) + log1pf(__expf(-fabsf(nl)))) * (-8.0f * LOG2E); }
            if (tid < 32) ST[tid] = 0.f;
            u32x4 ur[2], uh = (u32x4){0u, 0u, 0u, 0u};
            { const int rowbase = ML + b * CTX;
#pragma unroll
              for (int i2 = 0; i2 < 2; ++i2) { const int S = stok + 64 * i2; const int row = rowbase + (dir ? CTX - 1 - S : S); ur[i2] = *(const u32x4*)(ACT + (size_t)row * LD + cin0 + sch * 8); } }
            f32x4 hf0 = (f32x4){0.f, 0.f, 0.f, 0.f}, hf1 = hf0; u32x4 gv = (u32x4){0u, 0u, 0u, 0u}; size_t orow = 0; int oseq = 0;
#define LRU_OUT() do { const f32x4 h0 = *(const LAS f32x4*)(XF + otok * 36 + oq * 8), h1 = *(const LAS f32x4*)(XF + otok * 36 + oq * 8 + 4); \
                if (dir == 0) { f32x4* hp = (f32x4*)(HF + ((size_t)u * 2304 + oseq) * 32 + oq * 8); hp[0] = h0; hp[1] = h1; } \
                else { const f32x4 s0 = h0 + hf0, s1 = h1 + hf1; u32x4 w; \
                    w.x = pk2(s0.x * bflo(gv.x), s0.y * bfhi(gv.x)); w.y = pk2(s0.z * bflo(gv.y), s0.w * bfhi(gv.y)); w.z = pk2(s1.x * bflo(gv.z), s1.y * bfhi(gv.z)); w.w = pk2(s1.z * bflo(gv.w), s1.w * bfhi(gv.w)); \
                    *(u32x4*)(Y + orow * DM + c0 + oq * 8) = w; } } while (0)
#pragma unroll 1
            for (int tl = 0; tl < 18; ++tl) {
                const int seg = tl < 2 ? 0 : 1, S0 = seg ? (tl - 2) * TT : tl * TT, seglen = seg ? SEQ : CTX, rowbase = seg ? b * SEQ : ML + b * CTX;
                LBAR();
                *(LAS u32x4*)(UL + (3 + stok) * USTR + sch * 16) = ur[0]; *(LAS u32x4*)(UL + (3 + 64 + stok) * USTR + sch * 16) = ur[1];
                if (tid < 24) *(LAS u32x4*)(UL + stok * USTR + sch * 16) = uh;
                if (tl > 0) LRU_OUT();
                LBAR();
                { const int S = S0 + otok; const int pos = dir ? seglen - 1 - S : S; orow = (size_t)(rowbase + pos); oseq = seg ? CTX + pos : pos;
                  if (dir == 1) { const f32x4* hp = (const f32x4*)(HF + ((size_t)u * 2304 + oseq) * 32 + oq * 8); hf0 = hp[0]; hf1 = hp[1]; gv = *(const u32x4*)(ACT + orow * LD + 1024 + c0 + oq * 8); } }
                if (tl + 1 < 18) { const int tn = tl + 1; const int seg2 = tn < 2 ? 0 : 1, S02 = seg2 ? (tn - 2) * TT : tn * TT, seglen2 = seg2 ? SEQ : CTX, rowbase2 = seg2 ? b * SEQ : ML + b * CTX;
#pragma unroll
                    for (int i2 = 0; i2 < 2; ++i2) { const int S = S02 + stok + 64 * i2; const int row = rowbase2 + (dir ? seglen2 - 1 - S : S); ur[i2] = *(const u32x4*)(ACT + (size_t)row * LD + cin0 + sch * 8); }
                    uh = (u32x4){0u, 0u, 0u, 0u};
                    if (tid < 24 && S02 > 0) { const int S = S02 - 3 + stok; const int row = rowbase2 + (dir ? seglen2 - 1 - S : S); uh = *(const u32x4*)(ACT + (size_t)row * LD + cin0 + sch * 8); } }
                for (int rep_ = 0; rep_ < DUP_LRUBC; ++rep_) {
                { float x0[8], x1[8];
                  { const f32x4 ca = *(const LAS f32x4*)(CW + 256 + sch * 8), cc = *(const LAS f32x4*)(CW + 256 + sch * 8 + 4);
                    x0[0] = ca.x; x0[1] = ca.y; x0[2] = ca.z; x0[3] = ca.w; x0[4] = cc.x; x0[5] = cc.y; x0[6] = cc.z; x0[7] = cc.w;
#pragma unroll
                    for (int e = 0; e < 8; ++e) x1[e] = x0[e]; }
#pragma unroll
                  for (int k = 0; k < 4; ++k) { const f32x4 wa = *(const LAS f32x4*)(CW + k * 64 + sch * 8), wb = *(const LAS f32x4*)(CW + k * 64 + sch * 8 + 4);
                      const u32x4 u0 = *(const LAS u32x4*)(UL + (stok + k) * USTR + sch * 16), u1 = *(const LAS u32x4*)(UL + (stok + 64 + k) * USTR + sch * 16);
                      x0[0] += wa.x * bflo(u0.x); x0[1] += wa.y * bfhi(u0.x); x0[2] += wa.z * bflo(u0.y); x0[3] += wa.w * bfhi(u0.y);
                      x0[4] += wb.x * bflo(u0.z); x0[5] += wb.y * bfhi(u0.z); x0[6] += wb.z * bflo(u0.w); x0[7] += wb.w * bfhi(u0.w);
                      x1[0] += wa.x * bflo(u1.x); x1[1] += wa.y * bfhi(u1.x); x1[2] += wa.z * bflo(u1.y); x1[3] += wa.w * bfhi(u1.y);
                      x1[4] += wb.x * bflo(u1.z); x1[5] += wb.y * bfhi(u1.z); x1[6] += wb.z * bflo(u1.w); x1[7] += wb.w * bfhi(u1.w); }
                  u32x4 w; w.x = pk2(x0[0], x0[1]); w.y = pk2(x0[2], x0[3]); w.z = pk2(x0[4], x0[5]); w.w = pk2(x0[6], x0[7]);
                  *(LAS u32x4*)(XA + stok * USTR + sch * 16) = w;
                  w.x = pk2(x1[0], x1[1]); w.y = pk2(x1[2], x1[3]); w.z = pk2(x1[4], x1[5]); w.w = pk2(x1[6], x1[7]);
                  *(LAS u32x4*)(XA + (stok + 64) * USTR + sch * 16) = w;
                  if ((sch >> 2) == half) { LAS f32x4* xf = (LAS f32x4*)(XF + stok * 36 + (sch & 3) * 8); xf[0] = (f32x4){x0[0], x0[1], x0[2], x0[3]}; xf[1] = (f32x4){x0[4], x0[5], x0[6], x0[7]};
                      xf = (LAS f32x4*)(XF + (stok + 64) * 36 + (sch & 3) * 8); xf[0] = (f32x4){x1[0], x1[1], x1[2], x1[3]}; xf[1] = (f32x4){x1[4], x1[5], x1[6], x1[7]}; } }
                LBAR();
#pragma unroll
                for (int i2 = 0; i2 < 2; ++i2) { const int tb = (wave >> 1) + 4 * i2; const int tok = tb * 16 + fr;
                    const bf16x8 x0 = *(const LAS bf16x8*)(XA + tok * USTR + fq * 16), x1 = *(const LAS bf16x8*)(XA + tok * USTR + 64 + fq * 16);
                    f32x4 ar = (f32x4){0.f, 0.f, 0.f, 0.f}, ai = (f32x4){0.f, 0.f, 0.f, 0.f};
                    ar = MFMA16(wr_[0], x0, ar); ar = MFMA16(wr_[1], x1, ar); ai = MFMA16(wi_[0], x0, ai); ai = MFMA16(wi_[1], x1, ai);
                    const f32x4 xv = *(const LAS f32x4*)(XF + tok * 36 + cbk * 16 + 4 * fq);
                    float av[4], bv[4];
#pragma unroll
                    for (int e = 0; e < 4; ++e) { const float r = __builtin_amdgcn_rcpf(1.0f + __builtin_amdgcn_exp2f(-(ar[e] + eba[e]) * LOG2E)); const float ig = __builtin_amdgcn_rcpf(1.0f + __builtin_amdgcn_exp2f(-(ai[e] + ebx[e]) * LOG2E));
                        const float a_ = __builtin_amdgcn_exp2f(r * esp[e]); av[e] = a_; bv[e] = __builtin_amdgcn_sqrtf(fmaxf(1.0f - a_ * a_, 0.f)) * (ig * xv[e]); }
                    LAS f32x4* ab = (LAS f32x4*)(AB + tok * 34 + cbk * 16 + 4 * fq); ab[0] = (f32x4){av[0], bv[0], av[1], bv[1]}; ab[1] = (f32x4){av[2], bv[2], av[3], bv[3]}; }
                LBAR();
                }
                float a8[8], b8[8];
                { float Ap = 1.f, H = 0.f;
#pragma unroll
                  for (int k = 0; k < 8; ++k) { const f32x2 v = AB[(sc * 8 + k) * 34 + ch]; a8[k] = v.x; b8[k] = v.y; H = v.x * H + v.y; Ap *= v.x; }
                  CAR[sc * 32 + ch] = (f32x2){Ap, H}; }
                LBAR();
                float hrun = ST[(tl & 1) * 32 + ch];
                { f32x2 cr[15];
#pragma unroll
                  for (int s = 0; s < 15; ++s) cr[s] = CAR[s * 32 + ch];
#pragma unroll
                  for (int s = 0; s < 15; ++s) hrun = (s < sc) ? cr[s].x * hrun + cr[s].y : hrun; }
#pragma unroll
                for (int k = 0; k < 8; ++k) { hrun = a8[k] * hrun + b8[k]; XF[(sc * 8 + k) * 36 + ch] = hrun; }
                if (sc == 15) ST[((tl + 1) & 1) * 32 + ch] = hrun;
            }
            LBAR();
            LRU_OUT();
            asm volatile("s_waitcnt vmcnt(0)" ::: "memory");
        }
        LBAR();
    }
#undef LRU_OUT
}

__device__ __forceinline__ void cu8(const bf16_t* ACT, size_t row, int col, float* o) {
    const u32x4 a = __builtin_nontemporal_load((const u32x4*)(ACT + row * 4096 + col)), c = __builtin_nontemporal_load((const u32x4*)(ACT + row * 4096 + 2048 + col));
    o[0] = bflo(a.x) * bflo(c.x); o[1] = bfhi(a.x) * bfhi(c.x); o[2] = bflo(a.y) * bflo(c.y); o[3] = bfhi(a.y) * bfhi(c.y);
    o[4] = bflo(a.z) * bflo(c.z); o[5] = bfhi(a.z) * bfhi(c.z); o[6] = bflo(a.w) * bflo(c.w); o[7] = bfhi(a.w) * bfhi(c.w);
}
__device__ __forceinline__ void phase_conv(const Args& A, const bf16_t* ACT, bf16_t* Y, const int wv) {
    const float* conv_w = A.in[27]; const float* conv_b = A.in[28];
    const int nitems = (MT / 8) * 128;
    const int tid = otid(wv);
    for (int item = blockIdx.x * NTHREADS + tid; item < nitems; item += gridDim.x * NTHREADS) {
        const int rg = item >> 7, chunk = item & 127, col = chunk * 8, row0 = rg * 8;
        const int seglen = row0 < ML ? SEQ : CTX;
        const bool first = (row0 % seglen) == 0, last = ((row0 + 8) % seglen) == 0;
        float w0[8], w1[8], w2[8], cb[8];
        { const f32x4* p = (const f32x4*)(conv_w + col); f32x4 a = p[0], c = p[1]; w0[0] = a.x; w0[1] = a.y; w0[2] = a.z; w0[3] = a.w; w0[4] = c.x; w0[5] = c.y; w0[6] = c.z; w0[7] = c.w;
          p = (const f32x4*)(conv_w + DM + col); a = p[0]; c = p[1]; w1[0] = a.x; w1[1] = a.y; w1[2] = a.z; w1[3] = a.w; w1[4] = c.x; w1[5] = c.y; w1[6] = c.z; w1[7] = c.w;
          p = (const f32x4*)(conv_w + 2 * DM + col); a = p[0]; c = p[1]; w2[0] = a.x; w2[1] = a.y; w2[2] = a.z; w2[3] = a.w; w2[4] = c.x; w2[5] = c.y; w2[6] = c.z; w2[7] = c.w;
          p = (const f32x4*)(conv_b + col); a = p[0]; c = p[1]; cb[0] = a.x; cb[1] = a.y; cb[2] = a.z; cb[3] = a.w; cb[4] = c.x; cb[5] = c.y; cb[6] = c.z; cb[7] = c.w; }
        float prev[8], cur[8], nxt[8];
        if (first) {
#pragma unroll
            for (int e = 0; e < 8; ++e) prev[e] = 0.f;
        } else cu8(ACT, (size_t)row0 - 1, col, prev);
        cu8(ACT, (size_t)row0, col, cur);
#pragma unroll
        for (int k = 0; k < 8; ++k) {
            const size_t row = (size_t)row0 + k;
            if (k == 7 && last) {
#pragma unroll
                for (int e = 0; e < 8; ++e) nxt[e] = 0.f;
            } else cu8(ACT, row + 1, col, nxt);
            const u32x4 bgw = __builtin_nontemporal_load((const u32x4*)(ACT + row * 4096 + 1024 + col)), sgw = __builtin_nontemporal_load((const u32x4*)(ACT + row * 4096 + 3072 + col));
            float y[8];
#pragma unroll
            for (int e = 0; e < 8; ++e) y[e] = w0[e] * prev[e] + w1[e] * cur[e] + w2[e] * nxt[e] + cb[e];
            y[0] *= bflo(bgw.x) * bflo(sgw.x); y[1] *= bfhi(bgw.x) * bfhi(sgw.x); y[2] *= bflo(bgw.y) * bflo(sgw.y); y[3] *= bfhi(bgw.y) * bfhi(sgw.y);
            y[4] *= bflo(bgw.z) * bflo(sgw.z); y[5] *= bfhi(bgw.z) * bfhi(sgw.z); y[6] *= bflo(bgw.w) * bflo(sgw.w); y[7] *= bfhi(bgw.w) * bfhi(sgw.w);
            u32x4 w; w.x = pk2(y[0], y[1]); w.y = pk2(y[2], y[3]); w.z = pk2(y[4], y[5]); w.w = pk2(y[6], y[7]);
            *(u32x4*)(Y + row * DM + col) = w;
#pragma unroll
            for (int e = 0; e < 8; ++e) { prev[e] = cur[e]; cur[e] = nxt[e]; }
        }
    }
}

__device__ __forceinline__ void phase_ctx_wout(const bf16_t* Yc, const bf16_t* Wt, const float* xin, float* xout, const float* gate, LAS unsigned char* L, const int wv) {
    constexpr int PITCH = 144, ABYTES = 128 * PITCH, BUFB = 192 * PITCH;
    const int tid = otid(wv), lane = tid & 63, r32 = lane & 31, hi = lane >> 5, wave = wv, G = gridDim.x;
    const int srow = tid >> 3, sch = tid & 7;
    const int aoff = ((wave >> 1) * 32 + r32) * PITCH + hi * 64, boff = ABYTES + ((wave & 1) * 32 + r32) * PITCH + hi * 64;
    for (int t = blockIdx.x; t < 256; t += G) {
        const int tm = t >> 4, tn = t & 15;
        const bf16_t* ga0 = Yc + (size_t)(tm * 128 + srow) * DM + sch * 8; const bf16_t* ga1 = ga0 + (size_t)64 * DM; const bf16_t* gb = Wt + (size_t)(tn * 64 + srow) * DM + sch * 8;
        f32x16 acc;
#pragma unroll
        for (int r = 0; r < 16; ++r) acc[r] = 0.f;
        u32x4 qa0[3], qa1[3], qb[3];
#define CTX_LOAD(q, s_) do { qa0[q] = *(const u32x4*)(ga0 + (s_) * 64); qa1[q] = *(const u32x4*)(ga1 + (s_) * 64); qb[q] = *(const u32x4*)(gb + (s_) * 64); } while (0)
#define CTX_WRITE(q, buf) do { LAS unsigned char* Bn = L + (buf) * BUFB; *(LAS u32x4*)(Bn + srow * PITCH + sch * 16) = qa0[q]; *(LAS u32x4*)(Bn + (64 + srow) * PITCH + sch * 16) = qa1[q]; *(LAS u32x4*)(Bn + ABYTES + srow * PITCH + sch * 16) = qb[q]; } while (0)
#define CTX_STEP(s_, q) do { const int s = (s_); LAS const unsigned char* B = L + (s & 1) * BUFB; bf16x8 a[4], b[4]; \
            _Pragma("unroll") for (int j = 0; j < 4; ++j) { a[j] = *(const LAS bf16x8*)(B + aoff + j * 16); b[j] = *(const LAS bf16x8*)(B + boff + j * 16); } \
            _Pragma("unroll") for (int j = 0; j < 4; ++j) acc = MFMA32(a[j], b[j], acc); \
            if (s + 1 < 16) CTX_WRITE(q, (s + 1) & 1); \
            LBAR(); \
            if (s + 4 < 16) CTX_LOAD(q, s + 4); } while (0)
        CTX_LOAD(0, 0); CTX_LOAD(1, 1); CTX_LOAD(2, 2);
        LBAR();
        CTX_WRITE(0, 0);
        CTX_LOAD(0, 3);
        LBAR();
#pragma unroll 1
        for (int s0 = 0; s0 < 16; s0 += 3) {
            CTX_STEP(s0, 1);
            if (s0 + 1 < 16) CTX_STEP(s0 + 1, 2);
            if (s0 + 2 < 16) CTX_STEP(s0 + 2, 0);
        }
#undef CTX_LOAD
#undef CTX_WRITE
#undef CTX_STEP
        const int m0 = tm * 128 + (wave >> 1) * 32, col = tn * 64 + (wave & 1) * 32 + r32; const float gv = gate[col];
        float xv[16];
#pragma unroll
        for (int r = 0; r < 16; ++r) xv[r] = xin[(size_t)(m0 + crow(r, hi)) * DM + col];
#pragma unroll
        for (int r = 0; r < 16; ++r) xout[(size_t)(m0 + crow(r, hi)) * DM + col] = xv[r] + gv * acc[r];
    }
    LBAR();
}

__device__ __forceinline__ void phase_final(float* out, const float* g, const int wv) {
    const int tid = otid(wv); const int lane = tid & 63, gw = blockIdx.x * NWAVES + (tid >> 6), NGW = gridDim.x * NWAVES;
    f32x4 gv[4];
#pragma unroll
    for (int j = 0; j < 4; ++j) gv[j] = *((const f32x4*)g + 64 * j + lane);
    for (int row0 = gw * 4; row0 < ML; row0 += NGW * 4) {
        f32x4 v[4][4]; float s[4];
#pragma unroll
        for (int i = 0; i < 4; ++i) { const f32x4* xr = (const f32x4*)(out + (size_t)(row0 + i) * DM) + lane;
#pragma unroll
            for (int j = 0; j < 4; ++j) v[i][j] = __builtin_nontemporal_load(xr + 64 * j); }
#pragma unroll
        for (int i = 0; i < 4; ++i) { float a = 0.f;
#pragma unroll
            for (int j = 0; j < 4; ++j) a += (v[i][j].x * v[i][j].x + v[i][j].y * v[i][j].y) + (v[i][j].z * v[i][j].z + v[i][j].w * v[i][j].w);
            s[i] = a; }
#pragma unroll
        for (int o = 1; o < 64; o <<= 1) {
#pragma unroll
            for (int i = 0; i < 4; ++i) s[i] += __shfl_xor(s[i], o); }
#pragma unroll
        for (int i = 0; i < 4; ++i) { const float rstd = 1.0f / sqrtf(s[i] * (1.0f / DM) + EPS); f32x4* xr = (f32x4*)(out + (size_t)(row0 + i) * DM) + lane;
#pragma unroll
            for (int j = 0; j < 4; ++j) xr[64 * j] = v[i][j] * rstd * gv[j]; }
    }
}

#define RLX_AGENT __ATOMIC_RELAXED, __HIP_MEMORY_SCOPE_AGENT
#define XB_TMO      128
#define XB_XCNT(j)  (256  + 64 * (j))
#define XB_XSUB(j)  (1280 + 64 * (j))
#define XB_XGEN(j)  (2304 + 64 * (j))
#define XB_TOP      3328
#define XB_TOPGEN   3392
#define XCD_BAR_WORDS 3456
#define XB_SPIN_CAP (1u << 18)

__device__ __forceinline__ unsigned xb_ld(unsigned* p)              { return __hip_atomic_load(p, __ATOMIC_RELAXED, __HIP_MEMORY_SCOPE_AGENT); }
__device__ __forceinline__ unsigned xb_add(unsigned* p, unsigned v) { return __hip_atomic_fetch_add(p, v, __ATOMIC_RELAXED, __HIP_MEMORY_SCOPE_AGENT); }
__device__ __forceinline__ unsigned xb_xcc_id() { return (unsigned)__builtin_amdgcn_s_getreg((3 << 11) | 20) & 0xFu; }
#define XB_SPIN(cond, bar) do { unsigned _sp = 0; while (cond) { __builtin_amdgcn_s_sleep(1); \
    if ((++_sp & 255u) == 0u) { if (xb_ld(&(bar)[XB_TMO])) break; if (_sp > XB_SPIN_CAP) { atomicAdd(&(bar)[XB_TMO], 1u); break; } } } } while (0)

struct XcdBarrier {
    unsigned* bar; unsigned x;
    volatile LAS unsigned* st;
};

__device__ __forceinline__ XcdBarrier xcd_barrier_post(unsigned* bar, volatile LAS unsigned* st) {
    XcdBarrier b; b.bar = bar; b.x = xb_xcc_id(); b.st = st;
    if (threadIdx.x == 0) (void)xb_add(&bar[XB_XCNT(b.x)], 1u);
    return b;
}
__device__ __forceinline__ void xcd_barrier_complete(unsigned* bar, unsigned x, unsigned& nloc, unsigned& nx) {
    const unsigned G = gridDim.x * gridDim.y * gridDim.z;
    unsigned sum, cnt, mine, sp = 0u;
    for (;;) {
        sum = 0u; cnt = 0u; mine = 0u;
#pragma unroll
        for (unsigned j = 0; j < 16; ++j) { const unsigned c = xb_ld(&bar[XB_XCNT(j)]); sum += c; cnt += (c > 0u) ? 1u : 0u; mine = (j == x) ? c : mine; }
        if (sum == G) break;
        __builtin_amdgcn_s_sleep(1);
        if ((++sp & 255u) == 0u) { if (xb_ld(&bar[XB_TMO])) break; if (sp > XB_SPIN_CAP) { atomicAdd(&bar[XB_TMO], 1u); break; } }
    }
    nloc = mine > 0u ? mine : 1u; nx = cnt > 0u ? cnt : 1u;
}

__device__ __forceinline__ void xcd_barrier(const XcdBarrier& b) {
    asm volatile("s_waitcnt vmcnt(0)" ::: "memory");
    __syncthreads();
    if (threadIdx.x == 0) {
        unsigned* bar = b.bar;
        __builtin_amdgcn_s_waitcnt(0);
        unsigned nloc = b.st[0], nx = b.st[1];
        if (nloc == 0u) { xcd_barrier_complete(bar, b.x, nloc, nx); b.st[0] = nloc; b.st[1] = nx; }
        const unsigned old = xb_add(&bar[XB_XSUB(b.x)], 1u);
        const unsigned gen = old / nloc;
        if (old + 1u == (gen + 1u) * nloc) {
            __builtin_amdgcn_fence(__ATOMIC_RELEASE, "agent");
            asm volatile("s_waitcnt vmcnt(0)" ::: "memory");
            const unsigned og = xb_add(&bar[XB_TOP], 1u);
            const unsigned tg = og / nx;
            if (og + 1u == (tg + 1u) * nx) xb_add(&bar[XB_TOPGEN], 1u);
            else XB_SPIN(xb_ld(&bar[XB_TOPGEN]) == tg, bar);
            __builtin_amdgcn_fence(__ATOMIC_ACQUIRE, "agent");
            xb_add(&bar[XB_XGEN(b.x)], 1u);
            asm volatile("s_waitcnt vmcnt(0)" ::: "memory");
        } else {
            XB_SPIN(xb_ld(&bar[XB_XGEN(b.x)]) == gen, bar);
            __builtin_amdgcn_fence(__ATOMIC_ACQUIRE, "agent");
            asm volatile("s_waitcnt vmcnt(0)" ::: "memory");
        }
    }
    __syncthreads();
}

__global__ void __launch_bounds__(NTHREADS, 2) hybrid_fwd(Args A) {
    extern __shared__ __attribute__((aligned(16))) unsigned char lds[];
    cg::grid_group grid = cg::this_grid();
    LAS unsigned char* L = (LAS unsigned char*)lds;
    unsigned char* ws = A.ws;
    const int G = gridDim.x;
    float* XL = A.out; float* XC = (float*)(ws + WS_XC);
    bf16_t* XN = (bf16_t*)(ws + WS_XN); bf16_t* ACT = (bf16_t*)(ws + WS_ACT);
    const float* gatef = (const float*)(ws + WS_GATE);

    const int wv = __builtin_amdgcn_readfirstlane((int)threadIdx.x >> 6);
    volatile LAS unsigned* MISC = (volatile LAS unsigned*)(L + 131072 + 320);
    if (threadIdx.x < 32) MISC[threadIdx.x] = 0u;
    __syncthreads();
    XcdBarrier xbar = xcd_barrier_post((unsigned*)ws + 4096, MISC + 8);
#define GSYNC() xcd_barrier(xbar)
#pragma unroll 1
    for (int l = 0; l < 4; ++l) { phase_prep(A, L, l, (int)((blockIdx.x + 64 * l) % G), G, wv); LBAR(); }
    if (A.out == nullptr) grid.sync();
    for (int rep = 0; rep < DUP_SYNC; ++rep) GSYNC();
#pragma unroll 1
    for (int layer = 0; layer < 4; ++layer) {
        ws = ows(ws);
        const int kind = layer == 3 ? 0 : layer;
        const int Nin = kind == 0 ? 2560 : (kind == 1 ? 2048 : 4096);
        const float* xinL = layer == 0 ? A.in[0] : XL; const float* xinC = layer == 0 ? A.in[2] : XC;
        for (int rep = 0; rep < DUP_NORM; ++rep) phase_norm(A, layer, xinL, xinC, L, wv);
        GSYNC();
        {
            const bf16_t* Wt = (const bf16_t*)(ws + (layer == 0 ? WS_WIN[0] : layer == 1 ? WS_WIN[1] : layer == 2 ? WS_WIN[2] : WS_WIN[3]));
            pg8::Gemm g{XN, Wt, layer == 3 ? ML : MT, Nin, DM};
            pg8::OrderG S; S.so.init(layer == 3 ? ML : MT, Nin, G, (int)blockIdx.x); S.extra = layer == 3 ? 16 : 0;
            pg8::EpiIn E{ACT, Nin, kind, (const float*)(ws + WS_ROPE)};
            for (int rep = 0; rep < DUP_GIN; ++rep) pg8::gemm_phase<pg8::EpiIn, pg8::OrderG, true, true>(L, g, S, E, wv);
        }
        GSYNC();
        if (kind == 0) { for (int rep = 0; rep < DUP_ATTN; ++rep) phase_attn(ACT, XN, (layer == 0 ? A.in[9] : A.in[34]), layer == 0, L, wv); }
        else if (kind == 1) { for (int rep = 0; rep < DUP_LRU; ++rep) phase_lru(A, ACT, XN, (float*)(ws + WS_HF), L, wv); }
        else { for (int rep = 0; rep < DUP_CONV; ++rep) phase_conv(A, ACT, XN, wv); }
        GSYNC();
        {
            const bf16_t* Wt = (const bf16_t*)(ws + (layer == 0 ? WS_WOUT[0] : layer == 1 ? WS_WOUT[1] : layer == 2 ? WS_WOUT[2] : WS_WOUT[3]));
            const int Mo = (CTX_SMALL || layer == 3) ? ML : MT;
            pg8::Gemm g{XN, Wt, Mo, DM, DM};
            pg8::OrderG S; S.so.init(Mo, DM, G, (int)blockIdx.x); S.extra = 0;
            pg8::EpiRes E{xinL, xinC, XL, XC, gatef + (size_t)layer * 9 * 1024};
            const bool ctx_first = (blockIdx.x & 1) != 0;
#pragma unroll 1
            for (int step = 0; step < 2; ++step) {
                if ((step == 0) == ctx_first) { if (CTX_SMALL && layer < 3) phase_ctx_wout(XN + (size_t)ML * DM, Wt, xinC, XC, gatef + (size_t)(layer * 9 + 8) * 1024, L, wv); }
                else pg8::gemm_phase<pg8::EpiRes, pg8::OrderG, true, true>(L, g, S, E, wv);
            }
        }
        GSYNC();
    }
    phase_final(XL, A.in[35], wv);
}

extern "C" void kernel_launch(void* const* d_in, const int* in_sizes, int n_in, void* d_out, int out_size, void* d_ws, size_t ws_size, hipStream_t stream) {
    static int grid = 0;
    if (grid == 0) {
        if (n_in != 36 || out_size != ML * DM || ws_size < WS_END) { fprintf(stderr, "kernel_launch: unexpected shapes (n_in %d, out %d, ws %zu)\n", n_in, out_size, ws_size); grid = -1; return; }
        int dev = 0, cus = 0, per_cu = 0;
        hipGetDevice(&dev); hipDeviceGetAttribute(&cus, hipDeviceAttributeMultiprocessorCount, dev);
        if (hipFuncSetAttribute((const void*)hybrid_fwd, hipFuncAttributeMaxDynamicSharedMemorySize, LDS_BYTES) != hipSuccess) { fprintf(stderr, "kernel_launch: hipFuncSetAttribute failed\n"); grid = -1; return; }
        if (hipOccupancyMaxActiveBlocksPerMultiprocessor(&per_cu, (const void*)hybrid_fwd, NTHREADS, LDS_BYTES) != hipSuccess || per_cu < 1) { fprintf(stderr, "kernel_launch: occupancy query says %d\n", per_cu); per_cu = 1; }
        (void)hipGetLastError();
        grid = cus * (per_cu > 1 ? 1 : per_cu);
        if (grid > 256) grid = 256;
    }
    if (grid < 0) return;
    if (hipMemsetAsync(d_ws, 0, 65536, stream) != hipSuccess) { fprintf(stderr, "kernel_launch: memset failed\n"); return; }
    Args a{};
    for (int i = 0; i < 36; ++i) a.in[i] = (const float*)d_in[i];
    a.out = (float*)d_out; a.ws = (unsigned char*)d_ws;
    void* args[] = {&a};
    hipError_t e = hipLaunchCooperativeKernel((const void*)hybrid_fwd, dim3(grid), dim3(NTHREADS), args, LDS_BYTES, stream);
    if (e != hipSuccess) fprintf(stderr, "kernel_launch: cooperative launch failed: %s (grid %d)\n", hipGetErrorString(e), grid);
}
```

```cpp
#include <hip/hip_runtime.h>
#include <hip/hip_cooperative_groups.h>
#include <cstdio>
#include <cstdint>
namespace cg = cooperative_groups;

namespace pg8 {
#define PG8_LAS __attribute__((address_space(3)))
typedef unsigned short bf16_t;
typedef short bf16x8 __attribute__((ext_vector_type(8)));
typedef float f32x4 __attribute__((ext_vector_type(4)));
typedef unsigned u32x4 __attribute__((ext_vector_type(4)));
constexpr int BM = 256, BK = 64, HALF = 128, HTB = HALF * BK * 2  , STAGE_BYTES = 8 * HTB, NXCD = 8, WGM = 8;

__host__ __device__ __forceinline__ int lds_byte(int r, int c) { const int st = (r >> 4) * 2 + (c >> 5), rr = r & 15, cc = c & 31, ob = rr * 64 + cc * 2; return st * 1024 + (ob ^ (((ob >> 9) & 1) << 5)); }
__host__ __device__ __forceinline__ void stage_rc(int b, int& R, int& C) { const int st = b / 1024, sb = b % 1024, swz = sb ^ (((sb >> 9) & 1) << 5); R = (st >> 1) * 16 + swz / 64; C = (st & 1) * 32 + (swz % 64) / 2; }
__host__ __device__ __forceinline__ int perm32(int rho) { const int n = rho >> 4, i = rho & 15; return 8 * (i >> 2) + 4 * n + (i & 3); }

struct Unit { int pm, pn; };
struct Gemm { const bf16_t* A; const bf16_t* Bt; int M, N, K; };

struct StaticOrder {
    int nM, nN, nwg, G, c;
    __host__ __device__ void init(int M, int N, int G_, int c_) { nM = M / BM; nN = N / BM; nwg = nM * nN; G = G_; c = c_; }
    __host__ __device__ bool next(int i, Unit& u) const {
        const long L = (long)i * G + c; if (L >= nwg) return false;
        int wgid = (int)L; { const int q = nwg / NXCD, r = nwg % NXCD, xcd = wgid % NXCD, off = wgid / NXCD; wgid = (xcd < r ? xcd * (q + 1) : r * (q + 1) + (xcd - r) * q) + off; }
        const int nig = WGM * nN, gid = wgid / nig, fm = gid * WGM, gsz = (nM - fm) < WGM ? (nM - fm) : WGM;
        u.pm = fm + ((wgid % nig) % gsz); u.pn = (wgid % nig) / gsz; return true;
    }
    __device__ __forceinline__ void a_ready(const Unit&) const {}
    __device__ __forceinline__ void done(const Unit&) const {}
};

__device__ __forceinline__ unsigned cvt_pk_bf16(float lo, float hi) { unsigned r; asm volatile("v_cvt_pk_bf16_f32 %0, %1, %2" : "=v"(r) : "v"(lo), "v"(hi)); return r; }
typedef float f32x2 __attribute__((ext_vector_type(2)));
__device__ __forceinline__ float silu_f(float v) { return v * __builtin_amdgcn_rcpf(1.0f + __builtin_amdgcn_exp2f(-v * 1.4426950408889634f)); }
constexpr float QSCALE = 0.125f * 1.4426950408889634f;

struct OrderG {
    StaticOrder so; int extra;
    __device__ __forceinline__ bool next(int i, Unit& u) const {
        long L = (long)i * so.G + so.c; if (L < so.nwg) return so.next(i, u);
        L -= so.nwg; if (L >= extra) return false; u.pm = 64 + (int)(L >> 1); u.pn = 4 + (int)(L & 1); return true;
    }
    __device__ __forceinline__ void a_ready(const Unit&) const {}
    __device__ __forceinline__ void done(const Unit&) const {}
};

struct EpiIn {
    static constexpr bool PERM = true, AFTER_DRAIN = false;
    bf16_t* O; int ldc; int kind; const float* rope;
    __device__ __forceinline__ void operator()(const f32x4 (&acc)[2][2][4][2], const Unit& u, int wr, int wc, int fr, int fq) const {
        const int colt = u.pn * BM; const bool lat = u.pm < 64;
        int mode = 0; float sc = 1.f;
        if (kind == 0) { if (colt < 1024) { mode = lat ? 2 : 0; sc = QSCALE; } else if (colt < 1280) mode = lat ? 2 : 0; else if (colt < 1536) mode = 0; else mode = 1; }
        else if (kind == 1) mode = colt < 1024 ? 0 : 1;
        else mode = colt < 3072 ? 0 : 1;
        const int row0 = u.pm * BM + wr * 64 + fr; const int col0 = colt + wc * 32 + 8 * fq;
        const float sgn = (fq < 2) ? -1.f : 1.f;
#pragma unroll
        for (int ai = 0; ai < 2; ++ai)
#pragma unroll
            for (int m = 0; m < 4; ++m) {
                const int row = row0 + ai * HALF + m * 16;
                bf16_t* rowp = O + (size_t)row * ldc + col0;
                f32x4 cs[4];
                if (mode == 2) { const int l = row & 2047; const int p = (wc & 1) ? (l & 63) : (l >> 6); const f32x4* rp = (const f32x4*)(rope + (p * 16 + 8 * (fq & 1)) * 2);
                    cs[0] = rp[0]; cs[1] = rp[1]; cs[2] = rp[2]; cs[3] = rp[3]; }
#pragma unroll
                for (int bj = 0; bj < 2; ++bj) {
                    f32x4 v0 = acc[ai][bj][m][0], v1 = acc[ai][bj][m][1];
                    if (mode == 1) {
#pragma unroll
                        for (int e = 0; e < 4; ++e) { v0[e] = silu_f(v0[e]); v1[e] = silu_f(v1[e]); }
                    } else if (mode == 2) {
                        f32x4 p0, p1;
#pragma unroll
                        for (int e = 0; e < 4; ++e) { p0[e] = __shfl_xor(v0[e], 32); p1[e] = __shfl_xor(v1[e], 32); }
                        v0[0] = v0[0] * cs[0][0] + sgn * p0[0] * cs[0][1]; v0[1] = v0[1] * cs[0][2] + sgn * p0[1] * cs[0][3];
                        v0[2] = v0[2] * cs[1][0] + sgn * p0[2] * cs[1][1]; v0[3] = v0[3] * cs[1][2] + sgn * p0[3] * cs[1][3];
                        v1[0] = v1[0] * cs[2][0] + sgn * p1[0] * cs[2][1]; v1[1] = v1[1] * cs[2][2] + sgn * p1[1] * cs[2][3];
                        v1[2] = v1[2] * cs[3][0] + sgn * p1[2] * cs[3][1]; v1[3] = v1[3] * cs[3][2] + sgn * p1[3] * cs[3][3];
                    }
                    v0 = v0 * sc; v1 = v1 * sc;
                    u32x4 w; w.x = cvt_pk_bf16(v0[0], v0[1]); w.y = cvt_pk_bf16(v0[2], v0[3]); w.z = cvt_pk_bf16(v1[0], v1[1]); w.w = cvt_pk_bf16(v1[2], v1[3]);
                    *(u32x4*)(rowp + bj * HALF) = w;
                }
            }
    }
};

struct EpiRes {
    static constexpr bool PERM = true, AFTER_DRAIN = false;
    const float* inL; const float* inC; float* outL; float* outC; const float* gate;
    __device__ __forceinline__ void operator()(const f32x4 (&acc)[2][2][4][2], const Unit& u, int wr, int wc, int fr, int fq) const {
        const bool lat = u.pm < 64;
        const float* ib = lat ? inL + (size_t)u.pm * BM * 1024 : inC + (size_t)(u.pm - 64) * BM * 1024;
        float* ob = lat ? outL + (size_t)u.pm * BM * 1024 : outC + (size_t)(u.pm - 64) * BM * 1024;
        const float* g = gate + (lat ? (u.pm >> 3) : 8) * 1024;
        const int col0 = u.pn * BM + wc * 32 + 8 * fq;
        f32x4 gv[2][2];
#pragma unroll
        for (int bj = 0; bj < 2; ++bj)
#pragma unroll
            for (int n = 0; n < 2; ++n) gv[bj][n] = *(const f32x4*)(g + col0 + bj * HALF + n * 4);
#pragma unroll
        for (int ai = 0; ai < 2; ++ai)
#pragma unroll
            for (int mp = 0; mp < 2; ++mp) {
                f32x4 xv[2][2][2];
#pragma unroll
                for (int mm = 0; mm < 2; ++mm) { const size_t off = (size_t)(ai * HALF + wr * 64 + (2 * mp + mm) * 16 + fr) * 1024 + col0;
#pragma unroll
                    for (int bj = 0; bj < 2; ++bj)
#pragma unroll
                        for (int n = 0; n < 2; ++n) xv[mm][bj][n] = __builtin_nontemporal_load((const f32x4*)(ib + off + bj * HALF + n * 4)); }
#pragma unroll
                for (int mm = 0; mm < 2; ++mm) { const int m = 2 * mp + mm; const size_t off = (size_t)(ai * HALF + wr * 64 + m * 16 + fr) * 1024 + col0;
#pragma unroll
                    for (int bj = 0; bj < 2; ++bj)
#pragma unroll
                        for (int n = 0; n < 2; ++n) *(f32x4*)(ob + off + bj * HALF + n * 4) = xv[mm][bj][n] + gv[bj][n] * acc[ai][bj][m][n]; }
                asm volatile("" ::: "memory"); }
    }
};

template <class Epi, class Sched, bool ALIGN_EPI = false, bool SP2 = false>
__device__ __forceinline__ void gemm_phase(PG8_LAS unsigned char* lds, const Gemm g, const Sched& S, const Epi& E, const int wv_) {
    int tid_ = wv_ * 64 + (int)__builtin_amdgcn_mbcnt_hi(~0u, __builtin_amdgcn_mbcnt_lo(~0u, 0u)); asm volatile("" : "+v"(tid_));
    const int tid = tid_, wid = __builtin_amdgcn_readfirstlane(tid >> 6), lane = tid & 63, wr = wid >> 2, wc = wid & 3, fr = lane & 15, fq = lane >> 4;
    const int K = g.K, nt = K / BK;
    unsigned voffA[2], voffB[2];
#pragma unroll
    for (int i = 0; i < 2; ++i) { int R, C; stage_rc(tid * 16 + i * 8192, R, C); const int Rb = Epi::PERM ? ((R & ~31) + perm32(R & 31)) : R;
        voffA[i] = (unsigned)(R * K + C) * 2u; voffB[i] = (unsigned)(Rb * K + C) * 2u; }
    const size_t kstep = (size_t)(BK * 2);
    const size_t hstep = (size_t)HALF * K * 2;
    const size_t tstep = 2 * hstep;
    const unsigned ldsw = (unsigned)wid * 1024u;
    const int aoff = lds_byte(wr * 64 + fr, fq * 8), boff = lds_byte(wc * 32 + fr, fq * 8);
#define PG8_SA(b, h) (((b) * 2 + (h)) * HTB)
#define PG8_SB(b, h) ((4 + (b) * 2 + (h)) * HTB)
#define PG8_STAGE(bufoff, gbase, voff) do { _Pragma("unroll") for (int _i = 0; _i < 2; ++_i) \
        __builtin_amdgcn_global_load_lds((const unsigned*)((const char*)(gbase) + (voff)[_i]), (PG8_LAS unsigned*)(lds + (bufoff) + ldsw + _i * 8192), 16, 0, 0); } while (0)
#define PG8_LDA(dst, b, h) do { _Pragma("unroll") for (int m = 0; m < 4; ++m) _Pragma("unroll") for (int k = 0; k < 2; ++k) dst[m][k] = *(const PG8_LAS bf16x8*)(lds + PG8_SA(b, h) + aoff + m * 2048 + k * 1024); } while (0)
#define PG8_LDB(dst, b, h) do { _Pragma("unroll") for (int n = 0; n < 2; ++n) _Pragma("unroll") for (int k = 0; k < 2; ++k) dst[n][k] = *(const PG8_LAS bf16x8*)(lds + PG8_SB(b, h) + boff + n * 2048 + k * 1024); } while (0)
#define PG8_MMA(ai, bj, At, Bt) do { __builtin_amdgcn_s_setprio(1); _Pragma("unroll") for (int m = 0; m < 4; ++m) _Pragma("unroll") for (int n = 0; n < 2; ++n) _Pragma("unroll") for (int k = 0; k < 2; ++k) \
        acc[ai][bj][m][n] = __builtin_amdgcn_mfma_f32_16x16x32_bf16(Bt[n][k], At[m][k], acc[ai][bj][m][n], 0, 0, 0); __builtin_amdgcn_s_setprio(0); } while (0)
#define PG8_WAIT_V(n) asm volatile("s_waitcnt vmcnt(" #n ")" ::: "memory")
#define PG8_WAIT_L(n) asm volatile("s_waitcnt lgkmcnt(" #n ")" ::: "memory")
#define PG8_BAR __builtin_amdgcn_s_barrier()
#define PG8_SCHED __builtin_amdgcn_sched_barrier(0)
    Unit cur, nxt; int ui = 0;
    if (!S.next(0, cur)) return;
    f32x4 acc[2][2][4][2];
#pragma unroll
    for (int a = 0; a < 2; ++a)
#pragma unroll
        for (int b = 0; b < 2; ++b)
#pragma unroll
            for (int m = 0; m < 4; ++m)
#pragma unroll
                for (int n = 0; n < 2; ++n) acc[a][b][m][n] = (f32x4){0.f, 0.f, 0.f, 0.f};
    bf16x8 At[4][2], B0[2][2], B1[2][2];
    const char* cA = (const char*)g.A + (size_t)cur.pm * tstep; const char* cB = (const char*)g.Bt + (size_t)cur.pn * tstep;
    S.a_ready(cur);
    if constexpr (SP2) {
        PG8_STAGE(PG8_SB(0, 0), cB, voffB); PG8_STAGE(PG8_SB(0, 1), cB + hstep, voffB); PG8_STAGE(PG8_SA(0, 0), cA, voffA); PG8_STAGE(PG8_SA(0, 1), cA + hstep, voffA);
        if (wr == 1) PG8_BAR;
        PG8_WAIT_V(2); PG8_BAR;
        PG8_STAGE(PG8_SB(1, 0), cB + kstep, voffB); PG8_STAGE(PG8_SA(1, 0), cA + kstep, voffA); PG8_STAGE(PG8_SB(1, 1), cB + hstep + kstep, voffB);
        PG8_WAIT_V(6); PG8_BAR;
    } else {
        PG8_STAGE(PG8_SB(0, 0), cB, voffB); PG8_STAGE(PG8_SA(0, 0), cA, voffA); PG8_STAGE(PG8_SB(0, 1), cB + hstep, voffB); PG8_STAGE(PG8_SA(0, 1), cA + hstep, voffA);
        if (wr == 1) PG8_BAR;
        PG8_WAIT_V(4); PG8_BAR;
        PG8_STAGE(PG8_SB(1, 0), cB + kstep, voffB); PG8_STAGE(PG8_SA(1, 0), cA + kstep, voffA); PG8_STAGE(PG8_SB(1, 1), cB + hstep + kstep, voffB);
        PG8_WAIT_V(6); PG8_BAR;
    }
    for (;;) {
        const bool has_next = S.next(ui + 1, nxt);
        const char* nA = has_next ? (const char*)g.A + (size_t)nxt.pm * tstep : cA; const char* nB = has_next ? (const char*)g.Bt + (size_t)nxt.pn * tstep : cB;
        for (int t = 0; t < nt; t += 2) {
            const bool last = (t == nt - 2);
            const char* a1 = cA + (size_t)(t + 1) * kstep;
            const char* a2 = last ? nA : cA + (size_t)(t + 2) * kstep; const char* b2 = last ? nB : cB + (size_t)(t + 2) * kstep;
            const char* a3 = a2 + kstep; const char* b3 = b2 + kstep;
            if (last && has_next) S.a_ready(nxt);
            if constexpr (SP2) {
            PG8_LDB(B0, 0, 0); PG8_LDB(B1, 0, 1); PG8_SCHED; PG8_LDA(At, 0, 0); PG8_STAGE(PG8_SA(1, 1), a1 + hstep, voffA);
            PG8_WAIT_V(8); PG8_WAIT_L(0); PG8_BAR; PG8_MMA(0, 0, At, B0); PG8_MMA(0, 1, At, B1); PG8_BAR; PG8_SCHED;
            PG8_LDA(At, 0, 1); PG8_STAGE(PG8_SB(0, 0), b2, voffB); PG8_STAGE(PG8_SB(0, 1), b2 + hstep, voffB); PG8_STAGE(PG8_SA(0, 0), a2, voffA);
            PG8_WAIT_V(8); PG8_WAIT_L(0); PG8_BAR; PG8_MMA(1, 0, At, B0); PG8_MMA(1, 1, At, B1); PG8_BAR; PG8_SCHED;
            PG8_LDB(B0, 1, 0); PG8_LDB(B1, 1, 1); PG8_SCHED; PG8_LDA(At, 1, 0); PG8_STAGE(PG8_SA(0, 1), a2 + hstep, voffA);
            PG8_WAIT_V(8); PG8_WAIT_L(0); PG8_BAR; PG8_MMA(0, 0, At, B0); PG8_MMA(0, 1, At, B1); PG8_BAR; PG8_SCHED;
            PG8_LDA(At, 1, 1); PG8_STAGE(PG8_SB(1, 0), b3, voffB); PG8_STAGE(PG8_SB(1, 1), b3 + hstep, voffB); PG8_STAGE(PG8_SA(1, 0), a3, voffA);
            PG8_WAIT_V(8); PG8_WAIT_L(0); PG8_BAR; PG8_MMA(1, 0, At, B0); PG8_MMA(1, 1, At, B1); PG8_BAR; PG8_SCHED;
            } else {
            PG8_LDB(B0, 0, 0); PG8_SCHED; PG8_LDA(At, 0, 0); PG8_STAGE(PG8_SA(1, 1), a1 + hstep, voffA);
            PG8_WAIT_L(8); PG8_BAR; PG8_WAIT_L(0); PG8_MMA(0, 0, At, B0); PG8_BAR; PG8_SCHED;
            PG8_LDB(B1, 0, 1); PG8_STAGE(PG8_SB(0, 0), b2, voffB);
            PG8_BAR; PG8_WAIT_L(0); PG8_MMA(0, 1, At, B1); PG8_BAR;
            PG8_LDA(At, 0, 1); PG8_STAGE(PG8_SA(0, 0), a2, voffA);
            PG8_BAR; PG8_WAIT_L(0); PG8_MMA(1, 0, At, B0); PG8_BAR; PG8_SCHED;
            PG8_STAGE(PG8_SB(0, 1), b2 + hstep, voffB);
            PG8_WAIT_V(6); PG8_BAR; PG8_MMA(1, 1, At, B1); PG8_BAR;
            PG8_LDB(B0, 1, 0); PG8_SCHED; PG8_LDA(At, 1, 0); PG8_STAGE(PG8_SA(0, 1), a2 + hstep, voffA);
            PG8_WAIT_L(8); PG8_BAR; PG8_WAIT_L(0); PG8_MMA(0, 0, At, B0); PG8_BAR; PG8_SCHED;
            PG8_LDB(B1, 1, 1); PG8_STAGE(PG8_SB(1, 0), b3, voffB);
            PG8_BAR; PG8_WAIT_L(0); PG8_MMA(0, 1, At, B1); PG8_BAR;
            PG8_LDA(At, 1, 1); PG8_STAGE(PG8_SA(1, 0), a3, voffA);
            PG8_BAR; PG8_WAIT_L(0); PG8_MMA(1, 0, At, B0); PG8_BAR; PG8_SCHED;
            PG8_STAGE(PG8_SB(1, 1), b3 + hstep, voffB);
            PG8_WAIT_V(6); PG8_BAR; PG8_MMA(1, 1, At, B1); PG8_BAR;
            }
        }
        if constexpr (ALIGN_EPI) { if (wr == 0) PG8_BAR; }
        if constexpr (!Epi::AFTER_DRAIN) { E(acc, cur, wr, wc, fr, fq); S.done(cur); }
        if (!has_next) break;
#pragma unroll
        for (int a = 0; a < 2; ++a)
#pragma unroll
            for (int b = 0; b < 2; ++b)
#pragma unroll
                for (int m = 0; m < 4; ++m)
#pragma unroll
                    for (int n = 0; n < 2; ++n) acc[a][b][m][n] = (f32x4){0.f, 0.f, 0.f, 0.f};
        cur = nxt; cA = nA; cB = nB; ++ui;
        if constexpr (ALIGN_EPI) { if (wr == 1) PG8_BAR; }
    }
    PG8_WAIT_V(0);
    if constexpr (!ALIGN_EPI) { if (wr == 0) PG8_BAR; }
    PG8_BAR;
    if constexpr (Epi::AFTER_DRAIN) { E.fused(acc, cur, wr, wc, fr, fq, lds, wid, lane); S.done(cur); }
#undef PG8_SA
#undef PG8_SB
#undef PG8_STAGE
#undef PG8_LDA
#undef PG8_LDB
#undef PG8_MMA
#undef PG8_WAIT_V
#undef PG8_WAIT_L
#undef PG8_BAR
#undef PG8_SCHED
}
}

#define LAS __attribute__((address_space(3)))
typedef unsigned short bf16_t;
typedef short bf16x8 __attribute__((ext_vector_type(8)));
typedef short s16x4 __attribute__((ext_vector_type(4)));
typedef float f32x4 __attribute__((ext_vector_type(4)));
typedef float f32x2 __attribute__((ext_vector_type(2)));
typedef float f32x16 __attribute__((ext_vector_type(16)));
typedef unsigned u32x4 __attribute__((ext_vector_type(4)));
typedef unsigned u32x2 __attribute__((ext_vector_type(2)));

#ifndef DUP_ATTN
#define DUP_ATTN 1
#endif
#ifndef DUP_LRU
#define DUP_LRU 1
#endif
#ifndef DUP_CONV
#define DUP_CONV 1
#endif
#ifndef DUP_GIN
#define DUP_GIN 1
#endif
#ifndef DUP_NORM
#define DUP_NORM 1
#endif
#ifndef DUP_PRO
#define DUP_PRO 1
#endif
#ifndef DUP_GOUT0
#define DUP_GOUT0 1
#endif
#ifndef DUP_LRUBC
#define DUP_LRUBC 1
#endif
#ifndef DUP_ATTEPI
#define DUP_ATTEPI 1
#endif
#ifndef DUP_SYNC
#define DUP_SYNC 1
#endif
#ifndef CTX_SMALL
#define CTX_SMALL 1
#endif
constexpr int NTHREADS = 512, NWAVES = 8;
constexpr int DM = 1024, NB = 8, SEQ = 2048, CTX = 256;
constexpr int ML = NB * SEQ, MC = NB * CTX, MT = ML + MC;
constexpr float EPS = 1e-6f, LOG2E = 1.4426950408889634f;
constexpr int LDS_BYTES = 147456;

constexpr size_t MiB = 1u << 20;
constexpr size_t WS_MODP = 1 * MiB;
constexpr size_t WS_GATE = 5 * MiB;
constexpr size_t WS_ROPE = 5 * MiB + 512 * 1024;
constexpr size_t WS_GW = 6 * MiB;
constexpr size_t WS_WIN[4] = {8 * MiB, 15 * MiB, 21 * MiB, 31 * MiB};
constexpr size_t WS_WOUT[4] = {13 * MiB, 19 * MiB, 29 * MiB, 36 * MiB};
constexpr size_t WS_XC = 38 * MiB;
constexpr size_t WS_XN = 46 * MiB;
constexpr size_t WS_ACT = 82 * MiB;
constexpr size_t WS_HF = 154 * MiB;
constexpr size_t WS_END = 226 * MiB;

struct Args { const float* in[36]; float* out; unsigned char* ws; };

#define LBAR() do { asm volatile("s_waitcnt lgkmcnt(0)" ::: "memory"); __builtin_amdgcn_s_barrier(); asm volatile("" ::: "memory"); } while (0)

__device__ __forceinline__ unsigned f2bf(float f) { unsigned u = __builtin_bit_cast(unsigned, f); return (u + 0x7fffu + ((u >> 16) & 1u)) >> 16; }
__device__ __forceinline__ unsigned pk2(float lo, float hi) { return pg8::cvt_pk_bf16(lo, hi); }
__device__ __forceinline__ float bflo(unsigned w) { return __builtin_bit_cast(float, w << 16); }
__device__ __forceinline__ float bfhi(unsigned w) { return __builtin_bit_cast(float, w & 0xffff0000u); }
__device__ __forceinline__ unsigned char* ows(unsigned char* p) { unsigned long long v = (unsigned long long)p; asm volatile("" : "+s"(v)); return (unsigned char*)(__attribute__((address_space(1))) unsigned char*)v; }
__device__ __forceinline__ int otid(int wv) { int t = wv * 64 + (int)__builtin_amdgcn_mbcnt_hi(~0u, __builtin_amdgcn_mbcnt_lo(~0u, 0u)); asm volatile("" : "+v"(t)); return t; }
__device__ __forceinline__ float wave_sum(float v) {
#pragma unroll
    for (int o = 1; o < 64; o <<= 1) v += __shfl_xor(v, o);
    return v;
}
using pg8::silu_f;

__device__ __forceinline__ void transpose_item(const float* W, int K, int N, bf16_t* WT, LAS float* scr, int item, int lane) {
    const int nblk = N / 32, kb = item / nblk, nb = item % nblk, k0 = 64 * kb, n0 = 32 * nb;
    float tv[32];
#pragma unroll
    for (int i = 0; i < 32; ++i) tv[i] = __builtin_nontemporal_load(W + (size_t)(k0 + 2 * i + (lane >> 5)) * N + n0 + (lane & 31));
#pragma unroll
    for (int i = 0; i < 32; ++i) scr[(2 * i + (lane >> 5)) * 33 + (lane & 31)] = tv[i];
    asm volatile("s_waitcnt lgkmcnt(0)" ::: "memory");
    const int c = lane & 7;
#pragma unroll
    for (int j = 0; j < 4; ++j) { const int n = (lane >> 3) + 8 * j; const LAS float* s = scr + (8 * c) * 33 + n;
        u32x4 o; o.x = pk2(s[0 * 33], s[1 * 33]); o.y = pk2(s[2 * 33], s[3 * 33]); o.z = pk2(s[4 * 33], s[5 * 33]); o.w = pk2(s[6 * 33], s[7 * 33]);
        *(u32x4*)(WT + (size_t)(n0 + n) * K + k0 + 8 * c) = o; }
    asm volatile("s_waitcnt lgkmcnt(0)" ::: "memory");
}

__device__ __forceinline__ void phase_prep(const Args& A, LAS unsigned char* L, int layer, int vbid, int vG, const int wv) {
    const int tid = otid(wv), lane = tid & 63, wave = tid >> 6;
    unsigned char* ws = A.ws;
    const float* Wm = (layer == 0 ? A.in[5] : layer == 1 ? A.in[11] : layer == 2 ? A.in[23] : A.in[30]);
    for (int task = vbid; task < 48; task += vG) {
        const int cc = task >> 3, kc = task & 7;
        const int col = cc * 512 + tid;
        const float* wp = Wm + (size_t)(kc * 128) * 3072 + col;
        float wv_[128];
#pragma unroll
        for (int kk = 0; kk < 128; ++kk) wv_[kk] = __builtin_nontemporal_load(wp + (size_t)kk * 3072);
        LAS float* s = (LAS float*)L;
        for (int idx = tid; idx < 9 * 128; idx += NTHREADS) { const int r = idx >> 7, kk = idx & 127;
            const float v = (r < 8) ? A.in[1][r * DM + kc * 128 + kk] : A.in[3][kc * 128 + kk];
            s[idx] = v / (1.0f + __expf(-v)); }
        LBAR();
        float acc[9];
#pragma unroll
        for (int r = 0; r < 9; ++r) acc[r] = 0.f;
#pragma unroll
        for (int kk = 0; kk < 128; ++kk) { const float w = wv_[kk];
#pragma unroll
            for (int r = 0; r < 9; ++r) acc[r] += s[r * 128 + kk] * w; }
        float* mp = (float*)(ws + WS_MODP) + (size_t)((layer * 8 + kc) * 9) * 3072 + col;
#pragma unroll
        for (int r = 0; r < 9; ++r) mp[(size_t)r * 3072] = acc[r];
        LBAR();
    }
    if (layer == 0 && vbid == vG - 1) {
        float* rt = (float*)(ws + WS_ROPE);
        for (int idx = tid; idx < 1024; idx += NTHREADS) { const int p = idx >> 4, j = idx & 15;
            const float inv = 1.0f / __builtin_powf(10000.0f, (float)j * (1.0f / 16.0f));
            const float ang = (float)p * inv; float t = ang * 0.15915494309189535f; t -= __builtin_rintf(t);
            rt[idx * 2] = __builtin_amdgcn_cosf(t); rt[idx * 2 + 1] = __builtin_amdgcn_sinf(t); }
    }
    LAS float* scr = (LAS float*)(L + wave * 16384);
    const int rb = (vbid + vG - (48 % vG)) % vG;
    const int gw = rb * NWAVES + wave, NGW = vG * NWAVES;
    const int Nin = (layer == 0 || layer == 3) ? 2560 : (layer == 1 ? 2048 : 4096);
    const float* win = (layer == 0 ? A.in[7] : layer == 1 ? A.in[13] : layer == 2 ? A.in[25] : A.in[32]);
    const float* wout = (layer == 0 ? A.in[8] : layer == 1 ? A.in[14] : layer == 2 ? A.in[26] : A.in[33]);
    bf16_t* wint = (bf16_t*)(ws + (layer == 0 ? WS_WIN[0] : layer == 1 ? WS_WIN[1] : layer == 2 ? WS_WIN[2] : WS_WIN[3]));
    bf16_t* woutt = (bf16_t*)(ws + (layer == 0 ? WS_WOUT[0] : layer == 1 ? WS_WOUT[1] : layer == 2 ? WS_WOUT[2] : WS_WOUT[3]));
    const int IIN = 16 * (Nin / 32), IO = 16 * 32, IGW = layer == 0 ? 64 * 2 : 0;
    const int nitems = IIN + IO + IGW;
    for (int it = gw; it < nitems; it += NGW) {
        int r = it;
        if (r < IIN) { transpose_item(win, 1024, Nin, wint, scr, r, lane); continue; } r -= IIN;
        if (r < IO) { transpose_item(wout, 1024, 1024, woutt, scr, r, lane); continue; } r -= IO;
        { const int blk = r >> 1, sub = r & 1;
          const int dir = blk >> 5, gate = (blk >> 4) & 1, h = blk & 15;
          const float* src = (gate == 0 ? A.in[17] : A.in[19]) + (size_t)(dir * 16 + h) * 4096;
          transpose_item(src, 64, 64, (bf16_t*)(ws + WS_GW) + (size_t)blk * 4096, scr, sub, lane); }
    }
}

template <int NR> __device__ __forceinline__ void norm_load(const float* const (&xrow)[NR], f32x4 (&v)[NR][4], int lane) {
#pragma unroll
    for (int i = 0; i < NR; ++i) { const f32x4* xr = (const f32x4*)xrow[i] + lane;
#pragma unroll
        for (int j = 0; j < 4; ++j) v[i][j] = __builtin_nontemporal_load(xr + 64 * j); }
}
template <int NR> __device__ __forceinline__ void norm_proc(const f32x4 (&v)[NR][4], bf16_t* const (&orow)[NR], const LAS float* const (&gs)[NR], const LAS float* const (&sh)[NR], int lane) {
    float s[NR];
#pragma unroll
    for (int i = 0; i < NR; ++i) { float a = 0.f;
#pragma unroll
        for (int j = 0; j < 4; ++j) a += (v[i][j].x * v[i][j].x + v[i][j].y * v[i][j].y) + (v[i][j].z * v[i][j].z + v[i][j].w * v[i][j].w);
        s[i] = a; }
#pragma unroll
    for (int o = 1; o < 64; o <<= 1) {
#pragma unroll
        for (int i = 0; i < NR; ++i) s[i] += __shfl_xor(s[i], o); }
#pragma unroll
    for (int i = 0; i < NR; ++i) { const float rstd = 1.0f / sqrtf(s[i] * (1.0f / DM) + EPS); u32x2* o8 = (u32x2*)orow[i] + lane;
#pragma unroll
        for (int j = 0; j < 4; ++j) { const f32x4 g = *(const LAS f32x4*)(gs[i] + 256 * j + 4 * lane), b = *(const LAS f32x4*)(sh[i] + 256 * j + 4 * lane);
            const f32x4 y = v[i][j] * rstd * g + b; u32x2 w; w.x = pk2(y.x, y.y); w.y = pk2(y.z, y.w); o8[64 * j] = w; } }
}
__device__ __forceinline__ void phase_norm(const Args& A, int layer, const float* xL, const float* xC, LAS unsigned char* L, const int wv) {
    const int tid = otid(wv), lane = tid & 63, wave = tid >> 6, bid = blockIdx.x, G = gridDim.x;
    const float* norm_g = (layer == 0 ? A.in[4] : layer == 1 ? A.in[10] : layer == 2 ? A.in[22] : A.in[29]);
    const float* mod_b = (layer == 0 ? A.in[6] : layer == 1 ? A.in[12] : layer == 2 ? A.in[24] : A.in[31]);
    unsigned char* ws = ows(A.ws);
    const float* modp = (const float*)(ws + WS_MODP) + (size_t)(layer * 8) * 9 * 3072;
    bf16_t* XN = (bf16_t*)(ws + WS_XN);
    LAS float* tab = (LAS float*)L;
    for (int vb = bid; vb < 256; vb += G) {
        const int batch = vb >> 5;
        const float* xr[3][3]; bf16_t* orow[3][3]; const LAS float* gs[3][3]; const LAS float* sh[3][3];
#pragma unroll
          for (int bt = 0; bt < 3; ++bt)
#pragma unroll
            for (int i = 0; i < 3; ++i) { const int ri = bt * 3 + i;
                if (ri < 8) { const int row = vb * 64 + wave * 8 + ri; xr[bt][i] = xL + (size_t)row * DM; orow[bt][i] = XN + (size_t)row * DM; gs[bt][i] = tab; sh[bt][i] = tab + 1024; }
                else { const int row = vb * 8 + wave; xr[bt][i] = xC + (size_t)row * DM; orow[bt][i] = XN + (size_t)(ML + row) * DM; gs[bt][i] = tab + 2048; sh[bt][i] = tab + 3072; } }
          f32x4 va[3][4], vbb[3][4];
          norm_load<3>(xr[0], va, lane);
        { float bv[8], pv[8][8], gn[8];
#pragma unroll
          for (int i8 = 0; i8 < 8; ++i8) { const int idx = tid + i8 * NTHREADS; const int which = idx >> 10, col = idx & 1023; const int r = (which < 2) ? batch : 8; const int mcol = (which & 1) ? col : 1024 + col;
              bv[i8] = mod_b[mcol];
#pragma unroll
              for (int kc = 0; kc < 8; ++kc) pv[i8][kc] = modp[(size_t)(kc * 9 + r) * 3072 + mcol];
              gn[i8] = (which & 1) ? 0.f : norm_g[col]; }
#pragma unroll
          for (int i8 = 0; i8 < 8; ++i8) { const int idx = tid + i8 * NTHREADS; const int which = idx >> 10;
              float v = bv[i8];
#pragma unroll
              for (int kc = 0; kc < 8; ++kc) v += pv[i8][kc];
              if (!(which & 1)) v = gn[i8] * (1.0f + v);
              tab[idx] = v; } }
        if (vb < 9) { float* gf = (float*)(ws + WS_GATE) + (size_t)(layer * 9 + vb) * 1024;
            float gb[2], gp[2][8];
#pragma unroll
            for (int c2 = 0; c2 < 2; ++c2) { const int col = tid + c2 * NTHREADS; gb[c2] = mod_b[2048 + col];
#pragma unroll
                for (int kc = 0; kc < 8; ++kc) gp[c2][kc] = modp[(size_t)(kc * 9 + vb) * 3072 + 2048 + col]; }
#pragma unroll
            for (int c2 = 0; c2 < 2; ++c2) { float v = gb[c2];
#pragma unroll
                for (int kc = 0; kc < 8; ++kc) v += gp[c2][kc];
                gf[tid + c2 * NTHREADS] = v; } }
        norm_load<3>(xr[1], vbb, lane);
        LBAR();
        {
          norm_proc<3>(va, orow[0], gs[0], sh[0], lane);
          norm_load<3>(xr[2], va, lane);
          norm_proc<3>(vbb, orow[1], gs[1], sh[1], lane);
          norm_proc<3>(va, orow[2], gs[2], sh[2], lane); }
        LBAR();
    }
}

#define MFMA32(a, b, c) __builtin_amdgcn_mfma_f32_32x32x16_bf16((a), (b), (c), 0, 0, 0)
#define MFMA16(a, b, c) __builtin_amdgcn_mfma_f32_16x16x32_bf16((a), (b), (c), 0, 0, 0)
__device__ __forceinline__ int crow(int r, int hi) { return (r & 3) + 8 * (r >> 2) + 4 * hi; }
typedef short v4i16_t __attribute__((ext_vector_type(4)));
__device__ __forceinline__ float max3f(float a, float b, float c) { float r; asm("v_max3_f32 %0, %1, %2, %3" : "=v"(r) : "v"(a), "v"(b), "v"(c)); return r; }
__device__ __forceinline__ s16x4 vtr(LAS const unsigned char* p) { return __builtin_bit_cast(s16x4, __builtin_amdgcn_ds_read_tr16_b64_v4i16((LAS v4i16_t*)p)); }

__device__ __forceinline__ void phase_attn(const bf16_t* ACT, bf16_t* Y, const float* sink, bool need_ctx, LAS unsigned char* L, const int wv) {
    constexpr int LD = 2560, KSTR = 144, TILEB = 64 * KSTR, BUFB = 2 * TILEB;
    const int tid = otid(wv), lane = tid & 63, r32 = lane & 31, hi = lane >> 5, wave = __builtin_amdgcn_readfirstlane(tid >> 6);
    const int g = wave >> 1, half = wave & 1, G = gridDim.x;
    const int skey = tid >> 3, sch = tid & 7;
    const int stoff = skey * KSTR + sch * 16;
    const int koff = r32 * KSTR + hi * 16;
    const int voff = TILEB + (4 * hi + ((lane & 15) >> 2)) * KSTR + (16 * ((lane >> 4) & 1) + 4 * (lane & 3)) * 2;
    const int nunits = need_ctx ? 1152 : 1024;
    for (int u = blockIdx.x; u < nunits; u += G) {
        int b, kvh, qb; bool lat;
        if (u < 1024) { b = u >> 7; kvh = (u >> 5) & 3; qb = u & 31; lat = true; } else { const int e = u - 1024; b = e >> 4; kvh = (e >> 2) & 3; qb = e & 3; lat = false; }
        const int h = kvh * 4 + g;
        const int qpos = qb * 64 + half * 32 + r32;
        const int qrow = lat ? b * SEQ + qpos : ML + b * CTX + qpos;
        int tlo = 4, thi = 4;
        if (lat) { tlo = qb == 0 ? 6 : (qb == 1 ? 5 : 4); thi = qb == 31 ? 7 : (qb == 30 ? 8 : 9); }
        const int n = 4 + (thi - tlo);
        const int kp_base = qb * 64 - 128;
        bf16x8 qf[4];
        { const bf16_t* qp = ACT + (size_t)qrow * LD + h * 64 + hi * 8;
#pragma unroll
          for (int d0 = 0; d0 < 4; ++d0) qf[d0] = *(const bf16x8*)(qp + d0 * 16); }
        float m_run = sink[h] * LOG2E, l_run = hi ? 0.f : 1.f;
        f32x16 o0, o1;
#pragma unroll
        for (int r = 0; r < 16; ++r) { o0[r] = 0.f; o1[r] = 0.f; }
        const size_t kcol = 1024 + kvh * 64 + sch * 8, vcol = 1280 + kvh * 64 + sch * 8;
#define ATT_TROW(s_) (((s_) < 4 ? ML + b * CTX + (s_) * 64 : b * SEQ + kp_base + (tlo + (s_) - 8) * 64) + skey)
        u32x4 kq0, vq0, kq1, vq1, kq2, vq2;
        { const size_t krow = (size_t)ATT_TROW(0); kq0 = *(const u32x4*)(ACT + krow * LD + kcol); vq0 = *(const u32x4*)(ACT + krow * LD + vcol); }
        { const size_t krow = (size_t)ATT_TROW(1); kq1 = *(const u32x4*)(ACT + krow * LD + kcol); vq1 = *(const u32x4*)(ACT + krow * LD + vcol); }
        { const size_t krow = (size_t)ATT_TROW(2); kq2 = *(const u32x4*)(ACT + krow * LD + kcol); vq2 = *(const u32x4*)(ACT + krow * LD + vcol); }
        LBAR();
        *(LAS u32x4*)(L + stoff) = kq0; *(LAS u32x4*)(L + TILEB + stoff) = vq0;
        { const size_t krow = (size_t)ATT_TROW(3); kq0 = *(const u32x4*)(ACT + krow * LD + kcol); vq0 = *(const u32x4*)(ACT + krow * LD + vcol); }
        LBAR();
#define ATT_STEP(s_, KQ, VQ) do { const int s = (s_); \
            const int t = s < 4 ? s : tlo + (s - 4); \
            LAS const unsigned char* B = L + (s & 1) * BUFB; \
 \
              \
            bf16x8 kf[8]; s16x4 vl[8], vh[8]; \
_Pragma("unroll") \
            for (int d0 = 0; d0 < 4; ++d0) { kf[2 * d0] = *(const LAS bf16x8*)(B + koff + d0 * 32); kf[2 * d0 + 1] = *(const LAS bf16x8*)(B + koff + 32 * KSTR + d0 * 32); } \
_Pragma("unroll") \
            for (int i = 0; i < 4; ++i) { LAS const unsigned char* vp = B + voff + i * 16 * KSTR; vl[2 * i] = vtr(vp); vh[2 * i] = vtr(vp + 8 * KSTR); vl[2 * i + 1] = vtr(vp + 64); vh[2 * i + 1] = vtr(vp + 8 * KSTR + 64); } \
            __builtin_amdgcn_sched_barrier(0); \
            f32x16 p0, p1; \
_Pragma("unroll") \
            for (int r = 0; r < 16; ++r) { p0[r] = 0.f; p1[r] = 0.f; } \
_Pragma("unroll") \
            for (int d0 = 0; d0 < 4; ++d0) { p0 = MFMA32(kf[2 * d0], qf[d0], p0); p1 = MFMA32(kf[2 * d0 + 1], qf[d0], p1); } \
            if (t == 4 || t == 8) { const int kp0 = kp_base + (t - 4) * 64 - qpos; \
_Pragma("unroll") \
                for (int r = 0; r < 16; ++r) { const int d0 = kp0 + crow(r, hi), d1 = d0 + 32; \
                    if (d0 > 128 || d0 < -128) p0[r] = -1e30f; if (d1 > 128 || d1 < -128) p1[r] = -1e30f; } } \
            float mt = max3f(p0[0], p0[1], p1[0]), mt2 = max3f(p0[2], p0[3], p1[1]); mt = max3f(mt, p1[2], p1[3]); \
_Pragma("unroll") \
            for (int r = 4; r < 16; r += 4) { mt = max3f(mt, p0[r], p0[r + 1]); mt2 = max3f(mt2, p0[r + 2], p0[r + 3]); mt = max3f(mt, p1[r], p1[r + 1]); mt2 = max3f(mt2, p1[r + 2], p1[r + 3]); } \
            mt = fmaxf(mt, mt2); \
            mt = fmaxf(mt, __shfl_xor(mt, 32)) - m_run; \
 \
            float dl = 0.f; \
            if (s == 0) dl = fmaxf(mt, 0.f); else if (mt > 8.0f) dl = mt; \
            if (__any(dl != 0.f)) { const float alpha = __builtin_amdgcn_exp2f(-dl); m_run += dl; l_run *= alpha; \
_Pragma("unroll") \
                for (int r = 0; r < 16; ++r) { o0[r] *= alpha; o1[r] *= alpha; } } \
            float ls = 0.f, ls2 = 0.f; \
_Pragma("unroll") \
            for (int r = 0; r < 16; ++r) { p0[r] = __builtin_amdgcn_exp2f(p0[r] - m_run); p1[r] = __builtin_amdgcn_exp2f(p1[r] - m_run); ls += p0[r]; ls2 += p1[r]; } \
            ls += ls2; \
            l_run += ls; \
            bf16x8 pb[2][2]; \
_Pragma("unroll") \
            for (int j = 0; j < 2; ++j) { \
                u32x4 w0, w1; \
                w0.x = pk2(p0[8 * j + 0], p0[8 * j + 1]); w0.y = pk2(p0[8 * j + 2], p0[8 * j + 3]); w0.z = pk2(p0[8 * j + 4], p0[8 * j + 5]); w0.w = pk2(p0[8 * j + 6], p0[8 * j + 7]); \
                w1.x = pk2(p1[8 * j + 0], p1[8 * j + 1]); w1.y = pk2(p1[8 * j + 2], p1[8 * j + 3]); w1.z = pk2(p1[8 * j + 4], p1[8 * j + 5]); w1.w = pk2(p1[8 * j + 6], p1[8 * j + 7]); \
                pb[0][j] = __builtin_bit_cast(bf16x8, w0); pb[1][j] = __builtin_bit_cast(bf16x8, w1); \
            } \
 \
_Pragma("unroll") \
            for (int kb = 0; kb < 2; ++kb) \
_Pragma("unroll") \
                for (int j = 0; j < 2; ++j) { const int i = kb * 2 + j; \
                    const bf16x8 a0 = __builtin_shufflevector(vl[2 * i], vh[2 * i], 0, 1, 2, 3, 4, 5, 6, 7), a1 = __builtin_shufflevector(vl[2 * i + 1], vh[2 * i + 1], 0, 1, 2, 3, 4, 5, 6, 7); \
                    o0 = MFMA32(a0, pb[kb][j], o0); o1 = MFMA32(a1, pb[kb][j], o1); \
                } \
            if (s + 1 < n) { LAS unsigned char* Bn = L + ((s + 1) & 1) * BUFB; *(LAS u32x4*)(Bn + stoff) = KQ; *(LAS u32x4*)(Bn + TILEB + stoff) = VQ; } \
            LBAR(); \
            if (s + 4 < n) { const size_t krow = (size_t)ATT_TROW(s + 4); KQ = *(const u32x4*)(ACT + krow * LD + kcol); VQ = *(const u32x4*)(ACT + krow * LD + vcol); } \
        } while (0)
#pragma unroll 1
        for (int s0 = 0; s0 < n; s0 += 3) {
            ATT_STEP(s0, kq1, vq1);
            if (s0 + 1 < n) ATT_STEP(s0 + 1, kq2, vq2);
            if (s0 + 2 < n) ATT_STEP(s0 + 2, kq0, vq0);
        }
#undef ATT_STEP
#undef ATT_TROW
        u32x4 sgq[4];
        { const int qrow0 = qrow - r32;
#pragma unroll
          for (int it = 0; it < 4; ++it) sgq[it] = *(const u32x4*)(ACT + (size_t)(qrow0 + it * 8 + (lane >> 3)) * LD + 1536 + h * 64 + (lane & 7) * 8); }
        const float lt = l_run + __shfl_xor(l_run, 32); const float inv = 1.0f / lt;
        LAS float* stg = (LAS float*)(L + 40960 + wave * 8704);
#pragma unroll
        for (int db = 0; db < 2; ++db)
#pragma unroll
            for (int q4 = 0; q4 < 4; ++q4) { const int d = 32 * db + 8 * q4 + 4 * hi; f32x4 v;
                if (db == 0) v = (f32x4){o0[4 * q4], o0[4 * q4 + 1], o0[4 * q4 + 2], o0[4 * q4 + 3]}; else v = (f32x4){o1[4 * q4], o1[4 * q4 + 1], o1[4 * q4 + 2], o1[4 * q4 + 3]};
                *(LAS f32x4*)(stg + r32 * 68 + d) = v * inv; }
        asm volatile("s_waitcnt lgkmcnt(0)" ::: "memory");
        { const int qrow0 = qrow - r32; const int er = lane >> 3, ec = (lane & 7) * 8;
#pragma unroll
          for (int it = 0; it < 4; ++it) { const int row = it * 8 + er; const size_t grow = (size_t)(qrow0 + row);
              const f32x4 a0 = *(const LAS f32x4*)(stg + row * 68 + ec), a1 = *(const LAS f32x4*)(stg + row * 68 + ec + 4);
              const u32x4 gw = sgq[it];
              u32x4 w; w.x = pk2(a0.x * bflo(gw.x), a0.y * bfhi(gw.x)); w.y = pk2(a0.z * bflo(gw.y), a0.w * bfhi(gw.y)); w.z = pk2(a1.x * bflo(gw.z), a1.y * bfhi(gw.z)); w.w = pk2(a1.z * bflo(gw.w), a1.w * bfhi(gw.w));
              *(u32x4*)(Y + grow * DM + h * 64 + ec) = w; } }
    }
    LBAR();
}

__device__ __forceinline__ void phase_lru(const Args& A, const bf16_t* ACT, bf16_t* Y, float* HF, LAS unsigned char* L, const int wv) {
    constexpr int LD = 2048, TT = 128, USTR = 144;
    const int tid = otid(wv), lane = tid & 63, wave = __builtin_amdgcn_readfirstlane(tid >> 6), G = gridDim.x;
    LAS unsigned char* UL = L;
    LAS unsigned char* XA = L + 19200;
    LAS float* XF = (LAS float*)(L + 19200 + 18432);
    LAS f32x2* AB = (LAS f32x2*)(L + 19200 + 18432 + 18432);
    LAS f32x2* CAR = (LAS f32x2*)(L + 19200 + 18432 + 18432 + 34816);
    LAS float* ST = (LAS float*)(L + 19200 + 18432 + 18432 + 34816 + 4096);
    LAS float* CW = (LAS float*)(L + 19200 + 18432 + 18432 + 34816 + 4096 + 256);
    const bf16_t* gwT = (const bf16_t*)(ows(A.ws) + WS_GW);
    const float* conv_w = A.in[15]; const float* conv_b = A.in[16]; const float* ba = A.in[18]; const float* bx = A.in[20]; const float* lam = A.in[21];
    const int fr = lane & 15, fq = lane >> 4;
    const int stok = tid >> 3, sch = tid & 7;
    const int ch = tid & 31, sc = tid >> 5;
    const int otok = tid >> 2, oq = tid & 3;
    for (int u = blockIdx.x; u < 256; u += G) {
        const int b = u >> 5, hb = u & 31, hblk = hb >> 1, half = hb & 1, cin0 = hblk * 64, c0 = cin0 + half * 32;
#pragma unroll 1
        for (int dir = 0; dir < 2; ++dir) {
            LBAR();
            if (tid < 320) { const int k = tid >> 6, c = tid & 63; CW[tid] = (k < 4) ? conv_w[(size_t)(dir * 4 + k) * DM + cin0 + c] : conv_b[(size_t)dir * DM + cin0 + c]; }
            const int cbk = wave & 1;
            bf16x8 wr_[2], wi_[2];
            { const bf16_t* pr = gwT + ((size_t)((dir * 2 + 0) * 16 + hblk) * 64 + half * 32 + cbk * 16 + fr) * 64 + fq * 8;
              const bf16_t* pi = gwT + ((size_t)((dir * 2 + 1) * 16 + hblk) * 64 + half * 32 + cbk * 16 + fr) * 64 + fq * 8;
              wr_[0] = *(const bf16x8*)pr; wr_[1] = *(const bf16x8*)(pr + 32); wi_[0] = *(const bf16x8*)pi; wi_[1] = *(const bf16x8*)(pi + 32); }
            float eba[4], ebx[4], esp[4];
#pragma unroll
            for (int e = 0; e < 4; ++e) { const int c = dir * DM + c0 + cbk * 16 + 4 * fq + e; eba[e] = ba[c]; ebx[e] = bx[c];
                const float nl = -lam[c]; esp[e] = (fmaxf(nl, 0.f) + log1pf(__expf(-fabsf(nl)))) * (-8.0f * LOG2E); }
            if (tid < 32) ST[tid] = 0.f;
            u32x4 ur[2], uh = (u32x4){0u, 0u, 0u, 0u};
            { const int rowbase = ML + b * CTX;
#pragma unroll
              for (int i2 = 0; i2 < 2; ++i2) { const int S = stok + 64 * i2; const int row = rowbase + (dir ? CTX - 1 - S : S); ur[i2] = *(const u32x4*)(ACT + (size_t)row * LD + cin0 + sch * 8); } }
            f32x4 hf0 = (f32x4){0.f, 0.f, 0.f, 0.f}, hf1 = hf0; u32x4 gv = (u32x4){0u, 0u, 0u, 0u}; size_t orow = 0; int oseq = 0;
#define LRU_OUT() do { const f32x4 h0 = *(const LAS f32x4*)(XF + otok * 36 + oq * 8), h1 = *(const LAS f32x4*)(XF + otok * 36 + oq * 8 + 4); \
                if (dir == 0) { f32x4* hp = (f32x4*)(HF + ((size_t)u * 2304 + oseq) * 32 + oq * 8); hp[0] = h0; hp[1] = h1; } \
                else { const f32x4 s0 = h0 + hf0, s1 = h1 + hf1; u32x4 w; \
                    w.x = pk2(s0.x * bflo(gv.x), s0.y * bfhi(gv.x)); w.y = pk2(s0.z * bflo(gv.y), s0.w * bfhi(gv.y)); w.z = pk2(s1.x * bflo(gv.z), s1.y * bfhi(gv.z)); w.w = pk2(s1.z * bflo(gv.w), s1.w * bfhi(gv.w)); \
                    *(u32x4*)(Y + orow * DM + c0 + oq * 8) = w; } } while (0)
#pragma unroll 1
            for (int tl = 0; tl < 18; ++tl) {
                const int seg = tl < 2 ? 0 : 1, S0 = seg ? (tl - 2) * TT : tl * TT, seglen = seg ? SEQ : CTX, rowbase = seg ? b * SEQ : ML + b * CTX;
                LBAR();
                *(LAS u32x4*)(UL + (3 + stok) * USTR + sch * 16) = ur[0]; *(LAS u32x4*)(UL + (3 + 64 + stok) * USTR + sch * 16) = ur[1];
                if (tid < 24) *(LAS u32x4*)(UL + stok * USTR + sch * 16) = uh;
                if (tl > 0) LRU_OUT();
                LBAR();
                { const int S = S0 + otok; const int pos = dir ? seglen - 1 - S : S; orow = (size_t)(rowbase + pos); oseq = seg ? CTX + pos : pos;
                  if (dir == 1) { const f32x4* hp = (const f32x4*)(HF + ((size_t)u * 2304 + oseq) * 32 + oq * 8); hf0 = hp[0]; hf1 = hp[1]; gv = *(const u32x4*)(ACT + orow * LD + 1024 + c0 + oq * 8); } }
                if (tl + 1 < 18) { const int tn = tl + 1; const int seg2 = tn < 2 ? 0 : 1, S02 = seg2 ? (tn - 2) * TT : tn * TT, seglen2 = seg2 ? SEQ : CTX, rowbase2 = seg2 ? b * SEQ : ML + b * CTX;
#pragma unroll
                    for (int i2 = 0; i2 < 2; ++i2) { const int S = S02 + stok + 64 * i2; const int row = rowbase2 + (dir ? seglen2 - 1 - S : S); ur[i2] = *(const u32x4*)(ACT + (size_t)row * LD + cin0 + sch * 8); }
                    uh = (u32x4){0u, 0u, 0u, 0u};
                    if (tid < 24 && S02 > 0) { const int S = S02 - 3 + stok; const int row = rowbase2 + (dir ? seglen2 - 1 - S : S); uh = *(const u32x4*)(ACT + (size_t)row * LD + cin0 + sch * 8); } }
                for (int rep_ = 0; rep_ < DUP_LRUBC; ++rep_) {
                { float x0[8], x1[8];
                  { const f32x4 ca = *(const LAS f32x4*)(CW + 256 + sch * 8), cc = *(const LAS f32x4*)(CW + 256 + sch * 8 + 4);
                    x0[0] = ca.x; x0[1] = ca.y; x0[2] = ca.z; x0[3] = ca.w; x0[4] = cc.x; x0[5] = cc.y; x0[6] = cc.z; x0[7] = cc.w;
#pragma unroll
                    for (int e = 0; e < 8; ++e) x1[e] = x0[e]; }
#pragma unroll
                  for (int k = 0; k < 4; ++k) { const f32x4 wa = *(const LAS f32x4*)(CW + k * 64 + sch * 8), wb = *(const LAS f32x4*)(CW + k * 64 + sch * 8 + 4);
                      const u32x4 u0 = *(const LAS u32x4*)(UL + (stok + k) * USTR + sch * 16), u1 = *(const LAS u32x4*)(UL + (stok + 64 + k) * USTR + sch * 16);
                      x0[0] += wa.x * bflo(u0.x); x0[1] += wa.y * bfhi(u0.x); x0[2] += wa.z * bflo(u0.y); x0[3] += wa.w * bfhi(u0.y);
                      x0[4] += wb.x * bflo(u0.z); x0[5] += wb.y * bfhi(u0.z); x0[6] += wb.z * bflo(u0.w); x0[7] += wb.w * bfhi(u0.w);
                      x1[0] += wa.x * bflo(u1.x); x1[1] += wa.y * bfhi(u1.x); x1[2] += wa.z * bflo(u1.y); x1[3] += wa.w * bfhi(u1.y);
                      x1[4] += wb.x * bflo(u1.z); x1[5] += wb.y * bfhi(u1.z); x1[6] += wb.z * bflo(u1.w); x1[7] += wb.w * bfhi(u1.w); }
                  u32x4 w; w.x = pk2(x0[0], x0[1]); w.y = pk2(x0[2], x0[3]); w.z = pk2(x0[4], x0[5]); w.w = pk2(x0[6], x0[7]);
                  *(LAS u32x4*)(XA + stok * USTR + sch * 16) = w;
                  w.x = pk2(x1[0], x1[1]); w.y = pk2(x1[2], x1[3]); w.z = pk2(x1[4], x1[5]); w.w = pk2(x1[6], x1[7]);
                  *(LAS u32x4*)(XA + (stok + 64) * USTR + sch * 16) = w;
                  if ((sch >> 2) == half) { LAS f32x4* xf = (LAS f32x4*)(XF + stok * 36 + (sch & 3) * 8); xf[0] = (f32x4){x0[0], x0[1], x0[2], x0[3]}; xf[1] = (f32x4){x0[4], x0[5], x0[6], x0[7]};
                      xf = (LAS f32x4*)(XF + (stok + 64) * 36 + (sch & 3) * 8); xf[0] = (f32x4){x1[0], x1[1], x1[2], x1[3]}; xf[1] = (f32x4){x1[4], x1[5], x1[6], x1[7]}; } }
                LBAR();
#pragma unroll
                for (int i2 = 0; i2 < 2; ++i2) { const int tb = (wave >> 1) + 4 * i2; const int tok = tb * 16 + fr;
                    const bf16x8 x0 = *(const LAS bf16x8*)(XA + tok * USTR + fq * 16), x1 = *(const LAS bf16x8*)(XA + tok * USTR + 64 + fq * 16);
                    f32x4 ar = (f32x4){0.f, 0.f, 0.f, 0.f}, ai = (f32x4){0.f, 0.f, 0.f, 0.f};
                    ar = MFMA16(wr_[0], x0, ar); ar = MFMA16(wr_[1], x1, ar); ai = MFMA16(wi_[0], x0, ai); ai = MFMA16(wi_[1], x1, ai);
                    const f32x4 xv = *(const LAS f32x4*)(XF + tok * 36 + cbk * 16 + 4 * fq);
                    float av[4], bv[4];
#pragma unroll
                    for (int e = 0; e < 4; ++e) { const float r = __builtin_amdgcn_rcpf(1.0f + __builtin_amdgcn_exp2f(-(ar[e] + eba[e]) * LOG2E)); const float ig = __builtin_amdgcn_rcpf(1.0f + __builtin_amdgcn_exp2f(-(ai[e] + ebx[e]) * LOG2E));
                        const float a_ = __builtin_amdgcn_exp2f(r * esp[e]); av[e] = a_; bv[e] = __builtin_amdgcn_sqrtf(fmaxf(1.0f - a_ * a_, 0.f)) * (ig * xv[e]); }
                    LAS f32x4* ab = (LAS f32x4*)(AB + tok * 34 + cbk * 16 + 4 * fq); ab[0] = (f32x4){av[0], bv[0], av[1], bv[1]}; ab[1] = (f32x4){av[2], bv[2], av[3], bv[3]}; }
                LBAR();
                }
                float a8[8], b8[8];
                { float Ap = 1.f, H = 0.f;
#pragma unroll
                  for (int k = 0; k < 8; ++k) { const f32x2 v = AB[(sc * 8 + k) * 34 + ch]; a8[k] = v.x; b8[k] = v.y; H = v.x * H + v.y; Ap *= v.x; }
                  CAR[sc * 32 + ch] = (f32x2){Ap, H}; }
                LBAR();
                float hrun = ST[(tl & 1) * 32 + ch];
                { f32x2 cr[15];
#pragma unroll
                  for (int s = 0; s < 15; ++s) cr[s] = CAR[s * 32 + ch];
#pragma unroll
                  for (int s = 0; s < 15; ++s) hrun = (s < sc) ? cr[s].x * hrun + cr[s].y : hrun; }
#pragma unroll
                for (int k = 0; k < 8; ++k) { hrun = a8[k] * hrun + b8[k]; XF[(sc * 8 + k) * 36 + ch] = hrun; }
                if (sc == 15) ST[((tl + 1) & 1) * 32 + ch] = hrun;
            }
            LBAR();
            LRU_OUT();
            asm volatile("s_waitcnt vmcnt(0)" ::: "memory");
        }
        LBAR();
    }
#undef LRU_OUT
}

__device__ __forceinline__ void cu8(const bf16_t* ACT, size_t row, int col, float* o) {
    const u32x4 a = __builtin_nontemporal_load((const u32x4*)(ACT + row * 4096 + col)), c = __builtin_nontemporal_load((const u32x4*)(ACT + row * 4096 + 2048 + col));
    o[0] = bflo(a.x) * bflo(c.x); o[1] = bfhi(a.x) * bfhi(c.x); o[2] = bflo(a.y) * bflo(c.y); o[3] = bfhi(a.y) * bfhi(c.y);
    o[4] = bflo(a.z) * bflo(c.z); o[5] = bfhi(a.z) * bfhi(c.z); o[6] = bflo(a.w) * bflo(c.w); o[7] = bfhi(a.w) * bfhi(c.w);
}
__device__ __forceinline__ void phase_conv(const Args& A, const bf16_t* ACT, bf16_t* Y, const int wv) {
    const float* conv_w = A.in[27]; const float* conv_b = A.in[28];
    const int nitems = (MT / 8) * 128;
    const int tid = otid(wv);
    for (int item = blockIdx.x * NTHREADS + tid; item < nitems; item += gridDim.x * NTHREADS) {
        const int rg = item >> 7, chunk = item & 127, col = chunk * 8, row0 = rg * 8;
        const int seglen = row0 < ML ? SEQ : CTX;
        const bool first = (row0 % seglen) == 0, last = ((row0 + 8) % seglen) == 0;
        float w0[8], w1[8], w2[8], cb[8];
        { const f32x4* p = (const f32x4*)(conv_w + col); f32x4 a = p[0], c = p[1]; w0[0] = a.x; w0[1] = a.y; w0[2] = a.z; w0[3] = a.w; w0[4] = c.x; w0[5] = c.y; w0[6] = c.z; w0[7] = c.w;
          p = (const f32x4*)(conv_w + DM + col); a = p[0]; c = p[1]; w1[0] = a.x; w1[1] = a.y; w1[2] = a.z; w1[3] = a.w; w1[4] = c.x; w1[5] = c.y; w1[6] = c.z; w1[7] = c.w;
          p = (const f32x4*)(conv_w + 2 * DM + col); a = p[0]; c = p[1]; w2[0] = a.x; w2[1] = a.y; w2[2] = a.z; w2[3] = a.w; w2[4] = c.x; w2[5] = c.y; w2[6] = c.z; w2[7] = c.w;
          p = (const f32x4*)(conv_b + col); a = p[0]; c = p[1]; cb[0] = a.x; cb[1] = a.y; cb[2] = a.z; cb[3] = a.w; cb[4] = c.x; cb[5] = c.y; cb[6] = c.z; cb[7] = c.w; }
        float prev[8], cur[8], nxt[8];
        if (first) {
#pragma unroll
            for (int e = 0; e < 8; ++e) prev[e] = 0.f;
        } else cu8(ACT, (size_t)row0 - 1, col, prev);
        cu8(ACT, (size_t)row0, col, cur);
#pragma unroll
        for (int k = 0; k < 8; ++k) {
            const size_t row = (size_t)row0 + k;
            if (k == 7 && last) {
#pragma unroll
                for (int e = 0; e < 8; ++e) nxt[e] = 0.f;
            } else cu8(ACT, row + 1, col, nxt);
            const u32x4 bgw = __builtin_nontemporal_load((const u32x4*)(ACT + row * 4096 + 1024 + col)), sgw = __builtin_nontemporal_load((const u32x4*)(ACT + row * 4096 + 3072 + col));
            float y[8];
#pragma unroll
            for (int e = 0; e < 8; ++e) y[e] = w0[e] * prev[e] + w1[e] * cur[e] + w2[e] * nxt[e] + cb[e];
            y[0] *= bflo(bgw.x) * bflo(sgw.x); y[1] *= bfhi(bgw.x) * bfhi(sgw.x); y[2] *= bflo(bgw.y) * bflo(sgw.y); y[3] *= bfhi(bgw.y) * bfhi(sgw.y);
            y[4] *= bflo(bgw.z) * bflo(sgw.z); y[5] *= bfhi(bgw.z) * bfhi(sgw.z); y[6] *= bflo(bgw.w) * bflo(sgw.w); y[7] *= bfhi(bgw.w) * bfhi(sgw.w);
            u32x4 w; w.x = pk2(y[0], y[1]); w.y = pk2(y[2], y[3]); w.z = pk2(y[4], y[5]); w.w = pk2(y[6], y[7]);
            *(u32x4*)(Y + row * DM + col) = w;
#pragma unroll
            for (int e = 0; e < 8; ++e) { prev[e] = cur[e]; cur[e] = nxt[e]; }
        }
    }
}

__device__ __forceinline__ void phase_ctx_wout(const bf16_t* Yc, const bf16_t* Wt, const float* xin, float* xout, const float* gate, LAS unsigned char* L, const int wv) {
    constexpr int PITCH = 272, ABYTES = 128 * PITCH, BUFB = 192 * PITCH, NS = 8;
    const int tid = otid(wv), lane = tid & 63, r32 = lane & 31, hi = lane >> 5, wave = wv, G = gridDim.x;
    const int srow = tid >> 4, sch = tid & 15;
    const int aoff = ((wave >> 1) * 32 + r32) * PITCH + hi * 128, boff = ABYTES + ((wave & 1) * 32 + r32) * PITCH + hi * 128;
    for (int t = blockIdx.x; t < 256; t += G) {
        const int tm = t >> 4, tn = t & 15;
        const bf16_t* ga = Yc + (size_t)(tm * 128 + srow) * DM + sch * 8; const bf16_t* gb = Wt + (size_t)(tn * 64 + srow) * DM + sch * 8;
        f32x16 acc0, acc1;
#pragma unroll
        for (int r = 0; r < 16; ++r) { acc0[r] = 0.f; acc1[r] = 0.f; }
        u32x4 qa[3][4], qb[3][2];
#define CTX_LOAD(q, s_) do { _Pragma("unroll") for (int i = 0; i < 4; ++i) qa[q][i] = *(const u32x4*)(ga + (size_t)(32 * i) * DM + (s_) * 128); \
                             _Pragma("unroll") for (int i = 0; i < 2; ++i) qb[q][i] = *(const u32x4*)(gb + (size_t)(32 * i) * DM + (s_) * 128); } while (0)
#define CTX_WRITE(q, buf) do { LAS unsigned char* Bn = L + (buf) * BUFB; _Pragma("unroll") for (int i = 0; i < 4; ++i) *(LAS u32x4*)(Bn + (32 * i + srow) * PITCH + sch * 16) = qa[q][i]; \
                               _Pragma("unroll") for (int i = 0; i < 2; ++i) *(LAS u32x4*)(Bn + ABYTES + (32 * i + srow) * PITCH + sch * 16) = qb[q][i]; } while (0)
#define CTX_STEP(s_, q) do { const int s = (s_); LAS const unsigned char* B = L + (s & 1) * BUFB; bf16x8 a[8], b[8]; \
            _Pragma("unroll") for (int j = 0; j < 8; ++j) { a[j] = *(const LAS bf16x8*)(B + aoff + j * 16); b[j] = *(const LAS bf16x8*)(B + boff + j * 16); } \
            _Pragma("unroll") for (int j = 0; j < 8; j += 2) { acc0 = MFMA32(a[j], b[j], acc0); acc1 = MFMA32(a[j + 1], b[j + 1], acc1); } \
            if (s + 1 < NS) CTX_WRITE(q, (s + 1) & 1); \
            LBAR(); \
            if (s + 4 < NS) CTX_LOAD(q, s + 4); } while (0)
        CTX_LOAD(0, 0); CTX_LOAD(1, 1); CTX_LOAD(2, 2);
        LBAR();
        CTX_WRITE(0, 0);
        CTX_LOAD(0, 3);
        LBAR();
        CTX_STEP(0, 1); CTX_STEP(1, 2); CTX_STEP(2, 0); CTX_STEP(3, 1); CTX_STEP(4, 2); CTX_STEP(5, 0); CTX_STEP(6, 1); CTX_STEP(7, 2);
#undef CTX_LOAD
#undef CTX_WRITE
#undef CTX_STEP
        const int m0 = tm * 128 + (wave >> 1) * 32, col = tn * 64 + (wave & 1) * 32 + r32; const float gv = gate[col];
        float xv[16];
#pragma unroll
        for (int r = 0; r < 16; ++r) xv[r] = xin[(size_t)(m0 + crow(r, hi)) * DM + col];
#pragma unroll
        for (int r = 0; r < 16; ++r) xout[(size_t)(m0 + crow(r, hi)) * DM + col] = xv[r] + gv * (acc0[r] + acc1[r]);
    }
    LBAR();
}

__device__ __forceinline__ void phase_final(float* out, const float* g, const int wv) {
    const int tid = otid(wv); const int lane = tid & 63, gw = blockIdx.x * NWAVES + (tid >> 6), NGW = gridDim.x * NWAVES;
    f32x4 gv[4];
#pragma unroll
    for (int j = 0; j < 4; ++j) gv[j] = *((const f32x4*)g + 64 * j + lane);
    for (int row0 = gw * 4; row0 < ML; row0 += NGW * 4) {
        f32x4 v[4][4]; float s[4];
#pragma unroll
        for (int i = 0; i < 4; ++i) { const f32x4* xr = (const f32x4*)(out + (size_t)(row0 + i) * DM) + lane;
#pragma unroll
            for (int j = 0; j < 4; ++j) v[i][j] = __builtin_nontemporal_load(xr + 64 * j); }
#pragma unroll
        for (int i = 0; i < 4; ++i) { float a = 0.f;
#pragma unroll
            for (int j = 0; j < 4; ++j) a += (v[i][j].x * v[i][j].x + v[i][j].y * v[i][j].y) + (v[i][j].z * v[i][j].z + v[i][j].w * v[i][j].w);
            s[i] = a; }
#pragma unroll
        for (int o = 1; o < 64; o <<= 1) {
#pragma unroll
            for (int i = 0; i < 4; ++i) s[i] += __shfl_xor(s[i], o); }
#pragma unroll
        for (int i = 0; i < 4; ++i) { const float rstd = 1.0f / sqrtf(s[i] * (1.0f / DM) + EPS); f32x4* xr = (f32x4*)(out + (size_t)(row0 + i) * DM) + lane;
#pragma unroll
            for (int j = 0; j < 4; ++j) xr[64 * j] = v[i][j] * rstd * gv[j]; }
    }
}

#define RLX_AGENT __ATOMIC_RELAXED, __HIP_MEMORY_SCOPE_AGENT
#define XB_TMO      128
#define XB_XCNT(j)  (256  + 64 * (j))
#define XB_XSUB(j)  (1280 + 64 * (j))
#define XB_XGEN(j)  (2304 + 64 * (j))
#define XB_TOP      3328
#define XB_TOPGEN   3392
#define XCD_BAR_WORDS 3456
#define XB_SPIN_CAP (1u << 18)

__device__ __forceinline__ unsigned xb_ld(unsigned* p)              { return __hip_atomic_load(p, __ATOMIC_RELAXED, __HIP_MEMORY_SCOPE_AGENT); }
__device__ __forceinline__ unsigned xb_add(unsigned* p, unsigned v) { return __hip_atomic_fetch_add(p, v, __ATOMIC_RELAXED, __HIP_MEMORY_SCOPE_AGENT); }
__device__ __forceinline__ unsigned xb_xcc_id() { return (unsigned)__builtin_amdgcn_s_getreg((3 << 11) | 20) & 0xFu; }
#define XB_SPIN(cond, bar) do { unsigned _sp = 0; while (cond) { __builtin_amdgcn_s_sleep(1); \
    if ((++_sp & 255u) == 0u) { if (xb_ld(&(bar)[XB_TMO])) break; if (_sp > XB_SPIN_CAP) { atomicAdd(&(bar)[XB_TMO], 1u); break; } } } } while (0)

struct XcdBarrier {
    unsigned* bar; unsigned x;
    volatile LAS unsigned* st;
};

__device__ __forceinline__ XcdBarrier xcd_barrier_post(unsigned* bar, volatile LAS unsigned* st) {
    XcdBarrier b; b.bar = bar; b.x = xb_xcc_id(); b.st = st;
    if (threadIdx.x == 0) (void)xb_add(&bar[XB_XCNT(b.x)], 1u);
    return b;
}
__device__ __forceinline__ void xcd_barrier_complete(unsigned* bar, unsigned x, unsigned& nloc, unsigned& nx) {
    const unsigned G = gridDim.x * gridDim.y * gridDim.z;
    unsigned sum, cnt, mine, sp = 0u;
    for (;;) {
        sum = 0u; cnt = 0u; mine = 0u;
#pragma unroll
        for (unsigned j = 0; j < 16; ++j) { const unsigned c = xb_ld(&bar[XB_XCNT(j)]); sum += c; cnt += (c > 0u) ? 1u : 0u; mine = (j == x) ? c : mine; }
        if (sum == G) break;
        __builtin_amdgcn_s_sleep(1);
        if ((++sp & 255u) == 0u) { if (xb_ld(&bar[XB_TMO])) break; if (sp > XB_SPIN_CAP) { atomicAdd(&bar[XB_TMO], 1u); break; } }
    }
    nloc = mine > 0u ? mine : 1u; nx = cnt > 0u ? cnt : 1u;
}

__device__ __forceinline__ void xcd_barrier(const XcdBarrier& b) {
    asm volatile("s_waitcnt vmcnt(0)" ::: "memory");
    __syncthreads();
    if (threadIdx.x == 0) {
        unsigned* bar = b.bar;
        __builtin_amdgcn_s_waitcnt(0);
        unsigned nloc = b.st[0], nx = b.st[1];
        if (nloc == 0u) { xcd_barrier_complete(bar, b.x, nloc, nx); b.st[0] = nloc; b.st[1] = nx; }
        const unsigned old = xb_add(&bar[XB_XSUB(b.x)], 1u);
        const unsigned gen = old / nloc;
        if (old + 1u == (gen + 1u) * nloc) {
            __builtin_amdgcn_fence(__ATOMIC_RELEASE, "agent");
            asm volatile("s_waitcnt vmcnt(0)" ::: "memory");
            const unsigned og = xb_add(&bar[XB_TOP], 1u);
            const unsigned tg = og / nx;
            if (og + 1u == (tg + 1u) * nx) xb_add(&bar[XB_TOPGEN], 1u);
            else XB_SPIN(xb_ld(&bar[XB_TOPGEN]) == tg, bar);
            __builtin_amdgcn_fence(__ATOMIC_ACQUIRE, "agent");
            xb_add(&bar[XB_XGEN(b.x)], 1u);
            asm volatile("s_waitcnt vmcnt(0)" ::: "memory");
        } else {
            XB_SPIN(xb_ld(&bar[XB_XGEN(b.x)]) == gen, bar);
            __builtin_amdgcn_fence(__ATOMIC_ACQUIRE, "agent");
            asm volatile("s_waitcnt vmcnt(0)" ::: "memory");
        }
    }
    __syncthreads();
}

__global__ void __launch_bounds__(NTHREADS, 2) hybrid_fwd(Args A) {
    extern __shared__ __attribute__((aligned(16))) unsigned char lds[];
    cg::grid_group grid = cg::this_grid();
    LAS unsigned char* L = (LAS unsigned char*)lds;
    unsigned char* ws = A.ws;
    const int G = gridDim.x;
    float* XL = A.out; float* XC = (float*)(ws + WS_XC);
    bf16_t* XN = (bf16_t*)(ws + WS_XN); bf16_t* ACT = (bf16_t*)(ws + WS_ACT);
    const float* gatef = (const float*)(ws + WS_GATE);

    const int wv = __builtin_amdgcn_readfirstlane((int)threadIdx.x >> 6);
    volatile LAS unsigned* MISC = (volatile LAS unsigned*)(L + 131072 + 320);
    if (threadIdx.x < 32) MISC[threadIdx.x] = 0u;
    __syncthreads();
    XcdBarrier xbar = xcd_barrier_post((unsigned*)ws + 4096, MISC + 8);
#define GSYNC() xcd_barrier(xbar)
#pragma unroll 1
    for (int l = 0; l < 4; ++l) { phase_prep(A, L, l, (int)((blockIdx.x + 64 * l) % G), G, wv); LBAR(); }
    if (A.out == nullptr) grid.sync();
    for (int rep = 0; rep < DUP_SYNC; ++rep) GSYNC();
#pragma unroll 1
    for (int layer = 0; layer < 4; ++layer) {
        ws = ows(ws);
        const int kind = layer == 3 ? 0 : layer;
        const int Nin = kind == 0 ? 2560 : (kind == 1 ? 2048 : 4096);
        const float* xinL = layer == 0 ? A.in[0] : XL; const float* xinC = layer == 0 ? A.in[2] : XC;
        for (int rep = 0; rep < DUP_NORM; ++rep) phase_norm(A, layer, xinL, xinC, L, wv);
        GSYNC();
        {
            const bf16_t* Wt = (const bf16_t*)(ws + (layer == 0 ? WS_WIN[0] : layer == 1 ? WS_WIN[1] : layer == 2 ? WS_WIN[2] : WS_WIN[3]));
            pg8::Gemm g{XN, Wt, layer == 3 ? ML : MT, Nin, DM};
            pg8::OrderG S; S.so.init(layer == 3 ? ML : MT, Nin, G, (int)blockIdx.x); S.extra = layer == 3 ? 16 : 0;
            pg8::EpiIn E{ACT, Nin, kind, (const float*)(ws + WS_ROPE)};
            for (int rep = 0; rep < DUP_GIN; ++rep) pg8::gemm_phase<pg8::EpiIn, pg8::OrderG, true, true>(L, g, S, E, wv);
        }
        GSYNC();
        if (kind == 0) { for (int rep = 0; rep < DUP_ATTN; ++rep) phase_attn(ACT, XN, (layer == 0 ? A.in[9] : A.in[34]), layer == 0, L, wv); }
        else if (kind == 1) { for (int rep = 0; rep < DUP_LRU; ++rep) phase_lru(A, ACT, XN, (float*)(ws + WS_HF), L, wv); }
        else { for (int rep = 0; rep < DUP_CONV; ++rep) phase_conv(A, ACT, XN, wv); }
        GSYNC();
        {
            const bf16_t* Wt = (const bf16_t*)(ws + (layer == 0 ? WS_WOUT[0] : layer == 1 ? WS_WOUT[1] : layer == 2 ? WS_WOUT[2] : WS_WOUT[3]));
            const int Mo = (CTX_SMALL || layer == 3) ? ML : MT;
            pg8::Gemm g{XN, Wt, Mo, DM, DM};
            pg8::OrderG S; S.so.init(Mo, DM, G, (int)blockIdx.x); S.extra = 0;
            pg8::EpiRes E{xinL, xinC, XL, XC, gatef + (size_t)layer * 9 * 1024};
            const bool ctx_first = (blockIdx.x & 1) != 0;
#pragma unroll 1
            for (int step = 0; step < 2; ++step) {
                if ((step == 0) == ctx_first) { if (CTX_SMALL && layer < 3) phase_ctx_wout(XN + (size_t)ML * DM, Wt, xinC, XC, gatef + (size_t)(layer * 9 + 8) * 1024, L, wv); }
                else pg8::gemm_phase<pg8::EpiRes, pg8::OrderG, true, true>(L, g, S, E, wv);
            }
        }
        GSYNC();
    }
    phase_final(XL, A.in[35], wv);
}

extern "C" void kernel_launch(void* const* d_in, const int* in_sizes, int n_in, void* d_out, int out_size, void* d_ws, size_t ws_size, hipStream_t stream) {
    static int grid = 0;
    if (grid == 0) {
        if (n_in != 36 || out_size != ML * DM || ws_size < WS_END) { fprintf(stderr, "kernel_launch: unexpected shapes (n_in %d, out %d, ws %zu)\n", n_in, out_size, ws_size); grid = -1; return; }
        int dev = 0, cus = 0, per_cu = 0;
        hipGetDevice(&dev); hipDeviceGetAttribute(&cus, hipDeviceAttributeMultiprocessorCount, dev);
        if (hipFuncSetAttribute((const void*)hybrid_fwd, hipFuncAttributeMaxDynamicSharedMemorySize, LDS_BYTES) != hipSuccess) { fprintf(stderr, "kernel_launch: hipFuncSetAttribute failed\n"); grid = -1; return; }
        if (hipOccupancyMaxActiveBlocksPerMultiprocessor(&per_cu, (const void*)hybrid_fwd, NTHREADS, LDS_BYTES) != hipSuccess || per_cu < 1) { fprintf(stderr, "kernel_launch: occupancy query says %d\n", per_cu); per_cu = 1; }
        (void)hipGetLastError();
        grid = cus * (per_cu > 1 ? 1 : per_cu);
        if (grid > 256) grid = 256;
    }
    if (grid < 0) return;
    if (hipMemsetAsync(d_ws, 0, 65536, stream) != hipSuccess) { fprintf(stderr, "kernel_launch: memset failed\n"); return; }
    Args a{};
    for (int i = 0; i < 36; ++i) a.in[i] = (const float*)d_in[i];
    a.out = (float*)d_out; a.ws = (unsigned char*)d_ws;
    void* args[] = {&a};
    hipError_t e = hipLaunchCooperativeKernel((const void*)hybrid_fwd, dim3(grid), dim3(NTHREADS), args, LDS_BYTES, stream);
    if (e != hipSuccess) fprintf(stderr, "kernel_launch: cooperative launch failed: %s (grid %d)\n", hipGetErrorString(e), grid);
}
```

```cpp
#include <hip/hip_runtime.h>
#include <hip/hip_cooperative_groups.h>
#include <cstdio>
#include <cstdint>
namespace cg = cooperative_groups;

namespace pg8 {
#define PG8_LAS __attribute__((address_space(3)))
typedef unsigned short bf16_t;
typedef short bf16x8 __attribute__((ext_vector_type(8)));
typedef float f32x4 __attribute__((ext_vector_type(4)));
typedef unsigned u32x4 __attribute__((ext_vector_type(4)));
constexpr int BM = 256, BK = 64, HALF = 128, HTB = HALF * BK * 2  , STAGE_BYTES = 8 * HTB, NXCD = 8, WGM = 8;

__host__ __device__ __forceinline__ int lds_byte(int r, int c) { const int st = (r >> 4) * 2 + (c >> 5), rr = r & 15, cc = c & 31, ob = rr * 64 + cc * 2; return st * 1024 + (ob ^ (((ob >> 9) & 1) << 5)); }
__host__ __device__ __forceinline__ void stage_rc(int b, int& R, int& C) { const int st = b / 1024, sb = b % 1024, swz = sb ^ (((sb >> 9) & 1) << 5); R = (st >> 1) * 16 + swz / 64; C = (st & 1) * 32 + (swz % 64) / 2; }
__host__ __device__ __forceinline__ int perm32(int rho) { const int n = rho >> 4, i = rho & 15; return 8 * (i >> 2) + 4 * n + (i & 3); }

struct Unit { int pm, pn; };
struct Gemm { const bf16_t* A; const bf16_t* Bt; int M, N, K; };

struct StaticOrder {
    int nM, nN, nwg, G, c;
    __host__ __device__ void init(int M, int N, int G_, int c_) { nM = M / BM; nN = N / BM; nwg = nM * nN; G = G_; c = c_; }
    __host__ __device__ bool next(int i, Unit& u) const {
        const long L = (long)i * G + c; if (L >= nwg) return false;
        int wgid = (int)L; { const int q = nwg / NXCD, r = nwg % NXCD, xcd = wgid % NXCD, off = wgid / NXCD; wgid = (xcd < r ? xcd * (q + 1) : r * (q + 1) + (xcd - r) * q) + off; }
        const int nig = WGM * nN, gid = wgid / nig, fm = gid * WGM, gsz = (nM - fm) < WGM ? (nM - fm) : WGM;
        u.pm = fm + ((wgid % nig) % gsz); u.pn = (wgid % nig) / gsz; return true;
    }
    __device__ __forceinline__ void a_ready(const Unit&) const {}
    __device__ __forceinline__ void done(const Unit&) const {}
};

__device__ __forceinline__ unsigned cvt_pk_bf16(float lo, float hi) { unsigned r; asm volatile("v_cvt_pk_bf16_f32 %0, %1, %2" : "=v"(r) : "v"(lo), "v"(hi)); return r; }
typedef float f32x2 __attribute__((ext_vector_type(2)));
__device__ __forceinline__ float silu_f(float v) { return v * __builtin_amdgcn_rcpf(1.0f + __builtin_amdgcn_exp2f(-v * 1.4426950408889634f)); }
constexpr float QSCALE = 0.125f * 1.4426950408889634f;

struct OrderG {
    StaticOrder so; int extra;
    __device__ __forceinline__ bool next(int i, Unit& u) const {
        long L = (long)i * so.G + so.c; if (L < so.nwg) return so.next(i, u);
        L -= so.nwg; if (L >= extra) return false; u.pm = 64 + (int)(L >> 1); u.pn = 4 + (int)(L & 1); return true;
    }
    __device__ __forceinline__ void a_ready(const Unit&) const {}
    __device__ __forceinline__ void done(const Unit&) const {}
};

struct EpiIn {
    static constexpr bool PERM = true, AFTER_DRAIN = false;
    bf16_t* O; int ldc; int kind; const float* rope;
    __device__ __forceinline__ void operator()(const f32x4 (&acc)[2][2][4][2], const Unit& u, int wr, int wc, int fr, int fq) const {
        const int colt = u.pn * BM; const bool lat = u.pm < 64;
        int mode = 0; float sc = 1.f;
        if (kind == 0) { if (colt < 1024) { mode = lat ? 2 : 0; sc = QSCALE; } else if (colt < 1280) mode = lat ? 2 : 0; else if (colt < 1536) mode = 0; else mode = 1; }
        else if (kind == 1) mode = colt < 1024 ? 0 : 1;
        else mode = colt < 3072 ? 0 : 1;
        const int row0 = u.pm * BM + wr * 64 + fr; const int col0 = colt + wc * 32 + 8 * fq;
        const float sgn = (fq < 2) ? -1.f : 1.f;
#pragma unroll
        for (int ai = 0; ai < 2; ++ai)
#pragma unroll
            for (int m = 0; m < 4; ++m) {
                const int row = row0 + ai * HALF + m * 16;
                bf16_t* rowp = O + (size_t)row * ldc + col0;
                f32x4 cs[4];
                if (mode == 2) { const int l = row & 2047; const int p = (wc & 1) ? (l & 63) : (l >> 6); const f32x4* rp = (const f32x4*)(rope + (p * 16 + 8 * (fq & 1)) * 2);
                    cs[0] = rp[0]; cs[1] = rp[1]; cs[2] = rp[2]; cs[3] = rp[3]; }
#pragma unroll
                for (int bj = 0; bj < 2; ++bj) {
                    f32x4 v0 = acc[ai][bj][m][0], v1 = acc[ai][bj][m][1];
                    if (mode == 1) {
#pragma unroll
                        for (int e = 0; e < 4; ++e) { v0[e] = silu_f(v0[e]); v1[e] = silu_f(v1[e]); }
                    } else if (mode == 2) {
                        f32x4 p0, p1;
#pragma unroll
                        for (int e = 0; e < 4; ++e) { p0[e] = __shfl_xor(v0[e], 32); p1[e] = __shfl_xor(v1[e], 32); }
                        v0[0] = v0[0] * cs[0][0] + sgn * p0[0] * cs[0][1]; v0[1] = v0[1] * cs[0][2] + sgn * p0[1] * cs[0][3];
                        v0[2] = v0[2] * cs[1][0] + sgn * p0[2] * cs[1][1]; v0[3] = v0[3] * cs[1][2] + sgn * p0[3] * cs[1][3];
                        v1[0] = v1[0] * cs[2][0] + sgn * p1[0] * cs[2][1]; v1[1] = v1[1] * cs[2][2] + sgn * p1[1] * cs[2][3];
                        v1[2] = v1[2] * cs[3][0] + sgn * p1[2] * cs[3][1]; v1[3] = v1[3] * cs[3][2] + sgn * p1[3] * cs[3][3];
                    }
                    v0 = v0 * sc; v1 = v1 * sc;
                    u32x4 w; w.x = cvt_pk_bf16(v0[0], v0[1]); w.y = cvt_pk_bf16(v0[2], v0[3]); w.z = cvt_pk_bf16(v1[0], v1[1]); w.w = cvt_pk_bf16(v1[2], v1[3]);
                    *(u32x4*)(rowp + bj * HALF) = w;
                }
            }
    }
};

struct EpiRes {
    static constexpr bool PERM = true, AFTER_DRAIN = false;
    const float* inL; const float* inC; float* outL; float* outC; const float* gate;
    __device__ __forceinline__ void operator()(const f32x4 (&acc)[2][2][4][2], const Unit& u, int wr, int wc, int fr, int fq) const {
        const bool lat = u.pm < 64;
        const float* ib = lat ? inL + (size_t)u.pm * BM * 1024 : inC + (size_t)(u.pm - 64) * BM * 1024;
        float* ob = lat ? outL + (size_t)u.pm * BM * 1024 : outC + (size_t)(u.pm - 64) * BM * 1024;
        const float* g = gate + (lat ? (u.pm >> 3) : 8) * 1024;
        const int col0 = u.pn * BM + wc * 32 + 8 * fq;
        f32x4 gv[2][2];
#pragma unroll
        for (int bj = 0; bj < 2; ++bj)
#pragma unroll
            for (int n = 0; n < 2; ++n) gv[bj][n] = *(const f32x4*)(g + col0 + bj * HALF + n * 4);
#pragma unroll
        for (int ai = 0; ai < 2; ++ai)
#pragma unroll
            for (int mp = 0; mp < 2; ++mp) {
                f32x4 xv[2][2][2];
#pragma unroll
                for (int mm = 0; mm < 2; ++mm) { const size_t off = (size_t)(ai * HALF + wr * 64 + (2 * mp + mm) * 16 + fr) * 1024 + col0;
#pragma unroll
                    for (int bj = 0; bj < 2; ++bj)
#pragma unroll
                        for (int n = 0; n < 2; ++n) xv[mm][bj][n] = __builtin_nontemporal_load((const f32x4*)(ib + off + bj * HALF + n * 4)); }
#pragma unroll
                for (int mm = 0; mm < 2; ++mm) { const int m = 2 * mp + mm; const size_t off = (size_t)(ai * HALF + wr * 64 + m * 16 + fr) * 1024 + col0;
#pragma unroll
                    for (int bj = 0; bj < 2; ++bj)
#pragma unroll
                        for (int n = 0; n < 2; ++n) *(f32x4*)(ob + off + bj * HALF + n * 4) = xv[mm][bj][n] + gv[bj][n] * acc[ai][bj][m][n]; }
                asm volatile("" ::: "memory"); }
    }
};

template <class Epi, class Sched, bool ALIGN_EPI = false, bool SP2 = false>
__device__ __forceinline__ void gemm_phase(PG8_LAS unsigned char* lds, const Gemm g, const Sched& S, const Epi& E, const int wv_) {
    int tid_ = wv_ * 64 + (int)__builtin_amdgcn_mbcnt_hi(~0u, __builtin_amdgcn_mbcnt_lo(~0u, 0u)); asm volatile("" : "+v"(tid_));
    const int tid = tid_, wid = __builtin_amdgcn_readfirstlane(tid >> 6), lane = tid & 63, wr = wid >> 2, wc = wid & 3, fr = lane & 15, fq = lane >> 4;
    const int K = g.K, nt = K / BK;
    unsigned voffA[2], voffB[2];
#pragma unroll
    for (int i = 0; i < 2; ++i) { int R, C; stage_rc(tid * 16 + i * 8192, R, C); const int Rb = Epi::PERM ? ((R & ~31) + perm32(R & 31)) : R;
        voffA[i] = (unsigned)(R * K + C) * 2u; voffB[i] = (unsigned)(Rb * K + C) * 2u; }
    const size_t kstep = (size_t)(BK * 2);
    const size_t hstep = (size_t)HALF * K * 2;
    const size_t tstep = 2 * hstep;
    const unsigned ldsw = (unsigned)wid * 1024u;
    const int aoff = lds_byte(wr * 64 + fr, fq * 8), boff = lds_byte(wc * 32 + fr, fq * 8);
#define PG8_SA(b, h) (((b) * 2 + (h)) * HTB)
#define PG8_SB(b, h) ((4 + (b) * 2 + (h)) * HTB)
#define PG8_STAGE(bufoff, gbase, voff) do { _Pragma("unroll") for (int _i = 0; _i < 2; ++_i) \
        __builtin_amdgcn_global_load_lds((const unsigned*)((const char*)(gbase) + (voff)[_i]), (PG8_LAS unsigned*)(lds + (bufoff) + ldsw + _i * 8192), 16, 0, 0); } while (0)
#define PG8_LDA(dst, b, h) do { _Pragma("unroll") for (int m = 0; m < 4; ++m) _Pragma("unroll") for (int k = 0; k < 2; ++k) dst[m][k] = *(const PG8_LAS bf16x8*)(lds + PG8_SA(b, h) + aoff + m * 2048 + k * 1024); } while (0)
#define PG8_LDB(dst, b, h) do { _Pragma("unroll") for (int n = 0; n < 2; ++n) _Pragma("unroll") for (int k = 0; k < 2; ++k) dst[n][k] = *(const PG8_LAS bf16x8*)(lds + PG8_SB(b, h) + boff + n * 2048 + k * 1024); } while (0)
#define PG8_MMA(ai, bj, At, Bt) do { __builtin_amdgcn_s_setprio(1); _Pragma("unroll") for (int m = 0; m < 4; ++m) _Pragma("unroll") for (int n = 0; n < 2; ++n) _Pragma("unroll") for (int k = 0; k < 2; ++k) \
        acc[ai][bj][m][n] = __builtin_amdgcn_mfma_f32_16x16x32_bf16(Bt[n][k], At[m][k], acc[ai][bj][m][n], 0, 0, 0); __builtin_amdgcn_s_setprio(0); } while (0)
#define PG8_WAIT_V(n) asm volatile("s_waitcnt vmcnt(" #n ")" ::: "memory")
#define PG8_WAIT_L(n) asm volatile("s_waitcnt lgkmcnt(" #n ")" ::: "memory")
#define PG8_BAR __builtin_amdgcn_s_barrier()
#define PG8_SCHED __builtin_amdgcn_sched_barrier(0)
    Unit cur, nxt; int ui = 0;
    if (!S.next(0, cur)) return;
    f32x4 acc[2][2][4][2];
#pragma unroll
    for (int a = 0; a < 2; ++a)
#pragma unroll
        for (int b = 0; b < 2; ++b)
#pragma unroll
            for (int m = 0; m < 4; ++m)
#pragma unroll
                for (int n = 0; n < 2; ++n) acc[a][b][m][n] = (f32x4){0.f, 0.f, 0.f, 0.f};
    bf16x8 At[4][2], B0[2][2], B1[2][2];
    const char* cA = (const char*)g.A + (size_t)cur.pm * tstep; const char* cB = (const char*)g.Bt + (size_t)cur.pn * tstep;
    S.a_ready(cur);
    if constexpr (SP2) {
        PG8_STAGE(PG8_SB(0, 0), cB, voffB); PG8_STAGE(PG8_SB(0, 1), cB + hstep, voffB); PG8_STAGE(PG8_SA(0, 0), cA, voffA); PG8_STAGE(PG8_SA(0, 1), cA + hstep, voffA);
        if (wr == 1) PG8_BAR;
        PG8_WAIT_V(2); PG8_BAR;
        PG8_STAGE(PG8_SB(1, 0), cB + kstep, voffB); PG8_STAGE(PG8_SA(1, 0), cA + kstep, voffA); PG8_STAGE(PG8_SB(1, 1), cB + hstep + kstep, voffB);
        PG8_WAIT_V(6); PG8_BAR;
    } else {
        PG8_STAGE(PG8_SB(0, 0), cB, voffB); PG8_STAGE(PG8_SA(0, 0), cA, voffA); PG8_STAGE(PG8_SB(0, 1), cB + hstep, voffB); PG8_STAGE(PG8_SA(0, 1), cA + hstep, voffA);
        if (wr == 1) PG8_BAR;
        PG8_WAIT_V(4); PG8_BAR;
        PG8_STAGE(PG8_SB(1, 0), cB + kstep, voffB); PG8_STAGE(PG8_SA(1, 0), cA + kstep, voffA); PG8_STAGE(PG8_SB(1, 1), cB + hstep + kstep, voffB);
        PG8_WAIT_V(6); PG8_BAR;
    }
    for (;;) {
        const bool has_next = S.next(ui + 1, nxt);
        const char* nA = has_next ? (const char*)g.A + (size_t)nxt.pm * tstep : cA; const char* nB = has_next ? (const char*)g.Bt + (size_t)nxt.pn * tstep : cB;
        for (int t = 0; t < nt; t += 2) {
            const bool last = (t == nt - 2);
            const char* a1 = cA + (size_t)(t + 1) * kstep;
            const char* a2 = last ? nA : cA + (size_t)(t + 2) * kstep; const char* b2 = last ? nB : cB + (size_t)(t + 2) * kstep;
            const char* a3 = a2 + kstep; const char* b3 = b2 + kstep;
            if (last && has_next) S.a_ready(nxt);
            if constexpr (SP2) {
            PG8_LDB(B0, 0, 0); PG8_LDB(B1, 0, 1); PG8_SCHED; PG8_LDA(At, 0, 0); PG8_STAGE(PG8_SA(1, 1), a1 + hstep, voffA);
            PG8_WAIT_V(8); PG8_WAIT_L(0); PG8_BAR; PG8_MMA(0, 0, At, B0); PG8_MMA(0, 1, At, B1); PG8_BAR; PG8_SCHED;
            PG8_LDA(At, 0, 1); PG8_STAGE(PG8_SB(0, 0), b2, voffB); PG8_STAGE(PG8_SB(0, 1), b2 + hstep, voffB); PG8_STAGE(PG8_SA(0, 0), a2, voffA);
            PG8_WAIT_V(8); PG8_WAIT_L(0); PG8_BAR; PG8_MMA(1, 0, At, B0); PG8_MMA(1, 1, At, B1); PG8_BAR; PG8_SCHED;
            PG8_LDB(B0, 1, 0); PG8_LDB(B1, 1, 1); PG8_SCHED; PG8_LDA(At, 1, 0); PG8_STAGE(PG8_SA(0, 1), a2 + hstep, voffA);
            PG8_WAIT_V(8); PG8_WAIT_L(0); PG8_BAR; PG8_MMA(0, 0, At, B0); PG8_MMA(0, 1, At, B1); PG8_BAR; PG8_SCHED;
            PG8_LDA(At, 1, 1); PG8_STAGE(PG8_SB(1, 0), b3, voffB); PG8_STAGE(PG8_SB(1, 1), b3 + hstep, voffB); PG8_STAGE(PG8_SA(1, 0), a3, voffA);
            PG8_WAIT_V(8); PG8_WAIT_L(0); PG8_BAR; PG8_MMA(1, 0, At, B0); PG8_MMA(1, 1, At, B1); PG8_BAR; PG8_SCHED;
            } else {
            PG8_LDB(B0, 0, 0); PG8_SCHED; PG8_LDA(At, 0, 0); PG8_STAGE(PG8_SA(1, 1), a1 + hstep, voffA);
            PG8_WAIT_L(8); PG8_BAR; PG8_WAIT_L(0); PG8_MMA(0, 0, At, B0); PG8_BAR; PG8_SCHED;
            PG8_LDB(B1, 0, 1); PG8_STAGE(PG8_SB(0, 0), b2, voffB);
            PG8_BAR; PG8_WAIT_L(0); PG8_MMA(0, 1, At, B1); PG8_BAR;
            PG8_LDA(At, 0, 1); PG8_STAGE(PG8_SA(0, 0), a2, voffA);
            PG8_BAR; PG8_WAIT_L(0); PG8_MMA(1, 0, At, B0); PG8_BAR; PG8_SCHED;
            PG8_STAGE(PG8_SB(0, 1), b2 + hstep, voffB);
            PG8_WAIT_V(6); PG8_BAR; PG8_MMA(1, 1, At, B1); PG8_BAR;
            PG8_LDB(B0, 1, 0); PG8_SCHED; PG8_LDA(At, 1, 0); PG8_STAGE(PG8_SA(0, 1), a2 + hstep, voffA);
            PG8_WAIT_L(8); PG8_BAR; PG8_WAIT_L(0); PG8_MMA(0, 0, At, B0); PG8_BAR; PG8_SCHED;
            PG8_LDB(B1, 1, 1); PG8_STAGE(PG8_SB(1, 0), b3, voffB);
            PG8_BAR; PG8_WAIT_L(0); PG8_MMA(0, 1, At, B1); PG8_BAR;
            PG8_LDA(At, 1, 1); PG8_STAGE(PG8_SA(1, 0), a3, voffA);
            PG8_BAR; PG8_WAIT_L(0); PG8_MMA(1, 0, At, B0); PG8_BAR; PG8_SCHED;
            PG8_STAGE(PG8_SB(1, 1), b3 + hstep, voffB);
            PG8_WAIT_V(6); PG8_BAR; PG8_MMA(1, 1, At, B1); PG8_BAR;
            }
        }
        if constexpr (ALIGN_EPI) { if (wr == 0) PG8_BAR; }
        if constexpr (!Epi::AFTER_DRAIN) { E(acc, cur, wr, wc, fr, fq); S.done(cur); }
        if (!has_next) break;
#pragma unroll
        for (int a = 0; a < 2; ++a)
#pragma unroll
            for (int b = 0; b < 2; ++b)
#pragma unroll
                for (int m = 0; m < 4; ++m)
#pragma unroll
                    for (int n = 0; n < 2; ++n) acc[a][b][m][n] = (f32x4){0.f, 0.f, 0.f, 0.f};
        cur = nxt; cA = nA; cB = nB; ++ui;
        if constexpr (ALIGN_EPI) { if (wr == 1) PG8_BAR; }
    }
    PG8_WAIT_V(0);
    if constexpr (!ALIGN_EPI) { if (wr == 0) PG8_BAR; }
    PG8_BAR;
    if constexpr (Epi::AFTER_DRAIN) { E.fused(acc, cur, wr, wc, fr, fq, lds, wid, lane); S.done(cur); }
#undef PG8_SA
#undef PG8_SB
#undef PG8_STAGE
#undef PG8_LDA
#undef PG8_LDB
#undef PG8_MMA
#undef PG8_WAIT_V
#undef PG8_WAIT_L
#undef PG8_BAR
#undef PG8_SCHED
}
}

#define LAS __attribute__((address_space(3)))
typedef unsigned short bf16_t;
typedef short bf16x8 __attribute__((ext_vector_type(8)));
typedef short s16x4 __attribute__((ext_vector_type(4)));
typedef float f32x4 __attribute__((ext_vector_type(4)));
typedef float f32x2 __attribute__((ext_vector_type(2)));
typedef float f32x16 __attribute__((ext_vector_type(16)));
typedef unsigned u32x4 __attribute__((ext_vector_type(4)));
typedef unsigned u32x2 __attribute__((ext_vector_type(2)));

#ifndef DUP_ATTN
#define DUP_ATTN 1
#endif
#ifndef DUP_LRU
#define DUP_LRU 1
#endif
#ifndef DUP_CONV
#define DUP_CONV 1
#endif
#ifndef DUP_GIN
#define DUP_GIN 1
#endif
#ifndef DUP_NORM
#define DUP_NORM 1
#endif
#ifndef DUP_PRO
#define DUP_PRO 1
#endif
#ifndef DUP_GOUT0
#define DUP_GOUT0 1
#endif
#ifndef DUP_LRUBC
#define DUP_LRUBC 1
#endif
#ifndef DUP_ATTEPI
#define DUP_ATTEPI 1
#endif
#ifndef DUP_SYNC
#define DUP_SYNC 1
#endif
#ifndef CTX_SMALL
#define CTX_SMALL 1
#endif
constexpr int NTHREADS = 512, NWAVES = 8;
constexpr int DM = 1024, NB = 8, SEQ = 2048, CTX = 256;
constexpr int ML = NB * SEQ, MC = NB * CTX, MT = ML + MC;
constexpr float EPS = 1e-6f, LOG2E = 1.4426950408889634f;
constexpr int LDS_BYTES = 147456;

constexpr size_t MiB = 1u << 20;
constexpr size_t WS_MODP = 1 * MiB;
constexpr size_t WS_GATE = 5 * MiB;
constexpr size_t WS_ROPE = 5 * MiB + 512 * 1024;
constexpr size_t WS_GW = 6 * MiB;
constexpr size_t WS_WIN[4] = {8 * MiB, 15 * MiB, 21 * MiB, 31 * MiB};
constexpr size_t WS_WOUT[4] = {13 * MiB, 19 * MiB, 29 * MiB, 36 * MiB};
constexpr size_t WS_XC = 38 * MiB;
constexpr size_t WS_XN = 46 * MiB;
constexpr size_t WS_ACT = 82 * MiB;
constexpr size_t WS_HF = 154 * MiB;
constexpr size_t WS_END = 226 * MiB;

struct Args { const float* in[36]; float* out; unsigned char* ws; };

#define LBAR() do { asm volatile("s_waitcnt lgkmcnt(0)" ::: "memory"); __builtin_amdgcn_s_barrier(); asm volatile("" ::: "memory"); } while (0)

__device__ __forceinline__ unsigned f2bf(float f) { unsigned u = __builtin_bit_cast(unsigned, f); return (u + 0x7fffu + ((u >> 16) & 1u)) >> 16; }
__device__ __forceinline__ unsigned pk2(float lo, float hi) { return pg8::cvt_pk_bf16(lo, hi); }
__device__ __forceinline__ float bflo(unsigned w) { return __builtin_bit_cast(float, w << 16); }
__device__ __forceinline__ float bfhi(unsigned w) { return __builtin_bit_cast(float, w & 0xffff0000u); }
__device__ __forceinline__ unsigned char* ows(unsigned char* p) { unsigned long long v = (unsigned long long)p; asm volatile("" : "+s"(v)); return (unsigned char*)(__attribute__((address_space(1))) unsigned char*)v; }
__device__ __forceinline__ int otid(int wv) { int t = wv * 64 + (int)__builtin_amdgcn_mbcnt_hi(~0u, __builtin_amdgcn_mbcnt_lo(~0u, 0u)); asm volatile("" : "+v"(t)); return t; }
__device__ __forceinline__ float wave_sum(float v) {
#pragma unroll
    for (int o = 1; o < 64; o <<= 1) v += __shfl_xor(v, o);
    return v;
}
using pg8::silu_f;

__device__ __forceinline__ void transpose_item(const float* W, int K, int N, bf16_t* WT, LAS float* scr, int item, int lane) {
    const int nblk = N / 32, kb = item / nblk, nb = item % nblk, k0 = 64 * kb, n0 = 32 * nb;
    float tv[32];
#pragma unroll
    for (int i = 0; i < 32; ++i) tv[i] = __builtin_nontemporal_load(W + (size_t)(k0 + 2 * i + (lane >> 5)) * N + n0 + (lane & 31));
#pragma unroll
    for (int i = 0; i < 32; ++i) scr[(2 * i + (lane >> 5)) * 33 + (lane & 31)] = tv[i];
    asm volatile("s_waitcnt lgkmcnt(0)" ::: "memory");
    const int c = lane & 7;
#pragma unroll
    for (int j = 0; j < 4; ++j) { const int n = (lane >> 3) + 8 * j; const LAS float* s = scr + (8 * c) * 33 + n;
        u32x4 o; o.x = pk2(s[0 * 33], s[1 * 33]); o.y = pk2(s[2 * 33], s[3 * 33]); o.z = pk2(s[4 * 33], s[5 * 33]); o.w = pk2(s[6 * 33], s[7 * 33]);
        *(u32x4*)(WT + (size_t)(n0 + n) * K + k0 + 8 * c) = o; }
    asm volatile("s_waitcnt lgkmcnt(0)" ::: "memory");
}

__device__ __forceinline__ void phase_prep(const Args& A, LAS unsigned char* L, int layer, int vbid, int vG, const int wv) {
    const int tid = otid(wv), lane = tid & 63, wave = tid >> 6;
    unsigned char* ws = A.ws;
    const float* Wm = (layer == 0 ? A.in[5] : layer == 1 ? A.in[11] : layer == 2 ? A.in[23] : A.in[30]);
    for (int task = vbid; task < 48; task += vG) {
        const int cc = task >> 3, kc = task & 7;
        const int col = cc * 512 + tid;
        const float* wp = Wm + (size_t)(kc * 128) * 3072 + col;
        float wv_[128];
#pragma unroll
        for (int kk = 0; kk < 128; ++kk) wv_[kk] = __builtin_nontemporal_load(wp + (size_t)kk * 3072);
        LAS float* s = (LAS float*)L;
        for (int idx = tid; idx < 9 * 128; idx += NTHREADS) { const int r = idx >> 7, kk = idx & 127;
            const float v = (r < 8) ? A.in[1][r * DM + kc * 128 + kk] : A.in[3][kc * 128 + kk];
            s[idx] = v / (1.0f + __expf(-v)); }
        LBAR();
        float acc[9];
#pragma unroll
        for (int r = 0; r < 9; ++r) acc[r] = 0.f;
#pragma unroll
        for (int kk = 0; kk < 128; ++kk) { const float w = wv_[kk];
#pragma unroll
            for (int r = 0; r < 9; ++r) acc[r] += s[r * 128 + kk] * w; }
        float* mp = (float*)(ws + WS_MODP) + (size_t)((layer * 8 + kc) * 9) * 3072 + col;
#pragma unroll
        for (int r = 0; r < 9; ++r) mp[(size_t)r * 3072] = acc[r];
        LBAR();
    }
    if (layer == 0 && vbid == vG - 1) {
        float* rt = (float*)(ws + WS_ROPE);
        for (int idx = tid; idx < 1024; idx += NTHREADS) { const int p = idx >> 4, j = idx & 15;
            const float inv = 1.0f / __builtin_powf(10000.0f, (float)j * (1.0f / 16.0f));
            const float ang = (float)p * inv; float t = ang * 0.15915494309189535f; t -= __builtin_rintf(t);
            rt[idx * 2] = __builtin_amdgcn_cosf(t); rt[idx * 2 + 1] = __builtin_amdgcn_sinf(t); }
    }
    LAS float* scr = (LAS float*)(L + wave * 16384);
    const int rb = (vbid + vG - (48 % vG)) % vG;
    const int gw = rb * NWAVES + wave, NGW = vG * NWAVES;
    const int Nin = (layer == 0 || layer == 3) ? 2560 : (layer == 1 ? 2048 : 4096);
    const float* win = (layer == 0 ? A.in[7] : layer == 1 ? A.in[13] : layer == 2 ? A.in[25] : A.in[32]);
    const float* wout = (layer == 0 ? A.in[8] : layer == 1 ? A.in[14] : layer == 2 ? A.in[26] : A.in[33]);
    bf16_t* wint = (bf16_t*)(ws + (layer == 0 ? WS_WIN[0] : layer == 1 ? WS_WIN[1] : layer == 2 ? WS_WIN[2] : WS_WIN[3]));
    bf16_t* woutt = (bf16_t*)(ws + (layer == 0 ? WS_WOUT[0] : layer == 1 ? WS_WOUT[1] : layer == 2 ? WS_WOUT[2] : WS_WOUT[3]));
    const int IIN = 16 * (Nin / 32), IO = 16 * 32, IGW = layer == 0 ? 64 * 2 : 0;
    const int nitems = IIN + IO + IGW;
    for (int it = gw; it < nitems; it += NGW) {
        int r = it;
        if (r < IIN) { transpose_item(win, 1024, Nin, wint, scr, r, lane); continue; } r -= IIN;
        if (r < IO) { transpose_item(wout, 1024, 1024, woutt, scr, r, lane); continue; } r -= IO;
        { const int blk = r >> 1, sub = r & 1;
          const int dir = blk >> 5, gate = (blk >> 4) & 1, h = blk & 15;
          const float* src = (gate == 0 ? A.in[17] : A.in[19]) + (size_t)(dir * 16 + h) * 4096;
          transpose_item(src, 64, 64, (bf16_t*)(ws + WS_GW) + (size_t)blk * 4096, scr, sub, lane); }
    }
}

template <int NR> __device__ __forceinline__ void norm_load(const float* const (&xrow)[NR], f32x4 (&v)[NR][4], int lane) {
#pragma unroll
    for (int i = 0; i < NR; ++i) { const f32x4* xr = (const f32x4*)xrow[i] + lane;
#pragma unroll
        for (int j = 0; j < 4; ++j) v[i][j] = __builtin_nontemporal_load(xr + 64 * j); }
}
template <int NR> __device__ __forceinline__ void norm_proc(const f32x4 (&v)[NR][4], bf16_t* const (&orow)[NR], const LAS float* const (&gs)[NR], const LAS float* const (&sh)[NR], int lane) {
    float s[NR];
#pragma unroll
    for (int i = 0; i < NR; ++i) { float a = 0.f;
#pragma unroll
        for (int j = 0; j < 4; ++j) a += (v[i][j].x * v[i][j].x + v[i][j].y * v[i][j].y) + (v[i][j].z * v[i][j].z + v[i][j].w * v[i][j].w);
        s[i] = a; }
#pragma unroll
    for (int o = 1; o < 64; o <<= 1) {
#pragma unroll
        for (int i = 0; i < NR; ++i) s[i] += __shfl_xor(s[i], o); }
#pragma unroll
    for (int i = 0; i < NR; ++i) { const float rstd = 1.0f / sqrtf(s[i] * (1.0f / DM) + EPS); u32x2* o8 = (u32x2*)orow[i] + lane;
#pragma unroll
        for (int j = 0; j < 4; ++j) { const f32x4 g = *(const LAS f32x4*)(gs[i] + 256 * j + 4 * lane), b = *(const LAS f32x4*)(sh[i] + 256 * j + 4 * lane);
            const f32x4 y = v[i][j] * rstd * g + b; u32x2 w; w.x = pk2(y.x, y.y); w.y = pk2(y.z, y.w); o8[64 * j] = w; } }
}
__device__ __forceinline__ void phase_norm(const Args& A, int layer, const float* xL, const float* xC, LAS unsigned char* L, const int wv) {
    const int tid = otid(wv), lane = tid & 63, wave = tid >> 6, bid = blockIdx.x, G = gridDim.x;
    const float* norm_g = (layer == 0 ? A.in[4] : layer == 1 ? A.in[10] : layer == 2 ? A.in[22] : A.in[29]);
    const float* mod_b = (layer == 0 ? A.in[6] : layer == 1 ? A.in[12] : layer == 2 ? A.in[24] : A.in[31]);
    unsigned char* ws = ows(A.ws);
    const float* modp = (const float*)(ws + WS_MODP) + (size_t)(layer * 8) * 9 * 3072;
    bf16_t* XN = (bf16_t*)(ws + WS_XN);
    LAS float* tab = (LAS float*)L;
    for (int vb = bid; vb < 256; vb += G) {
        const int batch = vb >> 5;
        const float* xr[3][3]; bf16_t* orow[3][3]; const LAS float* gs[3][3]; const LAS float* sh[3][3];
#pragma unroll
          for (int bt = 0; bt < 3; ++bt)
#pragma unroll
            for (int i = 0; i < 3; ++i) { const int ri = bt * 3 + i;
                if (ri < 8) { const int row = vb * 64 + wave * 8 + ri; xr[bt][i] = xL + (size_t)row * DM; orow[bt][i] = XN + (size_t)row * DM; gs[bt][i] = tab; sh[bt][i] = tab + 1024; }
                else { const int row = vb * 8 + wave; xr[bt][i] = xC + (size_t)row * DM; orow[bt][i] = XN + (size_t)(ML + row) * DM; gs[bt][i] = tab + 2048; sh[bt][i] = tab + 3072; } }
          f32x4 va[3][4], vbb[3][4];
          norm_load<3>(xr[0], va, lane);
        { float bv[8], pv[8][8], gn[8];
#pragma unroll
          for (int i8 = 0; i8 < 8; ++i8) { const int idx = tid + i8 * NTHREADS; const int which = idx >> 10, col = idx & 1023; const int r = (which < 2) ? batch : 8; const int mcol = (which & 1) ? col : 1024 + col;
              bv[i8] = mod_b[mcol];
#pragma unroll
              for (int kc = 0; kc < 8; ++kc) pv[i8][kc] = modp[(size_t)(kc * 9 + r) * 3072 + mcol];
              gn[i8] = (which & 1) ? 0.f : norm_g[col]; }
#pragma unroll
          for (int i8 = 0; i8 < 8; ++i8) { const int idx = tid + i8 * NTHREADS; const int which = idx >> 10;
              float v = bv[i8];
#pragma unroll
              for (int kc = 0; kc < 8; ++kc) v += pv[i8][kc];
              if (!(which & 1)) v = gn[i8] * (1.0f + v);
              tab[idx] = v; } }
        if (vb < 9) { float* gf = (float*)(ws + WS_GATE) + (size_t)(layer * 9 + vb) * 1024;
            float gb[2], gp[2][8];
#pragma unroll
            for (int c2 = 0; c2 < 2; ++c2) { const int col = tid + c2 * NTHREADS; gb[c2] = mod_b[2048 + col];
#pragma unroll
                for (int kc = 0; kc < 8; ++kc) gp[c2][kc] = modp[(size_t)(kc * 9 + vb) * 3072 + 2048 + col]; }
#pragma unroll
            for (int c2 = 0; c2 < 2; ++c2) { float v = gb[c2];
#pragma unroll
                for (int kc = 0; kc < 8; ++kc) v += gp[c2][kc];
                gf[tid + c2 * NTHREADS] = v; } }
        norm_load<3>(xr[1], vbb, lane);
        LBAR();
        {
          norm_proc<3>(va, orow[0], gs[0], sh[0], lane);
          norm_load<3>(xr[2], va, lane);
          norm_proc<3>(vbb, orow[1], gs[1], sh[1], lane);
          norm_proc<3>(va, orow[2], gs[2], sh[2], lane); }
        LBAR();
    }
}

#define MFMA32(a, b, c) __builtin_amdgcn_mfma_f32_32x32x16_bf16((a), (b), (c), 0, 0, 0)
#define MFMA16(a, b, c) __builtin_amdgcn_mfma_f32_16x16x32_bf16((a), (b), (c), 0, 0, 0)
__device__ __forceinline__ int crow(int r, int hi) { return (r & 3) + 8 * (r >> 2) + 4 * hi; }
typedef short v4i16_t __attribute__((ext_vector_type(4)));
__device__ __forceinline__ float max3f(float a, float b, float c) { float r; asm("v_max3_f32 %0, %1, %2, %3" : "=v"(r) : "v"(a), "v"(b), "v"(c)); return r; }
__device__ __forceinline__ s16x4 vtr(LAS const unsigned char* p) { return __builtin_bit_cast(s16x4, __builtin_amdgcn_ds_read_tr16_b64_v4i16((LAS v4i16_t*)p)); }

__device__ __forceinline__ void phase_attn(const bf16_t* ACT, bf16_t* Y, const float* sink, bool need_ctx, LAS unsigned char* L, const int wv) {
    constexpr int LD = 2560, KSTR = 144, TILEB = 64 * KSTR, BUFB = 2 * TILEB;
    const int tid = otid(wv), lane = tid & 63, r32 = lane & 31, hi = lane >> 5, wave = __builtin_amdgcn_readfirstlane(tid >> 6);
    const int g = wave >> 1, half = wave & 1, G = gridDim.x;
    const int skey = tid >> 3, sch = tid & 7;
    const int stoff = skey * KSTR + sch * 16;
    const int koff = r32 * KSTR + hi * 16;
    const int voff = TILEB + (4 * hi + ((lane & 15) >> 2)) * KSTR + (16 * ((lane >> 4) & 1) + 4 * (lane & 3)) * 2;
    const int nunits = need_ctx ? 1152 : 1024;
    for (int u = blockIdx.x; u < nunits; u += G) {
        int b, kvh, qb; bool lat;
        if (u < 1024) { b = u >> 7; kvh = (u >> 5) & 3; qb = u & 31; lat = true; } else { const int e = u - 1024; b = e >> 4; kvh = (e >> 2) & 3; qb = e & 3; lat = false; }
        const int h = kvh * 4 + g;
        const int qpos = qb * 64 + half * 32 + r32;
        const int qrow = lat ? b * SEQ + qpos : ML + b * CTX + qpos;
        int tlo = 4, thi = 4;
        if (lat) { tlo = qb == 0 ? 6 : (qb == 1 ? 5 : 4); thi = qb == 31 ? 7 : (qb == 30 ? 8 : 9); }
        const int n = 4 + (thi - tlo);
        const int kp_base = qb * 64 - 128;
        bf16x8 qf[4];
        { const bf16_t* qp = ACT + (size_t)qrow * LD + h * 64 + hi * 8;
#pragma unroll
          for (int d0 = 0; d0 < 4; ++d0) qf[d0] = *(const bf16x8*)(qp + d0 * 16); }
        float m_run = sink[h] * LOG2E, l_run = hi ? 0.f : 1.f;
        f32x16 o0, o1;
#pragma unroll
        for (int r = 0; r < 16; ++r) { o0[r] = 0.f; o1[r] = 0.f; }
        const size_t kcol = 1024 + kvh * 64 + sch * 8, vcol = 1280 + kvh * 64 + sch * 8;
#define ATT_TROW(s_) (((s_) < 4 ? ML + b * CTX + (s_) * 64 : b * SEQ + kp_base + (tlo + (s_) - 8) * 64) + skey)
        u32x4 kq0, vq0, kq1, vq1, kq2, vq2;
        { const size_t krow = (size_t)ATT_TROW(0); kq0 = *(const u32x4*)(ACT + krow * LD + kcol); vq0 = *(const u32x4*)(ACT + krow * LD + vcol); }
        { const size_t krow = (size_t)ATT_TROW(1); kq1 = *(const u32x4*)(ACT + krow * LD + kcol); vq1 = *(const u32x4*)(ACT + krow * LD + vcol); }
        { const size_t krow = (size_t)ATT_TROW(2); kq2 = *(const u32x4*)(ACT + krow * LD + kcol); vq2 = *(const u32x4*)(ACT + krow * LD + vcol); }
        LBAR();
        *(LAS u32x4*)(L + stoff) = kq0; *(LAS u32x4*)(L + TILEB + stoff) = vq0;
        { const size_t krow = (size_t)ATT_TROW(3); kq0 = *(const u32x4*)(ACT + krow * LD + kcol); vq0 = *(const u32x4*)(ACT + krow * LD + vcol); }
        LBAR();
#define ATT_STEP(s_, KQ, VQ) do { const int s = (s_); \
            const int t = s < 4 ? s : tlo + (s - 4); \
            LAS const unsigned char* B = L + (s & 1) * BUFB; \
 \
              \
            bf16x8 kf[8]; s16x4 vl[8], vh[8]; \
_Pragma("unroll") \
            for (int d0 = 0; d0 < 4; ++d0) { kf[2 * d0] = *(const LAS bf16x8*)(B + koff + d0 * 32); kf[2 * d0 + 1] = *(const LAS bf16x8*)(B + koff + 32 * KSTR + d0 * 32); } \
_Pragma("unroll") \
            for (int i = 0; i < 4; ++i) { LAS const unsigned char* vp = B + voff + i * 16 * KSTR; vl[2 * i] = vtr(vp); vh[2 * i] = vtr(vp + 8 * KSTR); vl[2 * i + 1] = vtr(vp + 64); vh[2 * i + 1] = vtr(vp + 8 * KSTR + 64); } \
            __builtin_amdgcn_sched_barrier(0); \
            f32x16 p0, p1; \
_Pragma("unroll") \
            for (int r = 0; r < 16; ++r) { p0[r] = 0.f; p1[r] = 0.f; } \
_Pragma("unroll") \
            for (int d0 = 0; d0 < 4; ++d0) { p0 = MFMA32(kf[2 * d0], qf[d0], p0); p1 = MFMA32(kf[2 * d0 + 1], qf[d0], p1); } \
            if (t == 4 || t == 8) { const int kp0 = kp_base + (t - 4) * 64 - qpos; \
_Pragma("unroll") \
                for (int r = 0; r < 16; ++r) { const int d0 = kp0 + crow(r, hi), d1 = d0 + 32; \
                    if (d0 > 128 || d0 < -128) p0[r] = -1e30f; if (d1 > 128 || d1 < -128) p1[r] = -1e30f; } } \
            float mt = max3f(p0[0], p0[1], p1[0]), mt2 = max3f(p0[2], p0[3], p1[1]); mt = max3f(mt, p1[2], p1[3]); \
_Pragma("unroll") \
            for (int r = 4; r < 16; r += 4) { mt = max3f(mt, p0[r], p0[r + 1]); mt2 = max3f(mt2, p0[r + 2], p0[r + 3]); mt = max3f(mt, p1[r], p1[r + 1]); mt2 = max3f(mt2, p1[r + 2], p1[r + 3]); } \
            mt = fmaxf(mt, mt2); \
            mt = fmaxf(mt, __shfl_xor(mt, 32)) - m_run; \
 \
            float dl = 0.f; \
            if (s == 0) dl = fmaxf(mt, 0.f); else if (mt > 8.0f) dl = mt; \
            if (__any(dl != 0.f)) { const float alpha = __builtin_amdgcn_exp2f(-dl); m_run += dl; l_run *= alpha; \
_Pragma("unroll") \
                for (int r = 0; r < 16; ++r) { o0[r] *= alpha; o1[r] *= alpha; } } \
            float ls = 0.f, ls2 = 0.f; \
_Pragma("unroll") \
            for (int r = 0; r < 16; ++r) { p0[r] = __builtin_amdgcn_exp2f(p0[r] - m_run); p1[r] = __builtin_amdgcn_exp2f(p1[r] - m_run); ls += p0[r]; ls2 += p1[r]; } \
            ls += ls2; \
            l_run += ls; \
            bf16x8 pb[2][2]; \
_Pragma("unroll") \
            for (int j = 0; j < 2; ++j) { \
                u32x4 w0, w1; \
                w0.x = pk2(p0[8 * j + 0], p0[8 * j + 1]); w0.y = pk2(p0[8 * j + 2], p0[8 * j + 3]); w0.z = pk2(p0[8 * j + 4], p0[8 * j + 5]); w0.w = pk2(p0[8 * j + 6], p0[8 * j + 7]); \
                w1.x = pk2(p1[8 * j + 0], p1[8 * j + 1]); w1.y = pk2(p1[8 * j + 2], p1[8 * j + 3]); w1.z = pk2(p1[8 * j + 4], p1[8 * j + 5]); w1.w = pk2(p1[8 * j + 6], p1[8 * j + 7]); \
                pb[0][j] = __builtin_bit_cast(bf16x8, w0); pb[1][j] = __builtin_bit_cast(bf16x8, w1); \
            } \
 \
_Pragma("unroll") \
            for (int kb = 0; kb < 2; ++kb) \
_Pragma("unroll") \
                for (int j = 0; j < 2; ++j) { const int i = kb * 2 + j; \
                    const bf16x8 a0 = __builtin_shufflevector(vl[2 * i], vh[2 * i], 0, 1, 2, 3, 4, 5, 6, 7), a1 = __builtin_shufflevector(vl[2 * i + 1], vh[2 * i + 1], 0, 1, 2, 3, 4, 5, 6, 7); \
                    o0 = MFMA32(a0, pb[kb][j], o0); o1 = MFMA32(a1, pb[kb][j], o1); \
                } \
            if (s + 1 < n) { LAS unsigned char* Bn = L + ((s + 1) & 1) * BUFB; *(LAS u32x4*)(Bn + stoff) = KQ; *(LAS u32x4*)(Bn + TILEB + stoff) = VQ; } \
            LBAR(); \
            if (s + 4 < n) { const size_t krow = (size_t)ATT_TROW(s + 4); KQ = *(const u32x4*)(ACT + krow * LD + kcol); VQ = *(const u32x4*)(ACT + krow * LD + vcol); } \
        } while (0)
#pragma unroll 1
        for (int s0 = 0; s0 < n; s0 += 3) {
            ATT_STEP(s0, kq1, vq1);
            if (s0 + 1 < n) ATT_STEP(s0 + 1, kq2, vq2);
            if (s0 + 2 < n) ATT_STEP(s0 + 2, kq0, vq0);
        }
#undef ATT_STEP
#undef ATT_TROW
        u32x4 sgq[4];
        { const int qrow0 = qrow - r32;
#pragma unroll
          for (int it = 0; it < 4; ++it) sgq[it] = *(const u32x4*)(ACT + (size_t)(qrow0 + it * 8 + (lane >> 3)) * LD + 1536 + h * 64 + (lane & 7) * 8); }
        const float lt = l_run + __shfl_xor(l_run, 32); const float inv = 1.0f / lt;
        LAS float* stg = (LAS float*)(L + 40960 + wave * 8704);
#pragma unroll
        for (int db = 0; db < 2; ++db)
#pragma unroll
            for (int q4 = 0; q4 < 4; ++q4) { const int d = 32 * db + 8 * q4 + 4 * hi; f32x4 v;
                if (db == 0) v = (f32x4){o0[4 * q4], o0[4 * q4 + 1], o0[4 * q4 + 2], o0[4 * q4 + 3]}; else v = (f32x4){o1[4 * q4], o1[4 * q4 + 1], o1[4 * q4 + 2], o1[4 * q4 + 3]};
                *(LAS f32x4*)(stg + r32 * 68 + d) = v * inv; }
        asm volatile("s_waitcnt lgkmcnt(0)" ::: "memory");
        { const int qrow0 = qrow - r32; const int er = lane >> 3, ec = (lane & 7) * 8;
#pragma unroll
          for (int it = 0; it < 4; ++it) { const int row = it * 8 + er; const size_t grow = (size_t)(qrow0 + row);
              const f32x4 a0 = *(const LAS f32x4*)(stg + row * 68 + ec), a1 = *(const LAS f32x4*)(stg + row * 68 + ec + 4);
              const u32x4 gw = sgq[it];
              u32x4 w; w.x = pk2(a0.x * bflo(gw.x), a0.y * bfhi(gw.x)); w.y = pk2(a0.z * bflo(gw.y), a0.w * bfhi(gw.y)); w.z = pk2(a1.x * bflo(gw.z), a1.y * bfhi(gw.z)); w.w = pk2(a1.z * bflo(gw.w), a1.w * bfhi(gw.w));
              *(u32x4*)(Y + grow * DM + h * 64 + ec) = w; } }
    }
    LBAR();
}

__device__ __forceinline__ void phase_lru(const Args& A, const bf16_t* ACT, bf16_t* Y, float* HF, LAS unsigned char* L, const int wv) {
    constexpr int LD = 2048, TT = 128, USTR = 144;
    const int tid = otid(wv), lane = tid & 63, wave = __builtin_amdgcn_readfirstlane(tid >> 6), G = gridDim.x;
    LAS unsigned char* UL = L;
    LAS unsigned char* XA = L + 19200;
    LAS float* XF = (LAS float*)(L + 19200 + 18432);
    LAS f32x2* AB = (LAS f32x2*)(L + 19200 + 18432 + 18432);
    LAS f32x2* CAR = (LAS f32x2*)(L + 19200 + 18432 + 18432 + 34816);
    LAS float* ST = (LAS float*)(L + 19200 + 18432 + 18432 + 34816 + 4096);
    LAS float* CW = (LAS float*)(L + 19200 + 18432 + 18432 + 34816 + 4096 + 256);
    const bf16_t* gwT = (const bf16_t*)(ows(A.ws) + WS_GW);
    const float* conv_w = A.in[15]; const float* conv_b = A.in[16]; const float* ba = A.in[18]; const float* bx = A.in[20]; const float* lam = A.in[21];
    const int fr = lane & 15, fq = lane >> 4;
    const int stok = tid >> 3, sch = tid & 7;
    const int ch = tid & 31, sc = tid >> 5;
    const int otok = tid >> 2, oq = tid & 3;
    for (int u = blockIdx.x; u < 256; u += G) {
        const int b = u >> 5, hb = u & 31, hblk = hb >> 1, half = hb & 1, cin0 = hblk * 64, c0 = cin0 + half * 32;
#pragma unroll 1
        for (int dir = 0; dir < 2; ++dir) {
            LBAR();
            if (tid < 320) { const int k = tid >> 6, c = tid & 63; CW[tid] = (k < 4) ? conv_w[(size_t)(dir * 4 + k) * DM + cin0 + c] : conv_b[(size_t)dir * DM + cin0 + c]; }
            const int cbk = wave & 1;
            bf16x8 wr_[2], wi_[2];
            { const bf16_t* pr = gwT + ((size_t)((dir * 2 + 0) * 16 + hblk) * 64 + half * 32 + cbk * 16 + fr) * 64 + fq * 8;
              const bf16_t* pi = gwT + ((size_t)((dir * 2 + 1) * 16 + hblk) * 64 + half * 32 + cbk * 16 + fr) * 64 + fq * 8;
              wr_[0] = *(const bf16x8*)pr; wr_[1] = *(const bf16x8*)(pr + 32); wi_[0] = *(const bf16x8*)pi; wi_[1] = *(const bf16x8*)(pi + 32); }
            float eba[4], ebx[4], esp[4];
#pragma unroll
            for (int e = 0; e < 4; ++e) { const int c = dir * DM + c0 + cbk * 16 + 4 * fq + e; eba[e] = ba[c]; ebx[e] = bx[c];
                const float nl = -lam[c]; esp[e] = (fmaxf(nl, 0.f) + log1pf(__expf(-fabsf(nl)))) * (-8.0f * LOG2E); }
            if (tid < 32) ST[tid] = 0.f;
            u32x4 ur[2], uh = (u32x4){0u, 0u, 0u, 0u};
            { const int rowbase = ML + b * CTX;
#pragma unroll
              for (int i2 = 0; i2 < 2; ++i2) { const int S = stok + 64 * i2; const int row = rowbase + (dir ? CTX - 1 - S : S); ur[i2] = *(const u32x4*)(ACT + (size_t)row * LD + cin0 + sch * 8); } }
            f32x4 hf0 = (f32x4){0.f, 0.f, 0.f, 0.f}, hf1 = hf0; u32x4 gv = (u32x4){0u, 0u, 0u, 0u}; size_t orow = 0; int oseq = 0;
#define LRU_OUT() do { const f32x4 h0 = *(const LAS f32x4*)(XF + otok * 36 + oq * 8), h1 = *(const LAS f32x4*)(XF + otok * 36 + oq * 8 + 4); \
                if (dir == 0) { f32x4* hp = (f32x4*)(HF + ((size_t)u * 2304 + oseq) * 32 + oq * 8); hp[0] = h0; hp[1] = h1; } \
                else { const f32x4 s0 = h0 + hf0, s1 = h1 + hf1; u32x4 w; \
                    w.x = pk2(s0.x * bflo(gv.x), s0.y * bfhi(gv.x)); w.y = pk2(s0.z * bflo(gv.y), s0.w * bfhi(gv.y)); w.z = pk2(s1.x * bflo(gv.z), s1.y * bfhi(gv.z)); w.w = pk2(s1.z * bflo(gv.w), s1.w * bfhi(gv.w)); \
                    *(u32x4*)(Y + orow * DM + c0 + oq * 8) = w; } } while (0)
#pragma unroll 1
            for (int tl = 0; tl < 18; ++tl) {
                const int seg = tl < 2 ? 0 : 1, S0 = seg ? (tl - 2) * TT : tl * TT, seglen = seg ? SEQ : CTX, rowbase = seg ? b * SEQ : ML + b * CTX;
                LBAR();
                *(LAS u32x4*)(UL + (3 + stok) * USTR + sch * 16) = ur[0]; *(LAS u32x4*)(UL + (3 + 64 + stok) * USTR + sch * 16) = ur[1];
                if (tid < 24) *(LAS u32x4*)(UL + stok * USTR + sch * 16) = uh;
                if (tl > 0) LRU_OUT();
                LBAR();
                { const int S = S0 + otok; const int pos = dir ? seglen - 1 - S : S; orow = (size_t)(rowbase + pos); oseq = seg ? CTX + pos : pos;
                  if (dir == 1) { const f32x4* hp = (const f32x4*)(HF + ((size_t)u * 2304 + oseq) * 32 + oq * 8); hf0 = hp[0]; hf1 = hp[1]; gv = *(const u32x4*)(ACT + orow * LD + 1024 + c0 + oq * 8); } }
                if (tl + 1 < 18) { const int tn = tl + 1; const int seg2 = tn < 2 ? 0 : 1, S02 = seg2 ? (tn - 2) * TT : tn * TT, seglen2 = seg2 ? SEQ : CTX, rowbase2 = seg2 ? b * SEQ : ML + b * CTX;
#pragma unroll
                    for (int i2 = 0; i2 < 2; ++i2) { const int S = S02 + stok + 64 * i2; const int row = rowbase2 + (dir ? seglen2 - 1 - S : S); ur[i2] = *(const u32x4*)(ACT + (size_t)row * LD + cin0 + sch * 8); }
                    uh = (u32x4){0u, 0u, 0u, 0u};
                    if (tid < 24 && S02 > 0) { const int S = S02 - 3 + stok; const int row = rowbase2 + (dir ? seglen2 - 1 - S : S); uh = *(const u32x4*)(ACT + (size_t)row * LD + cin0 + sch * 8); } }
                for (int rep_ = 0; rep_ < DUP_LRUBC; ++rep_) {
                { float x0[8], x1[8];
                  { const f32x4 ca = *(const LAS f32x4*)(CW + 256 + sch * 8), cc = *(const LAS f32x4*)(CW + 256 + sch * 8 + 4);
                    x0[0] = ca.x; x0[1] = ca.y; x0[2] = ca.z; x0[3] = ca.w; x0[4] = cc.x; x0[5] = cc.y; x0[6] = cc.z; x0[7] = cc.w;
#pragma unroll
                    for (int e = 0; e < 8; ++e) x1[e] = x0[e]; }
#pragma unroll
                  for (int k = 0; k < 4; ++k) { const f32x4 wa = *(const LAS f32x4*)(CW + k * 64 + sch * 8), wb = *(const LAS f32x4*)(CW + k * 64 + sch * 8 + 4);
                      const u32x4 u0 = *(const LAS u32x4*)(UL + (stok + k) * USTR + sch * 16), u1 = *(const LAS u32x4*)(UL + (stok + 64 + k) * USTR + sch * 16);
                      x0[0] += wa.x * bflo(u0.x); x0[1] += wa.y * bfhi(u0.x); x0[2] += wa.z * bflo(u0.y); x0[3] += wa.w * bfhi(u0.y);
                      x0[4] += wb.x * bflo(u0.z); x0[5] += wb.y * bfhi(u0.z); x0[6] += wb.z * bflo(u0.w); x0[7] += wb.w * bfhi(u0.w);
                      x1[0] += wa.x * bflo(u1.x); x1[1] += wa.y * bfhi(u1.x); x1[2] += wa.z * bflo(u1.y); x1[3] += wa.w * bfhi(u1.y);
                      x1[4] += wb.x * bflo(u1.z); x1[5] += wb.y * bfhi(u1.z); x1[6] += wb.z * bflo(u1.w); x1[7] += wb.w * bfhi(u1.w); }
                  u32x4 w; w.x = pk2(x0[0], x0[1]); w.y = pk2(x0[2], x0[3]); w.z = pk2(x0[4], x0[5]); w.w = pk2(x0[6], x0[7]);
                  *(LAS u32x4*)(XA + stok * USTR + sch * 16) = w;
                  w.x = pk2(x1[0], x1[1]); w.y = pk2(x1[2], x1[3]); w.z = pk2(x1[4], x1[5]); w.w = pk2(x1[6], x1[7]);
                  *(LAS u32x4*)(XA + (stok + 64) * USTR + sch * 16) = w;
                  if ((sch >> 2) == half) { LAS f32x4* xf = (LAS f32x4*)(XF + stok * 36 + (sch & 3) * 8); xf[0] = (f32x4){x0[0], x0[1], x0[2], x0[3]}; xf[1] = (f32x4){x0[4], x0[5], x0[6], x0[7]};
                      xf = (LAS f32x4*)(XF + (stok + 64) * 36 + (sch & 3) * 8); xf[0] = (f32x4){x1[0], x1[1], x1[2], x1[3]}; xf[1] = (f32x4){x1[4], x1[5], x1[6], x1[7]}; } }
                LBAR();
#pragma unroll
                for (int i2 = 0; i2 < 2; ++i2) { const int tb = (wave >> 1) + 4 * i2; const int tok = tb * 16 + fr;
                    const bf16x8 x0 = *(const LAS bf16x8*)(XA + tok * USTR + fq * 16), x1 = *(const LAS bf16x8*)(XA + tok * USTR + 64 + fq * 16);
                    f32x4 ar = (f32x4){0.f, 0.f, 0.f, 0.f}, ai = (f32x4){0.f, 0.f, 0.f, 0.f};
                    ar = MFMA16(wr_[0], x0, ar); ar = MFMA16(wr_[1], x1, ar); ai = MFMA16(wi_[0], x0, ai); ai = MFMA16(wi_[1], x1, ai);
                    const f32x4 xv = *(const LAS f32x4*)(XF + tok * 36 + cbk * 16 + 4 * fq);
                    float av[4], bv[4];
#pragma unroll
                    for (int e = 0; e < 4; ++e) { const float r = __builtin_amdgcn_rcpf(1.0f + __builtin_amdgcn_exp2f(-(ar[e] + eba[e]) * LOG2E)); const float ig = __builtin_amdgcn_rcpf(1.0f + __builtin_amdgcn_exp2f(-(ai[e] + ebx[e]) * LOG2E));
                        const float a_ = __builtin_amdgcn_exp2f(r * esp[e]); av[e] = a_; bv[e] = __builtin_amdgcn_sqrtf(fmaxf(1.0f - a_ * a_, 0.f)) * (ig * xv[e]); }
                    LAS f32x4* ab = (LAS f32x4*)(AB + tok * 34 + cbk * 16 + 4 * fq); ab[0] = (f32x4){av[0], bv[0], av[1], bv[1]}; ab[1] = (f32x4){av[2], bv[2], av[3], bv[3]}; }
                LBAR();
                }
                float a8[8], b8[8];
                { float Ap = 1.f, H = 0.f;
#pragma unroll
                  for (int k = 0; k < 8; ++k) { const f32x2 v = AB[(sc * 8 + k) * 34 + ch]; a8[k] = v.x; b8[k] = v.y; H = v.x * H + v.y; Ap *= v.x; }
                  CAR[sc * 32 + ch] = (f32x2){Ap, H}; }
                LBAR();
                float hrun = ST[(tl & 1) * 32 + ch];
                { f32x2 cr[15];
#pragma unroll
                  for (int s = 0; s < 15; ++s) cr[s] = CAR[s * 32 + ch];
#pragma unroll
                  for (int s = 0; s < 15; ++s) hrun = (s < sc) ? cr[s].x * hrun + cr[s].y : hrun; }
#pragma unroll
                for (int k = 0; k < 8; ++k) { hrun = a8[k] * hrun + b8[k]; XF[(sc * 8 + k) * 36 + ch] = hrun; }
                if (sc == 15) ST[((tl + 1) & 1) * 32 + ch] = hrun;
            }
            LBAR();
            LRU_OUT();
            asm volatile("s_waitcnt vmcnt(0)" ::: "memory");
        }
        LBAR();
    }
#undef LRU_OUT
}

__device__ __forceinline__ void cu8(const bf16_t* ACT, size_t row, int col, float* o) {
    const u32x4 a = __builtin_nontemporal_load((const u32x4*)(ACT + row * 4096 + col)), c = __builtin_nontemporal_load((const u32x4*)(ACT + row * 4096 + 2048 + col));
    o[0] = bflo(a.x) * bflo(c.x); o[1] = bfhi(a.x) * bfhi(c.x); o[2] = bflo(a.y) * bflo(c.y); o[3] = bfhi(a.y) * bfhi(c.y);
    o[4] = bflo(a.z) * bflo(c.z); o[5] = bfhi(a.z) * bfhi(c.z); o[6] = bflo(a.w) * bflo(c.w); o[7] = bfhi(a.w) * bfhi(c.w);
}
__device__ __forceinline__ void phase_conv(const Args& A, const bf16_t* ACT, bf16_t* Y, const int wv) {
    const float* conv_w = A.in[27]; const float* conv_b = A.in[28];
    const int nitems = (MT / 8) * 128;
    const int tid = otid(wv);
    for (int item = blockIdx.x * NTHREADS + tid; item < nitems; item += gridDim.x * NTHREADS) {
        const int rg = item >> 7, chunk = item & 127, col = chunk * 8, row0 = rg * 8;
        const int seglen = row0 < ML ? SEQ : CTX;
        const bool first = (row0 % seglen) == 0, last = ((row0 + 8) % seglen) == 0;
        float w0[8], w1[8], w2[8], cb[8];
        { const f32x4* p = (const f32x4*)(conv_w + col); f32x4 a = p[0], c = p[1]; w0[0] = a.x; w0[1] = a.y; w0[2] = a.z; w0[3] = a.w; w0[4] = c.x; w0[5] = c.y; w0[6] = c.z; w0[7] = c.w;
          p = (const f32x4*)(conv_w + DM + col); a = p[0]; c = p[1]; w1[0] = a.x; w1[1] = a.y; w1[2] = a.z; w1[3] = a.w; w1[4] = c.x; w1[5] = c.y; w1[6] = c.z; w1[7] = c.w;
          p = (const f32x4*)(conv_w + 2 * DM + col); a = p[0]; c = p[1]; w2[0] = a.x; w2[1] = a.y; w2[2] = a.z; w2[3] = a.w; w2[4] = c.x; w2[5] = c.y; w2[6] = c.z; w2[7] = c.w;
          p = (const f32x4*)(conv_b + col); a = p[0]; c = p[1]; cb[0] = a.x; cb[1] = a.y; cb[2] = a.z; cb[3] = a.w; cb[4] = c.x; cb[5] = c.y; cb[6] = c.z; cb[7] = c.w; }
        float prev[8], cur[8], nxt[8];
        if (first) {
#pragma unroll
            for (int e = 0; e < 8; ++e) prev[e] = 0.f;
        } else cu8(ACT, (size_t)row0 - 1, col, prev);
        cu8(ACT, (size_t)row0, col, cur);
#pragma unroll
        for (int k = 0; k < 8; ++k) {
            const size_t row = (size_t)row0 + k;
            if (k == 7 && last) {
#pragma unroll
                for (int e = 0; e < 8; ++e) nxt[e] = 0.f;
            } else cu8(ACT, row + 1, col, nxt);
            const u32x4 bgw = __builtin_nontemporal_load((const u32x4*)(ACT + row * 4096 + 1024 + col)), sgw = __builtin_nontemporal_load((const u32x4*)(ACT + row * 4096 + 3072 + col));
            float y[8];
#pragma unroll
            for (int e = 0; e < 8; ++e) y[e] = w0[e] * prev[e] + w1[e] * cur[e] + w2[e] * nxt[e] + cb[e];
            y[0] *= bflo(bgw.x) * bflo(sgw.x); y[1] *= bfhi(bgw.x) * bfhi(sgw.x); y[2] *= bflo(bgw.y) * bflo(sgw.y); y[3] *= bfhi(bgw.y) * bfhi(sgw.y);
            y[4] *= bflo(bgw.z) * bflo(sgw.z); y[5] *= bfhi(bgw.z) * bfhi(sgw.z); y[6] *= bflo(bgw.w) * bflo(sgw.w); y[7] *= bfhi(bgw.w) * bfhi(sgw.w);
            u32x4 w; w.x = pk2(y[0], y[1]); w.y = pk2(y[2], y[3]); w.z = pk2(y[4], y[5]); w.w = pk2(y[6], y[7]);
            *(u32x4*)(Y + row * DM + col) = w;
#pragma unroll
            for (int e = 0; e < 8; ++e) { prev[e] = cur[e]; cur[e] = nxt[e]; }
        }
    }
}

__device__ __forceinline__ void phase_ctx_wout(const bf16_t* Yc, const bf16_t* Wt, const float* xin, float* xout, const float* gate, LAS unsigned char* L, const int wv) {
    constexpr int PITCH = 272, ABYTES = 128 * PITCH, BUFB = 192 * PITCH, NS = 8;
    const int tid = otid(wv), lane = tid & 63, r32 = lane & 31, hi = lane >> 5, wave = wv, G = gridDim.x;
    const int srow = tid >> 4, sch = tid & 15;
    const int aoff = ((wave >> 1) * 32 + r32) * PITCH + hi * 128, boff = ABYTES + ((wave & 1) * 32 + r32) * PITCH + hi * 128;
    for (int t = blockIdx.x; t < 256; t += G) {
        const int tm = t >> 4, tn = t & 15;
        const bf16_t* ga = Yc + (size_t)(tm * 128 + srow) * DM + sch * 8; const bf16_t* gb = Wt + (size_t)(tn * 64 + srow) * DM + sch * 8;
        f32x16 acc0, acc1;
#pragma unroll
        for (int r = 0; r < 16; ++r) { acc0[r] = 0.f; acc1[r] = 0.f; }
        const int m0 = tm * 128 + (wave >> 1) * 32, col = tn * 64 + (wave & 1) * 32 + r32; const float gv = gate[col];
        float xv[16];
#pragma unroll
        for (int r = 0; r < 16; ++r) xv[r] = xin[(size_t)(m0 + crow(r, hi)) * DM + col];
        u32x4 qa[3][4], qb[3][2];
#define CTX_LOAD(q, s_) do { _Pragma("unroll") for (int i = 0; i < 4; ++i) qa[q][i] = *(const u32x4*)(ga + (size_t)(32 * i) * DM + (s_) * 128); \
                             _Pragma("unroll") for (int i = 0; i < 2; ++i) qb[q][i] = *(const u32x4*)(gb + (size_t)(32 * i) * DM + (s_) * 128); } while (0)
#define CTX_WRITE(q, buf) do { LAS unsigned char* Bn = L + (buf) * BUFB; _Pragma("unroll") for (int i = 0; i < 4; ++i) *(LAS u32x4*)(Bn + (32 * i + srow) * PITCH + sch * 16) = qa[q][i]; \
                               _Pragma("unroll") for (int i = 0; i < 2; ++i) *(LAS u32x4*)(Bn + ABYTES + (32 * i + srow) * PITCH + sch * 16) = qb[q][i]; } while (0)
#define CTX_STEP(s_, q) do { const int s = (s_); LAS const unsigned char* B = L + (s & 1) * BUFB; bf16x8 a[8], b[8]; \
            _Pragma("unroll") for (int j = 0; j < 8; ++j) { a[j] = *(const LAS bf16x8*)(B + aoff + j * 16); b[j] = *(const LAS bf16x8*)(B + boff + j * 16); } \
            _Pragma("unroll") for (int j = 0; j < 8; j += 2) { acc0 = MFMA32(a[j], b[j], acc0); acc1 = MFMA32(a[j + 1], b[j + 1], acc1); } \
            if (s + 1 < NS) CTX_WRITE(q, (s + 1) & 1); \
            LBAR(); \
            if (s + 4 < NS) CTX_LOAD(q, s + 4); } while (0)
        CTX_LOAD(0, 0); CTX_LOAD(1, 1); CTX_LOAD(2, 2);
        LBAR();
        CTX_WRITE(0, 0);
        CTX_LOAD(0, 3);
        LBAR();
        CTX_STEP(0, 1); CTX_STEP(1, 2); CTX_STEP(2, 0); CTX_STEP(3, 1); CTX_STEP(4, 2); CTX_STEP(5, 0); CTX_STEP(6, 1); CTX_STEP(7, 2);
#undef CTX_LOAD
#undef CTX_WRITE
#undef CTX_STEP
#pragma unroll
        for (int r = 0; r < 16; ++r) xout[(size_t)(m0 + crow(r, hi)) * DM + col] = xv[r] + gv * (acc0[r] + acc1[r]);
    }
    LBAR();
}

__device__ __forceinline__ void phase_final(float* out, const float* g, const int wv) {
    const int tid = otid(wv); const int lane = tid & 63, gw = blockIdx.x * NWAVES + (tid >> 6), NGW = gridDim.x * NWAVES;
    f32x4 gv[4];
#pragma unroll
    for (int j = 0; j < 4; ++j) gv[j] = *((const f32x4*)g + 64 * j + lane);
    for (int row0 = gw * 4; row0 < ML; row0 += NGW * 4) {
        f32x4 v[4][4]; float s[4];
#pragma unroll
        for (int i = 0; i < 4; ++i) { const f32x4* xr = (const f32x4*)(out + (size_t)(row0 + i) * DM) + lane;
#pragma unroll
            for (int j = 0; j < 4; ++j) v[i][j] = __builtin_nontemporal_load(xr + 64 * j); }
#pragma unroll
        for (int i = 0; i < 4; ++i) { float a = 0.f;
#pragma unroll
            for (int j = 0; j < 4; ++j) a += (v[i][j].x * v[i][j].x + v[i][j].y * v[i][j].y) + (v[i][j].z * v[i][j].z + v[i][j].w * v[i][j].w);
            s[i] = a; }
#pragma unroll
        for (int o = 1; o < 64; o <<= 1) {
#pragma unroll
            for (int i = 0; i < 4; ++i) s[i] += __shfl_xor(s[i], o); }
#pragma unroll
        for (int i = 0; i < 4; ++i) { const float rstd = 1.0f / sqrtf(s[i] * (1.0f / DM) + EPS); f32x4* xr = (f32x4*)(out + (size_t)(row0 + i) * DM) + lane;
#pragma unroll
            for (int j = 0; j < 4; ++j) xr[64 * j] = v[i][j] * rstd * gv[j]; }
    }
}

#define RLX_AGENT __ATOMIC_RELAXED, __HIP_MEMORY_SCOPE_AGENT
#define XB_TMO      128
#define XB_XCNT(j)  (256  + 64 * (j))
#define XB_XSUB(j)  (1280 + 64 * (j))
#define XB_XGEN(j)  (2304 + 64 * (j))
#define XB_TOP      3328
#define XB_TOPGEN   3392
#define XCD_BAR_WORDS 3456
#define XB_SPIN_CAP (1u << 18)

__device__ __forceinline__ unsigned xb_ld(unsigned* p)              { return __hip_atomic_load(p, __ATOMIC_RELAXED, __HIP_MEMORY_SCOPE_AGENT); }
__device__ __forceinline__ unsigned xb_add(unsigned* p, unsigned v) { return __hip_atomic_fetch_add(p, v, __ATOMIC_RELAXED, __HIP_MEMORY_SCOPE_AGENT); }
__device__ __forceinline__ unsigned xb_xcc_id() { return (unsigned)__builtin_amdgcn_s_getreg((3 << 11) | 20) & 0xFu; }
#define XB_SPIN(cond, bar) do { unsigned _sp = 0; while (cond) { __builtin_amdgcn_s_sleep(1); \
    if ((++_sp & 255u) == 0u) { if (xb_ld(&(bar)[XB_TMO])) break; if (_sp > XB_SPIN_CAP) { atomicAdd(&(bar)[XB_TMO], 1u); break; } } } } while (0)

struct XcdBarrier {
    unsigned* bar; unsigned x;
    volatile LAS unsigned* st;
};

__device__ __forceinline__ XcdBarrier xcd_barrier_post(unsigned* bar, volatile LAS unsigned* st) {
    XcdBarrier b; b.bar = bar; b.x = xb_xcc_id(); b.st = st;
    if (threadIdx.x == 0) (void)xb_add(&bar[XB_XCNT(b.x)], 1u);
    return b;
}
__device__ __forceinline__ void xcd_barrier_complete(unsigned* bar, unsigned x, unsigned& nloc, unsigned& nx) {
    const unsigned G = gridDim.x * gridDim.y * gridDim.z;
    unsigned sum, cnt, mine, sp = 0u;
    for (;;) {
        sum = 0u; cnt = 0u; mine = 0u;
#pragma unroll
        for (unsigned j = 0; j < 16; ++j) { const unsigned c = xb_ld(&bar[XB_XCNT(j)]); sum += c; cnt += (c > 0u) ? 1u : 0u; mine = (j == x) ? c : mine; }
        if (sum == G) break;
        __builtin_amdgcn_s_sleep(1);
        if ((++sp & 255u) == 0u) { if (xb_ld(&bar[XB_TMO])) break; if (sp > XB_SPIN_CAP) { atomicAdd(&bar[XB_TMO], 1u); break; } }
    }
    nloc = mine > 0u ? mine : 1u; nx = cnt > 0u ? cnt : 1u;
}

__device__ __forceinline__ void xcd_barrier(const XcdBarrier& b) {
    asm volatile("s_waitcnt vmcnt(0)" ::: "memory");
    __syncthreads();
    if (threadIdx.x == 0) {
        unsigned* bar = b.bar;
        __builtin_amdgcn_s_waitcnt(0);
        unsigned nloc = b.st[0], nx = b.st[1];
        if (nloc == 0u) { xcd_barrier_complete(bar, b.x, nloc, nx); b.st[0] = nloc; b.st[1] = nx; }
        const unsigned old = xb_add(&bar[XB_XSUB(b.x)], 1u);
        const unsigned gen = old / nloc;
        if (old + 1u == (gen + 1u) * nloc) {
            __builtin_amdgcn_fence(__ATOMIC_RELEASE, "agent");
            asm volatile("s_waitcnt vmcnt(0)" ::: "memory");
            const unsigned og = xb_add(&bar[XB_TOP], 1u);
            const unsigned tg = og / nx;
            if (og + 1u == (tg + 1u) * nx) xb_add(&bar[XB_TOPGEN], 1u);
            else XB_SPIN(xb_ld(&bar[XB_TOPGEN]) == tg, bar);
            __builtin_amdgcn_fence(__ATOMIC_ACQUIRE, "agent");
            xb_add(&bar[XB_XGEN(b.x)], 1u);
            asm volatile("s_waitcnt vmcnt(0)" ::: "memory");
        } else {
            XB_SPIN(xb_ld(&bar[XB_XGEN(b.x)]) == gen, bar);
            __builtin_amdgcn_fence(__ATOMIC_ACQUIRE, "agent");
            asm volatile("s_waitcnt vmcnt(0)" ::: "memory");
        }
    }
    __syncthreads();
}

__global__ void __launch_bounds__(NTHREADS, 2) hybrid_fwd(Args A) {
    extern __shared__ __attribute__((aligned(16))) unsigned char lds[];
    cg::grid_group grid = cg::this_grid();
    LAS unsigned char* L = (LAS unsigned char*)lds;
    unsigned char* ws = A.ws;
    const int G = gridDim.x;
    float* XL = A.out; float* XC = (float*)(ws + WS_XC);
    bf16_t* XN = (bf16_t*)(ws + WS_XN); bf16_t* ACT = (bf16_t*)(ws + WS_ACT);
    const float* gatef = (const float*)(ws + WS_GATE);

    const int wv = __builtin_amdgcn_readfirstlane((int)threadIdx.x >> 6);
    volatile LAS unsigned* MISC = (volatile LAS unsigned*)(L + 131072 + 320);
    if (threadIdx.x < 32) MISC[threadIdx.x] = 0u;
    __syncthreads();
    XcdBarrier xbar = xcd_barrier_post((unsigned*)ws + 4096, MISC + 8);
#define GSYNC() xcd_barrier(xbar)
#pragma unroll 1
    for (int l = 0; l < 4; ++l) { phase_prep(A, L, l, (int)((blockIdx.x + 64 * l) % G), G, wv); LBAR(); }
    if (A.out == nullptr) grid.sync();
    for (int rep = 0; rep < DUP_SYNC; ++rep) GSYNC();
#pragma unroll 1
    for (int layer = 0; layer < 4; ++layer) {
        ws = ows(ws);
        const int kind = layer == 3 ? 0 : layer;
        const int Nin = kind == 0 ? 2560 : (kind == 1 ? 2048 : 4096);
        const float* xinL = layer == 0 ? A.in[0] : XL; const float* xinC = layer == 0 ? A.in[2] : XC;
        for (int rep = 0; rep < DUP_NORM; ++rep) phase_norm(A, layer, xinL, xinC, L, wv);
        GSYNC();
        {
            const bf16_t* Wt = (const bf16_t*)(ws + (layer == 0 ? WS_WIN[0] : layer == 1 ? WS_WIN[1] : layer == 2 ? WS_WIN[2] : WS_WIN[3]));
            pg8::Gemm g{XN, Wt, layer == 3 ? ML : MT, Nin, DM};
            pg8::OrderG S; S.so.init(layer == 3 ? ML : MT, Nin, G, (int)blockIdx.x); S.extra = layer == 3 ? 16 : 0;
            pg8::EpiIn E{ACT, Nin, kind, (const float*)(ws + WS_ROPE)};
            for (int rep = 0; rep < DUP_GIN; ++rep) pg8::gemm_phase<pg8::EpiIn, pg8::OrderG, true, true>(L, g, S, E, wv);
        }
        GSYNC();
        if (kind == 0) { for (int rep = 0; rep < DUP_ATTN; ++rep) phase_attn(ACT, XN, (layer == 0 ? A.in[9] : A.in[34]), layer == 0, L, wv); }
        else if (kind == 1) { for (int rep = 0; rep < DUP_LRU; ++rep) phase_lru(A, ACT, XN, (float*)(ws + WS_HF), L, wv); }
        else { for (int rep = 0; rep < DUP_CONV; ++rep) phase_conv(A, ACT, XN, wv); }
        GSYNC();
        {
            const bf16_t* Wt = (const bf16_t*)(ws + (layer == 0 ? WS_WOUT[0] : layer == 1 ? WS_WOUT[1] : layer == 2 ? WS_WOUT[2] : WS_WOUT[3]));
            const int Mo = (CTX_SMALL || layer == 3) ? ML : MT;
            pg8::Gemm g{XN, Wt, Mo, DM, DM};
            pg8::OrderG S; S.so.init(Mo, DM, G, (int)blockIdx.x); S.extra = 0;
            pg8::EpiRes E{xinL, xinC, XL, XC, gatef + (size_t)layer * 9 * 1024};
            const bool ctx_first = (blockIdx.x & 1) != 0;
#pragma unroll 1
            for (int step = 0; step < 2; ++step) {
                if ((step == 0) == ctx_first) { if (CTX_SMALL && layer < 3) phase_ctx_wout(XN + (size_t)ML * DM, Wt, xinC, XC, gatef + (size_t)(layer * 9 + 8) * 1024, L, wv); }
                else pg8::gemm_phase<pg8::EpiRes, pg8::OrderG, true, true>(L, g, S, E, wv);
            }
        }
        GSYNC();
    }
    phase_final(XL, A.in[35], wv);
}

extern "C" void kernel_launch(void* const* d_in, const int* in_sizes, int n_in, void* d_out, int out_size, void* d_ws, size_t ws_size, hipStream_t stream) {
    static int grid = 0;
    if (grid == 0) {
        if (n_in != 36 || out_size != ML * DM || ws_size < WS_END) { fprintf(stderr, "kernel_launch: unexpected shapes (n_in %d, out %d, ws %zu)\n", n_in, out_size, ws_size); grid = -1; return; }
        int dev = 0, cus = 0, per_cu = 0;
        hipGetDevice(&dev); hipDeviceGetAttribute(&cus, hipDeviceAttributeMultiprocessorCount, dev);
        if (hipFuncSetAttribute((const void*)hybrid_fwd, hipFuncAttributeMaxDynamicSharedMemorySize, LDS_BYTES) != hipSuccess) { fprintf(stderr, "kernel_launch: hipFuncSetAttribute failed\n"); grid = -1; return; }
        if (hipOccupancyMaxActiveBlocksPerMultiprocessor(&per_cu, (const void*)hybrid_fwd, NTHREADS, LDS_BYTES) != hipSuccess || per_cu < 1) { fprintf(stderr, "kernel_launch: occupancy query says %d\n", per_cu); per_cu = 1; }
        (void)hipGetLastError();
        grid = cus * (per_cu > 1 ? 1 : per_cu);
        if (grid > 256) grid = 256;
    }
    if (grid < 0) return;
    if (hipMemsetAsync(d_ws, 0, 65536, stream) != hipSuccess) { fprintf(stderr, "kernel_launch: memset failed\n"); return; }
    Args a{};
    for (int i = 0; i < 36; ++i) a.in[i] = (const float*)d_in[i];
    a.out = (float*)d_out; a.ws = (unsigned char*)d_ws;
    void* args[] = {&a};
    hipError_t e = hipLaunchCooperativeKernel((const void*)hybrid_fwd, dim3(grid), dim3(NTHREADS), args, LDS_BYTES, stream);
    if (e != hipSuccess) fprintf(stderr, "kernel_launch: cooperative launch failed: %s (grid %d)\n", hipGetErrorString(e), grid);
}
```

```cpp
#include <hip/hip_runtime.h>
#include <hip/hip_cooperative_groups.h>
#include <cstdio>
#include <cstdint>
namespace cg = cooperative_groups;

namespace pg8 {
#define PG8_LAS __attribute__((address_space(3)))
typedef unsigned short bf16_t;
typedef short bf16x8 __attribute__((ext_vector_type(8)));
typedef float f32x4 __attribute__((ext_vector_type(4)));
typedef unsigned u32x4 __attribute__((ext_vector_type(4)));
constexpr int BM = 256, BK = 64, HALF = 128, HTB = HALF * BK * 2  , STAGE_BYTES = 8 * HTB, NXCD = 8, WGM = 8;

__host__ __device__ __forceinline__ int lds_byte(int r, int c) { const int st = (r >> 4) * 2 + (c >> 5), rr = r & 15, cc = c & 31, ob = rr * 64 + cc * 2; return st * 1024 + (ob ^ (((ob >> 9) & 1) << 5)); }
__host__ __device__ __forceinline__ void stage_rc(int b, int& R, int& C) { const int st = b / 1024, sb = b % 1024, swz = sb ^ (((sb >> 9) & 1) << 5); R = (st >> 1) * 16 + swz / 64; C = (st & 1) * 32 + (swz % 64) / 2; }
__host__ __device__ __forceinline__ int perm32(int rho) { const int n = rho >> 4, i = rho & 15; return 8 * (i >> 2) + 4 * n + (i & 3); }

struct Unit { int pm, pn; };
struct Gemm { const bf16_t* A; const bf16_t* Bt; int M, N, K; };

struct StaticOrder {
    int nM, nN, nwg, G, c;
    __host__ __device__ void init(int M, int N, int G_, int c_) { nM = M / BM; nN = N / BM; nwg = nM * nN; G = G_; c = c_; }
    __host__ __device__ bool next(int i, Unit& u) const {
        const long L = (long)i * G + c; if (L >= nwg) return false;
        int wgid = (int)L; { const int q = nwg / NXCD, r = nwg % NXCD, xcd = wgid % NXCD, off = wgid / NXCD; wgid = (xcd < r ? xcd * (q + 1) : r * (q + 1) + (xcd - r) * q) + off; }
        const int nig = WGM * nN, gid = wgid / nig, fm = gid * WGM, gsz = (nM - fm) < WGM ? (nM - fm) : WGM;
        u.pm = fm + ((wgid % nig) % gsz); u.pn = (wgid % nig) / gsz; return true;
    }
    __device__ __forceinline__ void a_ready(const Unit&) const {}
    __device__ __forceinline__ void done(const Unit&) const {}
};

__device__ __forceinline__ unsigned cvt_pk_bf16(float lo, float hi) { unsigned r; asm volatile("v_cvt_pk_bf16_f32 %0, %1, %2" : "=v"(r) : "v"(lo), "v"(hi)); return r; }
typedef float f32x2 __attribute__((ext_vector_type(2)));
__device__ __forceinline__ float silu_f(float v) { return v * __builtin_amdgcn_rcpf(1.0f + __builtin_amdgcn_exp2f(-v * 1.4426950408889634f)); }
constexpr float QSCALE = 0.125f * 1.4426950408889634f;

struct OrderG {
    StaticOrder so; int extra;
    __device__ __forceinline__ bool next(int i, Unit& u) const {
        long L = (long)i * so.G + so.c; if (L < so.nwg) return so.next(i, u);
        L -= so.nwg; if (L >= extra) return false; u.pm = 64 + (int)(L >> 1); u.pn = 4 + (int)(L & 1); return true;
    }
    __device__ __forceinline__ void a_ready(const Unit&) const {}
    __device__ __forceinline__ void done(const Unit&) const {}
};

struct EpiIn {
    static constexpr bool PERM = true, AFTER_DRAIN = false;
    bf16_t* O; int ldc; int kind; const float* rope;
    __device__ __forceinline__ void operator()(const f32x4 (&acc)[2][2][4][2], const Unit& u, int wr, int wc, int fr, int fq) const {
        const int colt = u.pn * BM; const bool lat = u.pm < 64;
        int mode = 0; float sc = 1.f;
        if (kind == 0) { if (colt < 1024) { mode = lat ? 2 : 0; sc = QSCALE; } else if (colt < 1280) mode = lat ? 2 : 0; else if (colt < 1536) mode = 0; else mode = 1; }
        else if (kind == 1) mode = colt < 1024 ? 0 : 1;
        else mode = colt < 3072 ? 0 : 1;
        const int row0 = u.pm * BM + wr * 64 + fr; const int col0 = colt + wc * 32 + 8 * fq;
        const float sgn = (fq < 2) ? -1.f : 1.f;
#pragma unroll
        for (int ai = 0; ai < 2; ++ai)
#pragma unroll
            for (int m = 0; m < 4; ++m) {
                const int row = row0 + ai * HALF + m * 16;
                bf16_t* rowp = O + (size_t)row * ldc + col0;
                f32x4 cs[4];
                if (mode == 2) { const int l = row & 2047; const int p = (wc & 1) ? (l & 63) : (l >> 6); const f32x4* rp = (const f32x4*)(rope + (p * 16 + 8 * (fq & 1)) * 2);
                    cs[0] = rp[0]; cs[1] = rp[1]; cs[2] = rp[2]; cs[3] = rp[3]; }
#pragma unroll
                for (int bj = 0; bj < 2; ++bj) {
                    f32x4 v0 = acc[ai][bj][m][0], v1 = acc[ai][bj][m][1];
                    if (mode == 1) {
#pragma unroll
                        for (int e = 0; e < 4; ++e) { v0[e] = silu_f(v0[e]); v1[e] = silu_f(v1[e]); }
                    } else if (mode == 2) {
                        f32x4 p0, p1;
#pragma unroll
                        for (int e = 0; e < 4; ++e) { p0[e] = __shfl_xor(v0[e], 32); p1[e] = __shfl_xor(v1[e], 32); }
                        v0[0] = v0[0] * cs[0][0] + sgn * p0[0] * cs[0][1]; v0[1] = v0[1] * cs[0][2] + sgn * p0[1] * cs[0][3];
                        v0[2] = v0[2] * cs[1][0] + sgn * p0[2] * cs[1][1]; v0[3] = v0[3] * cs[1][2] + sgn * p0[3] * cs[1][3];
                        v1[0] = v1[0] * cs[2][0] + sgn * p1[0] * cs[2][1]; v1[1] = v1[1] * cs[2][2] + sgn * p1[1] * cs[2][3];
                        v1[2] = v1[2] * cs[3][0] + sgn * p1[2] * cs[3][1]; v1[3] = v1[3] * cs[3][2] + sgn * p1[3] * cs[3][3];
                    }
                    v0 = v0 * sc; v1 = v1 * sc;
                    u32x4 w; w.x = cvt_pk_bf16(v0[0], v0[1]); w.y = cvt_pk_bf16(v0[2], v0[3]); w.z = cvt_pk_bf16(v1[0], v1[1]); w.w = cvt_pk_bf16(v1[2], v1[3]);
                    *(u32x4*)(rowp + bj * HALF) = w;
                }
            }
    }
};

struct EpiRes {
    static constexpr bool PERM = true, AFTER_DRAIN = false;
    const float* inL; const float* inC; float* outL; float* outC; const float* gate;
    __device__ __forceinline__ void operator()(const f32x4 (&acc)[2][2][4][2], const Unit& u, int wr, int wc, int fr, int fq) const {
        const bool lat = u.pm < 64;
        const float* ib = lat ? inL + (size_t)u.pm * BM * 1024 : inC + (size_t)(u.pm - 64) * BM * 1024;
        float* ob = lat ? outL + (size_t)u.pm * BM * 1024 : outC + (size_t)(u.pm - 64) * BM * 1024;
        const float* g = gate + (lat ? (u.pm >> 3) : 8) * 1024;
        const int col0 = u.pn * BM + wc * 32 + 8 * fq;
        f32x4 gv[2][2];
#pragma unroll
        for (int bj = 0; bj < 2; ++bj)
#pragma unroll
            for (int n = 0; n < 2; ++n) gv[bj][n] = *(const f32x4*)(g + col0 + bj * HALF + n * 4);
#pragma unroll
        for (int ai = 0; ai < 2; ++ai)
#pragma unroll
            for (int mp = 0; mp < 2; ++mp) {
                f32x4 xv[2][2][2];
#pragma unroll
                for (int mm = 0; mm < 2; ++mm) { const size_t off = (size_t)(ai * HALF + wr * 64 + (2 * mp + mm) * 16 + fr) * 1024 + col0;
#pragma unroll
                    for (int bj = 0; bj < 2; ++bj)
#pragma unroll
                        for (int n = 0; n < 2; ++n) xv[mm][bj][n] = __builtin_nontemporal_load((const f32x4*)(ib + off + bj * HALF + n * 4)); }
#pragma unroll
                for (int mm = 0; mm < 2; ++mm) { const int m = 2 * mp + mm; const size_t off = (size_t)(ai * HALF + wr * 64 + m * 16 + fr) * 1024 + col0;
#pragma unroll
                    for (int bj = 0; bj < 2; ++bj)
#pragma unroll
                        for (int n = 0; n < 2; ++n) *(f32x4*)(ob + off + bj * HALF + n * 4) = xv[mm][bj][n] + gv[bj][n] * acc[ai][bj][m][n]; }
                asm volatile("" ::: "memory"); }
    }
};

template <class Epi, class Sched, bool ALIGN_EPI = false, bool SP2 = false>
__device__ __forceinline__ void gemm_phase(PG8_LAS unsigned char* lds, const Gemm g, const Sched& S, const Epi& E, const int wv_) {
    int tid_ = wv_ * 64 + (int)__builtin_amdgcn_mbcnt_hi(~0u, __builtin_amdgcn_mbcnt_lo(~0u, 0u)); asm volatile("" : "+v"(tid_));
    const int tid = tid_, wid = __builtin_amdgcn_readfirstlane(tid >> 6), lane = tid & 63, wr = wid >> 2, wc = wid & 3, fr = lane & 15, fq = lane >> 4;
    const int K = g.K, nt = K / BK;
    unsigned voffA[2], voffB[2];
#pragma unroll
    for (int i = 0; i < 2; ++i) { int R, C; stage_rc(tid * 16 + i * 8192, R, C); const int Rb = Epi::PERM ? ((R & ~31) + perm32(R & 31)) : R;
        voffA[i] = (unsigned)(R * K + C) * 2u; voffB[i] = (unsigned)(Rb * K + C) * 2u; }
    const size_t kstep = (size_t)(BK * 2);
    const size_t hstep = (size_t)HALF * K * 2;
    const size_t tstep = 2 * hstep;
    const unsigned ldsw = (unsigned)wid * 1024u;
    const int aoff = lds_byte(wr * 64 + fr, fq * 8), boff = lds_byte(wc * 32 + fr, fq * 8);
#define PG8_SA(b, h) (((b) * 2 + (h)) * HTB)
#define PG8_SB(b, h) ((4 + (b) * 2 + (h)) * HTB)
#define PG8_STAGE(bufoff, gbase, voff) do { _Pragma("unroll") for (int _i = 0; _i < 2; ++_i) \
        __builtin_amdgcn_global_load_lds((const unsigned*)((const char*)(gbase) + (voff)[_i]), (PG8_LAS unsigned*)(lds + (bufoff) + ldsw + _i * 8192), 16, 0, 0); } while (0)
#define PG8_LDA(dst, b, h) do { _Pragma("unroll") for (int m = 0; m < 4; ++m) _Pragma("unroll") for (int k = 0; k < 2; ++k) dst[m][k] = *(const PG8_LAS bf16x8*)(lds + PG8_SA(b, h) + aoff + m * 2048 + k * 1024); } while (0)
#define PG8_LDB(dst, b, h) do { _Pragma("unroll") for (int n = 0; n < 2; ++n) _Pragma("unroll") for (int k = 0; k < 2; ++k) dst[n][k] = *(const PG8_LAS bf16x8*)(lds + PG8_SB(b, h) + boff + n * 2048 + k * 1024); } while (0)
#define PG8_MMA(ai, bj, At, Bt) do { __builtin_amdgcn_s_setprio(1); _Pragma("unroll") for (int m = 0; m < 4; ++m) _Pragma("unroll") for (int n = 0; n < 2; ++n) _Pragma("unroll") for (int k = 0; k < 2; ++k) \
        acc[ai][bj][m][n] = __builtin_amdgcn_mfma_f32_16x16x32_bf16(Bt[n][k], At[m][k], acc[ai][bj][m][n], 0, 0, 0); __builtin_amdgcn_s_setprio(0); } while (0)
#define PG8_WAIT_V(n) asm volatile("s_waitcnt vmcnt(" #n ")" ::: "memory")
#define PG8_WAIT_L(n) asm volatile("s_waitcnt lgkmcnt(" #n ")" ::: "memory")
#define PG8_BAR __builtin_amdgcn_s_barrier()
#define PG8_SCHED __builtin_amdgcn_sched_barrier(0)
    Unit cur, nxt; int ui = 0;
    if (!S.next(0, cur)) return;
    f32x4 acc[2][2][4][2];
#pragma unroll
    for (int a = 0; a < 2; ++a)
#pragma unroll
        for (int b = 0; b < 2; ++b)
#pragma unroll
            for (int m = 0; m < 4; ++m)
#pragma unroll
                for (int n = 0; n < 2; ++n) acc[a][b][m][n] = (f32x4){0.f, 0.f, 0.f, 0.f};
    bf16x8 At[4][2], B0[2][2], B1[2][2];
    const char* cA = (const char*)g.A + (size_t)cur.pm * tstep; const char* cB = (const char*)g.Bt + (size_t)cur.pn * tstep;
    S.a_ready(cur);
    if constexpr (SP2) {
        PG8_STAGE(PG8_SB(0, 0), cB, voffB); PG8_STAGE(PG8_SB(0, 1), cB + hstep, voffB); PG8_STAGE(PG8_SA(0, 0), cA, voffA); PG8_STAGE(PG8_SA(0, 1), cA + hstep, voffA);
        if (wr == 1) PG8_BAR;
        PG8_WAIT_V(2); PG8_BAR;
        PG8_STAGE(PG8_SB(1, 0), cB + kstep, voffB); PG8_STAGE(PG8_SA(1, 0), cA + kstep, voffA); PG8_STAGE(PG8_SB(1, 1), cB + hstep + kstep, voffB);
        PG8_WAIT_V(6); PG8_BAR;
    } else {
        PG8_STAGE(PG8_SB(0, 0), cB, voffB); PG8_STAGE(PG8_SA(0, 0), cA, voffA); PG8_STAGE(PG8_SB(0, 1), cB + hstep, voffB); PG8_STAGE(PG8_SA(0, 1), cA + hstep, voffA);
        if (wr == 1) PG8_BAR;
        PG8_WAIT_V(4); PG8_BAR;
        PG8_STAGE(PG8_SB(1, 0), cB + kstep, voffB); PG8_STAGE(PG8_SA(1, 0), cA + kstep, voffA); PG8_STAGE(PG8_SB(1, 1), cB + hstep + kstep, voffB);
        PG8_WAIT_V(6); PG8_BAR;
    }
    for (;;) {
        const bool has_next = S.next(ui + 1, nxt);
        const char* nA = has_next ? (const char*)g.A + (size_t)nxt.pm * tstep : cA; const char* nB = has_next ? (const char*)g.Bt + (size_t)nxt.pn * tstep : cB;
        for (int t = 0; t < nt; t += 2) {
            const bool last = (t == nt - 2);
            const char* a1 = cA + (size_t)(t + 1) * kstep;
            const char* a2 = last ? nA : cA + (size_t)(t + 2) * kstep; const char* b2 = last ? nB : cB + (size_t)(t + 2) * kstep;
            const char* a3 = a2 + kstep; const char* b3 = b2 + kstep;
            if (last && has_next) S.a_ready(nxt);
            if constexpr (SP2) {
            PG8_LDB(B0, 0, 0); PG8_LDB(B1, 0, 1); PG8_SCHED; PG8_LDA(At, 0, 0); PG8_STAGE(PG8_SA(1, 1), a1 + hstep, voffA);
            PG8_WAIT_V(8); PG8_WAIT_L(0); PG8_BAR; PG8_MMA(0, 0, At, B0); PG8_MMA(0, 1, At, B1); PG8_BAR; PG8_SCHED;
            PG8_LDA(At, 0, 1); PG8_STAGE(PG8_SB(0, 0), b2, voffB); PG8_STAGE(PG8_SB(0, 1), b2 + hstep, voffB); PG8_STAGE(PG8_SA(0, 0), a2, voffA);
            PG8_WAIT_V(8); PG8_WAIT_L(0); PG8_BAR; PG8_MMA(1, 0, At, B0); PG8_MMA(1, 1, At, B1); PG8_BAR; PG8_SCHED;
            PG8_LDB(B0, 1, 0); PG8_LDB(B1, 1, 1); PG8_SCHED; PG8_LDA(At, 1, 0); PG8_STAGE(PG8_SA(0, 1), a2 + hstep, voffA);
            PG8_WAIT_V(8); PG8_WAIT_L(0); PG8_BAR; PG8_MMA(0, 0, At, B0); PG8_MMA(0, 1, At, B1); PG8_BAR; PG8_SCHED;
            PG8_LDA(At, 1, 1); PG8_STAGE(PG8_SB(1, 0), b3, voffB); PG8_STAGE(PG8_SB(1, 1), b3 + hstep, voffB); PG8_STAGE(PG8_SA(1, 0), a3, voffA);
            PG8_WAIT_V(8); PG8_WAIT_L(0); PG8_BAR; PG8_MMA(1, 0, At, B0); PG8_MMA(1, 1, At, B1); PG8_BAR; PG8_SCHED;
            } else {
            PG8_LDB(B0, 0, 0); PG8_SCHED; PG8_LDA(At, 0, 0); PG8_STAGE(PG8_SA(1, 1), a1 + hstep, voffA);
            PG8_WAIT_L(8); PG8_BAR; PG8_WAIT_L(0); PG8_MMA(0, 0, At, B0); PG8_BAR; PG8_SCHED;
            PG8_LDB(B1, 0, 1); PG8_STAGE(PG8_SB(0, 0), b2, voffB);
            PG8_BAR; PG8_WAIT_L(0); PG8_MMA(0, 1, At, B1); PG8_BAR;
            PG8_LDA(At, 0, 1); PG8_STAGE(PG8_SA(0, 0), a2, voffA);
            PG8_BAR; PG8_WAIT_L(0); PG8_MMA(1, 0, At, B0); PG8_BAR; PG8_SCHED;
            PG8_STAGE(PG8_SB(0, 1), b2 + hstep, voffB);
            PG8_WAIT_V(6); PG8_BAR; PG8_MMA(1, 1, At, B1); PG8_BAR;
            PG8_LDB(B0, 1, 0); PG8_SCHED; PG8_LDA(At, 1, 0); PG8_STAGE(PG8_SA(0, 1), a2 + hstep, voffA);
            PG8_WAIT_L(8); PG8_BAR; PG8_WAIT_L(0); PG8_MMA(0, 0, At, B0); PG8_BAR; PG8_SCHED;
            PG8_LDB(B1, 1, 1); PG8_STAGE(PG8_SB(1, 0), b3, voffB);
            PG8_BAR; PG8_WAIT_L(0); PG8_MMA(0, 1, At, B1); PG8_BAR;
            PG8_LDA(At, 1, 1); PG8_STAGE(PG8_SA(1, 0), a3, voffA);
            PG8_BAR; PG8_WAIT_L(0); PG8_MMA(1, 0, At, B0); PG8_BAR; PG8_SCHED;
            PG8_STAGE(PG8_SB(1, 1), b3 + hstep, voffB);
            PG8_WAIT_V(6); PG8_BAR; PG8_MMA(1, 1, At, B1); PG8_BAR;
            }
        }
        if constexpr (ALIGN_EPI) { if (wr == 0) PG8_BAR; }
        if constexpr (!Epi::AFTER_DRAIN) { E(acc, cur, wr, wc, fr, fq); S.done(cur); }
        if (!has_next) break;
#pragma unroll
        for (int a = 0; a < 2; ++a)
#pragma unroll
            for (int b = 0; b < 2; ++b)
#pragma unroll
                for (int m = 0; m < 4; ++m)
#pragma unroll
                    for (int n = 0; n < 2; ++n) acc[a][b][m][n] = (f32x4){0.f, 0.f, 0.f, 0.f};
        cur = nxt; cA = nA; cB = nB; ++ui;
        if constexpr (ALIGN_EPI) { if (wr == 1) PG8_BAR; }
    }
    PG8_WAIT_V(0);
    if constexpr (!ALIGN_EPI) { if (wr == 0) PG8_BAR; }
    PG8_BAR;
    if constexpr (Epi::AFTER_DRAIN) { E.fused(acc, cur, wr, wc, fr, fq, lds, wid, lane); S.done(cur); }
#undef PG8_SA
#undef PG8_SB
#undef PG8_STAGE
#undef PG8_LDA
#undef PG8_LDB
#undef PG8_MMA
#undef PG8_WAIT_V
#undef PG8_WAIT_L
#undef PG8_BAR
#undef PG8_SCHED
}
}

#define LAS __attribute__((address_space(3)))
typedef unsigned short bf16_t;
typedef short bf16x8 __attribute__((ext_vector_type(8)));
typedef short s16x4 __attribute__((ext_vector_type(4)));
typedef float f32x4 __attribute__((ext_vector_type(4)));
typedef float f32x2 __attribute__((ext_vector_type(2)));
typedef float f32x16 __attribute__((ext_vector_type(16)));
typedef unsigned u32x4 __attribute__((ext_vector_type(4)));
typedef unsigned u32x2 __attribute__((ext_vector_type(2)));

#ifndef DUP_ATTN
#define DUP_ATTN 1
#endif
#ifndef DUP_LRU
#define DUP_LRU 1
#endif
#ifndef DUP_CONV
#define DUP_CONV 1
#endif
#ifndef DUP_GIN
#define DUP_GIN 1
#endif
#ifndef DUP_NORM
#define DUP_NORM 1
#endif
#ifndef DUP_PRO
#define DUP_PRO 1
#endif
#ifndef DUP_GOUT0
#define DUP_GOUT0 1
#endif
#ifndef DUP_LRUBC
#define DUP_LRUBC 1
#endif
#ifndef DUP_ATTEPI
#define DUP_ATTEPI 1
#endif
#ifndef DUP_SYNC
#define DUP_SYNC 1
#endif
#ifndef CTX_SMALL
#define CTX_SMALL 1
#endif
constexpr int NTHREADS = 512, NWAVES = 8;
constexpr int DM = 1024, NB = 8, SEQ = 2048, CTX = 256;
constexpr int ML = NB * SEQ, MC = NB * CTX, MT = ML + MC;
constexpr float EPS = 1e-6f, LOG2E = 1.4426950408889634f;
constexpr int LDS_BYTES = 147456;

constexpr size_t MiB = 1u << 20;
constexpr size_t WS_MODP = 1 * MiB;
constexpr size_t WS_GATE = 5 * MiB;
constexpr size_t WS_ROPE = 5 * MiB + 512 * 1024;
constexpr size_t WS_GW = 6 * MiB;
constexpr size_t WS_WIN[4] = {8 * MiB, 15 * MiB, 21 * MiB, 31 * MiB};
constexpr size_t WS_WOUT[4] = {13 * MiB, 19 * MiB, 29 * MiB, 36 * MiB};
constexpr size_t WS_XC = 38 * MiB;
constexpr size_t WS_XN = 46 * MiB;
constexpr size_t WS_ACT = 82 * MiB;
constexpr size_t WS_HF = 154 * MiB;
constexpr size_t WS_END = 226 * MiB;

struct Args { const float* in[36]; float* out; unsigned char* ws; };

#define LBAR() do { asm volatile("s_waitcnt lgkmcnt(0)" ::: "memory"); __builtin_amdgcn_s_barrier(); asm volatile("" ::: "memory"); } while (0)

__device__ __forceinline__ unsigned f2bf(float f) { unsigned u = __builtin_bit_cast(unsigned, f); return (u + 0x7fffu + ((u >> 16) & 1u)) >> 16; }
__device__ __forceinline__ unsigned pk2(float lo, float hi) { return pg8::cvt_pk_bf16(lo, hi); }
__device__ __forceinline__ float bflo(unsigned w) { return __builtin_bit_cast(float, w << 16); }
__device__ __forceinline__ float bfhi(unsigned w) { return __builtin_bit_cast(float, w & 0xffff0000u); }
__device__ __forceinline__ unsigned char* ows(unsigned char* p) { unsigned long long v = (unsigned long long)p; asm volatile("" : "+s"(v)); return (unsigned char*)(__attribute__((address_space(1))) unsigned char*)v; }
__device__ __forceinline__ int otid(int wv) { int t = wv * 64 + (int)__builtin_amdgcn_mbcnt_hi(~0u, __builtin_amdgcn_mbcnt_lo(~0u, 0u)); asm volatile("" : "+v"(t)); return t; }
__device__ __forceinline__ float wave_sum(float v) {
#pragma unroll
    for (int o = 1; o < 64; o <<= 1) v += __shfl_xor(v, o);
    return v;
}
using pg8::silu_f;

__device__ __forceinline__ void transpose_item(const float* W, int K, int N, bf16_t* WT, LAS float* scr, int item, int lane) {
    const int nblk = N / 32, kb = item / nblk, nb = item % nblk, k0 = 64 * kb, n0 = 32 * nb;
    float tv[32];
#pragma unroll
    for (int i = 0; i < 32; ++i) tv[i] = __builtin_nontemporal_load(W + (size_t)(k0 + 2 * i + (lane >> 5)) * N + n0 + (lane & 31));
#pragma unroll
    for (int i = 0; i < 32; ++i) scr[(2 * i + (lane >> 5)) * 33 + (lane & 31)] = tv[i];
    asm volatile("s_waitcnt lgkmcnt(0)" ::: "memory");
    const int c = lane & 7;
#pragma unroll
    for (int j = 0; j < 4; ++j) { const int n = (lane >> 3) + 8 * j; const LAS float* s = scr + (8 * c) * 33 + n;
        u32x4 o; o.x = pk2(s[0 * 33], s[1 * 33]); o.y = pk2(s[2 * 33], s[3 * 33]); o.z = pk2(s[4 * 33], s[5 * 33]); o.w = pk2(s[6 * 33], s[7 * 33]);
        *(u32x4*)(WT + (size_t)(n0 + n) * K + k0 + 8 * c) = o; }
    asm volatile("s_waitcnt lgkmcnt(0)" ::: "memory");
}

__device__ __forceinline__ void phase_prep(const Args& A, LAS unsigned char* L, int layer, int vbid, int vG, const int wv) {
    const int tid = otid(wv), lane = tid & 63, wave = tid >> 6;
    unsigned char* ws = A.ws;
    const float* Wm = (layer == 0 ? A.in[5] : layer == 1 ? A.in[11] : layer == 2 ? A.in[23] : A.in[30]);
    for (int task = vbid; task < 48; task += vG) {
        const int cc = task >> 3, kc = task & 7;
        const int col = cc * 512 + tid;
        const float* wp = Wm + (size_t)(kc * 128) * 3072 + col;
        float wv_[128];
#pragma unroll
        for (int kk = 0; kk < 128; ++kk) wv_[kk] = __builtin_nontemporal_load(wp + (size_t)kk * 3072);
        LAS float* s = (LAS float*)L;
        for (int idx = tid; idx < 9 * 128; idx += NTHREADS) { const int r = idx >> 7, kk = idx & 127;
            const float v = (r < 8) ? A.in[1][r * DM + kc * 128 + kk] : A.in[3][kc * 128 + kk];
            s[idx] = v / (1.0f + __expf(-v)); }
        LBAR();
        float acc[9];
#pragma unroll
        for (int r = 0; r < 9; ++r) acc[r] = 0.f;
#pragma unroll
        for (int kk = 0; kk < 128; ++kk) { const float w = wv_[kk];
#pragma unroll
            for (int r = 0; r < 9; ++r) acc[r] += s[r * 128 + kk] * w; }
        float* mp = (float*)(ws + WS_MODP) + (size_t)((layer * 8 + kc) * 9) * 3072 + col;
#pragma unroll
        for (int r = 0; r < 9; ++r) mp[(size_t)r * 3072] = acc[r];
        LBAR();
    }
    if (layer == 0 && vbid == vG - 1) {
        float* rt = (float*)(ws + WS_ROPE);
        for (int idx = tid; idx < 1024; idx += NTHREADS) { const int p = idx >> 4, j = idx & 15;
            const float inv = 1.0f / __builtin_powf(10000.0f, (float)j * (1.0f / 16.0f));
            const float ang = (float)p * inv; float t = ang * 0.15915494309189535f; t -= __builtin_rintf(t);
            rt[idx * 2] = __builtin_amdgcn_cosf(t); rt[idx * 2 + 1] = __builtin_amdgcn_sinf(t); }
    }
    LAS float* scr = (LAS float*)(L + wave * 16384);
    const int rb = (vbid + vG - (48 % vG)) % vG;
    const int gw = rb * NWAVES + wave, NGW = vG * NWAVES;
    const int Nin = (layer == 0 || layer == 3) ? 2560 : (layer == 1 ? 2048 : 4096);
    const float* win = (layer == 0 ? A.in[7] : layer == 1 ? A.in[13] : layer == 2 ? A.in[25] : A.in[32]);
    const float* wout = (layer == 0 ? A.in[8] : layer == 1 ? A.in[14] : layer == 2 ? A.in[26] : A.in[33]);
    bf16_t* wint = (bf16_t*)(ws + (layer == 0 ? WS_WIN[0] : layer == 1 ? WS_WIN[1] : layer == 2 ? WS_WIN[2] : WS_WIN[3]));
    bf16_t* woutt = (bf16_t*)(ws + (layer == 0 ? WS_WOUT[0] : layer == 1 ? WS_WOUT[1] : layer == 2 ? WS_WOUT[2] : WS_WOUT[3]));
    const int IIN = 16 * (Nin / 32), IO = 16 * 32, IGW = layer == 0 ? 64 * 2 : 0;
    const int nitems = IIN + IO + IGW;
    for (int it = gw; it < nitems; it += NGW) {
        int r = it;
        if (r < IIN) { transpose_item(win, 1024, Nin, wint, scr, r, lane); continue; } r -= IIN;
        if (r < IO) { transpose_item(wout, 1024, 1024, woutt, scr, r, lane); continue; } r -= IO;
        { const int blk = r >> 1, sub = r & 1;
          const int dir = blk >> 5, gate = (blk >> 4) & 1, h = blk & 15;
          const float* src = (gate == 0 ? A.in[17] : A.in[19]) + (size_t)(dir * 16 + h) * 4096;
          transpose_item(src, 64, 64, (bf16_t*)(ws + WS_GW) + (size_t)blk * 4096, scr, sub, lane); }
    }
}

template <int NR> __device__ __forceinline__ void norm_load(const float* const (&xrow)[NR], f32x4 (&v)[NR][4], int lane) {
#pragma unroll
    for (int i = 0; i < NR; ++i) { const f32x4* xr = (const f32x4*)xrow[i] + lane;
#pragma unroll
        for (int j = 0; j < 4; ++j) v[i][j] = __builtin_nontemporal_load(xr + 64 * j); }
}
template <int NR> __device__ __forceinline__ void norm_proc(const f32x4 (&v)[NR][4], bf16_t* const (&orow)[NR], const LAS float* const (&gs)[NR], const LAS float* const (&sh)[NR], int lane) {
    float s[NR];
#pragma unroll
    for (int i = 0; i < NR; ++i) { float a = 0.f;
#pragma unroll
        for (int j = 0; j < 4; ++j) a += (v[i][j].x * v[i][j].x + v[i][j].y * v[i][j].y) + (v[i][j].z * v[i][j].z + v[i][j].w * v[i][j].w);
        s[i] = a; }
#pragma unroll
    for (int o = 1; o < 64; o <<= 1) {
#pragma unroll
        for (int i = 0; i < NR; ++i) s[i] += __shfl_xor(s[i], o); }
#pragma unroll
    for (int i = 0; i < NR; ++i) { const float rstd = 1.0f / sqrtf(s[i] * (1.0f / DM) + EPS); u32x2* o8 = (u32x2*)orow[i] + lane;
#pragma unroll
        for (int j = 0; j < 4; ++j) { const f32x4 g = *(const LAS f32x4*)(gs[i] + 256 * j + 4 * lane), b = *(const LAS f32x4*)(sh[i] + 256 * j + 4 * lane);
            const f32x4 y = v[i][j] * rstd * g + b; u32x2 w; w.x = pk2(y.x, y.y); w.y = pk2(y.z, y.w); o8[64 * j] = w; } }
}
__device__ __forceinline__ void phase_norm(const Args& A, int layer, const float* xL, const float* xC, LAS unsigned char* L, const int wv) {
    const int tid = otid(wv), lane = tid & 63, wave = tid >> 6, bid = blockIdx.x, G = gridDim.x;
    const float* norm_g = (layer == 0 ? A.in[4] : layer == 1 ? A.in[10] : layer == 2 ? A.in[22] : A.in[29]);
    const float* mod_b = (layer == 0 ? A.in[6] : layer == 1 ? A.in[12] : layer == 2 ? A.in[24] : A.in[31]);
    unsigned char* ws = ows(A.ws);
    const float* modp = (const float*)(ws + WS_MODP) + (size_t)(layer * 8) * 9 * 3072;
    bf16_t* XN = (bf16_t*)(ws + WS_XN);
    LAS float* tab = (LAS float*)L;
    for (int vb = bid; vb < 256; vb += G) {
        const int batch = vb >> 5;
        const float* xr[3][3]; bf16_t* orow[3][3]; const LAS float* gs[3][3]; const LAS float* sh[3][3];
#pragma unroll
          for (int bt = 0; bt < 3; ++bt)
#pragma unroll
            for (int i = 0; i < 3; ++i) { const int ri = bt * 3 + i;
                if (ri < 8) { const int row = vb * 64 + wave * 8 + ri; xr[bt][i] = xL + (size_t)row * DM; orow[bt][i] = XN + (size_t)row * DM; gs[bt][i] = tab; sh[bt][i] = tab + 1024; }
                else { const int row = vb * 8 + wave; xr[bt][i] = xC + (size_t)row * DM; orow[bt][i] = XN + (size_t)(ML + row) * DM; gs[bt][i] = tab + 2048; sh[bt][i] = tab + 3072; } }
          f32x4 va[3][4], vbb[3][4];
          norm_load<3>(xr[0], va, lane);
        { float bv[8], pv[8][8], gn[8];
#pragma unroll
          for (int i8 = 0; i8 < 8; ++i8) { const int idx = tid + i8 * NTHREADS; const int which = idx >> 10, col = idx & 1023; const int r = (which < 2) ? batch : 8; const int mcol = (which & 1) ? col : 1024 + col;
              bv[i8] = mod_b[mcol];
#pragma unroll
              for (int kc = 0; kc < 8; ++kc) pv[i8][kc] = modp[(size_t)(kc * 9 + r) * 3072 + mcol];
              gn[i8] = (which & 1) ? 0.f : norm_g[col]; }
#pragma unroll
          for (int i8 = 0; i8 < 8; ++i8) { const int idx = tid + i8 * NTHREADS; const int which = idx >> 10;
              float v = bv[i8];
#pragma unroll
              for (int kc = 0; kc < 8; ++kc) v += pv[i8][kc];
              if (!(which & 1)) v = gn[i8] * (1.0f + v);
              tab[idx] = v; } }
        if (vb < 9) { float* gf = (float*)(ws + WS_GATE) + (size_t)(layer * 9 + vb) * 1024;
            float gb[2], gp[2][8];
#pragma unroll
            for (int c2 = 0; c2 < 2; ++c2) { const int col = tid + c2 * NTHREADS; gb[c2] = mod_b[2048 + col];
#pragma unroll
                for (int kc = 0; kc < 8; ++kc) gp[c2][kc] = modp[(size_t)(kc * 9 + vb) * 3072 + 2048 + col]; }
#pragma unroll
            for (int c2 = 0; c2 < 2; ++c2) { float v = gb[c2];
#pragma unroll
                for (int kc = 0; kc < 8; ++kc) v += gp[c2][kc];
                gf[tid + c2 * NTHREADS] = v; } }
        norm_load<3>(xr[1], vbb, lane);
        LBAR();
        {
          norm_proc<3>(va, orow[0], gs[0], sh[0], lane);
          norm_load<3>(xr[2], va, lane);
          norm_proc<3>(vbb, orow[1], gs[1], sh[1], lane);
          norm_proc<3>(va, orow[2], gs[2], sh[2], lane); }
        LBAR();
    }
}

#define MFMA32(a, b, c) __builtin_amdgcn_mfma_f32_32x32x16_bf16((a), (b), (c), 0, 0, 0)
#define MFMA16(a, b, c) __builtin_amdgcn_mfma_f32_16x16x32_bf16((a), (b), (c), 0, 0, 0)
__device__ __forceinline__ int crow(int r, int hi) { return (r & 3) + 8 * (r >> 2) + 4 * hi; }
typedef short v4i16_t __attribute__((ext_vector_type(4)));
__device__ __forceinline__ float max3f(float a, float b, float c) { float r; asm("v_max3_f32 %0, %1, %2, %3" : "=v"(r) : "v"(a), "v"(b), "v"(c)); return r; }
__device__ __forceinline__ s16x4 vtr(LAS const unsigned char* p) { return __builtin_bit_cast(s16x4, __builtin_amdgcn_ds_read_tr16_b64_v4i16((LAS v4i16_t*)p)); }

__device__ __forceinline__ void phase_attn(const bf16_t* ACT, bf16_t* Y, const float* sink, bool need_ctx, LAS unsigned char* L, const int wv) {
    constexpr int LD = 2560, KSTR = 144, TILEB = 64 * KSTR, BUFB = 2 * TILEB;
    const int tid = otid(wv), lane = tid & 63, r32 = lane & 31, hi = lane >> 5, wave = __builtin_amdgcn_readfirstlane(tid >> 6);
    const int g = wave >> 1, half = wave & 1, G = gridDim.x;
    const int skey = tid >> 3, sch = tid & 7;
    const int stoff = skey * KSTR + sch * 16;
    const int koff = r32 * KSTR + hi * 16;
    const int voff = TILEB + (4 * hi + ((lane & 15) >> 2)) * KSTR + (16 * ((lane >> 4) & 1) + 4 * (lane & 3)) * 2;
    const int nunits = need_ctx ? 1152 : 1024;
    for (int u = blockIdx.x; u < nunits; u += G) {
        int b, kvh, qb; bool lat;
        if (u < 1024) { b = u >> 7; kvh = (u >> 5) & 3; qb = u & 31; lat = true; } else { const int e = u - 1024; b = e >> 4; kvh = (e >> 2) & 3; qb = e & 3; lat = false; }
        const int h = kvh * 4 + g;
        const int qpos = qb * 64 + half * 32 + r32;
        const int qrow = lat ? b * SEQ + qpos : ML + b * CTX + qpos;
        int tlo = 4, thi = 4;
        if (lat) { tlo = qb == 0 ? 6 : (qb == 1 ? 5 : 4); thi = qb == 31 ? 7 : (qb == 30 ? 8 : 9); }
        const int n = 4 + (thi - tlo);
        const int kp_base = qb * 64 - 128;
        bf16x8 qf[4];
        { const bf16_t* qp = ACT + (size_t)qrow * LD + h * 64 + hi * 8;
#pragma unroll
          for (int d0 = 0; d0 < 4; ++d0) qf[d0] = *(const bf16x8*)(qp + d0 * 16); }
        float m_run = sink[h] * LOG2E, l_run = hi ? 0.f : 1.f;
        f32x16 o0, o1;
#pragma unroll
        for (int r = 0; r < 16; ++r) { o0[r] = 0.f; o1[r] = 0.f; }
        const size_t kcol = 1024 + kvh * 64 + sch * 8, vcol = 1280 + kvh * 64 + sch * 8;
#define ATT_TROW(s_) (((s_) < 4 ? ML + b * CTX + (s_) * 64 : b * SEQ + kp_base + (tlo + (s_) - 8) * 64) + skey)
        u32x4 kq0, vq0, kq1, vq1, kq2, vq2;
        { const size_t krow = (size_t)ATT_TROW(0); kq0 = *(const u32x4*)(ACT + krow * LD + kcol); vq0 = *(const u32x4*)(ACT + krow * LD + vcol); }
        { const size_t krow = (size_t)ATT_TROW(1); kq1 = *(const u32x4*)(ACT + krow * LD + kcol); vq1 = *(const u32x4*)(ACT + krow * LD + vcol); }
        { const size_t krow = (size_t)ATT_TROW(2); kq2 = *(const u32x4*)(ACT + krow * LD + kcol); vq2 = *(const u32x4*)(ACT + krow * LD + vcol); }
        LBAR();
        *(LAS u32x4*)(L + stoff) = kq0; *(LAS u32x4*)(L + TILEB + stoff) = vq0;
        { const size_t krow = (size_t)ATT_TROW(3); kq0 = *(const u32x4*)(ACT + krow * LD + kcol); vq0 = *(const u32x4*)(ACT + krow * LD + vcol); }
        LBAR();
#define ATT_STEP(s_, KQ, VQ) do { const int s = (s_); \
            const int t = s < 4 ? s : tlo + (s - 4); \
            LAS const unsigned char* B = L + (s & 1) * BUFB; \
 \
              \
            bf16x8 kf[8]; s16x4 vl[8], vh[8]; \
_Pragma("unroll") \
            for (int d0 = 0; d0 < 4; ++d0) { kf[2 * d0] = *(const LAS bf16x8*)(B + koff + d0 * 32); kf[2 * d0 + 1] = *(const LAS bf16x8*)(B + koff + 32 * KSTR + d0 * 32); } \
_Pragma("unroll") \
            for (int i = 0; i < 4; ++i) { LAS const unsigned char* vp = B + voff + i * 16 * KSTR; vl[2 * i] = vtr(vp); vh[2 * i] = vtr(vp + 8 * KSTR); vl[2 * i + 1] = vtr(vp + 64); vh[2 * i + 1] = vtr(vp + 8 * KSTR + 64); } \
            __builtin_amdgcn_sched_barrier(0); \
            f32x16 p0, p1; \
_Pragma("unroll") \
            for (int r = 0; r < 16; ++r) { p0[r] = 0.f; p1[r] = 0.f; } \
_Pragma("unroll") \
            for (int d0 = 0; d0 < 4; ++d0) { p0 = MFMA32(kf[2 * d0], qf[d0], p0); p1 = MFMA32(kf[2 * d0 + 1], qf[d0], p1); } \
            if (t == 4 || t == 8) { const int kp0 = kp_base + (t - 4) * 64 - qpos; \
_Pragma("unroll") \
                for (int r = 0; r < 16; ++r) { const int d0 = kp0 + crow(r, hi), d1 = d0 + 32; \
                    if (d0 > 128 || d0 < -128) p0[r] = -1e30f; if (d1 > 128 || d1 < -128) p1[r] = -1e30f; } } \
            float mt = max3f(p0[0], p0[1], p1[0]), mt2 = max3f(p0[2], p0[3], p1[1]); mt = max3f(mt, p1[2], p1[3]); \
_Pragma("unroll") \
            for (int r = 4; r < 16; r += 4) { mt = max3f(mt, p0[r], p0[r + 1]); mt2 = max3f(mt2, p0[r + 2], p0[r + 3]); mt = max3f(mt, p1[r], p1[r + 1]); mt2 = max3f(mt2, p1[r + 2], p1[r + 3]); } \
            mt = fmaxf(mt, mt2); \
            mt = fmaxf(mt, __shfl_xor(mt, 32)) - m_run; \
 \
            float dl = 0.f; \
            if (s == 0) dl = fmaxf(mt, 0.f); else if (mt > 8.0f) dl = mt; \
            if (__any(dl != 0.f)) { const float alpha = __builtin_amdgcn_exp2f(-dl); m_run += dl; l_run *= alpha; \
_Pragma("unroll") \
                for (int r = 0; r < 16; ++r) { o0[r] *= alpha; o1[r] *= alpha; } } \
            float ls = 0.f, ls2 = 0.f; \
_Pragma("unroll") \
            for (int r = 0; r < 16; ++r) { p0[r] = __builtin_amdgcn_exp2f(p0[r] - m_run); p1[r] = __builtin_amdgcn_exp2f(p1[r] - m_run); ls += p0[r]; ls2 += p1[r]; } \
            ls += ls2; \
            l_run += ls; \
            bf16x8 pb[2][2]; \
_Pragma("unroll") \
            for (int j = 0; j < 2; ++j) { \
                u32x4 w0, w1; \
                w0.x = pk2(p0[8 * j + 0], p0[8 * j + 1]); w0.y = pk2(p0[8 * j + 2], p0[8 * j + 3]); w0.z = pk2(p0[8 * j + 4], p0[8 * j + 5]); w0.w = pk2(p0[8 * j + 6], p0[8 * j + 7]); \
                w1.x = pk2(p1[8 * j + 0], p1[8 * j + 1]); w1.y = pk2(p1[8 * j + 2], p1[8 * j + 3]); w1.z = pk2(p1[8 * j + 4], p1[8 * j + 5]); w1.w = pk2(p1[8 * j + 6], p1[8 * j + 7]); \
                pb[0][j] = __builtin_bit_cast(bf16x8, w0); pb[1][j] = __builtin_bit_cast(bf16x8, w1); \
            } \
 \
_Pragma("unroll") \
            for (int kb = 0; kb < 2; ++kb) \
_Pragma("unroll") \
                for (int j = 0; j < 2; ++j) { const int i = kb * 2 + j; \
                    const bf16x8 a0 = __builtin_shufflevector(vl[2 * i], vh[2 * i], 0, 1, 2, 3, 4, 5, 6, 7), a1 = __builtin_shufflevector(vl[2 * i + 1], vh[2 * i + 1], 0, 1, 2, 3, 4, 5, 6, 7); \
                    o0 = MFMA32(a0, pb[kb][j], o0); o1 = MFMA32(a1, pb[kb][j], o1); \
                } \
            if (s + 1 < n) { LAS unsigned char* Bn = L + ((s + 1) & 1) * BUFB; *(LAS u32x4*)(Bn + stoff) = KQ; *(LAS u32x4*)(Bn + TILEB + stoff) = VQ; } \
            LBAR(); \
            if (s + 4 < n) { const size_t krow = (size_t)ATT_TROW(s + 4); KQ = *(const u32x4*)(ACT + krow * LD + kcol); VQ = *(const u32x4*)(ACT + krow * LD + vcol); } \
        } while (0)
#pragma unroll 1
        for (int s0 = 0; s0 < n; s0 += 3) {
            ATT_STEP(s0, kq1, vq1);
            if (s0 + 1 < n) ATT_STEP(s0 + 1, kq2, vq2);
            if (s0 + 2 < n) ATT_STEP(s0 + 2, kq0, vq0);
        }
#undef ATT_STEP
#undef ATT_TROW
        u32x4 sgq[4];
        { const int qrow0 = qrow - r32;
#pragma unroll
          for (int it = 0; it < 4; ++it) sgq[it] = *(const u32x4*)(ACT + (size_t)(qrow0 + it * 8 + (lane >> 3)) * LD + 1536 + h * 64 + (lane & 7) * 8); }
        const float lt = l_run + __shfl_xor(l_run, 32); const float inv = 1.0f / lt;
        LAS float* stg = (LAS float*)(L + 40960 + wave * 8704);
#pragma unroll
        for (int db = 0; db < 2; ++db)
#pragma unroll
            for (int q4 = 0; q4 < 4; ++q4) { const int d = 32 * db + 8 * q4 + 4 * hi; f32x4 v;
                if (db == 0) v = (f32x4){o0[4 * q4], o0[4 * q4 + 1], o0[4 * q4 + 2], o0[4 * q4 + 3]}; else v = (f32x4){o1[4 * q4], o1[4 * q4 + 1], o1[4 * q4 + 2], o1[4 * q4 + 3]};
                *(LAS f32x4*)(stg + r32 * 68 + d) = v * inv; }
        asm volatile("s_waitcnt lgkmcnt(0)" ::: "memory");
        { const int qrow0 = qrow - r32; const int er = lane >> 3, ec = (lane & 7) * 8;
#pragma unroll
          for (int it = 0; it < 4; ++it) { const int row = it * 8 + er; const size_t grow = (size_t)(qrow0 + row);
              const f32x4 a0 = *(const LAS f32x4*)(stg + row * 68 + ec), a1 = *(const LAS f32x4*)(stg + row * 68 + ec + 4);
              const u32x4 gw = sgq[it];
              u32x4 w; w.x = pk2(a0.x * bflo(gw.x), a0.y * bfhi(gw.x)); w.y = pk2(a0.z * bflo(gw.y), a0.w * bfhi(gw.y)); w.z = pk2(a1.x * bflo(gw.z), a1.y * bfhi(gw.z)); w.w = pk2(a1.z * bflo(gw.w), a1.w * bfhi(gw.w));
              *(u32x4*)(Y + grow * DM + h * 64 + ec) = w; } }
    }
    LBAR();
}

__device__ __forceinline__ void phase_lru(const Args& A, const bf16_t* ACT, bf16_t* Y, float* HF, LAS unsigned char* L, const int wv) {
    constexpr int LD = 2048, TT = 128, USTR = 144;
    const int tid = otid(wv), lane = tid & 63, wave = __builtin_amdgcn_readfirstlane(tid >> 6), G = gridDim.x;
    LAS unsigned char* UL = L;
    LAS unsigned char* XA = L + 19200;
    LAS float* XF = (LAS float*)(L + 19200 + 18432);
    LAS f32x2* AB = (LAS f32x2*)(L + 19200 + 18432 + 18432);
    LAS f32x2* CAR = (LAS f32x2*)(L + 19200 + 18432 + 18432 + 34816);
    LAS float* ST = (LAS float*)(L + 19200 + 18432 + 18432 + 34816 + 4096);
    LAS float* CW = (LAS float*)(L + 19200 + 18432 + 18432 + 34816 + 4096 + 256);
    const bf16_t* gwT = (const bf16_t*)(ows(A.ws) + WS_GW);
    const float* conv_w = A.in[15]; const float* conv_b = A.in[16]; const float* ba = A.in[18]; const float* bx = A.in[20]; const float* lam = A.in[21];
    const int fr = lane & 15, fq = lane >> 4;
    const int stok = tid >> 3, sch = tid & 7;
    const int ch = tid & 31, sc = tid >> 5;
    const int otok = tid >> 2, oq = tid & 3;
    for (int u = blockIdx.x; u < 256; u += G) {
        const int b = u >> 5, hb = u & 31, hblk = hb >> 1, half = hb & 1, cin0 = hblk * 64, c0 = cin0 + half * 32;
#pragma unroll 1
        for (int dir = 0; dir < 2; ++dir) {
            LBAR();
            if (tid < 320) { const int k = tid >> 6, c = tid & 63; CW[tid] = (k < 4) ? conv_w[(size_t)(dir * 4 + k) * DM + cin0 + c] : conv_b[(size_t)dir * DM + cin0 + c]; }
            const int cbk = wave & 1;
            bf16x8 wr_[2], wi_[2];
            { const bf16_t* pr = gwT + ((size_t)((dir * 2 + 0) * 16 + hblk) * 64 + half * 32 + cbk * 16 + fr) * 64 + fq * 8;
              const bf16_t* pi = gwT + ((size_t)((dir * 2 + 1) * 16 + hblk) * 64 + half * 32 + cbk * 16 + fr) * 64 + fq * 8;
              wr_[0] = *(const bf16x8*)pr; wr_[1] = *(const bf16x8*)(pr + 32); wi_[0] = *(const bf16x8*)pi; wi_[1] = *(const bf16x8*)(pi + 32); }
            float eba[4], ebx[4], esp[4];
#pragma unroll
            for (int e = 0; e < 4; ++e) { const int c = dir * DM + c0 + cbk * 16 + 4 * fq + e; eba[e] = ba[c]; ebx[e] = bx[c];
                const float nl = -lam[c]; esp[e] = (fmaxf(nl, 0.f) + log1pf(__expf(-fabsf(nl)))) * (-8.0f * LOG2E); }
            if (tid < 32) ST[tid] = 0.f;
            u32x4 ur[2], uh = (u32x4){0u, 0u, 0u, 0u};
            { const int rowbase = ML + b * CTX;
#pragma unroll
              for (int i2 = 0; i2 < 2; ++i2) { const int S = stok + 64 * i2; const int row = rowbase + (dir ? CTX - 1 - S : S); ur[i2] = *(const u32x4*)(ACT + (size_t)row * LD + cin0 + sch * 8); } }
            f32x4 hf0 = (f32x4){0.f, 0.f, 0.f, 0.f}, hf1 = hf0; u32x4 gv = (u32x4){0u, 0u, 0u, 0u}; size_t orow = 0; int oseq = 0;
#define LRU_OUT() do { const f32x4 h0 = *(const LAS f32x4*)(XF + otok * 36 + oq * 8), h1 = *(const LAS f32x4*)(XF + otok * 36 + oq * 8 + 4); \
                if (dir == 0) { u32x4 hw; hw.x = pk2(h0.x, h0.y); hw.y = pk2(h0.z, h0.w); hw.z = pk2(h1.x, h1.y); hw.w = pk2(h1.z, h1.w); *(u32x4*)((bf16_t*)HF + ((size_t)u * 2304 + oseq) * 32 + oq * 8) = hw; }     \
                else { const f32x4 s0 = h0 + hf0, s1 = h1 + hf1; u32x4 w; \
                    w.x = pk2(s0.x * bflo(gv.x), s0.y * bfhi(gv.x)); w.y = pk2(s0.z * bflo(gv.y), s0.w * bfhi(gv.y)); w.z = pk2(s1.x * bflo(gv.z), s1.y * bfhi(gv.z)); w.w = pk2(s1.z * bflo(gv.w), s1.w * bfhi(gv.w)); \
                    *(u32x4*)(Y + orow * DM + c0 + oq * 8) = w; } } while (0)
#pragma unroll 1
            for (int tl = 0; tl < 18; ++tl) {
                const int seg = tl < 2 ? 0 : 1, S0 = seg ? (tl - 2) * TT : tl * TT, seglen = seg ? SEQ : CTX, rowbase = seg ? b * SEQ : ML + b * CTX;
                LBAR();
                *(LAS u32x4*)(UL + (3 + stok) * USTR + sch * 16) = ur[0]; *(LAS u32x4*)(UL + (3 + 64 + stok) * USTR + sch * 16) = ur[1];
                if (tid < 24) *(LAS u32x4*)(UL + stok * USTR + sch * 16) = uh;
                if (tl > 0) LRU_OUT();
                LBAR();
                { const int S = S0 + otok; const int pos = dir ? seglen - 1 - S : S; orow = (size_t)(rowbase + pos); oseq = seg ? CTX + pos : pos;
                  if (dir == 1) { const u32x4 hw = *(const u32x4*)((const bf16_t*)HF + ((size_t)u * 2304 + oseq) * 32 + oq * 8); hf0 = (f32x4){bflo(hw.x), bfhi(hw.x), bflo(hw.y), bfhi(hw.y)}; hf1 = (f32x4){bflo(hw.z), bfhi(hw.z), bflo(hw.w), bfhi(hw.w)}; gv = *(const u32x4*)(ACT + orow * LD + 1024 + c0 + oq * 8); } }
                if (tl + 1 < 18) { const int tn = tl + 1; const int seg2 = tn < 2 ? 0 : 1, S02 = seg2 ? (tn - 2) * TT : tn * TT, seglen2 = seg2 ? SEQ : CTX, rowbase2 = seg2 ? b * SEQ : ML + b * CTX;
#pragma unroll
                    for (int i2 = 0; i2 < 2; ++i2) { const int S = S02 + stok + 64 * i2; const int row = rowbase2 + (dir ? seglen2 - 1 - S : S); ur[i2] = *(const u32x4*)(ACT + (size_t)row * LD + cin0 + sch * 8); }
                    uh = (u32x4){0u, 0u, 0u, 0u};
                    if (tid < 24 && S02 > 0) { const int S = S02 - 3 + stok; const int row = rowbase2 + (dir ? seglen2 - 1 - S : S); uh = *(const u32x4*)(ACT + (size_t)row * LD + cin0 + sch * 8); } }
                for (int rep_ = 0; rep_ < DUP_LRUBC; ++rep_) {
                { float x0[8], x1[8];
                  { const f32x4 ca = *(const LAS f32x4*)(CW + 256 + sch * 8), cc = *(const LAS f32x4*)(CW + 256 + sch * 8 + 4);
                    x0[0] = ca.x; x0[1] = ca.y; x0[2] = ca.z; x0[3] = ca.w; x0[4] = cc.x; x0[5] = cc.y; x0[6] = cc.z; x0[7] = cc.w;
#pragma unroll
                    for (int e = 0; e < 8; ++e) x1[e] = x0[e]; }
#pragma unroll
                  for (int k = 0; k < 4; ++k) { const f32x4 wa = *(const LAS f32x4*)(CW + k * 64 + sch * 8), wb = *(const LAS f32x4*)(CW + k * 64 + sch * 8 + 4);
                      const u32x4 u0 = *(const LAS u32x4*)(UL + (stok + k) * USTR + sch * 16), u1 = *(const LAS u32x4*)(UL + (stok + 64 + k) * USTR + sch * 16);
                      x0[0] += wa.x * bflo(u0.x); x0[1] += wa.y * bfhi(u0.x); x0[2] += wa.z * bflo(u0.y); x0[3] += wa.w * bfhi(u0.y);
                      x0[4] += wb.x * bflo(u0.z); x0[5] += wb.y * bfhi(u0.z); x0[6] += wb.z * bflo(u0.w); x0[7] += wb.w * bfhi(u0.w);
                      x1[0] += wa.x * bflo(u1.x); x1[1] += wa.y * bfhi(u1.x); x1[2] += wa.z * bflo(u1.y); x1[3] += wa.w * bfhi(u1.y);
                      x1[4] += wb.x * bflo(u1.z); x1[5] += wb.y * bfhi(u1.z); x1[6] += wb.z * bflo(u1.w); x1[7] += wb.w * bfhi(u1.w); }
                  u32x4 w; w.x = pk2(x0[0], x0[1]); w.y = pk2(x0[2], x0[3]); w.z = pk2(x0[4], x0[5]); w.w = pk2(x0[6], x0[7]);
                  *(LAS u32x4*)(XA + stok * USTR + sch * 16) = w;
                  w.x = pk2(x1[0], x1[1]); w.y = pk2(x1[2], x1[3]); w.z = pk2(x1[4], x1[5]); w.w = pk2(x1[6], x1[7]);
                  *(LAS u32x4*)(XA + (stok + 64) * USTR + sch * 16) = w;
                  if ((sch >> 2) == half) { LAS f32x4* xf = (LAS f32x4*)(XF + stok * 36 + (sch & 3) * 8); xf[0] = (f32x4){x0[0], x0[1], x0[2], x0[3]}; xf[1] = (f32x4){x0[4], x0[5], x0[6], x0[7]};
                      xf = (LAS f32x4*)(XF + (stok + 64) * 36 + (sch & 3) * 8); xf[0] = (f32x4){x1[0], x1[1], x1[2], x1[3]}; xf[1] = (f32x4){x1[4], x1[5], x1[6], x1[7]}; } }
                LBAR();
#pragma unroll
                for (int i2 = 0; i2 < 2; ++i2) { const int tb = (wave >> 1) + 4 * i2; const int tok = tb * 16 + fr;
                    const bf16x8 x0 = *(const LAS bf16x8*)(XA + tok * USTR + fq * 16), x1 = *(const LAS bf16x8*)(XA + tok * USTR + 64 + fq * 16);
                    f32x4 ar = (f32x4){0.f, 0.f, 0.f, 0.f}, ai = (f32x4){0.f, 0.f, 0.f, 0.f};
                    ar = MFMA16(wr_[0], x0, ar); ar = MFMA16(wr_[1], x1, ar); ai = MFMA16(wi_[0], x0, ai); ai = MFMA16(wi_[1], x1, ai);
                    const f32x4 xv = *(const LAS f32x4*)(XF + tok * 36 + cbk * 16 + 4 * fq);
                    float av[4], bv[4];
#pragma unroll
                    for (int e = 0; e < 4; ++e) { const float r = __builtin_amdgcn_rcpf(1.0f + __builtin_amdgcn_exp2f(-(ar[e] + eba[e]) * LOG2E)); const float ig = __builtin_amdgcn_rcpf(1.0f + __builtin_amdgcn_exp2f(-(ai[e] + ebx[e]) * LOG2E));
                        const float a_ = __builtin_amdgcn_exp2f(r * esp[e]); av[e] = a_; bv[e] = __builtin_amdgcn_sqrtf(fmaxf(1.0f - a_ * a_, 0.f)) * (ig * xv[e]); }
                    LAS f32x4* ab = (LAS f32x4*)(AB + tok * 34 + cbk * 16 + 4 * fq); ab[0] = (f32x4){av[0], bv[0], av[1], bv[1]}; ab[1] = (f32x4){av[2], bv[2], av[3], bv[3]}; }
                LBAR();
                }
                float a8[8], b8[8];
                { float Ap = 1.f, H = 0.f;
#pragma unroll
                  for (int k = 0; k < 8; ++k) { const f32x2 v = AB[(sc * 8 + k) * 34 + ch]; a8[k] = v.x; b8[k] = v.y; H = v.x * H + v.y; Ap *= v.x; }
                  CAR[sc * 32 + ch] = (f32x2){Ap, H}; }
                LBAR();
                float hrun = ST[(tl & 1) * 32 + ch];
                { f32x2 cr[15];
#pragma unroll
                  for (int s = 0; s < 15; ++s) cr[s] = CAR[s * 32 + ch];
#pragma unroll
                  for (int s = 0; s < 15; ++s) hrun = (s < sc) ? cr[s].x * hrun + cr[s].y : hrun; }
#pragma unroll
                for (int k = 0; k < 8; ++k) { hrun = a8[k] * hrun + b8[k]; XF[(sc * 8 + k) * 36 + ch] = hrun; }
                if (sc == 15) ST[((tl + 1) & 1) * 32 + ch] = hrun;
            }
            LBAR();
            LRU_OUT();
            asm volatile("s_waitcnt vmcnt(0)" ::: "memory");
        }
        LBAR();
    }
#undef LRU_OUT
}

__device__ __forceinline__ void cu8(const bf16_t* ACT, size_t row, int col, float* o) {
    const u32x4 a = __builtin_nontemporal_load((const u32x4*)(ACT + row * 4096 + col)), c = __builtin_nontemporal_load((const u32x4*)(ACT + row * 4096 + 2048 + col));
    o[0] = bflo(a.x) * bflo(c.x); o[1] = bfhi(a.x) * bfhi(c.x); o[2] = bflo(a.y) * bflo(c.y); o[3] = bfhi(a.y) * bfhi(c.y);
    o[4] = bflo(a.z) * bflo(c.z); o[5] = bfhi(a.z) * bfhi(c.z); o[6] = bflo(a.w) * bflo(c.w); o[7] = bfhi(a.w) * bfhi(c.w);
}
__device__ __forceinline__ void phase_conv(const Args& A, const bf16_t* ACT, bf16_t* Y, const int wv) {
    const float* conv_w = A.in[27]; const float* conv_b = A.in[28];
    const int nitems = (MT / 8) * 128;
    const int tid = otid(wv);
    for (int item = blockIdx.x * NTHREADS + tid; item < nitems; item += gridDim.x * NTHREADS) {
        const int rg = item >> 7, chunk = item & 127, col = chunk * 8, row0 = rg * 8;
        const int seglen = row0 < ML ? SEQ : CTX;
        const bool first = (row0 % seglen) == 0, last = ((row0 + 8) % seglen) == 0;
        float w0[8], w1[8], w2[8], cb[8];
        { const f32x4* p = (const f32x4*)(conv_w + col); f32x4 a = p[0], c = p[1]; w0[0] = a.x; w0[1] = a.y; w0[2] = a.z; w0[3] = a.w; w0[4] = c.x; w0[5] = c.y; w0[6] = c.z; w0[7] = c.w;
          p = (const f32x4*)(conv_w + DM + col); a = p[0]; c = p[1]; w1[0] = a.x; w1[1] = a.y; w1[2] = a.z; w1[3] = a.w; w1[4] = c.x; w1[5] = c.y; w1[6] = c.z; w1[7] = c.w;
          p = (const f32x4*)(conv_w + 2 * DM + col); a = p[0]; c = p[1]; w2[0] = a.x; w2[1] = a.y; w2[2] = a.z; w2[3] = a.w; w2[4] = c.x; w2[5] = c.y; w2[6] = c.z; w2[7] = c.w;
          p = (const f32x4*)(conv_b + col); a = p[0]; c = p[1]; cb[0] = a.x; cb[1] = a.y; cb[2] = a.z; cb[3] = a.w; cb[4] = c.x; cb[5] = c.y; cb[6] = c.z; cb[7] = c.w; }
        float prev[8], cur[8], nxt[8];
        if (first) {
#pragma unroll
            for (int e = 0; e < 8; ++e) prev[e] = 0.f;
        } else cu8(ACT, (size_t)row0 - 1, col, prev);
        cu8(ACT, (size_t)row0, col, cur);
#pragma unroll
        for (int k = 0; k < 8; ++k) {
            const size_t row = (size_t)row0 + k;
            if (k == 7 && last) {
#pragma unroll
                for (int e = 0; e < 8; ++e) nxt[e] = 0.f;
            } else cu8(ACT, row + 1, col, nxt);
            const u32x4 bgw = __builtin_nontemporal_load((const u32x4*)(ACT + row * 4096 + 1024 + col)), sgw = __builtin_nontemporal_load((const u32x4*)(ACT + row * 4096 + 3072 + col));
            float y[8];
#pragma unroll
            for (int e = 0; e < 8; ++e) y[e] = w0[e] * prev[e] + w1[e] * cur[e] + w2[e] * nxt[e] + cb[e];
            y[0] *= bflo(bgw.x) * bflo(sgw.x); y[1] *= bfhi(bgw.x) * bfhi(sgw.x); y[2] *= bflo(bgw.y) * bflo(sgw.y); y[3] *= bfhi(bgw.y) * bfhi(sgw.y);
            y[4] *= bflo(bgw.z) * bflo(sgw.z); y[5] *= bfhi(bgw.z) * bfhi(sgw.z); y[6] *= bflo(bgw.w) * bflo(sgw.w); y[7] *= bfhi(bgw.w) * bfhi(sgw.w);
            u32x4 w; w.x = pk2(y[0], y[1]); w.y = pk2(y[2], y[3]); w.z = pk2(y[4], y[5]); w.w = pk2(y[6], y[7]);
            *(u32x4*)(Y + row * DM + col) = w;
#pragma unroll
            for (int e = 0; e < 8; ++e) { prev[e] = cur[e]; cur[e] = nxt[e]; }
        }
    }
}

__device__ __forceinline__ void phase_ctx_wout(const bf16_t* Yc, const bf16_t* Wt, const float* xin, float* xout, const float* gate, LAS unsigned char* L, const int wv) {
    constexpr int PITCH = 272, ABYTES = 128 * PITCH, BUFB = 192 * PITCH, NS = 8;
    const int tid = otid(wv), lane = tid & 63, r32 = lane & 31, hi = lane >> 5, wave = wv, G = gridDim.x;
    const int srow = tid >> 4, sch = tid & 15;
    const int aoff = ((wave >> 1) * 32 + r32) * PITCH + hi * 128, boff = ABYTES + ((wave & 1) * 32 + r32) * PITCH + hi * 128;
    for (int t = blockIdx.x; t < 256; t += G) {
        const int tm = t >> 4, tn = t & 15;
        const bf16_t* ga = Yc + (size_t)(tm * 128 + srow) * DM + sch * 8; const bf16_t* gb = Wt + (size_t)(tn * 64 + srow) * DM + sch * 8;
        f32x16 acc0, acc1;
#pragma unroll
        for (int r = 0; r < 16; ++r) { acc0[r] = 0.f; acc1[r] = 0.f; }
        const int m0 = tm * 128 + (wave >> 1) * 32, col = tn * 64 + (wave & 1) * 32 + r32; const float gv = gate[col];
        float xv[16];
#pragma unroll
        for (int r = 0; r < 16; ++r) xv[r] = xin[(size_t)(m0 + crow(r, hi)) * DM + col];
        u32x4 qa[3][4], qb[3][2];
#define CTX_LOAD(q, s_) do { _Pragma("unroll") for (int i = 0; i < 4; ++i) qa[q][i] = *(const u32x4*)(ga + (size_t)(32 * i) * DM + (s_) * 128); \
                             _Pragma("unroll") for (int i = 0; i < 2; ++i) qb[q][i] = *(const u32x4*)(gb + (size_t)(32 * i) * DM + (s_) * 128); } while (0)
#define CTX_WRITE(q, buf) do { LAS unsigned char* Bn = L + (buf) * BUFB; _Pragma("unroll") for (int i = 0; i < 4; ++i) *(LAS u32x4*)(Bn + (32 * i + srow) * PITCH + sch * 16) = qa[q][i]; \
                               _Pragma("unroll") for (int i = 0; i < 2; ++i) *(LAS u32x4*)(Bn + ABYTES + (32 * i + srow) * PITCH + sch * 16) = qb[q][i]; } while (0)
#define CTX_STEP(s_, q) do { const int s = (s_); LAS const unsigned char* B = L + (s & 1) * BUFB; bf16x8 a[8], b[8]; \
            _Pragma("unroll") for (int j = 0; j < 8; ++j) { a[j] = *(const LAS bf16x8*)(B + aoff + j * 16); b[j] = *(const LAS bf16x8*)(B + boff + j * 16); } \
            _Pragma("unroll") for (int j = 0; j < 8; j += 2) { acc0 = MFMA32(a[j], b[j], acc0); acc1 = MFMA32(a[j + 1], b[j + 1], acc1); } \
            if (s + 1 < NS) CTX_WRITE(q, (s + 1) & 1); \
            LBAR(); \
            if (s + 4 < NS) CTX_LOAD(q, s + 4); } while (0)
        CTX_LOAD(0, 0); CTX_LOAD(1, 1); CTX_LOAD(2, 2);
        LBAR();
        CTX_WRITE(0, 0);
        CTX_LOAD(0, 3);
        LBAR();
        CTX_STEP(0, 1); CTX_STEP(1, 2); CTX_STEP(2, 0); CTX_STEP(3, 1); CTX_STEP(4, 2); CTX_STEP(5, 0); CTX_STEP(6, 1); CTX_STEP(7, 2);
#undef CTX_LOAD
#undef CTX_WRITE
#undef CTX_STEP
#pragma unroll
        for (int r = 0; r < 16; ++r) xout[(size_t)(m0 + crow(r, hi)) * DM + col] = xv[r] + gv * (acc0[r] + acc1[r]);
    }
    LBAR();
}

__device__ __forceinline__ void phase_final(float* out, const float* g, const int wv) {
    const int tid = otid(wv); const int lane = tid & 63, gw = blockIdx.x * NWAVES + (tid >> 6), NGW = gridDim.x * NWAVES;
    f32x4 gv[4];
#pragma unroll
    for (int j = 0; j < 4; ++j) gv[j] = *((const f32x4*)g + 64 * j + lane);
    for (int row0 = gw * 4; row0 < ML; row0 += NGW * 4) {
        f32x4 v[4][4]; float s[4];
#pragma unroll
        for (int i = 0; i < 4; ++i) { const f32x4* xr = (const f32x4*)(out + (size_t)(row0 + i) * DM) + lane;
#pragma unroll
            for (int j = 0; j < 4; ++j) v[i][j] = __builtin_nontemporal_load(xr + 64 * j); }
#pragma unroll
        for (int i = 0; i < 4; ++i) { float a = 0.f;
#pragma unroll
            for (int j = 0; j < 4; ++j) a += (v[i][j].x * v[i][j].x + v[i][j].y * v[i][j].y) + (v[i][j].z * v[i][j].z + v[i][j].w * v[i][j].w);
            s[i] = a; }
#pragma unroll
        for (int o = 1; o < 64; o <<= 1) {
#pragma unroll
            for (int i = 0; i < 4; ++i) s[i] += __shfl_xor(s[i], o); }
#pragma unroll
        for (int i = 0; i < 4; ++i) { const float rstd = 1.0f / sqrtf(s[i] * (1.0f / DM) + EPS); f32x4* xr = (f32x4*)(out + (size_t)(row0 + i) * DM) + lane;
#pragma unroll
            for (int j = 0; j < 4; ++j) xr[64 * j] = v[i][j] * rstd * gv[j]; }
    }
}

#define RLX_AGENT __ATOMIC_RELAXED, __HIP_MEMORY_SCOPE_AGENT
#define XB_TMO      128
#define XB_XCNT(j)  (256  + 64 * (j))
#define XB_XSUB(j)  (1280 + 64 * (j))
#define XB_XGEN(j)  (2304 + 64 * (j))
#define XB_TOP      3328
#define XB_TOPGEN   3392
#define XCD_BAR_WORDS 3456
#define XB_SPIN_CAP (1u << 18)

__device__ __forceinline__ unsigned xb_ld(unsigned* p)              { return __hip_atomic_load(p, __ATOMIC_RELAXED, __HIP_MEMORY_SCOPE_AGENT); }
__device__ __forceinline__ unsigned xb_add(unsigned* p, unsigned v) { return __hip_atomic_fetch_add(p, v, __ATOMIC_RELAXED, __HIP_MEMORY_SCOPE_AGENT); }
__device__ __forceinline__ unsigned xb_xcc_id() { return (unsigned)__builtin_amdgcn_s_getreg((3 << 11) | 20) & 0xFu; }
#define XB_SPIN(cond, bar) do { unsigned _sp = 0; while (cond) { __builtin_amdgcn_s_sleep(1); \
    if ((++_sp & 255u) == 0u) { if (xb_ld(&(bar)[XB_TMO])) break; if (_sp > XB_SPIN_CAP) { atomicAdd(&(bar)[XB_TMO], 1u); break; } } } } while (0)

struct XcdBarrier {
    unsigned* bar; unsigned x;
    volatile LAS unsigned* st;
};

__device__ __forceinline__ XcdBarrier xcd_barrier_post(unsigned* bar, volatile LAS unsigned* st) {
    XcdBarrier b; b.bar = bar; b.x = xb_xcc_id(); b.st = st;
    if (threadIdx.x == 0) (void)xb_add(&bar[XB_XCNT(b.x)], 1u);
    return b;
}
__device__ __forceinline__ void xcd_barrier_complete(unsigned* bar, unsigned x, unsigned& nloc, unsigned& nx) {
    const unsigned G = gridDim.x * gridDim.y * gridDim.z;
    unsigned sum, cnt, mine, sp = 0u;
    for (;;) {
        sum = 0u; cnt = 0u; mine = 0u;
#pragma unroll
        for (unsigned j = 0; j < 16; ++j) { const unsigned c = xb_ld(&bar[XB_XCNT(j)]); sum += c; cnt += (c > 0u) ? 1u : 0u; mine = (j == x) ? c : mine; }
        if (sum == G) break;
        __builtin_amdgcn_s_sleep(1);
        if ((++sp & 255u) == 0u) { if (xb_ld(&bar[XB_TMO])) break; if (sp > XB_SPIN_CAP) { atomicAdd(&bar[XB_TMO], 1u); break; } }
    }
    nloc = mine > 0u ? mine : 1u; nx = cnt > 0u ? cnt : 1u;
}

__device__ __forceinline__ void xcd_barrier(const XcdBarrier& b) {
    asm volatile("s_waitcnt vmcnt(0)" ::: "memory");
    __syncthreads();
    if (threadIdx.x == 0) {
        unsigned* bar = b.bar;
        __builtin_amdgcn_s_waitcnt(0);
        unsigned nloc = b.st[0], nx = b.st[1];
        if (nloc == 0u) { xcd_barrier_complete(bar, b.x, nloc, nx); b.st[0] = nloc; b.st[1] = nx; }
        const unsigned old = xb_add(&bar[XB_XSUB(b.x)], 1u);
        const unsigned gen = old / nloc;
        if (old + 1u == (gen + 1u) * nloc) {
            __builtin_amdgcn_fence(__ATOMIC_RELEASE, "agent");
            asm volatile("s_waitcnt vmcnt(0)" ::: "memory");
            const unsigned og = xb_add(&bar[XB_TOP], 1u);
            const unsigned tg = og / nx;
            if (og + 1u == (tg + 1u) * nx) xb_add(&bar[XB_TOPGEN], 1u);
            else XB_SPIN(xb_ld(&bar[XB_TOPGEN]) == tg, bar);
            __builtin_amdgcn_fence(__ATOMIC_ACQUIRE, "agent");
            xb_add(&bar[XB_XGEN(b.x)], 1u);
            asm volatile("s_waitcnt vmcnt(0)" ::: "memory");
        } else {
            XB_SPIN(xb_ld(&bar[XB_XGEN(b.x)]) == gen, bar);
            __builtin_amdgcn_fence(__ATOMIC_ACQUIRE, "agent");
            asm volatile("s_waitcnt vmcnt(0)" ::: "memory");
        }
    }
    __syncthreads();
}

__global__ void __launch_bounds__(NTHREADS, 2) hybrid_fwd(Args A) {
    extern __shared__ __attribute__((aligned(16))) unsigned char lds[];
    cg::grid_group grid = cg::this_grid();
    LAS unsigned char* L = (LAS unsigned char*)lds;
    unsigned char* ws = A.ws;
    const int G = gridDim.x;
    float* XL = A.out; float* XC = (float*)(ws + WS_XC);
    bf16_t* XN = (bf16_t*)(ws + WS_XN); bf16_t* ACT = (bf16_t*)(ws + WS_ACT);
    const float* gatef = (const float*)(ws + WS_GATE);

    const int wv = __builtin_amdgcn_readfirstlane((int)threadIdx.x >> 6);
    volatile LAS unsigned* MISC = (volatile LAS unsigned*)(L + 131072 + 320);
    if (threadIdx.x < 32) MISC[threadIdx.x] = 0u;
    __syncthreads();
    XcdBarrier xbar = xcd_barrier_post((unsigned*)ws + 4096, MISC + 8);
#define GSYNC() xcd_barrier(xbar)
#pragma unroll 1
    for (int l = 0; l < 4; ++l) { phase_prep(A, L, l, (int)((blockIdx.x + 64 * l) % G), G, wv); LBAR(); }
    if (A.out == nullptr) grid.sync();
    for (int rep = 0; rep < DUP_SYNC; ++rep) GSYNC();
#pragma unroll 1
    for (int layer = 0; layer < 4; ++layer) {
        ws = ows(ws);
        const int kind = layer == 3 ? 0 : layer;
        const int Nin = kind == 0 ? 2560 : (kind == 1 ? 2048 : 4096);
        const float* xinL = layer == 0 ? A.in[0] : XL; const float* xinC = layer == 0 ? A.in[2] : XC;
        for (int rep = 0; rep < DUP_NORM; ++rep) phase_norm(A, layer, xinL, xinC, L, wv);
        GSYNC();
        {
            const bf16_t* Wt = (const bf16_t*)(ws + (layer == 0 ? WS_WIN[0] : layer == 1 ? WS_WIN[1] : layer == 2 ? WS_WIN[2] : WS_WIN[3]));
            pg8::Gemm g{XN, Wt, layer == 3 ? ML : MT, Nin, DM};
            pg8::OrderG S; S.so.init(layer == 3 ? ML : MT, Nin, G, (int)blockIdx.x); S.extra = layer == 3 ? 16 : 0;
            pg8::EpiIn E{ACT, Nin, kind, (const float*)(ws + WS_ROPE)};
            for (int rep = 0; rep < DUP_GIN; ++rep) pg8::gemm_phase<pg8::EpiIn, pg8::OrderG, true, true>(L, g, S, E, wv);
        }
        GSYNC();
        if (kind == 0) { for (int rep = 0; rep < DUP_ATTN; ++rep) phase_attn(ACT, XN, (layer == 0 ? A.in[9] : A.in[34]), layer == 0, L, wv); }
        else if (kind == 1) { for (int rep = 0; rep < DUP_LRU; ++rep) phase_lru(A, ACT, XN, (float*)(ws + WS_HF), L, wv); }
        else { for (int rep = 0; rep < DUP_CONV; ++rep) phase_conv(A, ACT, XN, wv); }
        GSYNC();
        {
            const bf16_t* Wt = (const bf16_t*)(ws + (layer == 0 ? WS_WOUT[0] : layer == 1 ? WS_WOUT[1] : layer == 2 ? WS_WOUT[2] : WS_WOUT[3]));
            const int Mo = (CTX_SMALL || layer == 3) ? ML : MT;
            pg8::Gemm g{XN, Wt, Mo, DM, DM};
            pg8::OrderG S; S.so.init(Mo, DM, G, (int)blockIdx.x); S.extra = 0;
            pg8::EpiRes E{xinL, xinC, XL, XC, gatef + (size_t)layer * 9 * 1024};
            const bool ctx_first = (blockIdx.x & 1) != 0;
#pragma unroll 1
            for (int step = 0; step < 2; ++step) {
                if ((step == 0) == ctx_first) { if (CTX_SMALL && layer < 3) phase_ctx_wout(XN + (size_t)ML * DM, Wt, xinC, XC, gatef + (size_t)(layer * 9 + 8) * 1024, L, wv); }
                else pg8::gemm_phase<pg8::EpiRes, pg8::OrderG, true, true>(L, g, S, E, wv);
            }
        }
        GSYNC();
    }
    phase_final(XL, A.in[35], wv);
}

extern "C" void kernel_launch(void* const* d_in, const int* in_sizes, int n_in, void* d_out, int out_size, void* d_ws, size_t ws_size, hipStream_t stream) {
    static int grid = 0;
    if (grid == 0) {
        if (n_in != 36 || out_size != ML * DM || ws_size < WS_END) { fprintf(stderr, "kernel_launch: unexpected shapes (n_in %d, out %d, ws %zu)\n", n_in, out_size, ws_size); grid = -1; return; }
        int dev = 0, cus = 0, per_cu = 0;
        hipGetDevice(&dev); hipDeviceGetAttribute(&cus, hipDeviceAttributeMultiprocessorCount, dev);
        if (hipFuncSetAttribute((const void*)hybrid_fwd, hipFuncAttributeMaxDynamicSharedMemorySize, LDS_BYTES) != hipSuccess) { fprintf(stderr, "kernel_launch: hipFuncSetAttribute failed\n"); grid = -1; return; }
        if (hipOccupancyMaxActiveBlocksPerMultiprocessor(&per_cu, (const void*)hybrid_fwd, NTHREADS, LDS_BYTES) != hipSuccess || per_cu < 1) { fprintf(stderr, "kernel_launch: occupancy query says %d\n", per_cu); per_cu = 1; }
        (void)hipGetLastError();
        grid = cus * (per_cu > 1 ? 1 : per_cu);
        if (grid > 256) grid = 256;
    }
    if (grid < 0) return;
    if (hipMemsetAsync(d_ws, 0, 65536, stream) != hipSuccess) { fprintf(stderr, "kernel_launch: memset failed\n"); return; }
    Args a{};
    for (int i = 0; i < 36; ++i) a.in[i] = (const float*)d_in[i];
    a.out = (float*)d_out; a.ws = (unsigned char*)d_ws;
    void* args[] = {&a};
    hipError_t e = hipLaunchCooperativeKernel((const void*)hybrid_fwd, dim3(grid), dim3(NTHREADS), args, LDS_BYTES, stream);
    if (e != hipSuccess) fprintf(stderr, "kernel_launch: cooperative launch failed: %s (grid %d)\n", hipGetErrorString(e), grid);
}
```
